# Optimizing an MI355X kernel written in HIP

```python
import math
import jax, jax.numpy as jnp
from jax import lax
import numpy as np

D_MODEL = 1024
BATCH = 4
SEQ = 8192
DEPTH = 1

D_MIX = D_MODEL
D_LRU = D_MIX // 2
D_HY = D_MIX - D_LRU
LRU_HEADS = 8
LRU_HEAD_DIM = D_LRU // LRU_HEADS
LRU_CONV = 4
LRU_C = 8.0
HY_ORDER = 2
HY_CONV = 3
HY_BANDS = 16
HY_EMB = 2 * HY_BANDS + 1
HY_FFN = 64
HY_FAST_DECAY_PCT = 0.3
HY_SLOW_DECAY_PCT = 1.5
HY_DECAY_TARGET = 1e-2
D_IN = 2 * D_LRU + (HY_ORDER + 1) * D_HY
N_GROUPS = 4
EXPERTS_PER_GROUP = 8
N_EXPERTS = N_GROUPS * EXPERTS_PER_GROUP
TOP_K = 2
D_EXPERT = D_MODEL // 2
MOE_BLOCK = 128
EPS = 1e-6

kernel_name = "hybrid_lru_hyena_hmoe_encoder"


def _rmsnorm(x, g):
    x32 = x.astype(jnp.float32)
    y = x32 * lax.rsqrt(jnp.mean(x32 * x32, axis=-1, keepdims=True) + EPS)
    return (y * g.astype(jnp.float32)).astype(x.dtype)


def _dwconv(x, w, b, pad):
    c = x.shape[-1]
    y = lax.conv_general_dilated(x, w[:, None, :].astype(x.dtype), window_strides=(1,), padding=[pad], dimension_numbers=("NWC", "WIO", "NWC"), feature_group_count=c)
    return y + b.astype(x.dtype)


def _lin_combine(c1, c2):
    a1, b1 = c1
    a2, b2 = c2
    return a1 * a2, a2 * b1 + b2


def _rg_lru(xc, wr, br, wi, bi, lam, reverse):
    bsz, seq, c = xc.shape
    xh = xc.reshape(bsz, seq, LRU_HEADS, LRU_HEAD_DIM)
    r = jax.nn.sigmoid((jnp.einsum("bshi,hij->bshj", xh, wr).reshape(bsz, seq, c) + br).astype(jnp.float32))
    i = jax.nn.sigmoid((jnp.einsum("bshi,hij->bshj", xh, wi).reshape(bsz, seq, c) + bi).astype(jnp.float32))
    log_a = -LRU_C * r * jax.nn.softplus(-lam.astype(jnp.float32))
    a = jnp.exp(log_a)
    b = jnp.sqrt(-jnp.expm1(2.0 * log_a)) * (i * xc.astype(jnp.float32))
    _, h = lax.associative_scan(_lin_combine, (a, b), axis=1, reverse=reverse)
    return h


def _hyena_filters(seq, fw1, fb1, ff1, fw2, fb2, ff2, fw3):
    f32 = jnp.float32
    pos = jnp.arange(seq, dtype=f32)
    t = jnp.linspace(0.0, 1.0, seq, dtype=f32)
    w = (2.0 * math.pi / seq) * pos
    bands = jnp.linspace(1e-4, HY_BANDS - 1, HY_BANDS, dtype=f32)
    ang = w[:, None] * bands[None, :]
    feats = jnp.concatenate([t[:, None], jnp.cos(ang), jnp.sin(ang)], axis=-1)
    z = jnp.sin(ff1.astype(f32) * (feats @ fw1.astype(f32) + fb1.astype(f32)))
    z = jnp.sin(ff2.astype(f32) * (z @ fw2.astype(f32) + fb2.astype(f32)))
    h = (z @ fw3.astype(f32)).reshape(seq, 2, HY_ORDER, D_HY)
    deltas = jnp.abs(jnp.linspace(math.log(HY_DECAY_TARGET) / HY_SLOW_DECAY_PCT, math.log(HY_DECAY_TARGET) / HY_FAST_DECAY_PCT, D_HY, dtype=f32))
    h = h * jnp.exp(-t[:, None, None, None] * deltas)
    hf, hb = h[:, 0], h[:, 1]
    k = jnp.concatenate([hf, jnp.zeros((1, HY_ORDER, D_HY), f32), hb[1:][::-1]], axis=0)
    k = k / (jnp.sum(jnp.abs(k), axis=0, keepdims=True) + EPS)
    return jnp.fft.rfft(k, axis=0)


def _long_conv(z, kf, skip):
    seq = z.shape[1]
    zf = jnp.fft.rfft(z, n=2 * seq, axis=1)
    y = jnp.fft.irfft(zf * kf[None], n=2 * seq, axis=1)[:, :seq]
    return y + z * skip


def _hyena(u, conv_w, conv_b, kf, skip):
    uc = _dwconv(u, conv_w, conv_b, (1, 1)).astype(jnp.float32)
    v, x1, x2 = uc[..., :D_HY], uc[..., D_HY:2 * D_HY], uc[..., 2 * D_HY:]
    skip = skip.astype(jnp.float32)
    z = x1 * _long_conv(v, kf[:, 0], skip[0])
    z = x2 * _long_conv(z, kf[:, 1], skip[1])
    return z


def _hier_moe(h, wg, bg, we, be, w1, w3, w2):
    bsz, seq, d = h.shape
    n_tok = bsz * seq
    hf = h.reshape(n_tok, d)
    lg = (hf @ wg + bg).astype(jnp.float32)
    pg = jax.nn.softmax(lg, axis=-1)
    g_idx = jnp.argmax(lg, axis=-1)
    g_p = jnp.take_along_axis(pg, g_idx[:, None], axis=1)[:, 0]
    le = (hf @ we + be).astype(jnp.float32).reshape(n_tok, N_GROUPS, EXPERTS_PER_GROUP)
    le = jnp.take_along_axis(le, g_idx[:, None, None], axis=1)[:, 0]
    pe = jax.nn.softmax(le, axis=-1)
    top_p, top_i = lax.top_k(pe, TOP_K)
    gate = g_p[:, None] * top_p / jnp.sum(top_p, axis=-1, keepdims=True)
    eid = (g_idx[:, None] * EXPERTS_PER_GROUP + top_i).astype(jnp.int32)
    n_assign = n_tok * TOP_K
    flat_e = eid.reshape(n_assign)
    order = jnp.argsort(flat_e)
    sorted_e = flat_e[order]
    sorted_tok = (order // TOP_K).astype(jnp.int32)
    sorted_gate = gate.reshape(n_assign)[order]
    counts = jnp.bincount(flat_e, length=N_EXPERTS).astype(jnp.int32)
    padded = (counts + MOE_BLOCK - 1) // MOE_BLOCK * MOE_BLOCK
    raw_start = jnp.cumsum(counts) - counts
    pad_end = jnp.cumsum(padded)
    pad_start = pad_end - padded
    dest = pad_start[sorted_e] + jnp.arange(n_assign, dtype=jnp.int32) - raw_start[sorted_e]
    n_blocks = (n_assign + MOE_BLOCK - 1) // MOE_BLOCK + N_EXPERTS
    n_slots = n_blocks * MOE_BLOCK
    slot_tok = jnp.full((n_slots,), n_tok, jnp.int32).at[dest].set(sorted_tok)
    block_e = jnp.minimum(jnp.searchsorted(pad_end, jnp.arange(n_blocks, dtype=jnp.int32) * MOE_BLOCK, side="right"), N_EXPERTS - 1)
    h_pad = jnp.concatenate([hf, jnp.zeros((1, d), hf.dtype)], axis=0)
    xb = h_pad[slot_tok].reshape(n_blocks, MOE_BLOCK, d)

    def expert_block(args):
        xblk, e = args
        a = jax.nn.silu(xblk @ w1[e]) * (xblk @ w3[e])
        return a @ w2[e]

    yb = lax.map(expert_block, (xb, block_e)).reshape(n_slots, d)
    y = jnp.zeros((n_tok, d), h.dtype).at[sorted_tok].add(yb[dest] * sorted_gate[:, None].astype(h.dtype))
    return y.reshape(bsz, seq, d)


def setup_inputs(seed: int = 0) -> dict:
    key = jax.random.key(seed)
    ks = iter(jax.random.split(key, 48))

    def nrm(shape, scale):
        return jax.random.normal(next(ks), shape, jnp.float32) * scale

    def gain(shape):
        return 1.0 + nrm(shape, 0.02)

    def lam_init():
        u = jax.random.uniform(next(ks), (DEPTH, D_LRU), jnp.float32, minval=0.9, maxval=0.999)
        a = u ** (1.0 / LRU_C)
        return jnp.log(a) - jnp.log1p(-a)

    hd = LRU_HEAD_DIM
    return {
        "x": nrm((BATCH, SEQ, D_MODEL), 1.0),
        "norm_mix_g": gain((DEPTH, D_MODEL)),
        "w_in": nrm((DEPTH, D_MODEL, D_IN), D_MODEL ** -0.5),
        "lru_conv_w": nrm((DEPTH, LRU_CONV, D_LRU), LRU_CONV ** -0.5),
        "lru_conv_b": nrm((DEPTH, D_LRU), 0.01),
        "lru_wr_f": nrm((DEPTH, LRU_HEADS, hd, hd), hd ** -0.5),
        "lru_br_f": nrm((DEPTH, D_LRU), 0.01),
        "lru_wi_f": nrm((DEPTH, LRU_HEADS, hd, hd), hd ** -0.5),
        "lru_bi_f": nrm((DEPTH, D_LRU), 0.01),
        "lru_lambda_f": lam_init(),
        "lru_wr_b": nrm((DEPTH, LRU_HEADS, hd, hd), hd ** -0.5),
        "lru_br_b": nrm((DEPTH, D_LRU), 0.01),
        "lru_wi_b": nrm((DEPTH, LRU_HEADS, hd, hd), hd ** -0.5),
        "lru_bi_b": nrm((DEPTH, D_LRU), 0.01),
        "lru_lambda_b": lam_init(),
        "hy_conv_w": nrm((DEPTH, HY_CONV, (HY_ORDER + 1) * D_HY), HY_CONV ** -0.5),
        "hy_conv_b": nrm((DEPTH, (HY_ORDER + 1) * D_HY), 0.01),
        "hy_filt_w1": nrm((DEPTH, HY_EMB, HY_FFN), HY_EMB ** -0.5),
        "hy_filt_b1": nrm((DEPTH, HY_FFN), 0.1),
        "hy_filt_freq1": gain((DEPTH, HY_FFN)),
        "hy_filt_w2": nrm((DEPTH, HY_FFN, HY_FFN), HY_FFN ** -0.5),
        "hy_filt_b2": nrm((DEPTH, HY_FFN), 0.1),
        "hy_filt_freq2": gain((DEPTH, HY_FFN)),
        "hy_filt_w3": nrm((DEPTH, HY_FFN, 2 * HY_ORDER * D_HY), HY_FFN ** -0.5),
        "hy_skip": nrm((DEPTH, HY_ORDER, D_HY), 1.0),
        "grp_norm_lru_g": gain((DEPTH, D_LRU)),
        "grp_norm_hy_g": gain((DEPTH, D_HY)),
        "w_out": nrm((DEPTH, D_MIX, D_MODEL), D_MIX ** -0.5),
        "norm_ffn_g": gain((DEPTH, D_MODEL)),
        "router_group_w": nrm((DEPTH, D_MODEL, N_GROUPS), D_MODEL ** -0.5),
        "router_group_b": nrm((DEPTH, N_GROUPS), 0.01),
        "router_expert_w": nrm((DEPTH, D_MODEL, N_EXPERTS), D_MODEL ** -0.5),
        "router_expert_b": nrm((DEPTH, N_EXPERTS), 0.01),
        "exp_w1": nrm((DEPTH, N_EXPERTS, D_MODEL, D_EXPERT), D_MODEL ** -0.5),
        "exp_w3": nrm((DEPTH, N_EXPERTS, D_MODEL, D_EXPERT), D_MODEL ** -0.5),
        "exp_w2": nrm((DEPTH, N_EXPERTS, D_EXPERT, D_MODEL), D_EXPERT ** -0.5),
        "norm_final_g": gain((D_MODEL,)),
    }


def reference(x, norm_mix_g, w_in, lru_conv_w, lru_conv_b, lru_wr_f, lru_br_f, lru_wi_f, lru_bi_f, lru_lambda_f, lru_wr_b, lru_br_b, lru_wi_b, lru_bi_b, lru_lambda_b, hy_conv_w, hy_conv_b, hy_filt_w1, hy_filt_b1, hy_filt_freq1, hy_filt_w2, hy_filt_b2, hy_filt_freq2, hy_filt_w3, hy_skip, grp_norm_lru_g, grp_norm_hy_g, w_out, norm_ffn_g, router_group_w, router_group_b, router_expert_w, router_expert_b, exp_w1, exp_w3, exp_w2, norm_final_g):
    seq = x.shape[1]
    for l in range(DEPTH):
        hn = _rmsnorm(x, norm_mix_g[l])
        proj = hn @ w_in[l]
        lru_x = proj[..., :D_LRU]
        lru_gate = proj[..., D_LRU:2 * D_LRU]
        hy_u = proj[..., 2 * D_LRU:]
        xc = _dwconv(lru_x, lru_conv_w[l], lru_conv_b[l], (2, 1))
        h_lru = _rg_lru(xc, lru_wr_f[l], lru_br_f[l], lru_wi_f[l], lru_bi_f[l], lru_lambda_f[l], False) + _rg_lru(xc, lru_wr_b[l], lru_br_b[l], lru_wi_b[l], lru_bi_b[l], lru_lambda_b[l], True)
        y_lru = (h_lru * jax.nn.gelu(lru_gate.astype(jnp.float32))).astype(x.dtype)
        kf = _hyena_filters(seq, hy_filt_w1[l], hy_filt_b1[l], hy_filt_freq1[l], hy_filt_w2[l], hy_filt_b2[l], hy_filt_freq2[l], hy_filt_w3[l])
        y_hy = _hyena(hy_u, hy_conv_w[l], hy_conv_b[l], kf, hy_skip[l]).astype(x.dtype)
        y_cat = jnp.concatenate([_rmsnorm(y_lru, grp_norm_lru_g[l]), _rmsnorm(y_hy, grp_norm_hy_g[l])], axis=-1)
        x = x + y_cat @ w_out[l]
        x = x + _hier_moe(_rmsnorm(x, norm_ffn_g[l]), router_group_w[l], router_group_b[l], router_expert_w[l], router_expert_b[l], exp_w1[l], exp_w3[l], exp_w2[l])
    return _rmsnorm(x, norm_final_g)
```

```cpp
#include <hip/hip_runtime.h>
#include <stdint.h>

typedef unsigned short bf16;
__device__ __forceinline__ float bf2f(bf16 v) { return __uint_as_float(((unsigned)v) << 16); }
__device__ __forceinline__ bf16 f2bf(float f) { unsigned u = __float_as_uint(f); u += 0x7fffu + ((u >> 16) & 1u); return (bf16)(u >> 16); }

constexpr int NB = 4, SEQ = 8192, DM = 1024, NTOK = NB * SEQ, DIN = 2560, DL = 512, DH = 512;
constexpr float EPS = 1e-6f;

__device__ __forceinline__ float wave_sum(float v) {
#pragma unroll
    for (int o = 1; o < 64; o <<= 1) v += __shfl_xor(v, o);
    return v;
}
__device__ __forceinline__ float gelu_tanh(float x) { return 0.5f * x * (1.0f + tanhf(0.7978845608028654f * (x + 0.044715f * x * x * x))); }

__global__ __launch_bounds__(256) void k_rmsnorm_bf16(const float* __restrict__ x, const float* __restrict__ g, bf16* __restrict__ out) {
    const int wave = threadIdx.x >> 6, lane = threadIdx.x & 63;
    const int row = blockIdx.x * 4 + wave;
    const float4* xr = (const float4*)(x + (size_t)row * DM);
    float4 v[4]; float s = 0.f;
#pragma unroll
    for (int j = 0; j < 4; ++j) { v[j] = xr[lane + 64 * j]; s += v[j].x * v[j].x + v[j].y * v[j].y + v[j].z * v[j].z + v[j].w * v[j].w; }
    s = wave_sum(s);
    const float rstd = rsqrtf(s * (1.0f / DM) + EPS);
#pragma unroll
    for (int j = 0; j < 4; ++j) {
        const int c = (lane + 64 * j) * 4;
        const float4 gg = *(const float4*)(g + c);
        ushort4 o; o.x = f2bf(v[j].x * rstd * gg.x); o.y = f2bf(v[j].y * rstd * gg.y); o.z = f2bf(v[j].z * rstd * gg.z); o.w = f2bf(v[j].w * rstd * gg.w);
        *(ushort4*)(out + (size_t)row * DM + c) = o;
    }
}

template <int MODE>
__global__ __launch_bounds__(256) void k_gemm_naive(const bf16* __restrict__ A, const float* __restrict__ B, int M, int N, int K,
                                                    bf16* __restrict__ o_lru, bf16* __restrict__ o_hyT, const float* __restrict__ xres, float* __restrict__ o_f32) {
    __shared__ float As[16][68];
    __shared__ float Bs[16][64];
    const int tid = threadIdx.x, tx = tid & 15, ty = tid >> 4;
    const int m0 = blockIdx.y * 64, n0 = blockIdx.x * 64;
    float acc[4][4];
#pragma unroll
    for (int i = 0; i < 4; ++i)
#pragma unroll
        for (int j = 0; j < 4; ++j) acc[i][j] = 0.f;
    for (int k0 = 0; k0 < K; k0 += 16) {
        { const int r = tid >> 2, kq = (tid & 3) * 4; const ushort4 v = *(const ushort4*)(A + (size_t)(m0 + r) * K + k0 + kq);
          As[kq + 0][r] = bf2f(v.x); As[kq + 1][r] = bf2f(v.y); As[kq + 2][r] = bf2f(v.z); As[kq + 3][r] = bf2f(v.w); }
        { const int kr = tid >> 4, nq = (tid & 15) * 4; const float4 v = *(const float4*)(B + (size_t)(k0 + kr) * N + n0 + nq);
          Bs[kr][nq + 0] = v.x; Bs[kr][nq + 1] = v.y; Bs[kr][nq + 2] = v.z; Bs[kr][nq + 3] = v.w; }
        __syncthreads();
#pragma unroll
        for (int kk = 0; kk < 16; ++kk) {
            float a[4], b[4];
#pragma unroll
            for (int i = 0; i < 4; ++i) a[i] = As[kk][ty * 4 + i];
#pragma unroll
            for (int j = 0; j < 4; ++j) b[j] = Bs[kk][tx * 4 + j];
#pragma unroll
            for (int i = 0; i < 4; ++i)
#pragma unroll
                for (int j = 0; j < 4; ++j) acc[i][j] += a[i] * b[j];
        }
        __syncthreads();
    }
#pragma unroll
    for (int i = 0; i < 4; ++i)
#pragma unroll
        for (int j = 0; j < 4; ++j) {
            const int row = m0 + ty * 4 + i, col = n0 + tx * 4 + j;
            if (MODE == 0) {
                if (col < 1024) o_lru[(size_t)row * 1024 + col] = f2bf(acc[i][j]);
                else o_hyT[(size_t)(col - 1024) * NTOK + row] = f2bf(acc[i][j]);
            } else {
                o_f32[(size_t)row * N + col] = xres[(size_t)row * N + col] + acc[i][j];
            }
        }
}

__global__ __launch_bounds__(256) void k_lru_conv(const bf16* __restrict__ lru, const float* __restrict__ w, const float* __restrict__ bias, float* __restrict__ xc) {
    const size_t idx = (size_t)blockIdx.x * 256 + threadIdx.x;
    const int c = (int)(idx & 511); const int tok = (int)(idx >> 9); const int t = tok & (SEQ - 1);
    float s = bias[c];
#pragma unroll
    for (int j = 0; j < 4; ++j) { const int tt = t + j - 2; if (tt >= 0 && tt < SEQ) s += w[j * DL + c] * bf2f(lru[(size_t)(tok + j - 2) * 1024 + c]); }
    xc[idx] = s;
}

__global__ __launch_bounds__(64) void k_lru_scan(const float* __restrict__ xc,
        const float* __restrict__ wr_f, const float* __restrict__ br_f, const float* __restrict__ wi_f, const float* __restrict__ bi_f, const float* __restrict__ lam_f,
        const float* __restrict__ wr_b, const float* __restrict__ br_b, const float* __restrict__ wi_b, const float* __restrict__ bi_b, const float* __restrict__ lam_b,
        bf16* __restrict__ hf, bf16* __restrict__ hb) {
    __shared__ float wr_s[4096], wi_s[4096], xs[64];
    const int b = blockIdx.x >> 4, h = (blockIdx.x >> 1) & 7, dir = blockIdx.x & 1;
    const float* wr = dir ? wr_b : wr_f; const float* br = dir ? br_b : br_f; const float* wi = dir ? wi_b : wi_f; const float* bi = dir ? bi_b : bi_f; const float* lam = dir ? lam_b : lam_f;
    bf16* out = dir ? hb : hf;
    const int tid = threadIdx.x, c = h * 64 + tid;
    for (int i = tid; i < 4096; i += 64) { wr_s[i] = wr[h * 4096 + i]; wi_s[i] = wi[h * 4096 + i]; }
    const float br_ = br[c], bi_ = bi[c];
    const float sp = log1pf(expf(-lam[c]));
    float hs = 0.f;
    for (int step = 0; step < SEQ; ++step) {
        const int t = dir ? (SEQ - 1 - step) : step;
        const float xv = xc[((size_t)(b * SEQ + t)) * DL + c];
        __syncthreads(); xs[tid] = xv; __syncthreads();
        float dr = br_, di = bi_;
#pragma unroll 16
        for (int i = 0; i < 64; ++i) { const float xx = xs[i]; dr += xx * wr_s[i * 64 + tid]; di += xx * wi_s[i * 64 + tid]; }
        const float r = 1.0f / (1.0f + expf(-dr)), ig = 1.0f / (1.0f + expf(-di));
        const float la = -8.0f * r * sp;
        const float a = expf(la);
        const float bb = sqrtf(-expm1f(2.0f * la)) * (ig * xv);
        hs = a * hs + bb;
        out[((size_t)(b * SEQ + t)) * DL + c] = f2bf(hs);
    }
}

__global__ __launch_bounds__(64) void k_filt_z(const float* __restrict__ w1, const float* __restrict__ b1, const float* __restrict__ f1,
                                               const float* __restrict__ w2, const float* __restrict__ b2, const float* __restrict__ f2, float* __restrict__ z2out) {
    __shared__ float feats[33], z1[64];
    const int t = blockIdx.x, tid = threadIdx.x;
    const float tn = (float)t / (float)(SEQ - 1);
    const float w = (6.283185307179586f / (float)SEQ) * (float)t;
    if (tid == 0) feats[0] = tn;
    if (tid < 16) { const float band = 1e-4f + (float)tid * ((15.0f - 1e-4f) / 15.0f); const float ang = w * band; feats[1 + tid] = cosf(ang); feats[17 + tid] = sinf(ang); }
    __syncthreads();
    float s = b1[tid];
    for (int i = 0; i < 33; ++i) s += feats[i] * w1[i * 64 + tid];
    z1[tid] = sinf(f1[tid] * s);
    __syncthreads();
    s = b2[tid];
    for (int i = 0; i < 64; ++i) s += z1[i] * w2[i * 64 + tid];
    z2out[t * 64 + tid] = sinf(f2[tid] * s);
}
__global__ __launch_bounds__(256) void k_filt_h(const float* __restrict__ z2, const float* __restrict__ w3, float* __restrict__ kT) {
    __shared__ float zr[64];
    const int t = blockIdx.x, tid = threadIdx.x;
    if (tid < 64) zr[tid] = z2[t * 64 + tid];
    __syncthreads();
    const float tn = (float)t / (float)(SEQ - 1);
    const float lo = logf(1e-2f) / 1.5f, hi = logf(1e-2f) / 0.3f;
    for (int col = tid; col < 2048; col += 256) {
        float h = 0.f;
        for (int j = 0; j < 64; ++j) h += zr[j] * w3[j * 2048 + col];
        const int dir = col >> 10, o = (col >> 9) & 1, c = col & 511;
        const float delta = fabsf(lo + (float)c * ((hi - lo) / 511.0f));
        h *= expf(-tn * delta);
        const size_t row = (size_t)(o * 512 + c) * 16384;
        if (dir == 0) kT[row + 8192 + t] = h;
        else { if (t == 0) kT[row] = 0.f; else kT[row + 8192 - t] = h; }
    }
}
__global__ __launch_bounds__(256) void k_filt_norm(float* __restrict__ kT) {
    __shared__ float red[4];
    float* row = kT + (size_t)blockIdx.x * 16384;
    float s = 0.f;
    for (int i = threadIdx.x; i < 16384; i += 256) s += fabsf(row[i]);
    s = wave_sum(s);
    if ((threadIdx.x & 63) == 0) red[threadIdx.x >> 6] = s;
    __syncthreads();
    const float inv = 1.0f / (red[0] + red[1] + red[2] + red[3] + EPS);
    for (int i = threadIdx.x; i < 16384; i += 256) row[i] *= inv;
}

__device__ __forceinline__ float hy_dwconv(const bf16* __restrict__ hyuT, const float* __restrict__ cw, const float* __restrict__ cb, int ch, int b, int t) {
    const bf16* p = hyuT + (size_t)ch * NTOK + b * SEQ;
    float s = cb[ch] + cw[1 * 1536 + ch] * bf2f(p[t]);
    if (t > 0) s += cw[0 * 1536 + ch] * bf2f(p[t - 1]);
    if (t < SEQ - 1) s += cw[2 * 1536 + ch] * bf2f(p[t + 1]);
    return s;
}
template <int ORDER>
__global__ __launch_bounds__(256) void k_hy_conv(const bf16* __restrict__ hyuT, const float* __restrict__ cw, const float* __restrict__ cb, const float* __restrict__ kT,
                                                 const float* __restrict__ skip, float* __restrict__ z1T, bf16* __restrict__ y_hyT) {
    __shared__ float kk[16384];
    __shared__ float4 zs[1024];
    const int c = blockIdx.x >> 5, tile = blockIdx.x & 31, tid = threadIdx.x, t = tile * 256 + tid;
    const float* krow = kT + (size_t)((ORDER - 1) * 512 + c) * 16384;
    for (int i = tid; i < 16384; i += 256) kk[i] = krow[i];
    float acc0 = 0.f, acc1 = 0.f, acc2 = 0.f, acc3 = 0.f;
    for (int s0 = 0; s0 < SEQ; s0 += 1024) {
        __syncthreads();
        for (int i = tid; i < 1024; i += 256) {
            float4 v;
            if (ORDER == 1) { v.x = hy_dwconv(hyuT, cw, cb, c, 0, s0 + i); v.y = hy_dwconv(hyuT, cw, cb, c, 1, s0 + i); v.z = hy_dwconv(hyuT, cw, cb, c, 2, s0 + i); v.w = hy_dwconv(hyuT, cw, cb, c, 3, s0 + i); }
            else { const float* p = z1T + (size_t)c * NTOK + s0 + i; v.x = p[0]; v.y = p[SEQ]; v.z = p[2 * SEQ]; v.w = p[3 * SEQ]; }
            zs[i] = v;
        }
        __syncthreads();
        const float* kp = kk + 8192 + t - s0;
#pragma unroll 8
        for (int s = 0; s < 1024; ++s) { const float kv = kp[-s]; const float4 z = zs[s]; acc0 += kv * z.x; acc1 += kv * z.y; acc2 += kv * z.z; acc3 += kv * z.w; }
    }
    const float sk = skip[(ORDER - 1) * 512 + c];
    float accs[4] = {acc0, acc1, acc2, acc3};
#pragma unroll
    for (int b = 0; b < 4; ++b) {
        float zv, gate;
        if (ORDER == 1) { zv = hy_dwconv(hyuT, cw, cb, c, b, t); gate = hy_dwconv(hyuT, cw, cb, 512 + c, b, t); }
        else { zv = z1T[(size_t)c * NTOK + b * SEQ + t]; gate = hy_dwconv(hyuT, cw, cb, 1024 + c, b, t); }
        const float y = gate * (accs[b] + sk * zv);
        if (ORDER == 1) z1T[(size_t)c * NTOK + b * SEQ + t] = y; else y_hyT[(size_t)c * NTOK + b * SEQ + t] = f2bf(y);
    }
}

__device__ __forceinline__ float block_sum_256(float v, float* red) {
    v = wave_sum(v);
    __syncthreads();
    if ((threadIdx.x & 63) == 0) red[threadIdx.x >> 6] = v;
    __syncthreads();
    return red[0] + red[1] + red[2] + red[3];
}
__global__ __launch_bounds__(256) void k_combine(const bf16* __restrict__ hf, const bf16* __restrict__ hb, const bf16* __restrict__ lru, const bf16* __restrict__ y_hyT,
                                                 const float* __restrict__ gA, const float* __restrict__ gB, bf16* __restrict__ y_cat) {
    __shared__ float red[4];
    const int tok = blockIdx.x, tid = threadIdx.x;
    float ya[2], yb[2]; float sa = 0.f, sb = 0.f;
#pragma unroll
    for (int j = 0; j < 2; ++j) {
        const int c = tid + 256 * j;
        const float hsum = bf2f(hf[(size_t)tok * DL + c]) + bf2f(hb[(size_t)tok * DL + c]);
        const float gate = bf2f(lru[(size_t)tok * 1024 + 512 + c]);
        ya[j] = hsum * gelu_tanh(gate); sa += ya[j] * ya[j];
        yb[j] = bf2f(y_hyT[(size_t)c * NTOK + tok]); sb += yb[j] * yb[j];
    }
    sa = block_sum_256(sa, red); sb = block_sum_256(sb, red);
    const float ra = rsqrtf(sa * (1.0f / DL) + EPS), rb = rsqrtf(sb * (1.0f / DH) + EPS);
#pragma unroll
    for (int j = 0; j < 2; ++j) {
        const int c = tid + 256 * j;
        y_cat[(size_t)tok * 1024 + c] = f2bf(ya[j] * ra * gA[c]);
        y_cat[(size_t)tok * 1024 + 512 + c] = f2bf(yb[j] * rb * gB[c]);
    }
}

__global__ __launch_bounds__(256) void k_route(const float* __restrict__ xmid, const float* __restrict__ g, const float* __restrict__ wg, const float* __restrict__ bg,
                                               const float* __restrict__ we, const float* __restrict__ be, bf16* __restrict__ hn2, int* __restrict__ eid, float* __restrict__ gate) {
    __shared__ float hrow[1024];
    __shared__ float red[4];
    __shared__ float lg[36];
    const int tok = blockIdx.x, tid = threadIdx.x;
    const float4 v = *(const float4*)(xmid + (size_t)tok * DM + tid * 4);
    float s = v.x * v.x + v.y * v.y + v.z * v.z + v.w * v.w;
    s = block_sum_256(s, red);
    const float rstd = rsqrtf(s * (1.0f / DM) + EPS);
    const float4 gg = *(const float4*)(g + tid * 4);
    const float h0 = v.x * rstd * gg.x, h1 = v.y * rstd * gg.y, h2 = v.z * rstd * gg.z, h3 = v.w * rstd * gg.w;
    hrow[tid * 4 + 0] = h0; hrow[tid * 4 + 1] = h1; hrow[tid * 4 + 2] = h2; hrow[tid * 4 + 3] = h3;
    ushort4 o; o.x = f2bf(h0); o.y = f2bf(h1); o.z = f2bf(h2); o.w = f2bf(h3);
    *(ushort4*)(hn2 + (size_t)tok * DM + tid * 4) = o;
    __syncthreads();
    if (tid < 36) {
        float d;
        if (tid < 4) { d = bg[tid]; for (int k = 0; k < DM; ++k) d += hrow[k] * wg[k * 4 + tid]; }
        else { const int j = tid - 4; d = be[j]; for (int k = 0; k < DM; ++k) d += hrow[k] * we[k * 32 + j]; }
        lg[tid] = d;
    }
    __syncthreads();
    if (tid == 0) {
        int gi = 0; float gm = lg[0];
        for (int i = 1; i < 4; ++i) if (lg[i] > gm) { gm = lg[i]; gi = i; }
        float gs = 0.f; for (int i = 0; i < 4; ++i) gs += expf(lg[i] - gm);
        const float gp = 1.0f / gs;
        const float* le = lg + 4 + gi * 8;
        int i1 = 0; float m1 = le[0];
        for (int i = 1; i < 8; ++i) if (le[i] > m1) { m1 = le[i]; i1 = i; }
        int i2 = -1; float m2 = -3.0e38f;
        for (int i = 0; i < 8; ++i) if (i != i1 && le[i] > m2) { m2 = le[i]; i2 = i; }
        const float e1 = 1.0f, e2 = expf(m2 - m1);
        eid[tok * 2 + 0] = gi * 8 + i1; eid[tok * 2 + 1] = gi * 8 + i2;
        gate[tok * 2 + 0] = gp * e1 / (e1 + e2); gate[tok * 2 + 1] = gp * e2 / (e1 + e2);
    }
}

__global__ __launch_bounds__(512) void k_moe_final(const bf16* __restrict__ hn2, const int* __restrict__ eid, const float* __restrict__ gate,
                                                   const float* __restrict__ w1, const float* __restrict__ w3, const float* __restrict__ w2,
                                                   const float* __restrict__ gfin, float* __restrict__ out) {
    __shared__ float hrow[1024];
    __shared__ float act[512];
    __shared__ float red[8];
    const int tok = blockIdx.x, tid = threadIdx.x;
    hrow[tid] = bf2f(hn2[(size_t)tok * DM + tid]); hrow[tid + 512] = bf2f(hn2[(size_t)tok * DM + tid + 512]);
    float y0 = 0.f, y1 = 0.f;
    for (int k = 0; k < 2; ++k) {
        const int e = eid[tok * 2 + k]; const float gk = gate[tok * 2 + k];
        const float* W1 = w1 + (size_t)e * 1024 * 512; const float* W3 = w3 + (size_t)e * 1024 * 512; const float* W2 = w2 + (size_t)e * 512 * 1024;
        __syncthreads();
        float a = 0.f, b = 0.f;
#pragma unroll 8
        for (int i = 0; i < 1024; ++i) { const float hv = hrow[i]; a += hv * W1[(size_t)i * 512 + tid]; b += hv * W3[(size_t)i * 512 + tid]; }
        act[tid] = (a / (1.0f + expf(-a))) * b;
        __syncthreads();
        float p0 = 0.f, p1 = 0.f;
#pragma unroll 8
        for (int i = 0; i < 512; ++i) { const float av = act[i]; p0 += av * W2[(size_t)i * 1024 + tid]; p1 += av * W2[(size_t)i * 1024 + tid + 512]; }
        y0 += gk * p0; y1 += gk * p1;
    }
    const float v0 = out[(size_t)tok * DM + tid] + y0, v1 = out[(size_t)tok * DM + tid + 512] + y1;
    float s = v0 * v0 + v1 * v1;
    s = wave_sum(s);
    __syncthreads();
    if ((tid & 63) == 0) red[tid >> 6] = s;
    __syncthreads();
    float tot = 0.f;
#pragma unroll
    for (int i = 0; i < 8; ++i) tot += red[i];
    const float rstd = rsqrtf(tot * (1.0f / DM) + EPS);
    out[(size_t)tok * DM + tid] = v0 * rstd * gfin[tid];
    out[(size_t)tok * DM + tid + 512] = v1 * rstd * gfin[tid + 512];
}

constexpr size_t MiB = 1u << 20;
namespace pg8 {
#define PG8_LAS __attribute__((address_space(3)))
typedef unsigned short bf16_t;
typedef short bf16x8 __attribute__((ext_vector_type(8)));
typedef float f32x4 __attribute__((ext_vector_type(4)));
typedef unsigned u32x4 __attribute__((ext_vector_type(4)));
constexpr int BM = 256, BK = 64, HALF = 128, HTB = HALF * BK * 2  , STAGE_BYTES = 8 * HTB, NXCD = 8, WGM = 8;

__host__ __device__ __forceinline__ int lds_byte(int r, int c) { const int st = (r >> 4) * 2 + (c >> 5), rr = r & 15, cc = c & 31, ob = rr * 64 + cc * 2; return st * 1024 + (ob ^ (((ob >> 9) & 1) << 5)); }
__host__ __device__ __forceinline__ void stage_rc(int b, int& R, int& C) { const int st = b / 1024, sb = b % 1024, swz = sb ^ (((sb >> 9) & 1) << 5); R = (st >> 1) * 16 + swz / 64; C = (st & 1) * 32 + (swz % 64) / 2; }
__host__ __device__ __forceinline__ int perm32(int rho) { const int n = rho >> 4, i = rho & 15; return 8 * (i >> 2) + 4 * n + (i & 3); }

struct Unit { int pm, pn; };
struct Gemm { const bf16_t* A; const bf16_t* Bt; int M, N, K; };

struct StaticOrder {
    int nM, nN, nwg, G, c;
    __host__ __device__ void init(int M, int N, int G_, int c_) { nM = M / BM; nN = N / BM; nwg = nM * nN; G = G_; c = c_; }
    __host__ __device__ bool next(int i, Unit& u) const {
        const long L = (long)i * G + c; if (L >= nwg) return false;
        int wgid = (int)L; { const int q = nwg / NXCD, r = nwg % NXCD, xcd = wgid % NXCD, off = wgid / NXCD; wgid = (xcd < r ? xcd * (q + 1) : r * (q + 1) + (xcd - r) * q) + off; }
        const int nig = WGM * nN, gid = wgid / nig, fm = gid * WGM, gsz = (nM - fm) < WGM ? (nM - fm) : WGM;
        u.pm = fm + ((wgid % nig) % gsz); u.pn = (wgid % nig) / gsz; return true;
    }
    __device__ __forceinline__ void a_ready(const Unit&) const {}
    __device__ __forceinline__ void done(const Unit&) const {}
    __device__ __forceinline__ const char* a_base(const Gemm& g, const Unit& u) const { return (const char*)g.A + (size_t)u.pm * ((size_t)BM * g.K * 2); }
    __device__ __forceinline__ const char* b_base(const Gemm& g, const Unit& u) const { return (const char*)g.Bt + (size_t)u.pn * ((size_t)BM * g.K * 2); }
};

__device__ __forceinline__ unsigned cvt_pk_bf16(float lo, float hi) { unsigned r; asm volatile("v_cvt_pk_bf16_f32 %0, %1, %2" : "=v"(r) : "v"(lo), "v"(hi)); return r; }
typedef float f32x2 __attribute__((ext_vector_type(2)));
__device__ __forceinline__ f32x2 gelu_pk(f32x2 v) {
    const f32x2 av = __builtin_elementwise_abs(v), d = av * 0.2316418882f + 1.0f;
    f32x2 t; t.x = __builtin_amdgcn_rcpf(d.x); t.y = __builtin_amdgcn_rcpf(d.y);
    f32x2 q = t * 0.5307027145f + (-0.7265760135f); q = q * t + 0.7107068705f; q = q * t + (-0.142248368f); q = q * t + 0.127414796f; q = q * t;
    const f32x2 s = (v * v) * (-0.72134752044f);
    f32x2 e; e.x = __builtin_amdgcn_exp2f(s.x); e.y = __builtin_amdgcn_exp2f(s.y);
    const f32x2 m = v * (q * e), r = v - m;
    f32x2 o; o.x = v.x < 0.f ? m.x : r.x; o.y = v.y < 0.f ? m.y : r.y; return o;
}

template <int ACT  > struct EpiBf16 {
    static constexpr bool PERM = true, AFTER_DRAIN = false; static_assert(ACT == 0 || ACT == 1, "EpiBf16: ACT is 0 (none) or 1 (gelu_pk)");
    bf16_t* O; int ldc; const float* bias; int split_cols; size_t split_stride; float scale0;
    __device__ __forceinline__ void operator()(const f32x4 (&acc)[2][2][4][2], const Unit& u, int wr, int wc, int fr, int fq) const {
        const int row0 = u.pm * BM + wr * 64 + fr; int colt = u.pn * BM; bf16_t* base = O;
        float sc = 1.f; if (split_cols) { const int t = colt / split_cols; base += (size_t)t * split_stride; colt -= t * split_cols; if (t == 0) sc = scale0; }
        const int col0 = colt + wc * 32 + 8 * fq, bcol0 = u.pn * BM + wc * 32 + 8 * fq;
        f32x4 bv[2][2];
#pragma unroll
        for (int bj = 0; bj < 2; ++bj)
#pragma unroll
            for (int n = 0; n < 2; ++n) bv[bj][n] = bias ? *(const f32x4*)(bias + bcol0 + bj * HALF + 4 * n) : (f32x4){0.f, 0.f, 0.f, 0.f};
#pragma unroll
        for (int ai = 0; ai < 2; ++ai)
#pragma unroll
            for (int m = 0; m < 4; ++m) { bf16_t* rowp = base + (size_t)(row0 + ai * HALF + m * 16) * ldc + col0;
#pragma unroll
                for (int bj = 0; bj < 2; ++bj) { f32x4 v0 = acc[ai][bj][m][0] + bv[bj][0], v1 = acc[ai][bj][m][1] + bv[bj][1];
                    if (ACT == 1) { f32x2 a = gelu_pk((f32x2){v0[0], v0[1]}), b = gelu_pk((f32x2){v0[2], v0[3]}), c = gelu_pk((f32x2){v1[0], v1[1]}), d = gelu_pk((f32x2){v1[2], v1[3]});
                        v0 = (f32x4){a.x, a.y, b.x, b.y}; v1 = (f32x4){c.x, c.y, d.x, d.y}; }
                    v0 = v0 * sc; v1 = v1 * sc; u32x4 w; w.x = cvt_pk_bf16(v0[0], v0[1]); w.y = cvt_pk_bf16(v0[2], v0[3]); w.z = cvt_pk_bf16(v1[0], v1[1]); w.w = cvt_pk_bf16(v1[2], v1[3]);
                    *(u32x4*)(rowp + bj * HALF) = w; } }
    }
};

struct EpiResF32 {
    static constexpr bool PERM = false, AFTER_DRAIN = false;
    const float* X; float* O; int ldc;
    __device__ __forceinline__ void operator()(const f32x4 (&acc)[2][2][4][2], const Unit& u, int wr, int wc, int fr, int fq) const {
        const int row0 = u.pm * BM + wr * 64 + fr, col0 = u.pn * BM + wc * 32 + 4 * fq;
#pragma unroll
        for (int ai = 0; ai < 2; ++ai)
#pragma unroll
            for (int m = 0; m < 4; ++m) { const size_t off = (size_t)(row0 + ai * HALF + m * 16) * ldc + col0;
#pragma unroll
                for (int bj = 0; bj < 2; ++bj)
#pragma unroll
                    for (int n = 0; n < 2; ++n) { const f32x4 xv = *(const f32x4*)(X + off + bj * HALF + n * 16); *(f32x4*)(O + off + bj * HALF + n * 16) = acc[ai][bj][m][n] + xv; } }
    }
};

struct MoeOrder {
    const PG8_LAS int* tile_e; int T, nN, G, c; size_t expert_stride_bytes;
    __device__ __forceinline__ bool next(int i, Unit& u) const {
        const int L = i * G + c; if (L >= T * nN) return false;
        u.pm = L / nN; u.pn = L % nN; return true;
    }
    __device__ __forceinline__ void a_ready(const Unit&) const {}
    __device__ __forceinline__ void done(const Unit&) const {}
    __device__ __forceinline__ const char* a_base(const Gemm& g, const Unit& u) const { return (const char*)g.A + (size_t)u.pm * ((size_t)BM * g.K * 2); }
    __device__ __forceinline__ const char* b_base(const Gemm& g, const Unit& u) const { return (const char*)g.Bt + (size_t)tile_e[u.pm] * expert_stride_bytes + (size_t)u.pn * ((size_t)BM * g.K * 2); }
};
__device__ __forceinline__ float silu_f(float a) { return a * __builtin_amdgcn_rcpf(1.0f + __builtin_amdgcn_exp2f(-1.4426950408889634f * a)); }
struct EpiSwiGLU {
    static constexpr bool PERM = true, AFTER_DRAIN = false;
    bf16_t* H;
    __device__ __forceinline__ void operator()(const f32x4 (&acc)[2][2][4][2], const Unit& u, int wr, int wc, int fr, int fq) const {
        const int row0 = u.pm * BM + wr * 64 + fr, col0 = u.pn * 128 + wc * 32 + 8 * fq;
#pragma unroll
        for (int ai = 0; ai < 2; ++ai)
#pragma unroll
            for (int m = 0; m < 4; ++m) { bf16_t* p = H + (size_t)(row0 + ai * HALF + m * 16) * 512 + col0;
                const f32x4 a0 = acc[ai][0][m][0], a1 = acc[ai][0][m][1], b0 = acc[ai][1][m][0], b1 = acc[ai][1][m][1];
                u32x4 w; w.x = cvt_pk_bf16(silu_f(a0[0]) * b0[0], silu_f(a0[1]) * b0[1]); w.y = cvt_pk_bf16(silu_f(a0[2]) * b0[2], silu_f(a0[3]) * b0[3]);
                w.z = cvt_pk_bf16(silu_f(a1[0]) * b1[0], silu_f(a1[1]) * b1[1]); w.w = cvt_pk_bf16(silu_f(a1[2]) * b1[2], silu_f(a1[3]) * b1[3]);
                *(u32x4*)p = w; }
    }
};
struct EpiRowScaleBf16 {
    static constexpr bool PERM = true, AFTER_DRAIN = false;
    bf16_t* O; int ldc; const float* rowscale;
    __device__ __forceinline__ void operator()(const f32x4 (&acc)[2][2][4][2], const Unit& u, int wr, int wc, int fr, int fq) const {
        const int row0 = u.pm * BM + wr * 64 + fr, col0 = u.pn * BM + wc * 32 + 8 * fq;
#pragma unroll
        for (int ai = 0; ai < 2; ++ai)
#pragma unroll
            for (int m = 0; m < 4; ++m) { const int row = row0 + ai * HALF + m * 16; const float sc = rowscale[row]; bf16_t* rowp = O + (size_t)row * ldc + col0;
#pragma unroll
                for (int bj = 0; bj < 2; ++bj) { const f32x4 v0 = acc[ai][bj][m][0] * sc, v1 = acc[ai][bj][m][1] * sc;
                    u32x4 w; w.x = cvt_pk_bf16(v0[0], v0[1]); w.y = cvt_pk_bf16(v0[2], v0[3]); w.z = cvt_pk_bf16(v1[0], v1[1]); w.w = cvt_pk_bf16(v1[2], v1[3]);
                    *(u32x4*)(rowp + bj * HALF) = w; } }
    }
};
template <class Epi, class Sched, bool ALIGN_EPI = false, bool SP2 = false>
__device__ __forceinline__ void gemm_phase(PG8_LAS unsigned char* lds, const Gemm g, const Sched& S, const Epi& E) {
    const int tid = threadIdx.x, wid = __builtin_amdgcn_readfirstlane(tid >> 6), lane = tid & 63, wr = wid >> 2, wc = wid & 3, fr = lane & 15, fq = lane >> 4;
    const int K = g.K, nt = K / BK;
    unsigned voffA[2], voffB[2];
#pragma unroll
    for (int i = 0; i < 2; ++i) { int R, C; stage_rc(tid * 16 + i * 8192, R, C); const int Rb = Epi::PERM ? ((R & ~31) + perm32(R & 31)) : R;
        voffA[i] = (unsigned)(R * K + C) * 2u; voffB[i] = (unsigned)(Rb * K + C) * 2u; }
    const size_t kstep = (size_t)(BK * 2);
    const size_t hstep = (size_t)HALF * K * 2;
    const size_t tstep = 2 * hstep; (void)tstep;
    const unsigned ldsw = (unsigned)wid * 1024u;
    const int aoff = lds_byte(wr * 64 + fr, fq * 8), boff = lds_byte(wc * 32 + fr, fq * 8);
#define PG8_SA(b, h) (((b) * 2 + (h)) * HTB)
#define PG8_SB(b, h) ((4 + (b) * 2 + (h)) * HTB)
#define PG8_STAGE(bufoff, gbase, voff) do { _Pragma("unroll") for (int _i = 0; _i < 2; ++_i) \
        __builtin_amdgcn_global_load_lds((const unsigned*)((const char*)(gbase) + (voff)[_i]), (PG8_LAS unsigned*)(lds + (bufoff) + ldsw + _i * 8192), 16, 0, 0); } while (0)
#define PG8_LDA(dst, b, h) do { _Pragma("unroll") for (int m = 0; m < 4; ++m) _Pragma("unroll") for (int k = 0; k < 2; ++k) dst[m][k] = *(const PG8_LAS bf16x8*)(lds + PG8_SA(b, h) + aoff + m * 2048 + k * 1024); } while (0)
#define PG8_LDB(dst, b, h) do { _Pragma("unroll") for (int n = 0; n < 2; ++n) _Pragma("unroll") for (int k = 0; k < 2; ++k) dst[n][k] = *(const PG8_LAS bf16x8*)(lds + PG8_SB(b, h) + boff + n * 2048 + k * 1024); } while (0)
#define PG8_MMA(ai, bj, At, Bt) do { __builtin_amdgcn_s_setprio(1); _Pragma("unroll") for (int m = 0; m < 4; ++m) _Pragma("unroll") for (int n = 0; n < 2; ++n) _Pragma("unroll") for (int k = 0; k < 2; ++k) \
        acc[ai][bj][m][n] = __builtin_amdgcn_mfma_f32_16x16x32_bf16(Bt[n][k], At[m][k], acc[ai][bj][m][n], 0, 0, 0); __builtin_amdgcn_s_setprio(0); } while (0)
#define PG8_WAIT_V(n) asm volatile("s_waitcnt vmcnt(" #n ")" ::: "memory")
#define PG8_WAIT_L(n) asm volatile("s_waitcnt lgkmcnt(" #n ")" ::: "memory")
#define PG8_BAR __builtin_amdgcn_s_barrier()
#define PG8_SCHED __builtin_amdgcn_sched_barrier(0)
    Unit cur, nxt; int ui = 0;
    if (!S.next(0, cur)) return;
    f32x4 acc[2][2][4][2];
#pragma unroll
    for (int a = 0; a < 2; ++a)
#pragma unroll
        for (int b = 0; b < 2; ++b)
#pragma unroll
            for (int m = 0; m < 4; ++m)
#pragma unroll
                for (int n = 0; n < 2; ++n) acc[a][b][m][n] = (f32x4){0.f, 0.f, 0.f, 0.f};
    bf16x8 At[4][2], B0[2][2], B1[2][2];
    const char* cA = S.a_base(g, cur); const char* cB = S.b_base(g, cur);
    S.a_ready(cur);
    if constexpr (SP2) {
        PG8_STAGE(PG8_SB(0, 0), cB, voffB); PG8_STAGE(PG8_SB(0, 1), cB + hstep, voffB); PG8_STAGE(PG8_SA(0, 0), cA, voffA); PG8_STAGE(PG8_SA(0, 1), cA + hstep, voffA);
        if (wr == 1) PG8_BAR;
        PG8_WAIT_V(2); PG8_BAR;
        PG8_STAGE(PG8_SB(1, 0), cB + kstep, voffB); PG8_STAGE(PG8_SA(1, 0), cA + kstep, voffA); PG8_STAGE(PG8_SB(1, 1), cB + hstep + kstep, voffB);
        PG8_WAIT_V(6); PG8_BAR;
    } else {
        PG8_STAGE(PG8_SB(0, 0), cB, voffB); PG8_STAGE(PG8_SA(0, 0), cA, voffA); PG8_STAGE(PG8_SB(0, 1), cB + hstep, voffB); PG8_STAGE(PG8_SA(0, 1), cA + hstep, voffA);
        if (wr == 1) PG8_BAR;
        PG8_WAIT_V(4); PG8_BAR;
        PG8_STAGE(PG8_SB(1, 0), cB + kstep, voffB); PG8_STAGE(PG8_SA(1, 0), cA + kstep, voffA); PG8_STAGE(PG8_SB(1, 1), cB + hstep + kstep, voffB);
        PG8_WAIT_V(6); PG8_BAR;
    }
    for (;;) {
        const bool has_next = S.next(ui + 1, nxt);
        const char* nA = has_next ? S.a_base(g, nxt) : cA; const char* nB = has_next ? S.b_base(g, nxt) : cB;
        for (int t = 0; t < nt; t += 2) {
            const bool last = (t == nt - 2);
            const char* a1 = cA + (size_t)(t + 1) * kstep;
            const char* a2 = last ? nA : cA + (size_t)(t + 2) * kstep; const char* b2 = last ? nB : cB + (size_t)(t + 2) * kstep;
            const char* a3 = a2 + kstep; const char* b3 = b2 + kstep;
            if (last && has_next) S.a_ready(nxt);
            if constexpr (SP2) {
            PG8_LDB(B0, 0, 0); PG8_LDB(B1, 0, 1); PG8_SCHED; PG8_LDA(At, 0, 0); PG8_STAGE(PG8_SA(1, 1), a1 + hstep, voffA);
            PG8_WAIT_V(8); PG8_WAIT_L(0); PG8_BAR; PG8_MMA(0, 0, At, B0); PG8_MMA(0, 1, At, B1); PG8_BAR; PG8_SCHED;
            PG8_LDA(At, 0, 1); PG8_STAGE(PG8_SB(0, 0), b2, voffB); PG8_STAGE(PG8_SB(0, 1), b2 + hstep, voffB); PG8_STAGE(PG8_SA(0, 0), a2, voffA);
            PG8_WAIT_V(8); PG8_WAIT_L(0); PG8_BAR; PG8_MMA(1, 0, At, B0); PG8_MMA(1, 1, At, B1); PG8_BAR; PG8_SCHED;
            PG8_LDB(B0, 1, 0); PG8_LDB(B1, 1, 1); PG8_SCHED; PG8_LDA(At, 1, 0); PG8_STAGE(PG8_SA(0, 1), a2 + hstep, voffA);
            PG8_WAIT_V(8); PG8_WAIT_L(0); PG8_BAR; PG8_MMA(0, 0, At, B0); PG8_MMA(0, 1, At, B1); PG8_BAR; PG8_SCHED;
            PG8_LDA(At, 1, 1); PG8_STAGE(PG8_SB(1, 0), b3, voffB); PG8_STAGE(PG8_SB(1, 1), b3 + hstep, voffB); PG8_STAGE(PG8_SA(1, 0), a3, voffA);
            PG8_WAIT_V(8); PG8_WAIT_L(0); PG8_BAR; PG8_MMA(1, 0, At, B0); PG8_MMA(1, 1, At, B1); PG8_BAR; PG8_SCHED;
            } else {
            PG8_LDB(B0, 0, 0); PG8_SCHED; PG8_LDA(At, 0, 0); PG8_STAGE(PG8_SA(1, 1), a1 + hstep, voffA);
            PG8_WAIT_L(8); PG8_BAR; PG8_WAIT_L(0); PG8_MMA(0, 0, At, B0); PG8_BAR; PG8_SCHED;
            PG8_LDB(B1, 0, 1); PG8_STAGE(PG8_SB(0, 0), b2, voffB);
            PG8_BAR; PG8_WAIT_L(0); PG8_MMA(0, 1, At, B1); PG8_BAR;
            PG8_LDA(At, 0, 1); PG8_STAGE(PG8_SA(0, 0), a2, voffA);
            PG8_BAR; PG8_WAIT_L(0); PG8_MMA(1, 0, At, B0); PG8_BAR; PG8_SCHED;
            PG8_STAGE(PG8_SB(0, 1), b2 + hstep, voffB);
            PG8_WAIT_V(6); PG8_BAR; PG8_MMA(1, 1, At, B1); PG8_BAR;
            PG8_LDB(B0, 1, 0); PG8_SCHED; PG8_LDA(At, 1, 0); PG8_STAGE(PG8_SA(0, 1), a2 + hstep, voffA);
            PG8_WAIT_L(8); PG8_BAR; PG8_WAIT_L(0); PG8_MMA(0, 0, At, B0); PG8_BAR; PG8_SCHED;
            PG8_LDB(B1, 1, 1); PG8_STAGE(PG8_SB(1, 0), b3, voffB);
            PG8_BAR; PG8_WAIT_L(0); PG8_MMA(0, 1, At, B1); PG8_BAR;
            PG8_LDA(At, 1, 1); PG8_STAGE(PG8_SA(1, 0), a3, voffA);
            PG8_BAR; PG8_WAIT_L(0); PG8_MMA(1, 0, At, B0); PG8_BAR; PG8_SCHED;
            PG8_STAGE(PG8_SB(1, 1), b3 + hstep, voffB);
            PG8_WAIT_V(6); PG8_BAR; PG8_MMA(1, 1, At, B1); PG8_BAR;
            }
        }
        if constexpr (ALIGN_EPI) { if (wr == 0) PG8_BAR; }
        if constexpr (!Epi::AFTER_DRAIN) { E(acc, cur, wr, wc, fr, fq); S.done(cur); }
        if (!has_next) break;
#pragma unroll
        for (int a = 0; a < 2; ++a)
#pragma unroll
            for (int b = 0; b < 2; ++b)
#pragma unroll
                for (int m = 0; m < 4; ++m)
#pragma unroll
                    for (int n = 0; n < 2; ++n) acc[a][b][m][n] = (f32x4){0.f, 0.f, 0.f, 0.f};
        cur = nxt; cA = nA; cB = nB; ++ui;
        if constexpr (ALIGN_EPI) { if (wr == 1) PG8_BAR; }
    }
    PG8_WAIT_V(0);
    if constexpr (!ALIGN_EPI) { if (wr == 0) PG8_BAR; }
    PG8_BAR;
    if constexpr (Epi::AFTER_DRAIN) { E.fused(acc, cur, wr, wc, fr, fq, lds, wid, lane); S.done(cur); }
#undef PG8_SA
#undef PG8_SB
#undef PG8_STAGE
#undef PG8_LDA
#undef PG8_LDB
#undef PG8_MMA
#undef PG8_WAIT_V
#undef PG8_WAIT_L
#undef PG8_BAR
#undef PG8_SCHED
}
}
#define LAS __attribute__((address_space(3)))
#define XB_TMO      128
#define XB_XCNT(j)  (256  + 64 * (j))
#define XB_XSUB(j)  (1280 + 64 * (j))
#define XB_XGEN(j)  (2304 + 64 * (j))
#define XB_TOP      3328
#define XB_TOPGEN   3392
#define XCD_BAR_WORDS 3456
#define XB_SPIN_CAP (1u << 18)

__device__ __forceinline__ unsigned xb_ld(unsigned* p)              { return __hip_atomic_load(p, __ATOMIC_RELAXED, __HIP_MEMORY_SCOPE_AGENT); }
__device__ __forceinline__ unsigned xb_add(unsigned* p, unsigned v) { return __hip_atomic_fetch_add(p, v, __ATOMIC_RELAXED, __HIP_MEMORY_SCOPE_AGENT); }
__device__ __forceinline__ unsigned xb_xcc_id() { return (unsigned)__builtin_amdgcn_s_getreg((3 << 11) | 20) & 0xFu; }
#define XB_SPIN(cond, bar) do { unsigned _sp = 0; while (cond) { __builtin_amdgcn_s_sleep(1); \
    if ((++_sp & 255u) == 0u) { if (xb_ld(&(bar)[XB_TMO])) break; if (_sp > XB_SPIN_CAP) { atomicAdd(&(bar)[XB_TMO], 1u); break; } } } } while (0)

struct XcdBarrier {
    unsigned* bar; unsigned x;
    volatile LAS unsigned* st;
};

__device__ __forceinline__ XcdBarrier xcd_barrier_post(unsigned* bar, volatile LAS unsigned* st) {
    XcdBarrier b; b.bar = bar; b.x = xb_xcc_id(); b.st = st;
    if (threadIdx.x == 0) (void)xb_add(&bar[XB_XCNT(b.x)], 1u);
    return b;
}
__device__ __forceinline__ void xcd_barrier_complete(unsigned* bar, unsigned x, unsigned& nloc, unsigned& nx) {
    const unsigned G = gridDim.x * gridDim.y * gridDim.z;
    unsigned sum, cnt, mine, sp = 0u;
    for (;;) {
        sum = 0u; cnt = 0u; mine = 0u;
#pragma unroll
        for (unsigned j = 0; j < 16; ++j) { const unsigned c = xb_ld(&bar[XB_XCNT(j)]); sum += c; cnt += (c > 0u) ? 1u : 0u; mine = (j == x) ? c : mine; }
        if (sum == G) break;
        __builtin_amdgcn_s_sleep(1);
        if ((++sp & 255u) == 0u) { if (xb_ld(&bar[XB_TMO])) break; if (sp > XB_SPIN_CAP) { atomicAdd(&bar[XB_TMO], 1u); break; } }
    }
    nloc = mine > 0u ? mine : 1u; nx = cnt > 0u ? cnt : 1u;
}

__device__ __forceinline__ void xcd_barrier(const XcdBarrier& b) {
    asm volatile("s_waitcnt vmcnt(0)" ::: "memory");
    __syncthreads();
    if (threadIdx.x == 0) {
        unsigned* bar = b.bar;
        __builtin_amdgcn_s_waitcnt(0);
        unsigned nloc = b.st[0], nx = b.st[1];
        if (nloc == 0u) { xcd_barrier_complete(bar, b.x, nloc, nx); b.st[0] = nloc; b.st[1] = nx; }
        const unsigned old = xb_add(&bar[XB_XSUB(b.x)], 1u);
        const unsigned gen = old / nloc;
        if (old + 1u == (gen + 1u) * nloc) {
            __builtin_amdgcn_fence(__ATOMIC_RELEASE, "agent");
            asm volatile("s_waitcnt vmcnt(0)" ::: "memory");
            const unsigned og = xb_add(&bar[XB_TOP], 1u);
            const unsigned tg = og / nx;
            if (og + 1u == (tg + 1u) * nx) xb_add(&bar[XB_TOPGEN], 1u);
            else XB_SPIN(xb_ld(&bar[XB_TOPGEN]) == tg, bar);
            __builtin_amdgcn_fence(__ATOMIC_ACQUIRE, "agent");
            xb_add(&bar[XB_XGEN(b.x)], 1u);
            asm volatile("s_waitcnt vmcnt(0)" ::: "memory");
        } else {
            XB_SPIN(xb_ld(&bar[XB_XGEN(b.x)]) == gen, bar);
            __builtin_amdgcn_fence(__ATOMIC_ACQUIRE, "agent");
            asm volatile("s_waitcnt vmcnt(0)" ::: "memory");
        }
    }
    __syncthreads();
}

#define GAS __attribute__((address_space(1)))
typedef unsigned v4u __attribute__((ext_vector_type(4)));
#define LDS_WAIT() asm volatile("s_waitcnt lgkmcnt(0)" ::: "memory")
constexpr int NWAVES = 8;
constexpr int RING_BYTES = 139264, LDSCTL_OFF = RING_BYTES, MISC_OFF = LDSCTL_OFF + 320, LDS_BYTES = 155648;
constexpr size_t CTL_ZERO_BYTES = 1 * MiB;
constexpr int CW_BAR = 4096;
constexpr int MAX_LAUNCHES = 12;
static_assert((CW_BAR + MAX_LAUNCHES * XCD_BAR_WORDS) * 4 <= (int)CTL_ZERO_BYTES, "ctl");

constexpr size_t WS_WINT = 1 * MiB, WS_WOUTT = 6 * MiB, WS_W13T = 8 * MiB, WS_W2T = 72 * MiB;
constexpr size_t WS_HN1 = 104 * MiB, WS_LRU = 168 * MiB, WS_HYUT = 232 * MiB, WS_HF = 396 * MiB, WS_HB = 428 * MiB;
constexpr size_t WS_YHYT = 104 * MiB, WS_YCAT = 232 * MiB, WS_HN2 = 168 * MiB, WS_EID = 460 * MiB, WS_GATE = 461 * MiB;
constexpr size_t WS_LIST = 460 * MiB, WS_LGATE = 464 * MiB, WS_TOKINFO = 468 * MiB, WS_WRT = 469 * MiB, WS_SGATE = 470 * MiB;
constexpr size_t WS_XS = 232 * MiB, WS_H = 376 * MiB, WS_Y = 104 * MiB;
constexpr size_t WS_XC = 104 * MiB, WS_Z2 = 392 * MiB, WS_KT = 328 * MiB;
constexpr int CW_CNT = 2048;
constexpr int LC_CNT = RING_BYTES + 1024, LC_BASE = RING_BYTES + 1152, LC_TSTART = RING_BYTES + 1280, LC_TILEE = RING_BYTES + 2048;

struct Args { const float* in[37]; float* out; unsigned char* ws; int ph_lo, ph_hi, li, pad; };

__device__ __forceinline__ unsigned pk2(float lo, float hi) { return (unsigned)f2bf(lo) | ((unsigned)f2bf(hi) << 16); }

__device__ __forceinline__ void p0_transpose_item(const float* __restrict__ W, int K, int N, bf16* __restrict__ WT, int drow0, LAS float* scr, int k0, int n0, int lane) {
#pragma unroll 8
    for (int i = 0; i < 32; ++i) { const int kk = 2 * i + (lane >> 5); scr[kk * 33 + (lane & 31)] = W[(size_t)(k0 + kk) * N + n0 + (lane & 31)]; }
    LDS_WAIT(); asm volatile("" ::: "memory");
    const int c = lane & 7;
#pragma unroll
    for (int j = 0; j < 4; ++j) { const int n = (lane >> 3) + 8 * j; const LAS float* s = scr + (8 * c) * 33 + n;
        v4u o; o.x = pk2(s[0 * 33], s[1 * 33]); o.y = pk2(s[2 * 33], s[3 * 33]); o.z = pk2(s[4 * 33], s[5 * 33]); o.w = pk2(s[6 * 33], s[7 * 33]);
        *(v4u*)(WT + (size_t)(drow0 + n) * K + k0 + 8 * c) = o; }
    LDS_WAIT(); asm volatile("" ::: "memory");
}
__device__ __forceinline__ void rms_row_to_bf16(const float* __restrict__ xrow, const float* __restrict__ g, bf16* __restrict__ orow, int lane) {
    const float4* xr = (const float4*)xrow;
    float4 v[4]; float s = 0.f;
#pragma unroll
    for (int j = 0; j < 4; ++j) { v[j] = xr[lane + 64 * j]; s += (v[j].x * v[j].x + v[j].y * v[j].y) + (v[j].z * v[j].z + v[j].w * v[j].w); }
    s = wave_sum(s);
    const float rstd = rsqrtf(s * (1.0f / DM) + EPS);
#pragma unroll
    for (int j = 0; j < 4; ++j) { const int c = (lane + 64 * j) * 4; const float4 gg = *(const float4*)(g + c);
        uint2 o; o.x = pk2(v[j].x * rstd * gg.x, v[j].y * rstd * gg.y); o.y = pk2(v[j].z * rstd * gg.z, v[j].w * rstd * gg.w);
        *(uint2*)(orow + c) = o; }
}


typedef short bf16x8_t __attribute__((ext_vector_type(8)));
typedef float f32x4_t __attribute__((ext_vector_type(4)));
__device__ __forceinline__ int moe_tables(LAS unsigned char* L, unsigned* ctl, int tid) {
    LAS int* cnt = (LAS int*)(L + LC_CNT); LAS int* tstart = (LAS int*)(L + LC_TSTART); LAS int* tile_e = (LAS int*)(L + LC_TILEE);
    __syncthreads();
    if (tid < 32) cnt[tid] = (int)__hip_atomic_load(ctl + CW_CNT + tid, __ATOMIC_RELAXED, __HIP_MEMORY_SCOPE_AGENT);
    __syncthreads();
    if (tid == 0) { int ts = 0; for (int e = 0; e < 32; ++e) { tstart[e] = ts; const int nt = (cnt[e] + 255) >> 8; for (int i = 0; i < nt; ++i) tile_e[ts + i] = e; ts += nt; } tstart[32] = ts; }
    __syncthreads();
    return tstart[32];
}

__device__ __forceinline__ void lru_load_frags(const bf16* xrow0, int sg0, int jl, int dir, v4u (&fr)[4][2]) {
#pragma unroll
    for (int mt = 0; mt < 4; ++mt) { const int sg = 16 * (jl >> 2) + 4 * mt + (jl & 3); const int tau = sg0 + sg; const int t = dir ? (SEQ - 1 - tau) : tau;
#pragma unroll
        for (int s = 0; s < 2; ++s) fr[mt][s] = *(const v4u*)(xrow0 + (size_t)t * 64 + 32 * s); }
}
__device__ __forceinline__ void lru_item(LAS unsigned char* L, const Args& a, int item, const bf16* __restrict__ xcb, bf16* __restrict__ hf, bf16* __restrict__ hb, int tid, int lane, int wave) {
    const int b = item >> 6, h = (item >> 3) & 7, q4 = (item >> 1) & 3, dir = item & 1;
    const float* wr = dir ? a.in[10] : a.in[5]; const float* br = dir ? a.in[11] : a.in[6]; const float* wi = dir ? a.in[12] : a.in[7];
    const float* bi = dir ? a.in[13] : a.in[8]; const float* lam = dir ? a.in[14] : a.in[9];
    bf16* outp = dir ? hb : hf;
    LAS float* carry = (LAS float*)(L + 2048);
    const int jl = lane & 15, kg = lane >> 4;
    const int c = 64 * h + 16 * q4 + jl;
    bf16x8_t Br[2], Bi[2], Bid;
#pragma unroll
    for (int s = 0; s < 2; ++s)
#pragma unroll
        for (int j = 0; j < 8; ++j) { const int i = 32 * s + 8 * kg + j;
            Br[s][j] = (short)f2bf(wr[h * 4096 + i * 64 + 16 * q4 + jl]); Bi[s][j] = (short)f2bf(wi[h * 4096 + i * 64 + 16 * q4 + jl]); }
#pragma unroll
    for (int j = 0; j < 8; ++j) Bid[j] = (8 * kg + j == 16 * (q4 & 1) + jl) ? (short)0x3f80 : (short)0;
    const int sid = q4 >> 1;
    const float brc = br[c], bic = bi[c];
    const float sp8l = 8.0f * log1pf(expf(-lam[c])) * 1.4426950408889634f;
    __syncthreads();
    float Hblk = 0.f;
    const bf16* xrow0 = xcb + ((size_t)(b * 8 + h) * SEQ) * 64 + 8 * kg;
    v4u frn[4][2];
    lru_load_frags(xrow0, 64 * wave, jl, dir, frn);
    for (int it = 0; it < 16; ++it) {
        const int sg0 = 512 * it + 64 * wave;
        bf16x8_t Af[4][2];
#pragma unroll
        for (int mt = 0; mt < 4; ++mt)
#pragma unroll
            for (int s = 0; s < 2; ++s) Af[mt][s] = __builtin_bit_cast(bf16x8_t, frn[mt][s]);
        if (it < 15) lru_load_frags(xrow0, sg0 + 512, jl, dir, frn);
        float hloc[16], Ploc[16];
        float hl = 0.f, P = 1.f;
#pragma unroll
        for (int mt = 0; mt < 4; ++mt) {
            f32x4_t aR = {0.f, 0.f, 0.f, 0.f}, aI = aR, aX = aR;
            aR = __builtin_amdgcn_mfma_f32_16x16x32_bf16(Af[mt][0], Br[0], aR, 0, 0, 0); aR = __builtin_amdgcn_mfma_f32_16x16x32_bf16(Af[mt][1], Br[1], aR, 0, 0, 0);
            aI = __builtin_amdgcn_mfma_f32_16x16x32_bf16(Af[mt][0], Bi[0], aI, 0, 0, 0); aI = __builtin_amdgcn_mfma_f32_16x16x32_bf16(Af[mt][1], Bi[1], aI, 0, 0, 0);
            aX = __builtin_amdgcn_mfma_f32_16x16x32_bf16(sid ? Af[mt][1] : Af[mt][0], Bid, aX, 0, 0, 0);
#pragma unroll
            for (int r = 0; r < 4; ++r) {
                const float rg = __builtin_amdgcn_rcpf(1.0f + __builtin_amdgcn_exp2f(-1.4426950408889634f * (aR[r] + brc)));
                const float ig = __builtin_amdgcn_rcpf(1.0f + __builtin_amdgcn_exp2f(-1.4426950408889634f * (aI[r] + bic)));
                const float av = __builtin_amdgcn_exp2f(-rg * sp8l);
                const float bb = __builtin_amdgcn_sqrtf(fmaxf(1.0f - av * av, 0.f)) * (ig * aX[r]);
                hl = av * hl + bb; P *= av;
                hloc[4 * mt + r] = hl; Ploc[4 * mt + r] = P;
            }
        }
        const float A0 = __shfl(P, jl), B0 = __shfl(hl, jl), A1 = __shfl(P, jl + 16), B1 = __shfl(hl, jl + 16);
        const float A2 = __shfl(P, jl + 32), B2 = __shfl(hl, jl + 32), A3 = __shfl(P, jl + 48), B3 = __shfl(hl, jl + 48);
        LAS float* cbuf = carry + (it & 1) * 256;
        if (kg == 0) { cbuf[(wave * 16 + jl) * 2 + 0] = A0 * A1 * A2 * A3; cbuf[(wave * 16 + jl) * 2 + 1] = ((B0 * A1 + B1) * A2 + B2) * A3 + B3; }
        __syncthreads();
        float Hw = Hblk, Hn = Hblk;
#pragma unroll
        for (int w2 = 0; w2 < 8; ++w2) { const float Aq = cbuf[(w2 * 16 + jl) * 2 + 0], Bq = cbuf[(w2 * 16 + jl) * 2 + 1];
            if (w2 < wave) Hw = Aq * Hw + Bq;
            Hn = Aq * Hn + Bq; }
        Hblk = Hn;
        float Hin = Hw;
        if (kg >= 1) Hin = A0 * Hin + B0;
        if (kg >= 2) Hin = A1 * Hin + B1;
        if (kg >= 3) Hin = A2 * Hin + B2;
#pragma unroll
        for (int k = 0; k < 16; ++k) { const int tau = sg0 + 16 * kg + k; const int t = dir ? (SEQ - 1 - tau) : tau;
            outp[((size_t)b * SEQ + t) * DL + c] = f2bf(hloc[k] + Ploc[k] * Hin); }
    }
}

typedef float f32x2_t __attribute__((ext_vector_type(2)));
typedef _Float16 f16x2_t __attribute__((ext_vector_type(2)));
constexpr int LC_TW = RING_BYTES + 4096, LC_TA = RING_BYTES + 8192, LC_TB = RING_BYTES + 9216, LC_RED = RING_BYTES + 3328;
constexpr size_t WS_SPEC = 328 * MiB, WS_HT = 396 * MiB, WS_XCB = 136 * MiB;
__device__ __forceinline__ f32x2_t cmul(f32x2_t a, f32x2_t b) { f32x2_t r; r.x = a.x * b.x - a.y * b.y; r.y = a.x * b.y + a.y * b.x; return r; }
__device__ __forceinline__ f32x2_t cmulc(f32x2_t a, f32x2_t b) { f32x2_t r; r.x = a.x * b.x + a.y * b.y; r.y = a.y * b.x - a.x * b.y; return r; }
template <bool INV> __device__ __forceinline__ f32x2_t twc(f32x2_t d, int e) {
    constexpr float CT[16] = {1.000000000e+00f, 9.807852804e-01f, 9.238795325e-01f, 8.314696123e-01f, 7.071067812e-01f, 5.555702330e-01f, 3.826834324e-01f, 1.950903220e-01f, 6.123233996e-17f, -1.950903220e-01f, -3.826834324e-01f, -5.555702330e-01f, -7.071067812e-01f, -8.314696123e-01f, -9.238795325e-01f, -9.807852804e-01f};
    constexpr float ST[16] = {0.000000000e+00f, 1.950903220e-01f, 3.826834324e-01f, 5.555702330e-01f, 7.071067812e-01f, 8.314696123e-01f, 9.238795325e-01f, 9.807852804e-01f, 1.000000000e+00f, 9.807852804e-01f, 9.238795325e-01f, 8.314696123e-01f, 7.071067812e-01f, 5.555702330e-01f, 3.826834324e-01f, 1.950903220e-01f};
    f32x2_t r;
    if (e == 0) return d;
    if (e == 8) { if (INV) { r.x = -d.y; r.y = d.x; } else { r.x = d.y; r.y = -d.x; } return r; }
    const float c = CT[e], s = INV ? -ST[e] : ST[e];
    if (e == 4) { r.x = (d.x + (INV ? -d.y : d.y)) * c; r.y = (d.y - (INV ? -d.x : d.x)) * c; return r; }
    r.x = d.x * c + d.y * s; r.y = d.y * c - d.x * s; return r;
}
template <int R, bool INV> struct DFT {
    static __device__ __forceinline__ void run(f32x2_t (&x)[R]) {
        f32x2_t u[R / 2], v[R / 2];
#pragma unroll
        for (int k = 0; k < R / 2; ++k) { const f32x2_t p = x[k], q = x[k + R / 2]; u[k] = p + q; v[k] = twc<INV>(p - q, k * (32 / R)); }
        DFT<R / 2, INV>::run(u); DFT<R / 2, INV>::run(v);
#pragma unroll
        for (int q = 0; q < R / 2; ++q) { x[2 * q] = u[q]; x[2 * q + 1] = v[q]; }
    }
};
template <bool INV> struct DFT<1, INV> { static __device__ __forceinline__ void run(f32x2_t (&)[1]) {} };
#define SWZ(p) ((p) + ((p) >> 5))
constexpr int FBUF = 8448;
template <bool CONJ> __device__ __forceinline__ void tw_apply16(f32x2_t (&x)[16], f32x2_t w1) {
    f32x2_t w = w1;
#pragma unroll
    for (int q = 1; q < 16; ++q) { x[q] = CONJ ? cmulc(x[q], w) : cmul(x[q], w); if (q < 15) w = cmul(w, w1); }
}
__device__ __forceinline__ void fft_tables_init(LAS unsigned char* L, int tid) {
    LAS f32x2_t* TW = (LAS f32x2_t*)(L + LC_TW); LAS f32x2_t* TA = (LAS f32x2_t*)(L + LC_TA); LAS f32x2_t* TB = (LAS f32x2_t*)(L + LC_TB);
    { float s, c; sincospif((float)tid * (1.0f / 4096.0f), &s, &c); f32x2_t w; w.x = c; w.y = -s; TW[tid] = w; }
    if (tid < 128) { float s, c; sincospif((float)tid * (1.0f / 128.0f), &s, &c); f32x2_t w; w.x = c; w.y = -s; TA[tid] = w; }
    if (tid < 64) { float s, c; sincospif((float)tid * (1.0f / 8192.0f), &s, &c); f32x2_t w; w.x = c; w.y = -s; TB[tid] = w; }
    __syncthreads();
}
#define OPAQUE(v) asm volatile("" : "+v"(v))
__device__ __forceinline__ void fwd_pass1(LAS f32x2_t* buf, const LAS f32x2_t* TW, int tid) {
    OPAQUE(tid);
    LAS f32x2_t* b0 = buf + tid + (tid >> 5);
    f32x2_t x[16];
#pragma unroll
    for (int m = 0; m < 16; ++m) x[m] = b0[528 * m];
    DFT<16, false>::run(x); tw_apply16<false>(x, TW[tid]);
#pragma unroll
    for (int q = 0; q < 16; ++q) b0[528 * q] = x[q];
}
__device__ __forceinline__ void fwd_pass2(LAS f32x2_t* buf, const LAS f32x2_t* TW, int tid) {
    OPAQUE(tid);
    LAS f32x2_t* b0 = buf + (tid >> 5) * 528 + (tid & 31);
    f32x2_t x[16];
#pragma unroll
    for (int m = 0; m < 16; ++m) x[m] = b0[33 * m];
    DFT<16, false>::run(x); tw_apply16<false>(x, TW[16 * (tid & 31)]);
#pragma unroll
    for (int q = 0; q < 16; ++q) b0[33 * q] = x[q];
}
__device__ __forceinline__ void inv_pass2(LAS f32x2_t* buf, const LAS f32x2_t* TW, int tid) {
    OPAQUE(tid);
    LAS f32x2_t* b0 = buf + (tid >> 5) * 528 + (tid & 31);
    f32x2_t x[16];
#pragma unroll
    for (int q = 0; q < 16; ++q) x[q] = b0[33 * q];
    tw_apply16<true>(x, TW[16 * (tid & 31)]); DFT<16, true>::run(x);
#pragma unroll
    for (int m = 0; m < 16; ++m) b0[33 * m] = x[m];
}
__device__ __forceinline__ void inv_pass1(LAS f32x2_t* buf, const LAS f32x2_t* TW, int tid) {
    OPAQUE(tid);
    LAS f32x2_t* b0 = buf + tid + (tid >> 5);
    f32x2_t x[16];
#pragma unroll
    for (int q = 0; q < 16; ++q) x[q] = b0[528 * q];
    tw_apply16<true>(x, TW[tid]); DFT<16, true>::run(x);
#pragma unroll
    for (int m = 0; m < 16; ++m) b0[528 * m] = x[m];
}
__device__ __forceinline__ void fft2_forward(LAS unsigned char* L) {
    const int tid = threadIdx.x;
    LAS f32x2_t* bufE = (LAS f32x2_t*)L; LAS f32x2_t* bufO = bufE + FBUF; const LAS f32x2_t* TW = (const LAS f32x2_t*)(L + LC_TW);
    fwd_pass1(bufE, TW, tid); fwd_pass1(bufO, TW, tid);
    __syncthreads();
    fwd_pass2(bufE, TW, tid); fwd_pass2(bufO, TW, tid);
    __syncthreads();
}
__device__ __forceinline__ f32x2_t h2_to_f2(unsigned u) { const f16x2_t h = __builtin_bit_cast(f16x2_t, u); f32x2_t k; k.x = (float)h.x; k.y = (float)h.y; return k; }
template <int MODE>
__device__ __forceinline__ void fft2_middle(LAS unsigned char* L, unsigned* specblk) {
    int tid = threadIdx.x; OPAQUE(tid); const int bsel = tid >> 8, blk = tid & 255;
    LAS f32x2_t* buf = (LAS f32x2_t*)L + (bsel ? FBUF : 0);
    f32x2_t x[32];
    LAS f32x2_t* bm = buf + 33 * blk;
#pragma unroll
    for (int q = 0; q < 32; ++q) x[q] = bm[q];
    DFT<32, false>::run(x);
    unsigned* sp = specblk + (size_t)bsel * 8192 + 32 * blk;
    if (MODE == 0) {
#pragma unroll
        for (int q = 0; q < 32; q += 4) { v4u w;
            { f16x2_t h; h.x = (_Float16)x[q].x; h.y = (_Float16)x[q].y; w.x = __builtin_bit_cast(unsigned, h); }
            { f16x2_t h; h.x = (_Float16)x[q + 1].x; h.y = (_Float16)x[q + 1].y; w.y = __builtin_bit_cast(unsigned, h); }
            { f16x2_t h; h.x = (_Float16)x[q + 2].x; h.y = (_Float16)x[q + 2].y; w.z = __builtin_bit_cast(unsigned, h); }
            { f16x2_t h; h.x = (_Float16)x[q + 3].x; h.y = (_Float16)x[q + 3].y; w.w = __builtin_bit_cast(unsigned, h); }
            *(v4u*)(sp + q) = w; }
    } else {
#pragma unroll
        for (int q = 0; q < 32; q += 4) { const v4u w = *(const v4u*)(sp + q);
            const unsigned w0 = w.x, w1 = w.y, w2 = w.z, w3 = w.w;
            x[q] = cmul(x[q], h2_to_f2(w0)); x[q + 1] = cmul(x[q + 1], h2_to_f2(w1)); x[q + 2] = cmul(x[q + 2], h2_to_f2(w2)); x[q + 3] = cmul(x[q + 3], h2_to_f2(w3)); }
        DFT<32, true>::run(x);
#pragma unroll
        for (int q = 0; q < 32; ++q) bm[q] = x[q];
    }
    __syncthreads();
}
__device__ __forceinline__ void fft2_inverse(LAS unsigned char* L) {
    const int tid = threadIdx.x;
    LAS f32x2_t* bufE = (LAS f32x2_t*)L; LAS f32x2_t* bufO = bufE + FBUF; const LAS f32x2_t* TW = (const LAS f32x2_t*)(L + LC_TW);
    inv_pass2(bufE, TW, tid); inv_pass2(bufO, TW, tid);
    __syncthreads();
    inv_pass1(bufE, TW, tid); inv_pass1(bufO, TW, tid);
}
__device__ __forceinline__ f32x2_t wn16384(const LAS f32x2_t* TA, f32x2_t wb, int tid, int m) { return cmul(TA[(tid >> 6) + 8 * m], wb); }
__device__ __forceinline__ float hy_conv3(const bf16* row, float w0, float w1, float w2, float bias, int n) {
    const int nm = n > 0 ? n - 1 : 0, np = n < SEQ - 1 ? n + 1 : SEQ - 1;
    const float wl = n > 0 ? w0 : 0.f, wr = n < SEQ - 1 ? w2 : 0.f;
    return bias + w1 * bf2f(row[n]) + wl * bf2f(row[nm]) + wr * bf2f(row[np]);
}

__device__ __forceinline__ void load_conv16(const bf16* row, int n0, float w0, float w1, float w2, float bias, float (&out)[16]) {
    const v4u a = *(const v4u*)(row + n0), b = *(const v4u*)(row + n0 + 8);
    const int nl = n0 > 0 ? n0 - 1 : 0, nr = n0 + 16 < SEQ ? n0 + 16 : SEQ - 1;
    const float ul = n0 > 0 ? bf2f(row[nl]) : 0.f, ur = n0 + 16 < SEQ ? bf2f(row[nr]) : 0.f;
    const unsigned a0 = a.x, a1 = a.y, a2 = a.z, a3 = a.w, b0 = b.x, b1 = b.y, b2 = b.z, b3 = b.w;
    float u[18];
    u[0] = ul; u[17] = ur;
    u[1] = __uint_as_float(a0 << 16); u[2] = __uint_as_float(a0 & 0xffff0000u); u[3] = __uint_as_float(a1 << 16); u[4] = __uint_as_float(a1 & 0xffff0000u);
    u[5] = __uint_as_float(a2 << 16); u[6] = __uint_as_float(a2 & 0xffff0000u); u[7] = __uint_as_float(a3 << 16); u[8] = __uint_as_float(a3 & 0xffff0000u);
    u[9] = __uint_as_float(b0 << 16); u[10] = __uint_as_float(b0 & 0xffff0000u); u[11] = __uint_as_float(b1 << 16); u[12] = __uint_as_float(b1 & 0xffff0000u);
    u[13] = __uint_as_float(b2 << 16); u[14] = __uint_as_float(b2 & 0xffff0000u); u[15] = __uint_as_float(b3 << 16); u[16] = __uint_as_float(b3 & 0xffff0000u);
#pragma unroll
    for (int i = 0; i < 16; ++i) out[i] = bias + w0 * u[i] + w1 * u[i + 1] + w2 * u[i + 2];
}
__device__ __forceinline__ void load_f32x16(const float* p, float (&out)[16]) {
#pragma unroll
    for (int i = 0; i < 4; ++i) { const float4 v = *(const float4*)(p + 4 * i); out[4 * i] = v.x; out[4 * i + 1] = v.y; out[4 * i + 2] = v.z; out[4 * i + 3] = v.w; }
}
__device__ __forceinline__ void filter_item(LAS unsigned char* L, const Args& a, int c, const float* hT, unsigned* spec, int tid, int lane, int wave) {
    LAS f32x2_t* bufE = (LAS f32x2_t*)L; LAS f32x2_t* bufO = bufE + FBUF;
    const LAS f32x2_t* TA = (const LAS f32x2_t*)(L + LC_TA); const LAS f32x2_t* TB = (const LAS f32x2_t*)(L + LC_TB);
    LAS float* red = (LAS float*)(L + LC_RED); LAS float* sc = (LAS float*)L;
    const int n0 = 16 * tid;
#pragma unroll 1
    for (int o = 0; o < 2; ++o) {
        float hfv[16], hbv[16];
        load_f32x16(hT + (size_t)(o * 512 + c) * SEQ + n0, hfv);
        load_f32x16(hT + (size_t)(1024 + o * 512 + c) * SEQ + n0, hbv);
        float s = 0.f;
#pragma unroll
        for (int i = 0; i < 16; ++i) { s += fabsf(hfv[i]) + ((n0 + i) > 0 ? fabsf(hbv[i]) : 0.f); sc[n0 + i] = hbv[i]; }
        s = wave_sum(s);
        if (lane == 0) red[wave] = s;
        __syncthreads();
        float tot = 0.f;
#pragma unroll
        for (int i = 0; i < 8; ++i) tot += red[i];
        const float inv = 1.0f / (tot + EPS);
        float ev[16], dv[16];
#pragma unroll
        for (int i = 0; i < 16; ++i) { const int n = n0 + i; const float hbm = n > 0 ? sc[SEQ - n] : 0.f; ev[i] = (hfv[i] + hbm) * inv; dv[i] = (hfv[i] - hbm) * inv; }
        __syncthreads();
        const f32x2_t wa = TA[tid >> 2];
#pragma unroll
        for (int i = 0; i < 16; ++i) { const int n = n0 + i; const f32x2_t wn = cmul(wa, TB[16 * (tid & 3) + i]);
            f32x2_t xe; xe.x = ev[i]; xe.y = 0.f; f32x2_t xo; xo.x = dv[i] * wn.x; xo.y = dv[i] * wn.y;
            (void)n; bufE[16 * tid + (tid >> 1) + i] = xe; bufO[16 * tid + (tid >> 1) + i] = xo; }
        __syncthreads();
        fft2_forward(L);
        fft2_middle<0>(L, spec + (size_t)(o * 512 + c) * 16384);
    }
}
template <int O>
__device__ __forceinline__ void hyena_pass(LAS unsigned char* L, const Args& a, int c, int bp, const bf16* hyuT, unsigned* spec, bf16* y_hyT, float* z1s, int tid) {
    LAS f32x2_t* bufE = (LAS f32x2_t*)L; LAS f32x2_t* bufO = bufE + FBUF;
    const LAS f32x2_t* TA = (const LAS f32x2_t*)(L + LC_TA); const LAS f32x2_t* TB = (const LAS f32x2_t*)(L + LC_TB);
    const float* cw = a.in[15]; const float* cb = a.in[16];
    const size_t seq0 = (size_t)c * NTOK + (size_t)(2 * bp) * SEQ;
    const bf16* v0 = hyuT + seq0; const bf16* v1 = v0 + SEQ;
    float* zs0 = z1s + seq0; float* zs1 = zs0 + SEQ;
    const float vw0 = cw[c], vw1 = cw[1536 + c], vw2 = cw[3072 + c], vbs = cb[c];
    const int n0 = 16 * tid;
    {   float xa[16], xb[16];
        if (O == 0) { load_conv16(v0, n0, vw0, vw1, vw2, vbs, xa); load_conv16(v1, n0, vw0, vw1, vw2, vbs, xb); } else { load_f32x16(zs0 + n0, xa); load_f32x16(zs1 + n0, xb); }
        const f32x2_t wa = TA[tid >> 2];
#pragma unroll
        for (int i = 0; i < 16; ++i) { const int n = n0 + i; f32x2_t x; x.x = xa[i]; x.y = xb[i];
            (void)n; bufE[16 * tid + (tid >> 1) + i] = x; bufO[16 * tid + (tid >> 1) + i] = cmul(x, cmul(wa, TB[16 * (tid & 3) + i])); } }
    __syncthreads();
    fft2_forward(L);
    fft2_middle<1>(L, spec + (size_t)(O * 512 + c) * 16384);
    fft2_inverse(L);
    __syncthreads();
    const int grow = (O ? 1024 : 512) + c;
    const float w0 = cw[grow], w1 = cw[1536 + grow], w2 = cw[3072 + grow], bs = cb[grow];
    const float skip = a.in[24][O * 512 + c];
    const bf16* g0 = hyuT + (size_t)grow * NTOK + (size_t)(2 * bp) * SEQ; const bf16* g1 = g0 + SEQ;
    float za[16], zb[16], ga[16], gb[16];
    if (O == 0) { load_conv16(v0, n0, vw0, vw1, vw2, vbs, za); load_conv16(v1, n0, vw0, vw1, vw2, vbs, zb); } else { load_f32x16(zs0 + n0, za); load_f32x16(zs1 + n0, zb); }
    load_conv16(g0, n0, w0, w1, w2, bs, ga); load_conv16(g1, n0, w0, w1, w2, bs, gb);
    const f32x2_t wa = TA[tid >> 2];
    float ra[16], rb[16];
#pragma unroll
    for (int i = 0; i < 16; ++i) { const int n = n0 + i;
        (void)n; const f32x2_t y = (bufE[16 * tid + (tid >> 1) + i] + cmulc(bufO[16 * tid + (tid >> 1) + i], cmul(wa, TB[16 * (tid & 3) + i]))) * (1.0f / 16384.0f);
        ra[i] = ga[i] * (y.x + skip * za[i]); rb[i] = gb[i] * (y.y + skip * zb[i]); }
    if (O == 0) {
#pragma unroll
        for (int i = 0; i < 4; ++i) { *(float4*)(zs0 + n0 + 4 * i) = make_float4(ra[4 * i], ra[4 * i + 1], ra[4 * i + 2], ra[4 * i + 3]); *(float4*)(zs1 + n0 + 4 * i) = make_float4(rb[4 * i], rb[4 * i + 1], rb[4 * i + 2], rb[4 * i + 3]); }
    } else {
        bf16* o0 = y_hyT + seq0; bf16* o1 = o0 + SEQ;
        v4u p0, p1, q0, q1;
        p0.x = pk2(ra[0], ra[1]); p0.y = pk2(ra[2], ra[3]); p0.z = pk2(ra[4], ra[5]); p0.w = pk2(ra[6], ra[7]); p1.x = pk2(ra[8], ra[9]); p1.y = pk2(ra[10], ra[11]); p1.z = pk2(ra[12], ra[13]); p1.w = pk2(ra[14], ra[15]);
        q0.x = pk2(rb[0], rb[1]); q0.y = pk2(rb[2], rb[3]); q0.z = pk2(rb[4], rb[5]); q0.w = pk2(rb[6], rb[7]); q1.x = pk2(rb[8], rb[9]); q1.y = pk2(rb[10], rb[11]); q1.z = pk2(rb[12], rb[13]); q1.w = pk2(rb[14], rb[15]);
        *(v4u*)(o0 + n0) = p0; *(v4u*)(o0 + n0 + 8) = p1; *(v4u*)(o1 + n0) = q0; *(v4u*)(o1 + n0 + 8) = q1;
    }
    __syncthreads();
}
__device__ __forceinline__ void hyena_item(LAS unsigned char* L, const Args& a, int c, int bp, const bf16* hyuT, unsigned* spec, bf16* y_hyT, float* z1s, int tid) {
    hyena_pass<0>(L, a, c, bp, hyuT, spec, y_hyT, z1s, tid);
    asm volatile("s_waitcnt vmcnt(0)" ::: "memory");
    hyena_pass<1>(L, a, c, bp, hyuT, spec, y_hyT, z1s, tid);
}

__global__ void __launch_bounds__(NWAVES * 64, 2) fwd(Args a) {
    extern __shared__ __attribute__((aligned(16))) unsigned char lds_raw[];
    LAS unsigned char* L = (LAS unsigned char*)lds_raw;
    volatile LAS unsigned* MISC = (volatile LAS unsigned*)(L + MISC_OFF);
    const int tid = threadIdx.x, lane = tid & 63, wave = __builtin_amdgcn_readfirstlane(tid >> 6);
    const int G = gridDim.x, bid = blockIdx.x;
    unsigned char* ws = a.ws;
    unsigned* ctl = (unsigned*)ws;
    for (int u = tid; u < (LDS_BYTES - LDSCTL_OFF) / 4; u += NWAVES * 64) ((LAS unsigned*)(L + LDSCTL_OFF))[u] = 0u;
    __syncthreads();
    const int lo = a.ph_lo, hi = a.ph_hi;
    XcdBarrier bar; bar.bar = ctl + CW_BAR + a.li * XCD_BAR_WORDS; bar.x = 0; bar.st = nullptr;
    bar = xcd_barrier_post(ctl + CW_BAR + a.li * XCD_BAR_WORDS, MISC + 8);
#define IN(k) (lo <= (k) && (k) < hi)
#define BOTH(k) (IN(k) && IN((k) + 1))
#ifndef DUP_BAR
#define DUP_BAR 1
#endif
#define GRID_BAR() do { xcd_barrier(bar); if (DUP_BAR > 1) xcd_barrier(bar); } while (0)

    bf16* WinT = (bf16*)(ws + WS_WINT); bf16* WoutT = (bf16*)(ws + WS_WOUTT);
    bf16* hn1 = (bf16*)(ws + WS_HN1); bf16* lru = (bf16*)(ws + WS_LRU); bf16* hyuT = (bf16*)(ws + WS_HYUT);
    bf16* y_cat = (bf16*)(ws + WS_YCAT);
    bf16* W13T = (bf16*)(ws + WS_W13T); bf16* W2T = (bf16*)(ws + WS_W2T); bf16* WrT = (bf16*)(ws + WS_WRT);
    bf16* hn2 = (bf16*)(ws + WS_HN2); int* list = (int*)(ws + WS_LIST); float* lgate = (float*)(ws + WS_LGATE); int4* tokinfo = (int4*)(ws + WS_TOKINFO);
    float* sgate = (float*)(ws + WS_SGATE); bf16* xs = (bf16*)(ws + WS_XS); bf16* Hb = (bf16*)(ws + WS_H); bf16* Yb = (bf16*)(ws + WS_Y);
    const int gw = bid * NWAVES + wave, NGW = G * NWAVES;

    if (IN(0)) {
#ifndef DUP_P0
#define DUP_P0 1
#endif
        for (int rep0 = 0; rep0 < DUP_P0; ++rep0) {
        LAS float* scr = (LAS float*)(L + wave * 16384);
        constexpr int I_IN = (DM / 64) * (DIN / 32), I_OUT = (DM / 64) * (DM / 32), I_EXP = 768;
        for (int it = gw; it < I_IN + I_OUT + 32 * I_EXP; it += NGW) {
            if (it < I_IN) { const int nblk = DIN / 32, kb = it / nblk, nb = it % nblk; p0_transpose_item(a.in[2], DM, DIN, WinT, 32 * nb, scr, 64 * kb, 32 * nb, lane); }
            else if (it < I_IN + I_OUT) { const int r = it - I_IN; const int nblk = DM / 32, kb = r / nblk, nb = r % nblk; p0_transpose_item(a.in[27], DM, DM, WoutT, 32 * nb, scr, 64 * kb, 32 * nb, lane); }
            else { const int r = it - I_IN - I_OUT, e = r / I_EXP, q = r % I_EXP;
                if (q < 512) { const int w3 = q >> 8, qq = q & 255, kb = qq >> 4, nb = qq & 15, n0 = 32 * nb;
                    p0_transpose_item(a.in[w3 ? 34 : 33] + (size_t)e * 1024 * 512, 1024, 512, W13T, e * 1024 + (n0 >> 7) * 256 + (n0 & 127) + w3 * 128, scr, 64 * kb, n0, lane); }
                else { const int qq = q - 512, kb = qq >> 5, nb = qq & 31;
                    p0_transpose_item(a.in[35] + (size_t)e * 512 * 1024, 512, 1024, W2T, e * 1024 + 32 * nb, scr, 64 * kb, 32 * nb, lane); } }
        }
        for (int idx = bid * (NWAVES * 64) + tid; idx < 48 * 1024; idx += G * NWAVES * 64) { const int j = idx >> 10, k = idx & 1023;
            WrT[idx] = j < 4 ? f2bf(a.in[29][k * 4 + j]) : (j < 36 ? f2bf(a.in[31][k * 32 + (j - 4)]) : (bf16)0); }
        { float* hT = (float*)(ws + WS_HT);
          const float* w1 = a.in[17]; const float* b1 = a.in[18]; const float* f1 = a.in[19]; const float* w2 = a.in[20]; const float* b2 = a.in[21]; const float* f2 = a.in[22]; const float* w3 = a.in[23];
          LAS float* w3s = (LAS float*)L;
          LAS float* z2s = (LAS float*)(L + 65536);
          LAS float* fts = (LAS float*)(L + 73728);
          LAS float* ot  = (LAS float*)(L + 81920);
          for (int tile = bid; tile < SEQ / 32; tile += G) {
              __syncthreads();
              { const int tl = tid & 31, i = tid >> 5; const int t = tile * 32 + tl;
                const float wq = (6.283185307179586f / (float)SEQ) * (float)t; const float band = 1e-4f + (float)i * ((15.0f - 1e-4f) / 15.0f);
                fts[(1 + i) * 32 + tl] = cosf(wq * band); fts[(17 + i) * 32 + tl] = sinf(wq * band);
                if (i == 0) fts[tl] = (float)t / (float)(SEQ - 1); }
              __syncthreads();
              const int tl4 = tid & 31, jq = tid >> 5;
              { float s0 = b1[4 * jq], s1 = b1[4 * jq + 1], s2 = b1[4 * jq + 2], s3 = b1[4 * jq + 3];
#pragma unroll 3
                for (int i = 0; i < 33; ++i) { const float fv = fts[i * 32 + tl4]; const float4 wv = *(const float4*)(w1 + i * 64 + 4 * jq); s0 += fv * wv.x; s1 += fv * wv.y; s2 += fv * wv.z; s3 += fv * wv.w; }
                const float4 fq = *(const float4*)(f1 + 4 * jq);
                s0 = sinf(fq.x * s0); s1 = sinf(fq.y * s1); s2 = sinf(fq.z * s2); s3 = sinf(fq.w * s3);
                __syncthreads();
                fts[(4 * jq) * 32 + tl4] = s0; fts[(4 * jq + 1) * 32 + tl4] = s1; fts[(4 * jq + 2) * 32 + tl4] = s2; fts[(4 * jq + 3) * 32 + tl4] = s3; }
              __syncthreads();
              { float s0 = b2[4 * jq], s1 = b2[4 * jq + 1], s2 = b2[4 * jq + 2], s3 = b2[4 * jq + 3];
#pragma unroll 4
                for (int i = 0; i < 64; ++i) { const float zv = fts[i * 32 + tl4]; const float4 wv = *(const float4*)(w2 + i * 64 + 4 * jq); s0 += zv * wv.x; s1 += zv * wv.y; s2 += zv * wv.z; s3 += zv * wv.w; }
                const float4 fq = *(const float4*)(f2 + 4 * jq);
                z2s[(4 * jq) * 32 + tl4] = sinf(fq.x * s0); z2s[(4 * jq + 1) * 32 + tl4] = sinf(fq.y * s1); z2s[(4 * jq + 2) * 32 + tl4] = sinf(fq.z * s2); z2s[(4 * jq + 3) * 32 + tl4] = sinf(fq.w * s3); }
              const float lo_ = logf(1e-2f) / 1.5f, hi_ = logf(1e-2f) / 0.3f;
              f32x4_t pre[4];
#pragma unroll
              for (int r = 0; r < 4; ++r) { const int q = tid + 512 * r; pre[r] = *(const f32x4_t*)(w3 + (size_t)(q >> 5) * 2048 + 4 * (q & 31)); }
              const int cq = tid & 31, tq = tid >> 5;
              for (int chunk = 0; chunk < 16; ++chunk) {
                  LAS float* wb_ = w3s + (chunk & 1) * 8192;
#pragma unroll
                  for (int r = 0; r < 4; ++r) { const int q = tid + 512 * r; *(LAS f32x4_t*)(wb_ + (q >> 5) * 128 + 4 * (q & 31)) = pre[r]; }
                  __syncthreads();
                  if (chunk < 15) {
#pragma unroll
                      for (int r = 0; r < 4; ++r) { const int q = tid + 512 * r; pre[r] = *(const f32x4_t*)(w3 + (size_t)(q >> 5) * 2048 + (chunk + 1) * 128 + 4 * (q & 31)); } }
                  f32x4_t acc0 = {0.f, 0.f, 0.f, 0.f}, acc1 = acc0;
#pragma unroll 8
                  for (int j = 0; j < 64; ++j) { const f32x4_t wv = *(const LAS f32x4_t*)(wb_ + j * 128 + 4 * cq); const float z0 = z2s[j * 32 + 2 * tq], z1v = z2s[j * 32 + 2 * tq + 1];
                      acc0 += wv * z0; acc1 += wv * z1v; }
#pragma unroll
                  for (int ci = 0; ci < 4; ++ci) { ot[(4 * cq + ci) * 33 + 2 * tq] = acc0[ci]; ot[(4 * cq + ci) * 33 + 2 * tq + 1] = acc1[ci]; }
                  __syncthreads();
                  { const int tl = lane & 31, half = lane >> 5; const int t = tile * 32 + tl; const float tn = (float)t / (float)(SEQ - 1);
#pragma unroll 4
                    for (int k = 0; k < 8; ++k) { const int cl = wave * 16 + 2 * k + half; const int col = chunk * 128 + cl; const int cc = col & 511;
                        const float delta = fabsf(lo_ + (float)cc * ((hi_ - lo_) / 511.0f));
                        hT[(size_t)col * SEQ + t] = ot[cl * 33 + tl] * __expf(-tn * delta); } }
              }
          } }
        __syncthreads();
        for (int m = gw; m < NTOK; m += NGW) rms_row_to_bf16(a.in[0] + (size_t)m * DM, a.in[1], hn1 + (size_t)m * DM, lane);
        }
        if (BOTH(0)) GRID_BAR();
    }
    if (IN(1)) {
#ifndef DUP_G1
#define DUP_G1 1
#endif
        { pg8::Gemm g{hn1, WinT, NTOK, 1024, DM}; pg8::StaticOrder S; S.init(NTOK, 1024, G, bid);
          pg8::EpiBf16<0> E{lru, 1024, nullptr, 0, 0, 1.f};
          pg8::gemm_phase<pg8::EpiBf16<0>, pg8::StaticOrder, true, true>(L, g, S, E); }
        { pg8::Gemm g{WinT + (size_t)1024 * DM, hn1, 1536, NTOK, DM}; pg8::StaticOrder S; S.init(1536, NTOK, G, bid);
          pg8::EpiBf16<0> E{hyuT, NTOK, nullptr, 0, 0, 1.f};
          pg8::gemm_phase<pg8::EpiBf16<0>, pg8::StaticOrder, true, true>(L, g, S, E); }
#if DUP_G1 > 1
        { pg8::Gemm g{hn1, WinT, NTOK, 1024, DM}; pg8::StaticOrder S; S.init(NTOK, 1024, G, bid);
          pg8::EpiBf16<0> E{lru, 1024, nullptr, 0, 0, 1.f};
          pg8::gemm_phase<pg8::EpiBf16<0>, pg8::StaticOrder, true, true>(L, g, S, E); }
        { pg8::Gemm g{WinT + (size_t)1024 * DM, hn1, 1536, NTOK, DM}; pg8::StaticOrder S; S.init(1536, NTOK, G, bid);
          pg8::EpiBf16<0> E{hyuT, NTOK, nullptr, 0, 0, 1.f};
          pg8::gemm_phase<pg8::EpiBf16<0>, pg8::StaticOrder, true, true>(L, g, S, E); }
#endif
        __syncthreads();
        fft_tables_init(L, tid);
#ifndef DUP_FILT
#define DUP_FILT 1
#endif
        for (int rep = 0; rep < DUP_FILT; ++rep)
        for (int c = bid; c < DH; c += G) filter_item(L, a, c, (const float*)(ws + WS_HT), (unsigned*)(ws + WS_SPEC), tid, lane, wave);
        if (BOTH(1)) GRID_BAR();
    }

    if (IN(2)) {
        bf16* hf = (bf16*)(ws + WS_HF); bf16* hb = (bf16*)(ws + WS_HB);
#ifndef DUP_LRU
#define DUP_LRU 1
#endif
#ifndef DUP_HY
#define DUP_HY 1
#endif
        { bf16* xcb = (bf16*)(ws + WS_XCB); const float* cwp = a.in[3]; const float* cbp = a.in[4];
          for (int idx = bid * (NWAVES * 64) + tid; idx < NTOK * 64; idx += G * NWAVES * 64) {
              const int tok = idx >> 6, c8 = (idx & 63) * 8, t = tok & (SEQ - 1), bb = tok >> 13;
              float acc[8];
              { const float4 c0 = *(const float4*)(cbp + c8), c1 = *(const float4*)(cbp + c8 + 4); acc[0] = c0.x; acc[1] = c0.y; acc[2] = c0.z; acc[3] = c0.w; acc[4] = c1.x; acc[5] = c1.y; acc[6] = c1.z; acc[7] = c1.w; }
#pragma unroll
              for (int tap = 0; tap < 4; ++tap) { const int tt = t + tap - 2; const bool ok = tt >= 0 && tt < SEQ; const int tc = ok ? tt : t;
                  const v4u xv = *(const v4u*)(lru + (size_t)(bb * SEQ + tc) * 1024 + c8);
                  const float4 w0 = *(const float4*)(cwp + tap * DL + c8), w1 = *(const float4*)(cwp + tap * DL + c8 + 4);
                  const float m = ok ? 1.f : 0.f; const unsigned x0 = xv.x, x1 = xv.y, x2 = xv.z, x3 = xv.w;
                  acc[0] += m * w0.x * __uint_as_float(x0 << 16); acc[1] += m * w0.y * __uint_as_float(x0 & 0xffff0000u);
                  acc[2] += m * w0.z * __uint_as_float(x1 << 16); acc[3] += m * w0.w * __uint_as_float(x1 & 0xffff0000u);
                  acc[4] += m * w1.x * __uint_as_float(x2 << 16); acc[5] += m * w1.y * __uint_as_float(x2 & 0xffff0000u);
                  acc[6] += m * w1.z * __uint_as_float(x3 << 16); acc[7] += m * w1.w * __uint_as_float(x3 & 0xffff0000u); }
              v4u pk; pk.x = pk2(acc[0], acc[1]); pk.y = pk2(acc[2], acc[3]); pk.z = pk2(acc[4], acc[5]); pk.w = pk2(acc[6], acc[7]);
              const int hh = c8 >> 6, cl = c8 & 63;
              *(v4u*)(xcb + (((size_t)(bb * 8 + hh) * SEQ + t) * 64 + cl)) = pk; } }
        GRID_BAR();
        for (int rep = 0; rep < DUP_LRU; ++rep)
        for (int item = bid; item < 256; item += G) lru_item(L, a, item, (const bf16*)(ws + WS_XCB), hf, hb, tid, lane, wave);
        __syncthreads();
        fft_tables_init(L, tid);
        for (int rep = 0; rep < DUP_HY; ++rep)
        for (int item = bid; item < 2 * DH; item += G) hyena_item(L, a, item >> 1, item & 1, hyuT, (unsigned*)(ws + WS_SPEC), (bf16*)(ws + WS_YHYT), a.out, tid);
        if (BOTH(2)) GRID_BAR();
    }

    if (IN(3)) {
        const bf16* hf = (const bf16*)(ws + WS_HF); const bf16* hb = (const bf16*)(ws + WS_HB); const bf16* y_hyT = (const bf16*)(ws + WS_YHYT);
        const float* gA = a.in[25]; const float* gB = a.in[26];
#ifndef DUP_P3
#define DUP_P3 1
#endif
        for (int rep3 = 0; rep3 < DUP_P3; ++rep3) {
        for (int tok = gw; tok < NTOK; tok += NGW) {
            const v4u vf = *(const v4u*)(hf + (size_t)tok * DL + 8 * lane), vb = *(const v4u*)(hb + (size_t)tok * DL + 8 * lane), vg = *(const v4u*)(lru + (size_t)tok * 1024 + 512 + 8 * lane);
            const unsigned f0 = vf.x, f1 = vf.y, f2 = vf.z, f3 = vf.w, b0 = vb.x, b1 = vb.y, b2 = vb.z, b3 = vb.w, g0 = vg.x, g1 = vg.y, g2 = vg.z, g3 = vg.w;
            float y[8];
            y[0] = (__uint_as_float(f0 << 16) + __uint_as_float(b0 << 16)) * gelu_tanh(__uint_as_float(g0 << 16));
            y[1] = (__uint_as_float(f0 & 0xffff0000u) + __uint_as_float(b0 & 0xffff0000u)) * gelu_tanh(__uint_as_float(g0 & 0xffff0000u));
            y[2] = (__uint_as_float(f1 << 16) + __uint_as_float(b1 << 16)) * gelu_tanh(__uint_as_float(g1 << 16));
            y[3] = (__uint_as_float(f1 & 0xffff0000u) + __uint_as_float(b1 & 0xffff0000u)) * gelu_tanh(__uint_as_float(g1 & 0xffff0000u));
            y[4] = (__uint_as_float(f2 << 16) + __uint_as_float(b2 << 16)) * gelu_tanh(__uint_as_float(g2 << 16));
            y[5] = (__uint_as_float(f2 & 0xffff0000u) + __uint_as_float(b2 & 0xffff0000u)) * gelu_tanh(__uint_as_float(g2 & 0xffff0000u));
            y[6] = (__uint_as_float(f3 << 16) + __uint_as_float(b3 << 16)) * gelu_tanh(__uint_as_float(g3 << 16));
            y[7] = (__uint_as_float(f3 & 0xffff0000u) + __uint_as_float(b3 & 0xffff0000u)) * gelu_tanh(__uint_as_float(g3 & 0xffff0000u));
            float s = 0.f;
#pragma unroll
            for (int i = 0; i < 8; ++i) s += y[i] * y[i];
            s = wave_sum(s);
            const float rstd = rsqrtf(s * (1.0f / DL) + EPS);
            const float4 ga0 = *(const float4*)(gA + 8 * lane), ga1 = *(const float4*)(gA + 8 * lane + 4);
            v4u o; o.x = pk2(y[0] * rstd * ga0.x, y[1] * rstd * ga0.y); o.y = pk2(y[2] * rstd * ga0.z, y[3] * rstd * ga0.w);
            o.z = pk2(y[4] * rstd * ga1.x, y[5] * rstd * ga1.y); o.w = pk2(y[6] * rstd * ga1.z, y[7] * rstd * ga1.w);
            *(v4u*)(y_cat + (size_t)tok * 1024 + 8 * lane) = o;
        }
        for (int tile = bid; tile < NTOK / 64; tile += G) {
            __syncthreads();
            const int tok0 = tile * 64;
            for (int ch = tid; ch < 512 * 8; ch += NWAVES * 64) { const int c = ch >> 3, piece = ch & 7;
                const v4u v = *(const v4u*)(y_hyT + (size_t)c * NTOK + tok0 + 8 * piece);
                LAS unsigned* d = (LAS unsigned*)(L + c * 132 + piece * 16); d[0] = v.x; d[1] = v.y; d[2] = v.z; d[3] = v.w; }
            __syncthreads();
            for (int tl = wave; tl < 64; tl += NWAVES) {
                float v[8]; float s = 0.f;
#pragma unroll
                for (int i = 0; i < 4; ++i) { const int c = 2 * lane + 128 * i;
                    v[2 * i] = bf2f(*(const LAS bf16*)(L + c * 132 + tl * 2)); v[2 * i + 1] = bf2f(*(const LAS bf16*)(L + (c + 1) * 132 + tl * 2));
                    s += v[2 * i] * v[2 * i] + v[2 * i + 1] * v[2 * i + 1]; }
                s = wave_sum(s);
                const float rstd = rsqrtf(s * (1.0f / DH) + EPS);
#pragma unroll
                for (int i = 0; i < 4; ++i) { const int c = 2 * lane + 128 * i;
                    *(unsigned*)(y_cat + (size_t)(tok0 + tl) * 1024 + 512 + c) = pk2(v[2 * i] * rstd * gB[c], v[2 * i + 1] * rstd * gB[c + 1]); }
            }
        }
        }
        if (BOTH(3)) GRID_BAR();
    }
    if (IN(4)) {
        pg8::Gemm g{y_cat, WoutT, NTOK, DM, DM}; pg8::StaticOrder S; S.init(NTOK, DM, G, bid);
        pg8::EpiResF32 E{a.in[0], a.out, DM};
#ifndef DUP_P4
#define DUP_P4 1
#endif
        pg8::gemm_phase<pg8::EpiResF32, pg8::StaticOrder, true, true>(L, g, S, E);
#if DUP_P4 > 1
        pg8::gemm_phase<pg8::EpiResF32, pg8::StaticOrder, true, true>(L, g, S, E);
#endif
        if (BOTH(4)) GRID_BAR();
    }

#ifndef DUP_P5
#define DUP_P5 1
#endif
    for (int rep5 = 0; rep5 < DUP_P5; ++rep5)
    if (IN(5)) {
        const bool dummy = (rep5 + 1 < DUP_P5);
        unsigned* cntg = ctl + (dummy ? 3072 : CW_CNT);
        int* list_ = dummy ? (int*)(ws + 376 * MiB) : list; float* lgate_ = dummy ? (float*)(ws + 380 * MiB) : lgate; int4* tokinfo_ = dummy ? (int4*)(ws + 384 * MiB) : tokinfo;
        bf16* hn2_ = dummy ? (bf16*)(ws + 232 * MiB) : hn2;
        LAS float* lg = (LAS float*)(L + 98304);
        LAS int* cnt_l = (LAS int*)(L + LC_CNT); LAS int* base_l = (LAS int*)(L + LC_BASE);
        const float* xmid = a.out; const float* gff = a.in[28];
        for (int tile = bid; tile < NTOK / 128; tile += G) {
            __syncthreads();
            for (int ch = tid; ch < 48 * 128; ch += NWAVES * 64) { const int row = ch >> 7, c16 = ch & 127;
                *(LAS v4u*)(L + row * 2048 + ((c16 ^ (row & 15)) << 4)) = *(const v4u*)(WrT + (size_t)row * 1024 + c16 * 8); }
            if (tid < 32) cnt_l[tid] = 0;
            __syncthreads();
            const int tk = lane & 15, kg = lane >> 4;
            const int tokw = tile * 128 + wave * 16 + tk;
            const float* xr = xmid + (size_t)tokw * DM + 8 * kg;
            float s = 0.f;
#pragma unroll 8
            for (int st = 0; st < 32; ++st) { const float4 p = *(const float4*)(xr + 32 * st), q = *(const float4*)(xr + 32 * st + 4);
                s += (p.x * p.x + p.y * p.y) + (p.z * p.z + p.w * p.w) + (q.x * q.x + q.y * q.y) + (q.z * q.z + q.w * q.w); }
            s += __shfl_xor(s, 16); s += __shfl_xor(s, 32);
            const float rstd = rsqrtf(s * (1.0f / DM) + EPS);
            f32x4_t acc0 = {0.f, 0.f, 0.f, 0.f}, acc1 = acc0, acc2 = acc0;
            bf16* hrow = hn2_ + (size_t)tokw * DM + 8 * kg;
#pragma unroll 4
            for (int st = 0; st < 32; ++st) {
                const float4 p = *(const float4*)(xr + 32 * st), q = *(const float4*)(xr + 32 * st + 4);
                const float4 g0 = *(const float4*)(gff + 32 * st + 8 * kg), g1 = *(const float4*)(gff + 32 * st + 8 * kg + 4);
                v4u w; w.x = pk2(p.x * rstd * g0.x, p.y * rstd * g0.y); w.y = pk2(p.z * rstd * g0.z, p.w * rstd * g0.w);
                w.z = pk2(q.x * rstd * g1.x, q.y * rstd * g1.y); w.w = pk2(q.z * rstd * g1.z, q.w * rstd * g1.w);
                *(v4u*)(hrow + 32 * st) = w;
                const bf16x8_t B = __builtin_bit_cast(bf16x8_t, w);
                const int chs = ((4 * st + kg) ^ tk) << 4;
                const bf16x8_t A0 = *(const LAS bf16x8_t*)(L + (0 + tk) * 2048 + chs), A1 = *(const LAS bf16x8_t*)(L + (16 + tk) * 2048 + chs), A2 = *(const LAS bf16x8_t*)(L + (32 + tk) * 2048 + chs);
                acc0 = __builtin_amdgcn_mfma_f32_16x16x32_bf16(A0, B, acc0, 0, 0, 0);
                acc1 = __builtin_amdgcn_mfma_f32_16x16x32_bf16(A1, B, acc1, 0, 0, 0);
                acc2 = __builtin_amdgcn_mfma_f32_16x16x32_bf16(A2, B, acc2, 0, 0, 0);
            }
            { LAS float* lr = lg + (wave * 16 + tk) * 49 + 4 * kg;
#pragma unroll
              for (int r = 0; r < 4; ++r) { lr[r] = acc0[r]; lr[16 + r] = acc1[r]; lr[32 + r] = acc2[r]; } }
            __syncthreads();
            int e0 = 0, e1 = 0, r0l = 0, r1l = 0; float g0 = 0.f, g1 = 0.f;
            if (tid < 128) {
                const LAS float* lr = lg + tid * 49; const float* bgp = a.in[30]; const float* bep = a.in[32];
                int gi = 0; float gm = lr[0] + bgp[0];
                for (int i = 1; i < 4; ++i) { const float v = lr[i] + bgp[i]; if (v > gm) { gm = v; gi = i; } }
                float gs = 0.f; for (int i = 0; i < 4; ++i) gs += __expf(lr[i] + bgp[i] - gm);
                const float gp = 1.0f / gs;
                const LAS float* le = lr + 4 + gi * 8; const float* beg = bep + gi * 8;
                int i1 = 0; float m1 = le[0] + beg[0];
                for (int i = 1; i < 8; ++i) { const float v = le[i] + beg[i]; if (v > m1) { m1 = v; i1 = i; } }
                int i2 = -1; float m2 = -3.0e38f;
                for (int i = 0; i < 8; ++i) { const float v = le[i] + beg[i]; if (i != i1 && v > m2) { m2 = v; i2 = i; } }
                const float ex2 = __expf(m2 - m1);
                e0 = gi * 8 + i1; e1 = gi * 8 + i2; g0 = gp / (1.0f + ex2); g1 = gp * ex2 / (1.0f + ex2);
                r0l = atomicAdd((int*)(cnt_l + e0), 1); r1l = atomicAdd((int*)(cnt_l + e1), 1);
            }
            __syncthreads();
            if (tid < 32) { const int c = cnt_l[tid]; base_l[tid] = c ? (int)atomicAdd(cntg + tid, (unsigned)c) : 0; }
            __syncthreads();
            if (tid < 128) { const int tok = tile * 128 + tid; const int r0 = base_l[e0] + r0l, r1 = base_l[e1] + r1l;
                list_[e0 * NTOK + r0] = tok; lgate_[e0 * NTOK + r0] = g0; list_[e1 * NTOK + r1] = tok; lgate_[e1 * NTOK + r1] = g1;
                tokinfo_[tok] = make_int4(e0, r0, e1, r1); }
        }
        if (BOTH(5) && !dummy) GRID_BAR();
    }
    if (IN(6)) {
        const int T = moe_tables(L, ctl, tid);
        const LAS int* cnt = (const LAS int*)(L + LC_CNT); const LAS int* tstart = (const LAS int*)(L + LC_TSTART); const LAS int* tile_e = (const LAS int*)(L + LC_TILEE);
#ifndef DUP_P6
#define DUP_P6 1
#endif
        for (int rep6 = 0; rep6 < DUP_P6; ++rep6)
        for (int rho = gw; rho < T * 256; rho += NGW) {
            const int tau = rho >> 8, rl = rho & 255, e = tile_e[tau], r = (tau - tstart[e]) * 256 + rl;
            const bool valid = r < cnt[e];
            v4u v0 = {0u, 0u, 0u, 0u}, v1 = v0; float gt = 0.f;
            if (valid) { const int tok = list[e * NTOK + r]; gt = lgate[e * NTOK + r]; const v4u* src = (const v4u*)(hn2 + (size_t)tok * DM); v0 = src[lane]; v1 = src[lane + 64]; }
            v4u* dst = (v4u*)(xs + (size_t)rho * DM); dst[lane] = v0; dst[lane + 64] = v1;
            if (lane == 0) sgate[rho] = gt;
        }
        if (BOTH(6)) GRID_BAR();
    }
    if (IN(7)) {
        const int T = moe_tables(L, ctl, tid);
        pg8::Gemm g{xs, W13T, T * 256, 1024, DM};
        pg8::MoeOrder S{(const LAS int*)(L + LC_TILEE), T, 4, G, bid, (size_t)1024 * 1024 * 2};
        pg8::EpiSwiGLU E{Hb};
#ifndef DUP_P7
#define DUP_P7 1
#endif
        pg8::gemm_phase<pg8::EpiSwiGLU, pg8::MoeOrder, true, true>(L, g, S, E);
#if DUP_P7 > 1
        pg8::gemm_phase<pg8::EpiSwiGLU, pg8::MoeOrder, true, true>(L, g, S, E);
#endif
        if (BOTH(7)) GRID_BAR();
    }
    if (IN(8)) {
        const int T = moe_tables(L, ctl, tid);
        pg8::Gemm g{Hb, W2T, T * 256, 1024, 512};
        pg8::MoeOrder S{(const LAS int*)(L + LC_TILEE), T, 4, G, bid, (size_t)1024 * 512 * 2};
        pg8::EpiRowScaleBf16 E{Yb, 1024, sgate};
#ifndef DUP_P8
#define DUP_P8 1
#endif
        pg8::gemm_phase<pg8::EpiRowScaleBf16, pg8::MoeOrder, true, true>(L, g, S, E);
#if DUP_P8 > 1
        pg8::gemm_phase<pg8::EpiRowScaleBf16, pg8::MoeOrder, true, true>(L, g, S, E);
#endif
        if (BOTH(8)) GRID_BAR();
    }
#ifndef DUP_P9
#define DUP_P9 1
#endif
    for (int rep9 = 0; rep9 < DUP_P9; ++rep9)
    if (IN(9)) {
        float* outw = (rep9 + 1 < DUP_P9) ? (float*)(ws + 256 * MiB) : a.out;
        (void)moe_tables(L, ctl, tid);
        const LAS int* tstart = (const LAS int*)(L + LC_TSTART);
        const float* gfin = a.in[36];
        for (int tok0 = gw * 4; tok0 < NTOK; tok0 += NGW * 4) {
            float4 v[4][4]; uint2 p[4][4], q[4][4];
#pragma unroll
            for (int u = 0; u < 4; ++u) { const int4 ti = tokinfo[tok0 + u];
                const size_t s0 = (size_t)tstart[ti.x] * 256 + ti.y, s1 = (size_t)tstart[ti.z] * 256 + ti.w;
                const uint2* y0 = (const uint2*)(Yb + s0 * DM); const uint2* y1 = (const uint2*)(Yb + s1 * DM);
                const float4* xr = (const float4*)(a.out + (size_t)(tok0 + u) * DM);
#pragma unroll
                for (int j = 0; j < 4; ++j) { v[u][j] = xr[lane + 64 * j]; p[u][j] = y0[lane + 64 * j]; q[u][j] = y1[lane + 64 * j]; } }
#pragma unroll
            for (int u = 0; u < 4; ++u) { float s = 0.f;
#pragma unroll
                for (int j = 0; j < 4; ++j) { const uint2 pp = p[u][j], qq = q[u][j];
                    v[u][j].x += __uint_as_float(pp.x << 16) + __uint_as_float(qq.x << 16); v[u][j].y += __uint_as_float(pp.x & 0xffff0000u) + __uint_as_float(qq.x & 0xffff0000u);
                    v[u][j].z += __uint_as_float(pp.y << 16) + __uint_as_float(qq.y << 16); v[u][j].w += __uint_as_float(pp.y & 0xffff0000u) + __uint_as_float(qq.y & 0xffff0000u);
                    s += (v[u][j].x * v[u][j].x + v[u][j].y * v[u][j].y) + (v[u][j].z * v[u][j].z + v[u][j].w * v[u][j].w); }
                s = wave_sum(s);
                const float rstd = rsqrtf(s * (1.0f / DM) + EPS);
                float4* xw = (float4*)(outw + (size_t)(tok0 + u) * DM);
#pragma unroll
                for (int j = 0; j < 4; ++j) { const float4 gg = *(const float4*)(gfin + (lane + 64 * j) * 4);
                    xw[lane + 64 * j] = make_float4(v[u][j].x * rstd * gg.x, v[u][j].y * rstd * gg.y, v[u][j].z * rstd * gg.z, v[u][j].w * rstd * gg.w); } }
        }
    }
#undef IN
#undef BOTH
#undef GRID_BAR
}

static void launch_fwd(const Args& base, int lo, int hi, int li, int grid, hipStream_t stream) {
    Args a = base; a.ph_lo = lo; a.ph_hi = hi; a.li = li; a.pad = 0;
    hipLaunchKernelGGL(fwd, dim3(grid), dim3(NWAVES * 64), LDS_BYTES, stream, a);
}

extern "C" void kernel_launch(void* const* d_in, const int* in_sizes, int n_in, void* d_out, int out_size, void* d_ws, size_t ws_size, hipStream_t stream) {
    (void)in_sizes; (void)n_in; (void)out_size; (void)ws_size;
    static int grid = 0;
    if (grid == 0) {
        int dev = 0, cus = 0;
        (void)hipGetDevice(&dev); (void)hipDeviceGetAttribute(&cus, hipDeviceAttributeMultiprocessorCount, dev);
        (void)hipFuncSetAttribute((const void*)fwd, hipFuncAttributeMaxDynamicSharedMemorySize, LDS_BYTES);
        grid = cus > 0 ? cus : 256;
    }
    const float* const* in = (const float* const*)d_in;
    unsigned char* ws = (unsigned char*)d_ws;
    float* out = (float*)d_out;
    (void)hipMemsetAsync(ws, 0, CTL_ZERO_BYTES, stream);
    Args base{};
    for (int i = 0; i < 37; ++i) base.in[i] = in[i];
    base.out = out; base.ws = ws;

    bf16* lru = (bf16*)(ws + WS_LRU); bf16* hyuT = (bf16*)(ws + WS_HYUT); float* xc = (float*)(ws + WS_XC);
    bf16* hf = (bf16*)(ws + WS_HF); bf16* hb = (bf16*)(ws + WS_HB); float* kT = (float*)(ws + WS_KT); float* z2 = (float*)(ws + WS_Z2); float* z1T = out;
    bf16* y_hyT = (bf16*)(ws + WS_YHYT); bf16* y_cat = (bf16*)(ws + WS_YCAT); bf16* hn2 = (bf16*)(ws + WS_HN2); int* eid = (int*)(ws + WS_EID); float* gate = (float*)(ws + WS_GATE);

#ifndef MK_PER_PHASE
    launch_fwd(base, 0, 10, 0, grid, stream);
#else
    for (int ph = 0; ph < 10; ++ph) launch_fwd(base, ph, ph + 1, ph, grid, stream);
#endif
    (void)lru; (void)hyuT; (void)xc; (void)hf; (void)hb; (void)kT; (void)z2; (void)z1T; (void)y_hyT; (void)y_cat;
    (void)hn2; (void)eid; (void)gate;
}
```

```cpp
#include <hip/hip_runtime.h>
#include <stdint.h>

typedef unsigned short bf16;
__device__ __forceinline__ float bf2f(bf16 v) { return __uint_as_float(((unsigned)v) << 16); }
__device__ __forceinline__ bf16 f2bf(float f) { unsigned u = __float_as_uint(f); u += 0x7fffu + ((u >> 16) & 1u); return (bf16)(u >> 16); }

constexpr int NB = 4, SEQ = 8192, DM = 1024, NTOK = NB * SEQ, DIN = 2560, DL = 512, DH = 512;
constexpr float EPS = 1e-6f;

__device__ __forceinline__ float wave_sum(float v) {
#pragma unroll
    for (int o = 1; o < 64; o <<= 1) v += __shfl_xor(v, o);
    return v;
}
__device__ __forceinline__ float gelu_tanh(float x) { return 0.5f * x * (1.0f + tanhf(0.7978845608028654f * (x + 0.044715f * x * x * x))); }

__global__ __launch_bounds__(256) void k_rmsnorm_bf16(const float* __restrict__ x, const float* __restrict__ g, bf16* __restrict__ out) {
    const int wave = threadIdx.x >> 6, lane = threadIdx.x & 63;
    const int row = blockIdx.x * 4 + wave;
    const float4* xr = (const float4*)(x + (size_t)row * DM);
    float4 v[4]; float s = 0.f;
#pragma unroll
    for (int j = 0; j < 4; ++j) { v[j] = xr[lane + 64 * j]; s += v[j].x * v[j].x + v[j].y * v[j].y + v[j].z * v[j].z + v[j].w * v[j].w; }
    s = wave_sum(s);
    const float rstd = rsqrtf(s * (1.0f / DM) + EPS);
#pragma unroll
    for (int j = 0; j < 4; ++j) {
        const int c = (lane + 64 * j) * 4;
        const float4 gg = *(const float4*)(g + c);
        ushort4 o; o.x = f2bf(v[j].x * rstd * gg.x); o.y = f2bf(v[j].y * rstd * gg.y); o.z = f2bf(v[j].z * rstd * gg.z); o.w = f2bf(v[j].w * rstd * gg.w);
        *(ushort4*)(out + (size_t)row * DM + c) = o;
    }
}

template <int MODE>
__global__ __launch_bounds__(256) void k_gemm_naive(const bf16* __restrict__ A, const float* __restrict__ B, int M, int N, int K,
                                                    bf16* __restrict__ o_lru, bf16* __restrict__ o_hyT, const float* __restrict__ xres, float* __restrict__ o_f32) {
    __shared__ float As[16][68];
    __shared__ float Bs[16][64];
    const int tid = threadIdx.x, tx = tid & 15, ty = tid >> 4;
    const int m0 = blockIdx.y * 64, n0 = blockIdx.x * 64;
    float acc[4][4];
#pragma unroll
    for (int i = 0; i < 4; ++i)
#pragma unroll
        for (int j = 0; j < 4; ++j) acc[i][j] = 0.f;
    for (int k0 = 0; k0 < K; k0 += 16) {
        { const int r = tid >> 2, kq = (tid & 3) * 4; const ushort4 v = *(const ushort4*)(A + (size_t)(m0 + r) * K + k0 + kq);
          As[kq + 0][r] = bf2f(v.x); As[kq + 1][r] = bf2f(v.y); As[kq + 2][r] = bf2f(v.z); As[kq + 3][r] = bf2f(v.w); }
        { const int kr = tid >> 4, nq = (tid & 15) * 4; const float4 v = *(const float4*)(B + (size_t)(k0 + kr) * N + n0 + nq);
          Bs[kr][nq + 0] = v.x; Bs[kr][nq + 1] = v.y; Bs[kr][nq + 2] = v.z; Bs[kr][nq + 3] = v.w; }
        __syncthreads();
#pragma unroll
        for (int kk = 0; kk < 16; ++kk) {
            float a[4], b[4];
#pragma unroll
            for (int i = 0; i < 4; ++i) a[i] = As[kk][ty * 4 + i];
#pragma unroll
            for (int j = 0; j < 4; ++j) b[j] = Bs[kk][tx * 4 + j];
#pragma unroll
            for (int i = 0; i < 4; ++i)
#pragma unroll
                for (int j = 0; j < 4; ++j) acc[i][j] += a[i] * b[j];
        }
        __syncthreads();
    }
#pragma unroll
    for (int i = 0; i < 4; ++i)
#pragma unroll
        for (int j = 0; j < 4; ++j) {
            const int row = m0 + ty * 4 + i, col = n0 + tx * 4 + j;
            if (MODE == 0) {
                if (col < 1024) o_lru[(size_t)row * 1024 + col] = f2bf(acc[i][j]);
                else o_hyT[(size_t)(col - 1024) * NTOK + row] = f2bf(acc[i][j]);
            } else {
                o_f32[(size_t)row * N + col] = xres[(size_t)row * N + col] + acc[i][j];
            }
        }
}

__global__ __launch_bounds__(256) void k_lru_conv(const bf16* __restrict__ lru, const float* __restrict__ w, const float* __restrict__ bias, float* __restrict__ xc) {
    const size_t idx = (size_t)blockIdx.x * 256 + threadIdx.x;
    const int c = (int)(idx & 511); const int tok = (int)(idx >> 9); const int t = tok & (SEQ - 1);
    float s = bias[c];
#pragma unroll
    for (int j = 0; j < 4; ++j) { const int tt = t + j - 2; if (tt >= 0 && tt < SEQ) s += w[j * DL + c] * bf2f(lru[(size_t)(tok + j - 2) * 1024 + c]); }
    xc[idx] = s;
}

__global__ __launch_bounds__(64) void k_lru_scan(const float* __restrict__ xc,
        const float* __restrict__ wr_f, const float* __restrict__ br_f, const float* __restrict__ wi_f, const float* __restrict__ bi_f, const float* __restrict__ lam_f,
        const float* __restrict__ wr_b, const float* __restrict__ br_b, const float* __restrict__ wi_b, const float* __restrict__ bi_b, const float* __restrict__ lam_b,
        bf16* __restrict__ hf, bf16* __restrict__ hb) {
    __shared__ float wr_s[4096], wi_s[4096], xs[64];
    const int b = blockIdx.x >> 4, h = (blockIdx.x >> 1) & 7, dir = blockIdx.x & 1;
    const float* wr = dir ? wr_b : wr_f; const float* br = dir ? br_b : br_f; const float* wi = dir ? wi_b : wi_f; const float* bi = dir ? bi_b : bi_f; const float* lam = dir ? lam_b : lam_f;
    bf16* out = dir ? hb : hf;
    const int tid = threadIdx.x, c = h * 64 + tid;
    for (int i = tid; i < 4096; i += 64) { wr_s[i] = wr[h * 4096 + i]; wi_s[i] = wi[h * 4096 + i]; }
    const float br_ = br[c], bi_ = bi[c];
    const float sp = log1pf(expf(-lam[c]));
    float hs = 0.f;
    for (int step = 0; step < SEQ; ++step) {
        const int t = dir ? (SEQ - 1 - step) : step;
        const float xv = xc[((size_t)(b * SEQ + t)) * DL + c];
        __syncthreads(); xs[tid] = xv; __syncthreads();
        float dr = br_, di = bi_;
#pragma unroll 16
        for (int i = 0; i < 64; ++i) { const float xx = xs[i]; dr += xx * wr_s[i * 64 + tid]; di += xx * wi_s[i * 64 + tid]; }
        const float r = 1.0f / (1.0f + expf(-dr)), ig = 1.0f / (1.0f + expf(-di));
        const float la = -8.0f * r * sp;
        const float a = expf(la);
        const float bb = sqrtf(-expm1f(2.0f * la)) * (ig * xv);
        hs = a * hs + bb;
        out[((size_t)(b * SEQ + t)) * DL + c] = f2bf(hs);
    }
}

__global__ __launch_bounds__(64) void k_filt_z(const float* __restrict__ w1, const float* __restrict__ b1, const float* __restrict__ f1,
                                               const float* __restrict__ w2, const float* __restrict__ b2, const float* __restrict__ f2, float* __restrict__ z2out) {
    __shared__ float feats[33], z1[64];
    const int t = blockIdx.x, tid = threadIdx.x;
    const float tn = (float)t / (float)(SEQ - 1);
    const float w = (6.283185307179586f / (float)SEQ) * (float)t;
    if (tid == 0) feats[0] = tn;
    if (tid < 16) { const float band = 1e-4f + (float)tid * ((15.0f - 1e-4f) / 15.0f); const float ang = w * band; feats[1 + tid] = cosf(ang); feats[17 + tid] = sinf(ang); }
    __syncthreads();
    float s = b1[tid];
    for (int i = 0; i < 33; ++i) s += feats[i] * w1[i * 64 + tid];
    z1[tid] = sinf(f1[tid] * s);
    __syncthreads();
    s = b2[tid];
    for (int i = 0; i < 64; ++i) s += z1[i] * w2[i * 64 + tid];
    z2out[t * 64 + tid] = sinf(f2[tid] * s);
}
__global__ __launch_bounds__(256) void k_filt_h(const float* __restrict__ z2, const float* __restrict__ w3, float* __restrict__ kT) {
    __shared__ float zr[64];
    const int t = blockIdx.x, tid = threadIdx.x;
    if (tid < 64) zr[tid] = z2[t * 64 + tid];
    __syncthreads();
    const float tn = (float)t / (float)(SEQ - 1);
    const float lo = logf(1e-2f) / 1.5f, hi = logf(1e-2f) / 0.3f;
    for (int col = tid; col < 2048; col += 256) {
        float h = 0.f;
        for (int j = 0; j < 64; ++j) h += zr[j] * w3[j * 2048 + col];
        const int dir = col >> 10, o = (col >> 9) & 1, c = col & 511;
        const float delta = fabsf(lo + (float)c * ((hi - lo) / 511.0f));
        h *= expf(-tn * delta);
        const size_t row = (size_t)(o * 512 + c) * 16384;
        if (dir == 0) kT[row + 8192 + t] = h;
        else { if (t == 0) kT[row] = 0.f; else kT[row + 8192 - t] = h; }
    }
}
__global__ __launch_bounds__(256) void k_filt_norm(float* __restrict__ kT) {
    __shared__ float red[4];
    float* row = kT + (size_t)blockIdx.x * 16384;
    float s = 0.f;
    for (int i = threadIdx.x; i < 16384; i += 256) s += fabsf(row[i]);
    s = wave_sum(s);
    if ((threadIdx.x & 63) == 0) red[threadIdx.x >> 6] = s;
    __syncthreads();
    const float inv = 1.0f / (red[0] + red[1] + red[2] + red[3] + EPS);
    for (int i = threadIdx.x; i < 16384; i += 256) row[i] *= inv;
}

__device__ __forceinline__ float hy_dwconv(const bf16* __restrict__ hyuT, const float* __restrict__ cw, const float* __restrict__ cb, int ch, int b, int t) {
    const bf16* p = hyuT + (size_t)ch * NTOK + b * SEQ;
    float s = cb[ch] + cw[1 * 1536 + ch] * bf2f(p[t]);
    if (t > 0) s += cw[0 * 1536 + ch] * bf2f(p[t - 1]);
    if (t < SEQ - 1) s += cw[2 * 1536 + ch] * bf2f(p[t + 1]);
    return s;
}
template <int ORDER>
__global__ __launch_bounds__(256) void k_hy_conv(const bf16* __restrict__ hyuT, const float* __restrict__ cw, const float* __restrict__ cb, const float* __restrict__ kT,
                                                 const float* __restrict__ skip, float* __restrict__ z1T, bf16* __restrict__ y_hyT) {
    __shared__ float kk[16384];
    __shared__ float4 zs[1024];
    const int c = blockIdx.x >> 5, tile = blockIdx.x & 31, tid = threadIdx.x, t = tile * 256 + tid;
    const float* krow = kT + (size_t)((ORDER - 1) * 512 + c) * 16384;
    for (int i = tid; i < 16384; i += 256) kk[i] = krow[i];
    float acc0 = 0.f, acc1 = 0.f, acc2 = 0.f, acc3 = 0.f;
    for (int s0 = 0; s0 < SEQ; s0 += 1024) {
        __syncthreads();
        for (int i = tid; i < 1024; i += 256) {
            float4 v;
            if (ORDER == 1) { v.x = hy_dwconv(hyuT, cw, cb, c, 0, s0 + i); v.y = hy_dwconv(hyuT, cw, cb, c, 1, s0 + i); v.z = hy_dwconv(hyuT, cw, cb, c, 2, s0 + i); v.w = hy_dwconv(hyuT, cw, cb, c, 3, s0 + i); }
            else { const float* p = z1T + (size_t)c * NTOK + s0 + i; v.x = p[0]; v.y = p[SEQ]; v.z = p[2 * SEQ]; v.w = p[3 * SEQ]; }
            zs[i] = v;
        }
        __syncthreads();
        const float* kp = kk + 8192 + t - s0;
#pragma unroll 8
        for (int s = 0; s < 1024; ++s) { const float kv = kp[-s]; const float4 z = zs[s]; acc0 += kv * z.x; acc1 += kv * z.y; acc2 += kv * z.z; acc3 += kv * z.w; }
    }
    const float sk = skip[(ORDER - 1) * 512 + c];
    float accs[4] = {acc0, acc1, acc2, acc3};
#pragma unroll
    for (int b = 0; b < 4; ++b) {
        float zv, gate;
        if (ORDER == 1) { zv = hy_dwconv(hyuT, cw, cb, c, b, t); gate = hy_dwconv(hyuT, cw, cb, 512 + c, b, t); }
        else { zv = z1T[(size_t)c * NTOK + b * SEQ + t]; gate = hy_dwconv(hyuT, cw, cb, 1024 + c, b, t); }
        const float y = gate * (accs[b] + sk * zv);
        if (ORDER == 1) z1T[(size_t)c * NTOK + b * SEQ + t] = y; else y_hyT[(size_t)c * NTOK + b * SEQ + t] = f2bf(y);
    }
}

__device__ __forceinline__ float block_sum_256(float v, float* red) {
    v = wave_sum(v);
    __syncthreads();
    if ((threadIdx.x & 63) == 0) red[threadIdx.x >> 6] = v;
    __syncthreads();
    return red[0] + red[1] + red[2] + red[3];
}
__global__ __launch_bounds__(256) void k_combine(const bf16* __restrict__ hf, const bf16* __restrict__ hb, const bf16* __restrict__ lru, const bf16* __restrict__ y_hyT,
                                                 const float* __restrict__ gA, const float* __restrict__ gB, bf16* __restrict__ y_cat) {
    __shared__ float red[4];
    const int tok = blockIdx.x, tid = threadIdx.x;
    float ya[2], yb[2]; float sa = 0.f, sb = 0.f;
#pragma unroll
    for (int j = 0; j < 2; ++j) {
        const int c = tid + 256 * j;
        const float hsum = bf2f(hf[(size_t)tok * DL + c]) + bf2f(hb[(size_t)tok * DL + c]);
        const float gate = bf2f(lru[(size_t)tok * 1024 + 512 + c]);
        ya[j] = hsum * gelu_tanh(gate); sa += ya[j] * ya[j];
        yb[j] = bf2f(y_hyT[(size_t)c * NTOK + tok]); sb += yb[j] * yb[j];
    }
    sa = block_sum_256(sa, red); sb = block_sum_256(sb, red);
    const float ra = rsqrtf(sa * (1.0f / DL) + EPS), rb = rsqrtf(sb * (1.0f / DH) + EPS);
#pragma unroll
    for (int j = 0; j < 2; ++j) {
        const int c = tid + 256 * j;
        y_cat[(size_t)tok * 1024 + c] = f2bf(ya[j] * ra * gA[c]);
        y_cat[(size_t)tok * 1024 + 512 + c] = f2bf(yb[j] * rb * gB[c]);
    }
}

__global__ __launch_bounds__(256) void k_route(const float* __restrict__ xmid, const float* __restrict__ g, const float* __restrict__ wg, const float* __restrict__ bg,
                                               const float* __restrict__ we, const float* __restrict__ be, bf16* __restrict__ hn2, int* __restrict__ eid, float* __restrict__ gate) {
    __shared__ float hrow[1024];
    __shared__ float red[4];
    __shared__ float lg[36];
    const int tok = blockIdx.x, tid = threadIdx.x;
    const float4 v = *(const float4*)(xmid + (size_t)tok * DM + tid * 4);
    float s = v.x * v.x + v.y * v.y + v.z * v.z + v.w * v.w;
    s = block_sum_256(s, red);
    const float rstd = rsqrtf(s * (1.0f / DM) + EPS);
    const float4 gg = *(const float4*)(g + tid * 4);
    const float h0 = v.x * rstd * gg.x, h1 = v.y * rstd * gg.y, h2 = v.z * rstd * gg.z, h3 = v.w * rstd * gg.w;
    hrow[tid * 4 + 0] = h0; hrow[tid * 4 + 1] = h1; hrow[tid * 4 + 2] = h2; hrow[tid * 4 + 3] = h3;
    ushort4 o; o.x = f2bf(h0); o.y = f2bf(h1); o.z = f2bf(h2); o.w = f2bf(h3);
    *(ushort4*)(hn2 + (size_t)tok * DM + tid * 4) = o;
    __syncthreads();
    if (tid < 36) {
        float d;
        if (tid < 4) { d = bg[tid]; for (int k = 0; k < DM; ++k) d += hrow[k] * wg[k * 4 + tid]; }
        else { const int j = tid - 4; d = be[j]; for (int k = 0; k < DM; ++k) d += hrow[k] * we[k * 32 + j]; }
        lg[tid] = d;
    }
    __syncthreads();
    if (tid == 0) {
        int gi = 0; float gm = lg[0];
        for (int i = 1; i < 4; ++i) if (lg[i] > gm) { gm = lg[i]; gi = i; }
        float gs = 0.f; for (int i = 0; i < 4; ++i) gs += expf(lg[i] - gm);
        const float gp = 1.0f / gs;
        const float* le = lg + 4 + gi * 8;
        int i1 = 0; float m1 = le[0];
        for (int i = 1; i < 8; ++i) if (le[i] > m1) { m1 = le[i]; i1 = i; }
        int i2 = -1; float m2 = -3.0e38f;
        for (int i = 0; i < 8; ++i) if (i != i1 && le[i] > m2) { m2 = le[i]; i2 = i; }
        const float e1 = 1.0f, e2 = expf(m2 - m1);
        eid[tok * 2 + 0] = gi * 8 + i1; eid[tok * 2 + 1] = gi * 8 + i2;
        gate[tok * 2 + 0] = gp * e1 / (e1 + e2); gate[tok * 2 + 1] = gp * e2 / (e1 + e2);
    }
}

__global__ __launch_bounds__(512) void k_moe_final(const bf16* __restrict__ hn2, const int* __restrict__ eid, const float* __restrict__ gate,
                                                   const float* __restrict__ w1, const float* __restrict__ w3, const float* __restrict__ w2,
                                                   const float* __restrict__ gfin, float* __restrict__ out) {
    __shared__ float hrow[1024];
    __shared__ float act[512];
    __shared__ float red[8];
    const int tok = blockIdx.x, tid = threadIdx.x;
    hrow[tid] = bf2f(hn2[(size_t)tok * DM + tid]); hrow[tid + 512] = bf2f(hn2[(size_t)tok * DM + tid + 512]);
    float y0 = 0.f, y1 = 0.f;
    for (int k = 0; k < 2; ++k) {
        const int e = eid[tok * 2 + k]; const float gk = gate[tok * 2 + k];
        const float* W1 = w1 + (size_t)e * 1024 * 512; const float* W3 = w3 + (size_t)e * 1024 * 512; const float* W2 = w2 + (size_t)e * 512 * 1024;
        __syncthreads();
        float a = 0.f, b = 0.f;
#pragma unroll 8
        for (int i = 0; i < 1024; ++i) { const float hv = hrow[i]; a += hv * W1[(size_t)i * 512 + tid]; b += hv * W3[(size_t)i * 512 + tid]; }
        act[tid] = (a / (1.0f + expf(-a))) * b;
        __syncthreads();
        float p0 = 0.f, p1 = 0.f;
#pragma unroll 8
        for (int i = 0; i < 512; ++i) { const float av = act[i]; p0 += av * W2[(size_t)i * 1024 + tid]; p1 += av * W2[(size_t)i * 1024 + tid + 512]; }
        y0 += gk * p0; y1 += gk * p1;
    }
    const float v0 = out[(size_t)tok * DM + tid] + y0, v1 = out[(size_t)tok * DM + tid + 512] + y1;
    float s = v0 * v0 + v1 * v1;
    s = wave_sum(s);
    __syncthreads();
    if ((tid & 63) == 0) red[tid >> 6] = s;
    __syncthreads();
    float tot = 0.f;
#pragma unroll
    for (int i = 0; i < 8; ++i) tot += red[i];
    const float rstd = rsqrtf(tot * (1.0f / DM) + EPS);
    out[(size_t)tok * DM + tid] = v0 * rstd * gfin[tid];
    out[(size_t)tok * DM + tid + 512] = v1 * rstd * gfin[tid + 512];
}

constexpr size_t MiB = 1u << 20;
namespace pg8 {
#define PG8_LAS __attribute__((address_space(3)))
typedef unsigned short bf16_t;
typedef short bf16x8 __attribute__((ext_vector_type(8)));
typedef float f32x4 __attribute__((ext_vector_type(4)));
typedef unsigned u32x4 __attribute__((ext_vector_type(4)));
constexpr int BM = 256, BK = 64, HALF = 128, HTB = HALF * BK * 2  , STAGE_BYTES = 8 * HTB, NXCD = 8, WGM = 8;

__host__ __device__ __forceinline__ int lds_byte(int r, int c) { const int st = (r >> 4) * 2 + (c >> 5), rr = r & 15, cc = c & 31, ob = rr * 64 + cc * 2; return st * 1024 + (ob ^ (((ob >> 9) & 1) << 5)); }
__host__ __device__ __forceinline__ void stage_rc(int b, int& R, int& C) { const int st = b / 1024, sb = b % 1024, swz = sb ^ (((sb >> 9) & 1) << 5); R = (st >> 1) * 16 + swz / 64; C = (st & 1) * 32 + (swz % 64) / 2; }
__host__ __device__ __forceinline__ int perm32(int rho) { const int n = rho >> 4, i = rho & 15; return 8 * (i >> 2) + 4 * n + (i & 3); }

struct Unit { int pm, pn; };
struct Gemm { const bf16_t* A; const bf16_t* Bt; int M, N, K; };

struct StaticOrder {
    int nM, nN, nwg, G, c;
    __host__ __device__ void init(int M, int N, int G_, int c_) { nM = M / BM; nN = N / BM; nwg = nM * nN; G = G_; c = c_; }
    __host__ __device__ bool next(int i, Unit& u) const {
        const long L = (long)i * G + c; if (L >= nwg) return false;
        int wgid = (int)L; { const int q = nwg / NXCD, r = nwg % NXCD, xcd = wgid % NXCD, off = wgid / NXCD; wgid = (xcd < r ? xcd * (q + 1) : r * (q + 1) + (xcd - r) * q) + off; }
        const int nig = WGM * nN, gid = wgid / nig, fm = gid * WGM, gsz = (nM - fm) < WGM ? (nM - fm) : WGM;
        u.pm = fm + ((wgid % nig) % gsz); u.pn = (wgid % nig) / gsz; return true;
    }
    __device__ __forceinline__ void a_ready(const Unit&) const {}
    __device__ __forceinline__ void done(const Unit&) const {}
    __device__ __forceinline__ const char* a_base(const Gemm& g, const Unit& u) const { return (const char*)g.A + (size_t)u.pm * ((size_t)BM * g.K * 2); }
    __device__ __forceinline__ const char* b_base(const Gemm& g, const Unit& u) const { return (const char*)g.Bt + (size_t)u.pn * ((size_t)BM * g.K * 2); }
};

__device__ __forceinline__ unsigned cvt_pk_bf16(float lo, float hi) { unsigned r; asm volatile("v_cvt_pk_bf16_f32 %0, %1, %2" : "=v"(r) : "v"(lo), "v"(hi)); return r; }
typedef float f32x2 __attribute__((ext_vector_type(2)));
__device__ __forceinline__ f32x2 gelu_pk(f32x2 v) {
    const f32x2 av = __builtin_elementwise_abs(v), d = av * 0.2316418882f + 1.0f;
    f32x2 t; t.x = __builtin_amdgcn_rcpf(d.x); t.y = __builtin_amdgcn_rcpf(d.y);
    f32x2 q = t * 0.5307027145f + (-0.7265760135f); q = q * t + 0.7107068705f; q = q * t + (-0.142248368f); q = q * t + 0.127414796f; q = q * t;
    const f32x2 s = (v * v) * (-0.72134752044f);
    f32x2 e; e.x = __builtin_amdgcn_exp2f(s.x); e.y = __builtin_amdgcn_exp2f(s.y);
    const f32x2 m = v * (q * e), r = v - m;
    f32x2 o; o.x = v.x < 0.f ? m.x : r.x; o.y = v.y < 0.f ? m.y : r.y; return o;
}

template <int ACT  > struct EpiBf16 {
    static constexpr bool PERM = true, AFTER_DRAIN = false; static_assert(ACT == 0 || ACT == 1, "EpiBf16: ACT is 0 (none) or 1 (gelu_pk)");
    bf16_t* O; int ldc; const float* bias; int split_cols; size_t split_stride; float scale0;
    __device__ __forceinline__ void operator()(const f32x4 (&acc)[2][2][4][2], const Unit& u, int wr, int wc, int fr, int fq) const {
        const int row0 = u.pm * BM + wr * 64 + fr; int colt = u.pn * BM; bf16_t* base = O;
        float sc = 1.f; if (split_cols) { const int t = colt / split_cols; base += (size_t)t * split_stride; colt -= t * split_cols; if (t == 0) sc = scale0; }
        const int col0 = colt + wc * 32 + 8 * fq, bcol0 = u.pn * BM + wc * 32 + 8 * fq;
        f32x4 bv[2][2];
#pragma unroll
        for (int bj = 0; bj < 2; ++bj)
#pragma unroll
            for (int n = 0; n < 2; ++n) bv[bj][n] = bias ? *(const f32x4*)(bias + bcol0 + bj * HALF + 4 * n) : (f32x4){0.f, 0.f, 0.f, 0.f};
#pragma unroll
        for (int ai = 0; ai < 2; ++ai)
#pragma unroll
            for (int m = 0; m < 4; ++m) { bf16_t* rowp = base + (size_t)(row0 + ai * HALF + m * 16) * ldc + col0;
#pragma unroll
                for (int bj = 0; bj < 2; ++bj) { f32x4 v0 = acc[ai][bj][m][0] + bv[bj][0], v1 = acc[ai][bj][m][1] + bv[bj][1];
                    if (ACT == 1) { f32x2 a = gelu_pk((f32x2){v0[0], v0[1]}), b = gelu_pk((f32x2){v0[2], v0[3]}), c = gelu_pk((f32x2){v1[0], v1[1]}), d = gelu_pk((f32x2){v1[2], v1[3]});
                        v0 = (f32x4){a.x, a.y, b.x, b.y}; v1 = (f32x4){c.x, c.y, d.x, d.y}; }
                    v0 = v0 * sc; v1 = v1 * sc; u32x4 w; w.x = cvt_pk_bf16(v0[0], v0[1]); w.y = cvt_pk_bf16(v0[2], v0[3]); w.z = cvt_pk_bf16(v1[0], v1[1]); w.w = cvt_pk_bf16(v1[2], v1[3]);
                    *(u32x4*)(rowp + bj * HALF) = w; } }
    }
};

struct EpiResF32 {
    static constexpr bool PERM = false, AFTER_DRAIN = false;
    const float* X; float* O; int ldc;
    __device__ __forceinline__ void operator()(const f32x4 (&acc)[2][2][4][2], const Unit& u, int wr, int wc, int fr, int fq) const {
        const int row0 = u.pm * BM + wr * 64 + fr, col0 = u.pn * BM + wc * 32 + 4 * fq;
#pragma unroll
        for (int ai = 0; ai < 2; ++ai)
#pragma unroll
            for (int m = 0; m < 4; ++m) { const size_t off = (size_t)(row0 + ai * HALF + m * 16) * ldc + col0;
#pragma unroll
                for (int bj = 0; bj < 2; ++bj)
#pragma unroll
                    for (int n = 0; n < 2; ++n) { const f32x4 xv = *(const f32x4*)(X + off + bj * HALF + n * 16); *(f32x4*)(O + off + bj * HALF + n * 16) = acc[ai][bj][m][n] + xv; } }
    }
};

struct MoeOrder {
    const PG8_LAS int* tile_e; int T, nN, G, c; size_t expert_stride_bytes;
    __device__ __forceinline__ bool next(int i, Unit& u) const {
        const int L = i * G + c; if (L >= T * nN) return false;
        u.pm = L / nN; u.pn = L % nN; return true;
    }
    __device__ __forceinline__ void a_ready(const Unit&) const {}
    __device__ __forceinline__ void done(const Unit&) const {}
    __device__ __forceinline__ const char* a_base(const Gemm& g, const Unit& u) const { return (const char*)g.A + (size_t)u.pm * ((size_t)BM * g.K * 2); }
    __device__ __forceinline__ const char* b_base(const Gemm& g, const Unit& u) const { return (const char*)g.Bt + (size_t)tile_e[u.pm] * expert_stride_bytes + (size_t)u.pn * ((size_t)BM * g.K * 2); }
};
__device__ __forceinline__ float silu_f(float a) { return a * __builtin_amdgcn_rcpf(1.0f + __builtin_amdgcn_exp2f(-1.4426950408889634f * a)); }
struct EpiSwiGLU {
    static constexpr bool PERM = true, AFTER_DRAIN = false;
    bf16_t* H;
    __device__ __forceinline__ void operator()(const f32x4 (&acc)[2][2][4][2], const Unit& u, int wr, int wc, int fr, int fq) const {
        const int row0 = u.pm * BM + wr * 64 + fr, col0 = u.pn * 128 + wc * 32 + 8 * fq;
#pragma unroll
        for (int ai = 0; ai < 2; ++ai)
#pragma unroll
            for (int m = 0; m < 4; ++m) { bf16_t* p = H + (size_t)(row0 + ai * HALF + m * 16) * 512 + col0;
                const f32x4 a0 = acc[ai][0][m][0], a1 = acc[ai][0][m][1], b0 = acc[ai][1][m][0], b1 = acc[ai][1][m][1];
                u32x4 w; w.x = cvt_pk_bf16(silu_f(a0[0]) * b0[0], silu_f(a0[1]) * b0[1]); w.y = cvt_pk_bf16(silu_f(a0[2]) * b0[2], silu_f(a0[3]) * b0[3]);
                w.z = cvt_pk_bf16(silu_f(a1[0]) * b1[0], silu_f(a1[1]) * b1[1]); w.w = cvt_pk_bf16(silu_f(a1[2]) * b1[2], silu_f(a1[3]) * b1[3]);
                *(u32x4*)p = w; }
    }
};
struct EpiRowScaleBf16 {
    static constexpr bool PERM = true, AFTER_DRAIN = false;
    bf16_t* O; int ldc; const float* rowscale;
    __device__ __forceinline__ void operator()(const f32x4 (&acc)[2][2][4][2], const Unit& u, int wr, int wc, int fr, int fq) const {
        const int row0 = u.pm * BM + wr * 64 + fr, col0 = u.pn * BM + wc * 32 + 8 * fq;
#pragma unroll
        for (int ai = 0; ai < 2; ++ai)
#pragma unroll
            for (int m = 0; m < 4; ++m) { const int row = row0 + ai * HALF + m * 16; const float sc = rowscale[row]; bf16_t* rowp = O + (size_t)row * ldc + col0;
#pragma unroll
                for (int bj = 0; bj < 2; ++bj) { const f32x4 v0 = acc[ai][bj][m][0] * sc, v1 = acc[ai][bj][m][1] * sc;
                    u32x4 w; w.x = cvt_pk_bf16(v0[0], v0[1]); w.y = cvt_pk_bf16(v0[2], v0[3]); w.z = cvt_pk_bf16(v1[0], v1[1]); w.w = cvt_pk_bf16(v1[2], v1[3]);
                    *(u32x4*)(rowp + bj * HALF) = w; } }
    }
};
template <class Epi, class Sched, bool ALIGN_EPI = false, bool SP2 = false>
__device__ __forceinline__ void gemm_phase(PG8_LAS unsigned char* lds, const Gemm g, const Sched& S, const Epi& E) {
    const int tid = threadIdx.x, wid = __builtin_amdgcn_readfirstlane(tid >> 6), lane = tid & 63, wr = wid >> 2, wc = wid & 3, fr = lane & 15, fq = lane >> 4;
    const int K = g.K, nt = K / BK;
    unsigned voffA[2], voffB[2];
#pragma unroll
    for (int i = 0; i < 2; ++i) { int R, C; stage_rc(tid * 16 + i * 8192, R, C); const int Rb = Epi::PERM ? ((R & ~31) + perm32(R & 31)) : R;
        voffA[i] = (unsigned)(R * K + C) * 2u; voffB[i] = (unsigned)(Rb * K + C) * 2u; }
    const size_t kstep = (size_t)(BK * 2);
    const size_t hstep = (size_t)HALF * K * 2;
    const size_t tstep = 2 * hstep; (void)tstep;
    const unsigned ldsw = (unsigned)wid * 1024u;
    const int aoff = lds_byte(wr * 64 + fr, fq * 8), boff = lds_byte(wc * 32 + fr, fq * 8);
#define PG8_SA(b, h) (((b) * 2 + (h)) * HTB)
#define PG8_SB(b, h) ((4 + (b) * 2 + (h)) * HTB)
#define PG8_STAGE(bufoff, gbase, voff) do { _Pragma("unroll") for (int _i = 0; _i < 2; ++_i) \
        __builtin_amdgcn_global_load_lds((const unsigned*)((const char*)(gbase) + (voff)[_i]), (PG8_LAS unsigned*)(lds + (bufoff) + ldsw + _i * 8192), 16, 0, 0); } while (0)
#define PG8_LDA(dst, b, h) do { _Pragma("unroll") for (int m = 0; m < 4; ++m) _Pragma("unroll") for (int k = 0; k < 2; ++k) dst[m][k] = *(const PG8_LAS bf16x8*)(lds + PG8_SA(b, h) + aoff + m * 2048 + k * 1024); } while (0)
#define PG8_LDB(dst, b, h) do { _Pragma("unroll") for (int n = 0; n < 2; ++n) _Pragma("unroll") for (int k = 0; k < 2; ++k) dst[n][k] = *(const PG8_LAS bf16x8*)(lds + PG8_SB(b, h) + boff + n * 2048 + k * 1024); } while (0)
#define PG8_MMA(ai, bj, At, Bt) do { __builtin_amdgcn_s_setprio(1); _Pragma("unroll") for (int m = 0; m < 4; ++m) _Pragma("unroll") for (int n = 0; n < 2; ++n) _Pragma("unroll") for (int k = 0; k < 2; ++k) \
        acc[ai][bj][m][n] = __builtin_amdgcn_mfma_f32_16x16x32_bf16(Bt[n][k], At[m][k], acc[ai][bj][m][n], 0, 0, 0); __builtin_amdgcn_s_setprio(0); } while (0)
#define PG8_WAIT_V(n) asm volatile("s_waitcnt vmcnt(" #n ")" ::: "memory")
#define PG8_WAIT_L(n) asm volatile("s_waitcnt lgkmcnt(" #n ")" ::: "memory")
#define PG8_BAR __builtin_amdgcn_s_barrier()
#define PG8_SCHED __builtin_amdgcn_sched_barrier(0)
    Unit cur, nxt; int ui = 0;
    if (!S.next(0, cur)) return;
    f32x4 acc[2][2][4][2];
#pragma unroll
    for (int a = 0; a < 2; ++a)
#pragma unroll
        for (int b = 0; b < 2; ++b)
#pragma unroll
            for (int m = 0; m < 4; ++m)
#pragma unroll
                for (int n = 0; n < 2; ++n) acc[a][b][m][n] = (f32x4){0.f, 0.f, 0.f, 0.f};
    bf16x8 At[4][2], B0[2][2], B1[2][2];
    const char* cA = S.a_base(g, cur); const char* cB = S.b_base(g, cur);
    S.a_ready(cur);
    if constexpr (SP2) {
        PG8_STAGE(PG8_SB(0, 0), cB, voffB); PG8_STAGE(PG8_SB(0, 1), cB + hstep, voffB); PG8_STAGE(PG8_SA(0, 0), cA, voffA); PG8_STAGE(PG8_SA(0, 1), cA + hstep, voffA);
        if (wr == 1) PG8_BAR;
        PG8_WAIT_V(2); PG8_BAR;
        PG8_STAGE(PG8_SB(1, 0), cB + kstep, voffB); PG8_STAGE(PG8_SA(1, 0), cA + kstep, voffA); PG8_STAGE(PG8_SB(1, 1), cB + hstep + kstep, voffB);
        PG8_WAIT_V(6); PG8_BAR;
    } else {
        PG8_STAGE(PG8_SB(0, 0), cB, voffB); PG8_STAGE(PG8_SA(0, 0), cA, voffA); PG8_STAGE(PG8_SB(0, 1), cB + hstep, voffB); PG8_STAGE(PG8_SA(0, 1), cA + hstep, voffA);
        if (wr == 1) PG8_BAR;
        PG8_WAIT_V(4); PG8_BAR;
        PG8_STAGE(PG8_SB(1, 0), cB + kstep, voffB); PG8_STAGE(PG8_SA(1, 0), cA + kstep, voffA); PG8_STAGE(PG8_SB(1, 1), cB + hstep + kstep, voffB);
        PG8_WAIT_V(6); PG8_BAR;
    }
    for (;;) {
        const bool has_next = S.next(ui + 1, nxt);
        const char* nA = has_next ? S.a_base(g, nxt) : cA; const char* nB = has_next ? S.b_base(g, nxt) : cB;
        for (int t = 0; t < nt; t += 2) {
            const bool last = (t == nt - 2);
            const char* a1 = cA + (size_t)(t + 1) * kstep;
            const char* a2 = last ? nA : cA + (size_t)(t + 2) * kstep; const char* b2 = last ? nB : cB + (size_t)(t + 2) * kstep;
            const char* a3 = a2 + kstep; const char* b3 = b2 + kstep;
            if (last && has_next) S.a_ready(nxt);
            if constexpr (SP2) {
            PG8_LDB(B0, 0, 0); PG8_LDB(B1, 0, 1); PG8_SCHED; PG8_LDA(At, 0, 0); PG8_STAGE(PG8_SA(1, 1), a1 + hstep, voffA);
            PG8_WAIT_V(8); PG8_WAIT_L(0); PG8_BAR; PG8_MMA(0, 0, At, B0); PG8_MMA(0, 1, At, B1); PG8_BAR; PG8_SCHED;
            PG8_LDA(At, 0, 1); PG8_STAGE(PG8_SB(0, 0), b2, voffB); PG8_STAGE(PG8_SB(0, 1), b2 + hstep, voffB); PG8_STAGE(PG8_SA(0, 0), a2, voffA);
            PG8_WAIT_V(8); PG8_WAIT_L(0); PG8_BAR; PG8_MMA(1, 0, At, B0); PG8_MMA(1, 1, At, B1); PG8_BAR; PG8_SCHED;
            PG8_LDB(B0, 1, 0); PG8_LDB(B1, 1, 1); PG8_SCHED; PG8_LDA(At, 1, 0); PG8_STAGE(PG8_SA(0, 1), a2 + hstep, voffA);
            PG8_WAIT_V(8); PG8_WAIT_L(0); PG8_BAR; PG8_MMA(0, 0, At, B0); PG8_MMA(0, 1, At, B1); PG8_BAR; PG8_SCHED;
            PG8_LDA(At, 1, 1); PG8_STAGE(PG8_SB(1, 0), b3, voffB); PG8_STAGE(PG8_SB(1, 1), b3 + hstep, voffB); PG8_STAGE(PG8_SA(1, 0), a3, voffA);
            PG8_WAIT_V(8); PG8_WAIT_L(0); PG8_BAR; PG8_MMA(1, 0, At, B0); PG8_MMA(1, 1, At, B1); PG8_BAR; PG8_SCHED;
            } else {
            PG8_LDB(B0, 0, 0); PG8_SCHED; PG8_LDA(At, 0, 0); PG8_STAGE(PG8_SA(1, 1), a1 + hstep, voffA);
            PG8_WAIT_L(8); PG8_BAR; PG8_WAIT_L(0); PG8_MMA(0, 0, At, B0); PG8_BAR; PG8_SCHED;
            PG8_LDB(B1, 0, 1); PG8_STAGE(PG8_SB(0, 0), b2, voffB);
            PG8_BAR; PG8_WAIT_L(0); PG8_MMA(0, 1, At, B1); PG8_BAR;
            PG8_LDA(At, 0, 1); PG8_STAGE(PG8_SA(0, 0), a2, voffA);
            PG8_BAR; PG8_WAIT_L(0); PG8_MMA(1, 0, At, B0); PG8_BAR; PG8_SCHED;
            PG8_STAGE(PG8_SB(0, 1), b2 + hstep, voffB);
            PG8_WAIT_V(6); PG8_BAR; PG8_MMA(1, 1, At, B1); PG8_BAR;
            PG8_LDB(B0, 1, 0); PG8_SCHED; PG8_LDA(At, 1, 0); PG8_STAGE(PG8_SA(0, 1), a2 + hstep, voffA);
            PG8_WAIT_L(8); PG8_BAR; PG8_WAIT_L(0); PG8_MMA(0, 0, At, B0); PG8_BAR; PG8_SCHED;
            PG8_LDB(B1, 1, 1); PG8_STAGE(PG8_SB(1, 0), b3, voffB);
            PG8_BAR; PG8_WAIT_L(0); PG8_MMA(0, 1, At, B1); PG8_BAR;
            PG8_LDA(At, 1, 1); PG8_STAGE(PG8_SA(1, 0), a3, voffA);
            PG8_BAR; PG8_WAIT_L(0); PG8_MMA(1, 0, At, B0); PG8_BAR; PG8_SCHED;
            PG8_STAGE(PG8_SB(1, 1), b3 + hstep, voffB);
            PG8_WAIT_V(6); PG8_BAR; PG8_MMA(1, 1, At, B1); PG8_BAR;
            }
        }
        if constexpr (ALIGN_EPI) { if (wr == 0) PG8_BAR; }
        if constexpr (!Epi::AFTER_DRAIN) { E(acc, cur, wr, wc, fr, fq); S.done(cur); }
        if (!has_next) break;
#pragma unroll
        for (int a = 0; a < 2; ++a)
#pragma unroll
            for (int b = 0; b < 2; ++b)
#pragma unroll
                for (int m = 0; m < 4; ++m)
#pragma unroll
                    for (int n = 0; n < 2; ++n) acc[a][b][m][n] = (f32x4){0.f, 0.f, 0.f, 0.f};
        cur = nxt; cA = nA; cB = nB; ++ui;
        if constexpr (ALIGN_EPI) { if (wr == 1) PG8_BAR; }
    }
    PG8_WAIT_V(0);
    if constexpr (!ALIGN_EPI) { if (wr == 0) PG8_BAR; }
    PG8_BAR;
    if constexpr (Epi::AFTER_DRAIN) { E.fused(acc, cur, wr, wc, fr, fq, lds, wid, lane); S.done(cur); }
#undef PG8_SA
#undef PG8_SB
#undef PG8_STAGE
#undef PG8_LDA
#undef PG8_LDB
#undef PG8_MMA
#undef PG8_WAIT_V
#undef PG8_WAIT_L
#undef PG8_BAR
#undef PG8_SCHED
}
}
#define LAS __attribute__((address_space(3)))
#define XB_TMO      128
#define XB_XCNT(j)  (256  + 64 * (j))
#define XB_XSUB(j)  (1280 + 64 * (j))
#define XB_XGEN(j)  (2304 + 64 * (j))
#define XB_TOP      3328
#define XB_TOPGEN   3392
#define XCD_BAR_WORDS 3456
#define XB_SPIN_CAP (1u << 18)

__device__ __forceinline__ unsigned xb_ld(unsigned* p)              { return __hip_atomic_load(p, __ATOMIC_RELAXED, __HIP_MEMORY_SCOPE_AGENT); }
__device__ __forceinline__ unsigned xb_add(unsigned* p, unsigned v) { return __hip_atomic_fetch_add(p, v, __ATOMIC_RELAXED, __HIP_MEMORY_SCOPE_AGENT); }
__device__ __forceinline__ unsigned xb_xcc_id() { return (unsigned)__builtin_amdgcn_s_getreg((3 << 11) | 20) & 0xFu; }
#define XB_SPIN(cond, bar) do { unsigned _sp = 0; while (cond) { __builtin_amdgcn_s_sleep(1); \
    if ((++_sp & 255u) == 0u) { if (xb_ld(&(bar)[XB_TMO])) break; if (_sp > XB_SPIN_CAP) { atomicAdd(&(bar)[XB_TMO], 1u); break; } } } } while (0)

struct XcdBarrier {
    unsigned* bar; unsigned x;
    volatile LAS unsigned* st;
};

__device__ __forceinline__ XcdBarrier xcd_barrier_post(unsigned* bar, volatile LAS unsigned* st) {
    XcdBarrier b; b.bar = bar; b.x = xb_xcc_id(); b.st = st;
    if (threadIdx.x == 0) (void)xb_add(&bar[XB_XCNT(b.x)], 1u);
    return b;
}
__device__ __forceinline__ void xcd_barrier_complete(unsigned* bar, unsigned x, unsigned& nloc, unsigned& nx) {
    const unsigned G = gridDim.x * gridDim.y * gridDim.z;
    unsigned sum, cnt, mine, sp = 0u;
    for (;;) {
        sum = 0u; cnt = 0u; mine = 0u;
#pragma unroll
        for (unsigned j = 0; j < 16; ++j) { const unsigned c = xb_ld(&bar[XB_XCNT(j)]); sum += c; cnt += (c > 0u) ? 1u : 0u; mine = (j == x) ? c : mine; }
        if (sum == G) break;
        __builtin_amdgcn_s_sleep(1);
        if ((++sp & 255u) == 0u) { if (xb_ld(&bar[XB_TMO])) break; if (sp > XB_SPIN_CAP) { atomicAdd(&bar[XB_TMO], 1u); break; } }
    }
    nloc = mine > 0u ? mine : 1u; nx = cnt > 0u ? cnt : 1u;
}

__device__ __forceinline__ void xcd_barrier(const XcdBarrier& b) {
    asm volatile("s_waitcnt vmcnt(0)" ::: "memory");
    __syncthreads();
    if (threadIdx.x == 0) {
        unsigned* bar = b.bar;
        __builtin_amdgcn_s_waitcnt(0);
        unsigned nloc = b.st[0], nx = b.st[1];
        if (nloc == 0u) { xcd_barrier_complete(bar, b.x, nloc, nx); b.st[0] = nloc; b.st[1] = nx; }
        const unsigned old = xb_add(&bar[XB_XSUB(b.x)], 1u);
        const unsigned gen = old / nloc;
        if (old + 1u == (gen + 1u) * nloc) {
            __builtin_amdgcn_fence(__ATOMIC_RELEASE, "agent");
            asm volatile("s_waitcnt vmcnt(0)" ::: "memory");
            const unsigned og = xb_add(&bar[XB_TOP], 1u);
            const unsigned tg = og / nx;
            if (og + 1u == (tg + 1u) * nx) xb_add(&bar[XB_TOPGEN], 1u);
            else XB_SPIN(xb_ld(&bar[XB_TOPGEN]) == tg, bar);
            __builtin_amdgcn_fence(__ATOMIC_ACQUIRE, "agent");
            xb_add(&bar[XB_XGEN(b.x)], 1u);
            asm volatile("s_waitcnt vmcnt(0)" ::: "memory");
        } else {
            XB_SPIN(xb_ld(&bar[XB_XGEN(b.x)]) == gen, bar);
            __builtin_amdgcn_fence(__ATOMIC_ACQUIRE, "agent");
            asm volatile("s_waitcnt vmcnt(0)" ::: "memory");
        }
    }
    __syncthreads();
}

#define GAS __attribute__((address_space(1)))
typedef unsigned v4u __attribute__((ext_vector_type(4)));
#define LDS_WAIT() asm volatile("s_waitcnt lgkmcnt(0)" ::: "memory")
constexpr int NWAVES = 8;
constexpr int RING_BYTES = 139264, LDSCTL_OFF = RING_BYTES, MISC_OFF = LDSCTL_OFF + 320, LDS_BYTES = 155648;
constexpr size_t CTL_ZERO_BYTES = 1 * MiB;
constexpr int CW_BAR = 4096;
constexpr int MAX_LAUNCHES = 12;
static_assert((CW_BAR + MAX_LAUNCHES * XCD_BAR_WORDS) * 4 <= (int)CTL_ZERO_BYTES, "ctl");

constexpr size_t WS_WINT = 1 * MiB, WS_WOUTT = 6 * MiB, WS_W13T = 8 * MiB, WS_W2T = 72 * MiB;
constexpr size_t WS_HN1 = 104 * MiB, WS_LRU = 168 * MiB, WS_HYUT = 232 * MiB, WS_HF = 396 * MiB, WS_HB = 428 * MiB;
constexpr size_t WS_YHYT = 104 * MiB, WS_YCAT = 232 * MiB, WS_HN2 = 168 * MiB, WS_EID = 460 * MiB, WS_GATE = 461 * MiB;
constexpr size_t WS_LIST = 460 * MiB, WS_LGATE = 464 * MiB, WS_TOKINFO = 468 * MiB, WS_WRT = 469 * MiB, WS_SGATE = 470 * MiB;
constexpr size_t WS_XS = 232 * MiB, WS_H = 376 * MiB, WS_Y = 104 * MiB;
constexpr size_t WS_XC = 104 * MiB, WS_Z2 = 392 * MiB, WS_KT = 328 * MiB;
constexpr int CW_CNT = 2048;
constexpr int LC_CNT = RING_BYTES + 1024, LC_BASE = RING_BYTES + 1152, LC_TSTART = RING_BYTES + 1280, LC_TILEE = RING_BYTES + 2048;

struct Args { const float* in[37]; float* out; unsigned char* ws; int ph_lo, ph_hi, li, pad; };

__device__ __forceinline__ unsigned pk2(float lo, float hi) { return (unsigned)f2bf(lo) | ((unsigned)f2bf(hi) << 16); }

__device__ __forceinline__ void p0_transpose_item(const float* __restrict__ W, int K, int N, bf16* __restrict__ WT, int drow0, LAS float* scr, int k0, int n0, int lane) {
#pragma unroll 8
    for (int i = 0; i < 32; ++i) { const int kk = 2 * i + (lane >> 5); scr[kk * 33 + (lane & 31)] = W[(size_t)(k0 + kk) * N + n0 + (lane & 31)]; }
    LDS_WAIT(); asm volatile("" ::: "memory");
    const int c = lane & 7;
#pragma unroll
    for (int j = 0; j < 4; ++j) { const int n = (lane >> 3) + 8 * j; const LAS float* s = scr + (8 * c) * 33 + n;
        v4u o; o.x = pk2(s[0 * 33], s[1 * 33]); o.y = pk2(s[2 * 33], s[3 * 33]); o.z = pk2(s[4 * 33], s[5 * 33]); o.w = pk2(s[6 * 33], s[7 * 33]);
        *(v4u*)(WT + (size_t)(drow0 + n) * K + k0 + 8 * c) = o; }
    LDS_WAIT(); asm volatile("" ::: "memory");
}
__device__ __forceinline__ void rms_row_to_bf16(const float* __restrict__ xrow, const float* __restrict__ g, bf16* __restrict__ orow, int lane) {
    const float4* xr = (const float4*)xrow;
    float4 v[4]; float s = 0.f;
#pragma unroll
    for (int j = 0; j < 4; ++j) { v[j] = xr[lane + 64 * j]; s += (v[j].x * v[j].x + v[j].y * v[j].y) + (v[j].z * v[j].z + v[j].w * v[j].w); }
    s = wave_sum(s);
    const float rstd = rsqrtf(s * (1.0f / DM) + EPS);
#pragma unroll
    for (int j = 0; j < 4; ++j) { const int c = (lane + 64 * j) * 4; const float4 gg = *(const float4*)(g + c);
        uint2 o; o.x = pk2(v[j].x * rstd * gg.x, v[j].y * rstd * gg.y); o.y = pk2(v[j].z * rstd * gg.z, v[j].w * rstd * gg.w);
        *(uint2*)(orow + c) = o; }
}


typedef short bf16x8_t __attribute__((ext_vector_type(8)));
typedef float f32x4_t __attribute__((ext_vector_type(4)));
__device__ __forceinline__ int moe_tables(LAS unsigned char* L, unsigned* ctl, int tid) {
    LAS int* cnt = (LAS int*)(L + LC_CNT); LAS int* tstart = (LAS int*)(L + LC_TSTART); LAS int* tile_e = (LAS int*)(L + LC_TILEE);
    __syncthreads();
    if (tid < 32) cnt[tid] = (int)__hip_atomic_load(ctl + CW_CNT + tid, __ATOMIC_RELAXED, __HIP_MEMORY_SCOPE_AGENT);
    __syncthreads();
    if (tid == 0) { int ts = 0; for (int e = 0; e < 32; ++e) { tstart[e] = ts; const int nt = (cnt[e] + 255) >> 8; for (int i = 0; i < nt; ++i) tile_e[ts + i] = e; ts += nt; } tstart[32] = ts; }
    __syncthreads();
    return tstart[32];
}

__device__ __forceinline__ void lru_load_frags(const bf16* xrow0, int sg0, int jl, int dir, v4u (&fr)[4][2]) {
#pragma unroll
    for (int mt = 0; mt < 4; ++mt) { const int sg = 16 * (jl >> 2) + 4 * mt + (jl & 3); const int tau = sg0 + sg; const int t = dir ? (SEQ - 1 - tau) : tau;
#pragma unroll
        for (int s = 0; s < 2; ++s) fr[mt][s] = *(const v4u*)(xrow0 + (size_t)t * 64 + 32 * s); }
}
__device__ __forceinline__ void lru_item(LAS unsigned char* L, const Args& a, int item, const bf16* __restrict__ xcb, bf16* __restrict__ hf, bf16* __restrict__ hb, int tid, int lane, int wave) {
    const int b = item >> 6, h = (item >> 3) & 7, q4 = (item >> 1) & 3, dir = item & 1;
    const float* wr = dir ? a.in[10] : a.in[5]; const float* br = dir ? a.in[11] : a.in[6]; const float* wi = dir ? a.in[12] : a.in[7];
    const float* bi = dir ? a.in[13] : a.in[8]; const float* lam = dir ? a.in[14] : a.in[9];
    bf16* outp = dir ? hb : hf;
    LAS float* carry = (LAS float*)(L + 2048);
    const int jl = lane & 15, kg = lane >> 4;
    const int c = 64 * h + 16 * q4 + jl;
    bf16x8_t Br[2], Bi[2], Bid;
#pragma unroll
    for (int s = 0; s < 2; ++s)
#pragma unroll
        for (int j = 0; j < 8; ++j) { const int i = 32 * s + 8 * kg + j;
            Br[s][j] = (short)f2bf(wr[h * 4096 + i * 64 + 16 * q4 + jl]); Bi[s][j] = (short)f2bf(wi[h * 4096 + i * 64 + 16 * q4 + jl]); }
#pragma unroll
    for (int j = 0; j < 8; ++j) Bid[j] = (8 * kg + j == 16 * (q4 & 1) + jl) ? (short)0x3f80 : (short)0;
    const int sid = q4 >> 1;
    const float brc = br[c], bic = bi[c];
    const float sp8l = 8.0f * log1pf(expf(-lam[c])) * 1.4426950408889634f;
    __syncthreads();
    float Hblk = 0.f;
    const bf16* xrow0 = xcb + ((size_t)(b * 8 + h) * SEQ) * 64 + 8 * kg;
    v4u frn[4][2];
    lru_load_frags(xrow0, 64 * wave, jl, dir, frn);
    for (int it = 0; it < 16; ++it) {
        const int sg0 = 512 * it + 64 * wave;
        bf16x8_t Af[4][2];
#pragma unroll
        for (int mt = 0; mt < 4; ++mt)
#pragma unroll
            for (int s = 0; s < 2; ++s) Af[mt][s] = __builtin_bit_cast(bf16x8_t, frn[mt][s]);
        if (it < 15) lru_load_frags(xrow0, sg0 + 512, jl, dir, frn);
        float hloc[16], Ploc[16];
        float hl = 0.f, P = 1.f;
#pragma unroll
        for (int mt = 0; mt < 4; ++mt) {
            f32x4_t aR = {0.f, 0.f, 0.f, 0.f}, aI = aR, aX = aR;
            aR = __builtin_amdgcn_mfma_f32_16x16x32_bf16(Af[mt][0], Br[0], aR, 0, 0, 0); aR = __builtin_amdgcn_mfma_f32_16x16x32_bf16(Af[mt][1], Br[1], aR, 0, 0, 0);
            aI = __builtin_amdgcn_mfma_f32_16x16x32_bf16(Af[mt][0], Bi[0], aI, 0, 0, 0); aI = __builtin_amdgcn_mfma_f32_16x16x32_bf16(Af[mt][1], Bi[1], aI, 0, 0, 0);
            aX = __builtin_amdgcn_mfma_f32_16x16x32_bf16(sid ? Af[mt][1] : Af[mt][0], Bid, aX, 0, 0, 0);
#pragma unroll
            for (int r = 0; r < 4; ++r) {
                const float rg = __builtin_amdgcn_rcpf(1.0f + __builtin_amdgcn_exp2f(-1.4426950408889634f * (aR[r] + brc)));
                const float ig = __builtin_amdgcn_rcpf(1.0f + __builtin_amdgcn_exp2f(-1.4426950408889634f * (aI[r] + bic)));
                const float av = __builtin_amdgcn_exp2f(-rg * sp8l);
                const float bb = __builtin_amdgcn_sqrtf(fmaxf(1.0f - av * av, 0.f)) * (ig * aX[r]);
                hl = av * hl + bb; P *= av;
                hloc[4 * mt + r] = hl; Ploc[4 * mt + r] = P;
            }
        }
        const float A0 = __shfl(P, jl), B0 = __shfl(hl, jl), A1 = __shfl(P, jl + 16), B1 = __shfl(hl, jl + 16);
        const float A2 = __shfl(P, jl + 32), B2 = __shfl(hl, jl + 32), A3 = __shfl(P, jl + 48), B3 = __shfl(hl, jl + 48);
        LAS float* cbuf = carry + (it & 1) * 256;
        if (kg == 0) { cbuf[(wave * 16 + jl) * 2 + 0] = A0 * A1 * A2 * A3; cbuf[(wave * 16 + jl) * 2 + 1] = ((B0 * A1 + B1) * A2 + B2) * A3 + B3; }
        __syncthreads();
        float Hw = Hblk, Hn = Hblk;
#pragma unroll
        for (int w2 = 0; w2 < 8; ++w2) { const float Aq = cbuf[(w2 * 16 + jl) * 2 + 0], Bq = cbuf[(w2 * 16 + jl) * 2 + 1];
            if (w2 < wave) Hw = Aq * Hw + Bq;
            Hn = Aq * Hn + Bq; }
        Hblk = Hn;
        float Hin = Hw;
        if (kg >= 1) Hin = A0 * Hin + B0;
        if (kg >= 2) Hin = A1 * Hin + B1;
        if (kg >= 3) Hin = A2 * Hin + B2;
#pragma unroll
        for (int k = 0; k < 16; ++k) { const int tau = sg0 + 16 * kg + k; const int t = dir ? (SEQ - 1 - tau) : tau;
            outp[((size_t)b * SEQ + t) * DL + c] = f2bf(hloc[k] + Ploc[k] * Hin); }
    }
}

typedef float f32x2_t __attribute__((ext_vector_type(2)));
typedef _Float16 f16x2_t __attribute__((ext_vector_type(2)));
constexpr int LC_TW = RING_BYTES + 4096, LC_TA = RING_BYTES + 8192, LC_TB = RING_BYTES + 9216, LC_RED = RING_BYTES + 3328;
constexpr size_t WS_SPEC = 328 * MiB, WS_HT = 396 * MiB, WS_XCB = 136 * MiB;
__device__ __forceinline__ f32x2_t cmul(f32x2_t a, f32x2_t b) { f32x2_t r; r.x = a.x * b.x - a.y * b.y; r.y = a.x * b.y + a.y * b.x; return r; }
__device__ __forceinline__ f32x2_t h2_to_f2(unsigned u) { const f16x2_t h = __builtin_bit_cast(f16x2_t, u); f32x2_t k; k.x = (float)h.x; k.y = (float)h.y; return k; }
__device__ __forceinline__ f32x2_t cmulc(f32x2_t a, f32x2_t b) { f32x2_t r; r.x = a.x * b.x + a.y * b.y; r.y = a.y * b.x - a.x * b.y; return r; }
template <bool INV> __device__ __forceinline__ f32x2_t twc(f32x2_t d, int e) {
    constexpr float CT[16] = {1.000000000e+00f, 9.807852804e-01f, 9.238795325e-01f, 8.314696123e-01f, 7.071067812e-01f, 5.555702330e-01f, 3.826834324e-01f, 1.950903220e-01f, 6.123233996e-17f, -1.950903220e-01f, -3.826834324e-01f, -5.555702330e-01f, -7.071067812e-01f, -8.314696123e-01f, -9.238795325e-01f, -9.807852804e-01f};
    constexpr float ST[16] = {0.000000000e+00f, 1.950903220e-01f, 3.826834324e-01f, 5.555702330e-01f, 7.071067812e-01f, 8.314696123e-01f, 9.238795325e-01f, 9.807852804e-01f, 1.000000000e+00f, 9.807852804e-01f, 9.238795325e-01f, 8.314696123e-01f, 7.071067812e-01f, 5.555702330e-01f, 3.826834324e-01f, 1.950903220e-01f};
    f32x2_t r;
    if (e == 0) return d;
    if (e == 8) { if (INV) { r.x = -d.y; r.y = d.x; } else { r.x = d.y; r.y = -d.x; } return r; }
    const float c = CT[e], s = INV ? -ST[e] : ST[e];
    if (e == 4) { r.x = (d.x + (INV ? -d.y : d.y)) * c; r.y = (d.y - (INV ? -d.x : d.x)) * c; return r; }
    r.x = d.x * c + d.y * s; r.y = d.y * c - d.x * s; return r;
}
template <int R, bool INV> struct DFT {
    static __device__ __forceinline__ void run(f32x2_t (&x)[R]) {
        f32x2_t u[R / 2], v[R / 2];
#pragma unroll
        for (int k = 0; k < R / 2; ++k) { const f32x2_t p = x[k], q = x[k + R / 2]; u[k] = p + q; v[k] = twc<INV>(p - q, k * (32 / R)); }
        DFT<R / 2, INV>::run(u); DFT<R / 2, INV>::run(v);
#pragma unroll
        for (int q = 0; q < R / 2; ++q) { x[2 * q] = u[q]; x[2 * q + 1] = v[q]; }
    }
};
template <bool INV> struct DFT<1, INV> { static __device__ __forceinline__ void run(f32x2_t (&)[1]) {} };

typedef f16x2_t c16;
__device__ __forceinline__ c16 c16_from(f32x2_t v) { c16 r; r.x = (_Float16)v.x; r.y = (_Float16)v.y; return r; }
__device__ __forceinline__ c16 cmul16(c16 a, c16 w) { c16 wx; wx.x = w.x; wx.y = w.x; c16 wy; wy.x = w.y; wy.y = w.y; c16 at; at.x = -a.y; at.y = a.x; return a * wx + at * wy; }
__device__ __forceinline__ c16 cmulc16(c16 a, c16 w) { c16 wx; wx.x = w.x; wx.y = w.x; c16 wy; wy.x = w.y; wy.y = w.y; c16 at; at.x = a.y; at.y = -a.x; return a * wx + at * wy; }
template <bool INV> __device__ __forceinline__ c16 twc(c16 d, int e) {
    constexpr float CT[16] = {1.000000000e+00f, 9.807852804e-01f, 9.238795325e-01f, 8.314696123e-01f, 7.071067812e-01f, 5.555702330e-01f, 3.826834324e-01f, 1.950903220e-01f, 6.123233996e-17f, -1.950903220e-01f, -3.826834324e-01f, -5.555702330e-01f, -7.071067812e-01f, -8.314696123e-01f, -9.238795325e-01f, -9.807852804e-01f};
    constexpr float ST[16] = {0.000000000e+00f, 1.950903220e-01f, 3.826834324e-01f, 5.555702330e-01f, 7.071067812e-01f, 8.314696123e-01f, 9.238795325e-01f, 9.807852804e-01f, 1.000000000e+00f, 9.807852804e-01f, 9.238795325e-01f, 8.314696123e-01f, 7.071067812e-01f, 5.555702330e-01f, 3.826834324e-01f, 1.950903220e-01f};
    c16 r;
    if (e == 0) return d;
    if (e == 8) { if (INV) { r.x = -d.y; r.y = d.x; } else { r.x = d.y; r.y = -d.x; } return r; }
    const _Float16 c = (_Float16)CT[e], s = (_Float16)(INV ? -ST[e] : ST[e]);
    c16 cc; cc.x = c; cc.y = c; c16 ss; ss.x = s; ss.y = s; c16 dt; dt.x = d.y; dt.y = -d.x;
    return d * cc + dt * ss;
}
template <int R, bool INV> struct DFTH {
    static __device__ __forceinline__ void run(c16 (&x)[R]) {
        c16 u[R / 2], v[R / 2];
#pragma unroll
        for (int k = 0; k < R / 2; ++k) { const c16 p = x[k], q = x[k + R / 2]; u[k] = p + q; v[k] = twc<INV>(p - q, k * (32 / R)); }
        DFTH<R / 2, INV>::run(u); DFTH<R / 2, INV>::run(v);
#pragma unroll
        for (int q = 0; q < R / 2; ++q) { x[2 * q] = u[q]; x[2 * q + 1] = v[q]; }
    }
};
template <bool INV> struct DFTH<1, INV> { static __device__ __forceinline__ void run(c16 (&)[1]) {} };
template <bool CONJ> __device__ __forceinline__ void tw_apply16h(c16 (&x)[16], f32x2_t w1) {
    f32x2_t w = w1;
#pragma unroll
    for (int q = 1; q < 16; ++q) { const c16 wh = c16_from(w); x[q] = CONJ ? cmulc16(x[q], wh) : cmul16(x[q], wh); if (q < 15) w = cmul(w, w1); }
}
#define SWZ(p) ((p) + ((p) >> 5))
constexpr int FBUF = 8448;
template <bool CONJ> __device__ __forceinline__ void tw_apply16(f32x2_t (&x)[16], f32x2_t w1) {
    f32x2_t w = w1;
#pragma unroll
    for (int q = 1; q < 16; ++q) { x[q] = CONJ ? cmulc(x[q], w) : cmul(x[q], w); if (q < 15) w = cmul(w, w1); }
}
__device__ __forceinline__ void fft_tables_init(LAS unsigned char* L, int tid) {
    LAS f32x2_t* TW = (LAS f32x2_t*)(L + LC_TW); LAS f32x2_t* TA = (LAS f32x2_t*)(L + LC_TA); LAS f32x2_t* TB = (LAS f32x2_t*)(L + LC_TB);
    { float s, c; sincospif((float)tid * (1.0f / 4096.0f), &s, &c); f32x2_t w; w.x = c; w.y = -s; TW[tid] = w; }
    if (tid < 128) { float s, c; sincospif((float)tid * (1.0f / 128.0f), &s, &c); f32x2_t w; w.x = c; w.y = -s; TA[tid] = w; }
    if (tid < 64) { float s, c; sincospif((float)tid * (1.0f / 8192.0f), &s, &c); f32x2_t w; w.x = c; w.y = -s; TB[tid] = w; }
    __syncthreads();
}
#define OPAQUE(v) asm volatile("" : "+v"(v))
__device__ __forceinline__ void fwd_pass1(LAS f32x2_t* buf, const LAS f32x2_t* TW, int tid) {
    OPAQUE(tid);
    LAS f32x2_t* b0 = buf + tid + (tid >> 5);
    f32x2_t x[16];
#pragma unroll
    for (int m = 0; m < 16; ++m) x[m] = b0[528 * m];
    DFT<16, false>::run(x); tw_apply16<false>(x, TW[tid]);
#pragma unroll
    for (int q = 0; q < 16; ++q) b0[528 * q] = x[q];
}
__device__ __forceinline__ void fwd_pass2(LAS f32x2_t* buf, const LAS f32x2_t* TW, int tid) {
    OPAQUE(tid);
    LAS f32x2_t* b0 = buf + (tid >> 5) * 528 + (tid & 31);
    f32x2_t x[16];
#pragma unroll
    for (int m = 0; m < 16; ++m) x[m] = b0[33 * m];
    DFT<16, false>::run(x); tw_apply16<false>(x, TW[16 * (tid & 31)]);
#pragma unroll
    for (int q = 0; q < 16; ++q) b0[33 * q] = x[q];
}
__device__ __forceinline__ void inv_pass2(LAS f32x2_t* buf, const LAS f32x2_t* TW, int tid) {
    OPAQUE(tid);
    LAS f32x2_t* b0 = buf + (tid >> 5) * 528 + (tid & 31);
    f32x2_t x[16];
#pragma unroll
    for (int q = 0; q < 16; ++q) x[q] = b0[33 * q];
    tw_apply16<true>(x, TW[16 * (tid & 31)]); DFT<16, true>::run(x);
#pragma unroll
    for (int m = 0; m < 16; ++m) b0[33 * m] = x[m];
}
__device__ __forceinline__ void inv_pass1(LAS f32x2_t* buf, const LAS f32x2_t* TW, int tid) {
    OPAQUE(tid);
    LAS f32x2_t* b0 = buf + tid + (tid >> 5);
    f32x2_t x[16];
#pragma unroll
    for (int q = 0; q < 16; ++q) x[q] = b0[528 * q];
    tw_apply16<true>(x, TW[tid]); DFT<16, true>::run(x);
#pragma unroll
    for (int m = 0; m < 16; ++m) b0[528 * m] = x[m];
}
__device__ __forceinline__ void fft2_forward(LAS unsigned char* L) {
    const int tid = threadIdx.x;
    LAS f32x2_t* bufE = (LAS f32x2_t*)L; LAS f32x2_t* bufO = bufE + FBUF; const LAS f32x2_t* TW = (const LAS f32x2_t*)(L + LC_TW);
    fwd_pass1(bufE, TW, tid); fwd_pass1(bufO, TW, tid);
    __syncthreads();
    fwd_pass2(bufE, TW, tid); fwd_pass2(bufO, TW, tid);
    __syncthreads();
}
template <int MODE>
__device__ __forceinline__ void fft2_middle(LAS unsigned char* L, unsigned* specblk) {
    int tid = threadIdx.x; OPAQUE(tid); const int bsel = tid >> 8, blk = tid & 255;
    LAS f32x2_t* buf = (LAS f32x2_t*)L + (bsel ? FBUF : 0);
    f32x2_t x[32];
    LAS f32x2_t* bm = buf + 33 * blk;
#pragma unroll
    for (int q = 0; q < 32; ++q) x[q] = bm[q];
    DFT<32, false>::run(x);
    unsigned* sp = specblk + (size_t)bsel * 8192 + 32 * blk;
    if (MODE == 0) {
#pragma unroll
        for (int q = 0; q < 32; q += 4) { v4u w;
            { f16x2_t h; h.x = (_Float16)(16.0f * x[q].x); h.y = (_Float16)(16.0f * x[q].y); w.x = __builtin_bit_cast(unsigned, h); }
            { f16x2_t h; h.x = (_Float16)(16.0f * x[q + 1].x); h.y = (_Float16)(16.0f * x[q + 1].y); w.y = __builtin_bit_cast(unsigned, h); }
            { f16x2_t h; h.x = (_Float16)(16.0f * x[q + 2].x); h.y = (_Float16)(16.0f * x[q + 2].y); w.z = __builtin_bit_cast(unsigned, h); }
            { f16x2_t h; h.x = (_Float16)(16.0f * x[q + 3].x); h.y = (_Float16)(16.0f * x[q + 3].y); w.w = __builtin_bit_cast(unsigned, h); }
            *(v4u*)(sp + q) = w; }
    } else {
#pragma unroll
        for (int q = 0; q < 32; q += 4) { const v4u w = *(const v4u*)(sp + q);
            const unsigned w0 = w.x, w1 = w.y, w2 = w.z, w3 = w.w;
            x[q] = cmul(x[q], h2_to_f2(w0)); x[q + 1] = cmul(x[q + 1], h2_to_f2(w1)); x[q + 2] = cmul(x[q + 2], h2_to_f2(w2)); x[q + 3] = cmul(x[q + 3], h2_to_f2(w3)); }
        DFT<32, true>::run(x);
#pragma unroll
        for (int q = 0; q < 32; ++q) bm[q] = x[q];
    }
    __syncthreads();
}
__device__ __forceinline__ void fft2_inverse(LAS unsigned char* L) {
    const int tid = threadIdx.x;
    LAS f32x2_t* bufE = (LAS f32x2_t*)L; LAS f32x2_t* bufO = bufE + FBUF; const LAS f32x2_t* TW = (const LAS f32x2_t*)(L + LC_TW);
    inv_pass2(bufE, TW, tid); inv_pass2(bufO, TW, tid);
    __syncthreads();
    inv_pass1(bufE, TW, tid); inv_pass1(bufO, TW, tid);
}

__device__ __forceinline__ void fwd_pass1h(LAS c16* buf, const LAS f32x2_t* TW, int tid) {
    OPAQUE(tid);
    LAS c16* b0 = buf + tid + (tid >> 5);
    c16 x[16];
#pragma unroll
    for (int m = 0; m < 16; ++m) x[m] = b0[528 * m];
    DFTH<16, false>::run(x); tw_apply16h<false>(x, TW[tid]);
#pragma unroll
    for (int q = 0; q < 16; ++q) b0[528 * q] = x[q];
}
__device__ __forceinline__ void fwd_pass2h(LAS c16* buf, const LAS f32x2_t* TW, int tid) {
    OPAQUE(tid);
    LAS c16* b0 = buf + (tid >> 5) * 528 + (tid & 31);
    c16 x[16];
#pragma unroll
    for (int m = 0; m < 16; ++m) x[m] = b0[33 * m];
    DFTH<16, false>::run(x); tw_apply16h<false>(x, TW[16 * (tid & 31)]);
#pragma unroll
    for (int q = 0; q < 16; ++q) b0[33 * q] = x[q];
}
__device__ __forceinline__ void inv_pass2h(LAS c16* buf, const LAS f32x2_t* TW, int tid) {
    OPAQUE(tid);
    LAS c16* b0 = buf + (tid >> 5) * 528 + (tid & 31);
    c16 x[16];
#pragma unroll
    for (int q = 0; q < 16; ++q) x[q] = b0[33 * q];
    tw_apply16h<true>(x, TW[16 * (tid & 31)]); DFTH<16, true>::run(x);
    c16 sc; sc.x = (_Float16)0.0625f; sc.y = (_Float16)0.0625f;
#pragma unroll
    for (int m = 0; m < 16; ++m) b0[33 * m] = x[m] * sc;
}
__device__ __forceinline__ void inv_pass1h(LAS c16* buf, const LAS f32x2_t* TW, int tid) {
    OPAQUE(tid);
    LAS c16* b0 = buf + tid + (tid >> 5);
    c16 x[16];
#pragma unroll
    for (int q = 0; q < 16; ++q) x[q] = b0[528 * q];
    tw_apply16h<true>(x, TW[tid]); DFTH<16, true>::run(x);
#pragma unroll
    for (int m = 0; m < 16; ++m) b0[528 * m] = x[m];
}
__device__ __forceinline__ void fft2h_forward(LAS unsigned char* L) {
    const int tid = threadIdx.x;
    LAS c16* bufE = (LAS c16*)L; LAS c16* bufO = bufE + FBUF; const LAS f32x2_t* TW = (const LAS f32x2_t*)(L + LC_TW);
    fwd_pass1h(bufE, TW, tid); fwd_pass1h(bufO, TW, tid);
    __syncthreads();
    fwd_pass2h(bufE, TW, tid); fwd_pass2h(bufO, TW, tid);
    __syncthreads();
}
__device__ __forceinline__ void fft2h_middle(LAS unsigned char* L, const unsigned* specblk) {
    int tid = threadIdx.x; OPAQUE(tid); const int bsel = tid >> 8, blk = tid & 255;
    LAS c16* bm = (LAS c16*)L + (bsel ? FBUF : 0) + 33 * blk;
    c16 x[32];
#pragma unroll
    for (int q = 0; q < 32; ++q) x[q] = bm[q];
    DFTH<32, false>::run(x);
    const unsigned* sp = specblk + (size_t)bsel * 8192 + 32 * blk;
#pragma unroll
    for (int q = 0; q < 32; q += 4) { const v4u w = *(const v4u*)(sp + q);
        const unsigned w0 = w.x, w1 = w.y, w2 = w.z, w3 = w.w;
        x[q] = cmul16(x[q], __builtin_bit_cast(c16, w0)); x[q + 1] = cmul16(x[q + 1], __builtin_bit_cast(c16, w1));
        x[q + 2] = cmul16(x[q + 2], __builtin_bit_cast(c16, w2)); x[q + 3] = cmul16(x[q + 3], __builtin_bit_cast(c16, w3)); }
    DFTH<32, true>::run(x);
    c16 sc; sc.x = (_Float16)0.0625f; sc.y = (_Float16)0.0625f;
#pragma unroll
    for (int q = 0; q < 32; ++q) bm[q] = x[q] * sc;
    __syncthreads();
}
__device__ __forceinline__ void fft2h_inverse(LAS unsigned char* L) {
    const int tid = threadIdx.x;
    LAS c16* bufE = (LAS c16*)L; LAS c16* bufO = bufE + FBUF; const LAS f32x2_t* TW = (const LAS f32x2_t*)(L + LC_TW);
    inv_pass2h(bufE, TW, tid); inv_pass2h(bufO, TW, tid);
    __syncthreads();
    inv_pass1h(bufE, TW, tid); inv_pass1h(bufO, TW, tid);
}
__device__ __forceinline__ f32x2_t wn16384(const LAS f32x2_t* TA, f32x2_t wb, int tid, int m) { return cmul(TA[(tid >> 6) + 8 * m], wb); }
__device__ __forceinline__ float hy_conv3(const bf16* row, float w0, float w1, float w2, float bias, int n) {
    const int nm = n > 0 ? n - 1 : 0, np = n < SEQ - 1 ? n + 1 : SEQ - 1;
    const float wl = n > 0 ? w0 : 0.f, wr = n < SEQ - 1 ? w2 : 0.f;
    return bias + w1 * bf2f(row[n]) + wl * bf2f(row[nm]) + wr * bf2f(row[np]);
}

__device__ __forceinline__ void load_conv16(const bf16* row, int n0, float w0, float w1, float w2, float bias, float (&out)[16]) {
    const v4u a = *(const v4u*)(row + n0), b = *(const v4u*)(row + n0 + 8);
    const int nl = n0 > 0 ? n0 - 1 : 0, nr = n0 + 16 < SEQ ? n0 + 16 : SEQ - 1;
    const float ul = n0 > 0 ? bf2f(row[nl]) : 0.f, ur = n0 + 16 < SEQ ? bf2f(row[nr]) : 0.f;
    const unsigned a0 = a.x, a1 = a.y, a2 = a.z, a3 = a.w, b0 = b.x, b1 = b.y, b2 = b.z, b3 = b.w;
    float u[18];
    u[0] = ul; u[17] = ur;
    u[1] = __uint_as_float(a0 << 16); u[2] = __uint_as_float(a0 & 0xffff0000u); u[3] = __uint_as_float(a1 << 16); u[4] = __uint_as_float(a1 & 0xffff0000u);
    u[5] = __uint_as_float(a2 << 16); u[6] = __uint_as_float(a2 & 0xffff0000u); u[7] = __uint_as_float(a3 << 16); u[8] = __uint_as_float(a3 & 0xffff0000u);
    u[9] = __uint_as_float(b0 << 16); u[10] = __uint_as_float(b0 & 0xffff0000u); u[11] = __uint_as_float(b1 << 16); u[12] = __uint_as_float(b1 & 0xffff0000u);
    u[13] = __uint_as_float(b2 << 16); u[14] = __uint_as_float(b2 & 0xffff0000u); u[15] = __uint_as_float(b3 << 16); u[16] = __uint_as_float(b3 & 0xffff0000u);
#pragma unroll
    for (int i = 0; i < 16; ++i) out[i] = bias + w0 * u[i] + w1 * u[i + 1] + w2 * u[i + 2];
}
__device__ __forceinline__ void load_f16x16(const _Float16* p, float (&out)[16]) {
    const v4u a = *(const v4u*)p, b = *(const v4u*)(p + 8);
    const unsigned w[8] = {a.x, a.y, a.z, a.w, b.x, b.y, b.z, b.w};
#pragma unroll
    for (int i = 0; i < 8; ++i) { const f32x2_t k = h2_to_f2(w[i]); out[2 * i] = k.x; out[2 * i + 1] = k.y; }
}
__device__ __forceinline__ void load_f32x16(const float* p, float (&out)[16]) {
#pragma unroll
    for (int i = 0; i < 4; ++i) { const float4 v = *(const float4*)(p + 4 * i); out[4 * i] = v.x; out[4 * i + 1] = v.y; out[4 * i + 2] = v.z; out[4 * i + 3] = v.w; }
}
__device__ __forceinline__ void filter_item(LAS unsigned char* L, const Args& a, int c, const _Float16* hT, unsigned* spec, int tid, int lane, int wave) {
    LAS f32x2_t* bufE = (LAS f32x2_t*)L; LAS f32x2_t* bufO = bufE + FBUF;
    const LAS f32x2_t* TA = (const LAS f32x2_t*)(L + LC_TA); const LAS f32x2_t* TB = (const LAS f32x2_t*)(L + LC_TB);
    LAS float* red = (LAS float*)(L + LC_RED); LAS float* sc = (LAS float*)L;
    const int n0 = 16 * tid;
#pragma unroll 1
    for (int o = 0; o < 2; ++o) {
        float hfv[16], hbv[16];
        load_f16x16(hT + (size_t)(o * 512 + c) * SEQ + n0, hfv);
        load_f16x16(hT + (size_t)(1024 + o * 512 + c) * SEQ + n0, hbv);
        float s = 0.f;
#pragma unroll
        for (int i = 0; i < 16; ++i) { s += fabsf(hfv[i]) + ((n0 + i) > 0 ? fabsf(hbv[i]) : 0.f); sc[n0 + i] = hbv[i]; }
        s = wave_sum(s);
        if (lane == 0) red[wave] = s;
        __syncthreads();
        float tot = 0.f;
#pragma unroll
        for (int i = 0; i < 8; ++i) tot += red[i];
        const float inv = 1.0f / (tot + EPS);
        float ev[16], dv[16];
#pragma unroll
        for (int i = 0; i < 16; ++i) { const int n = n0 + i; const float hbm = n > 0 ? sc[SEQ - n] : 0.f; ev[i] = (hfv[i] + hbm) * inv; dv[i] = (hfv[i] - hbm) * inv; }
        __syncthreads();
        const f32x2_t wa = TA[tid >> 2];
#pragma unroll
        for (int i = 0; i < 16; ++i) { const int n = n0 + i; const f32x2_t wn = cmul(wa, TB[16 * (tid & 3) + i]);
            f32x2_t xe; xe.x = ev[i]; xe.y = 0.f; f32x2_t xo; xo.x = dv[i] * wn.x; xo.y = dv[i] * wn.y;
            (void)n; bufE[16 * tid + (tid >> 1) + i] = xe; bufO[16 * tid + (tid >> 1) + i] = xo; }
        __syncthreads();
        fft2_forward(L);
        fft2_middle<0>(L, spec + (size_t)(o * 512 + c) * 16384);
    }
}
template <int O>
__device__ __forceinline__ void hyena_pass(LAS unsigned char* L, const Args& a, int c, int bp, const bf16* hyuT, unsigned* spec, int tid, float (&xa)[16], float (&xb)[16]) {
    LAS c16* bufE = (LAS c16*)L; LAS c16* bufO = bufE + FBUF;
    const LAS f32x2_t* TA = (const LAS f32x2_t*)(L + LC_TA); const LAS f32x2_t* TB = (const LAS f32x2_t*)(L + LC_TB);
    const float* cw = a.in[15]; const float* cb = a.in[16];
    const int n0 = 16 * tid;
    const int lb = 16 * tid + (tid >> 1);
    {   const f32x2_t wa = TA[tid >> 2];
#pragma unroll
        for (int i = 0; i < 16; ++i) { f32x2_t x; x.x = xa[i] * 0.0625f; x.y = xb[i] * 0.0625f; bufE[lb + i] = c16_from(x); bufO[lb + i] = c16_from(cmul(x, cmul(wa, TB[16 * (tid & 3) + i]))); } }
    __syncthreads();
    fft2h_forward(L);
    fft2h_middle(L, spec + (size_t)(O * 512 + c) * 16384);
    fft2h_inverse(L);
    __syncthreads();
    const int grow = (O ? 1024 : 512) + c;
    const float w0 = cw[grow], w1 = cw[1536 + grow], w2 = cw[3072 + grow], bs = cb[grow];
    const float skip = a.in[24][O * 512 + c];
    const bf16* g0 = hyuT + (size_t)grow * NTOK + (size_t)(2 * bp) * SEQ; const bf16* g1 = g0 + SEQ;
    float ga[16], gb[16];
    load_conv16(g0, n0, w0, w1, w2, bs, ga); load_conv16(g1, n0, w0, w1, w2, bs, gb);
    const f32x2_t wa = TA[tid >> 2];
#pragma unroll
    for (int i = 0; i < 16; ++i) {
        const c16 he = bufE[lb + i], ho = bufO[lb + i]; f32x2_t fe; fe.x = (float)he.x; fe.y = (float)he.y; f32x2_t fo; fo.x = (float)ho.x; fo.y = (float)ho.y;
        const f32x2_t y = (fe + cmulc(fo, cmul(wa, TB[16 * (tid & 3) + i]))) * (1.0f / 64.0f);
        xa[i] = ga[i] * (y.x + skip * xa[i]); xb[i] = gb[i] * (y.y + skip * xb[i]); }
    __syncthreads();
}
__device__ __forceinline__ void hyena_item(LAS unsigned char* L, const Args& a, int c, int bp, const bf16* hyuT, unsigned* spec, bf16* y_hyT, int tid) {
    const float* cw = a.in[15]; const float* cb = a.in[16];
    const size_t seq0 = (size_t)c * NTOK + (size_t)(2 * bp) * SEQ;
    const int n0 = 16 * tid;
    float xa[16], xb[16];
    load_conv16(hyuT + seq0, n0, cw[c], cw[1536 + c], cw[3072 + c], cb[c], xa); load_conv16(hyuT + seq0 + SEQ, n0, cw[c], cw[1536 + c], cw[3072 + c], cb[c], xb);
    hyena_pass<0>(L, a, c, bp, hyuT, spec, tid, xa, xb);
    hyena_pass<1>(L, a, c, bp, hyuT, spec, tid, xa, xb);
    bf16* o0 = y_hyT + seq0; bf16* o1 = o0 + SEQ;
    v4u p0, p1, q0, q1;
    p0.x = pk2(xa[0], xa[1]); p0.y = pk2(xa[2], xa[3]); p0.z = pk2(xa[4], xa[5]); p0.w = pk2(xa[6], xa[7]); p1.x = pk2(xa[8], xa[9]); p1.y = pk2(xa[10], xa[11]); p1.z = pk2(xa[12], xa[13]); p1.w = pk2(xa[14], xa[15]);
    q0.x = pk2(xb[0], xb[1]); q0.y = pk2(xb[2], xb[3]); q0.z = pk2(xb[4], xb[5]); q0.w = pk2(xb[6], xb[7]); q1.x = pk2(xb[8], xb[9]); q1.y = pk2(xb[10], xb[11]); q1.z = pk2(xb[12], xb[13]); q1.w = pk2(xb[14], xb[15]);
    *(v4u*)(o0 + n0) = p0; *(v4u*)(o0 + n0 + 8) = p1; *(v4u*)(o1 + n0) = q0; *(v4u*)(o1 + n0 + 8) = q1;
}

__global__ void __launch_bounds__(NWAVES * 64, 2) fwd(Args a) {
    extern __shared__ __attribute__((aligned(16))) unsigned char lds_raw[];
    LAS unsigned char* L = (LAS unsigned char*)lds_raw;
    volatile LAS unsigned* MISC = (volatile LAS unsigned*)(L + MISC_OFF);
    const int tid = threadIdx.x, lane = tid & 63, wave = __builtin_amdgcn_readfirstlane(tid >> 6);
    const int G = gridDim.x, bid = blockIdx.x;
    unsigned char* ws = a.ws;
    unsigned* ctl = (unsigned*)ws;
    for (int u = tid; u < (LDS_BYTES - LDSCTL_OFF) / 4; u += NWAVES * 64) ((LAS unsigned*)(L + LDSCTL_OFF))[u] = 0u;
    __syncthreads();
    const int lo = a.ph_lo, hi = a.ph_hi;
    XcdBarrier bar; bar.bar = ctl + CW_BAR + a.li * XCD_BAR_WORDS; bar.x = 0; bar.st = nullptr;
    bar = xcd_barrier_post(ctl + CW_BAR + a.li * XCD_BAR_WORDS, MISC + 8);
#define IN(k) (lo <= (k) && (k) < hi)
#define BOTH(k) (IN(k) && IN((k) + 1))
#ifndef DUP_BAR
#define DUP_BAR 1
#endif
#define GRID_BAR() do { xcd_barrier(bar); if (DUP_BAR > 1) xcd_barrier(bar); } while (0)

    bf16* WinT = (bf16*)(ws + WS_WINT); bf16* WoutT = (bf16*)(ws + WS_WOUTT);
    bf16* hn1 = (bf16*)(ws + WS_HN1); bf16* lru = (bf16*)(ws + WS_LRU); bf16* hyuT = (bf16*)(ws + WS_HYUT);
    bf16* y_cat = (bf16*)(ws + WS_YCAT);
    bf16* W13T = (bf16*)(ws + WS_W13T); bf16* W2T = (bf16*)(ws + WS_W2T); bf16* WrT = (bf16*)(ws + WS_WRT);
    bf16* hn2 = (bf16*)(ws + WS_HN2); int* list = (int*)(ws + WS_LIST); float* lgate = (float*)(ws + WS_LGATE); int4* tokinfo = (int4*)(ws + WS_TOKINFO);
    float* sgate = (float*)(ws + WS_SGATE); bf16* xs = (bf16*)(ws + WS_XS); bf16* Hb = (bf16*)(ws + WS_H); bf16* Yb = (bf16*)(ws + WS_Y);
    const int gw = bid * NWAVES + wave, NGW = G * NWAVES;

    if (IN(0)) {
#ifndef DUP_P0
#define DUP_P0 1
#endif
        for (int rep0 = 0; rep0 < DUP_P0; ++rep0) {
        LAS float* scr = (LAS float*)(L + wave * 16384);
        constexpr int I_IN = (DM / 64) * (DIN / 32), I_OUT = (DM / 64) * (DM / 32), I_EXP = 768;
        for (int it = gw; it < I_IN + I_OUT + 32 * I_EXP; it += NGW) {
            if (it < I_IN) { const int nblk = DIN / 32, kb = it / nblk, nb = it % nblk; p0_transpose_item(a.in[2], DM, DIN, WinT, 32 * nb, scr, 64 * kb, 32 * nb, lane); }
            else if (it < I_IN + I_OUT) { const int r = it - I_IN; const int nblk = DM / 32, kb = r / nblk, nb = r % nblk; p0_transpose_item(a.in[27], DM, DM, WoutT, 32 * nb, scr, 64 * kb, 32 * nb, lane); }
            else { const int r = it - I_IN - I_OUT, e = r / I_EXP, q = r % I_EXP;
                if (q < 512) { const int w3 = q >> 8, qq = q & 255, kb = qq >> 4, nb = qq & 15, n0 = 32 * nb;
                    p0_transpose_item(a.in[w3 ? 34 : 33] + (size_t)e * 1024 * 512, 1024, 512, W13T, e * 1024 + (n0 >> 7) * 256 + (n0 & 127) + w3 * 128, scr, 64 * kb, n0, lane); }
                else { const int qq = q - 512, kb = qq >> 5, nb = qq & 31;
                    p0_transpose_item(a.in[35] + (size_t)e * 512 * 1024, 512, 1024, W2T, e * 1024 + 32 * nb, scr, 64 * kb, 32 * nb, lane); } }
        }
        for (int idx = bid * (NWAVES * 64) + tid; idx < 48 * 1024; idx += G * NWAVES * 64) { const int j = idx >> 10, k = idx & 1023;
            WrT[idx] = j < 4 ? f2bf(a.in[29][k * 4 + j]) : (j < 36 ? f2bf(a.in[31][k * 32 + (j - 4)]) : (bf16)0); }
        { _Float16* hT = (_Float16*)(ws + WS_HT);
          const float* w1 = a.in[17]; const float* b1 = a.in[18]; const float* f1 = a.in[19]; const float* w2 = a.in[20]; const float* b2 = a.in[21]; const float* f2 = a.in[22]; const float* w3 = a.in[23];
          LAS float* w3s = (LAS float*)L;
          LAS float* z2s = (LAS float*)(L + 65536);
          LAS float* fts = (LAS float*)(L + 73728);
          LAS float* ot  = (LAS float*)(L + 81920);
          for (int tile = bid; tile < SEQ / 32; tile += G) {
              __syncthreads();
              { const int tl = tid & 31, i = tid >> 5; const int t = tile * 32 + tl;
                const float wq = (6.283185307179586f / (float)SEQ) * (float)t; const float band = 1e-4f + (float)i * ((15.0f - 1e-4f) / 15.0f);
                fts[(1 + i) * 32 + tl] = cosf(wq * band); fts[(17 + i) * 32 + tl] = sinf(wq * band);
                if (i == 0) fts[tl] = (float)t / (float)(SEQ - 1); }
              __syncthreads();
              const int tl4 = tid & 31, jq = tid >> 5;
              { float s0 = b1[4 * jq], s1 = b1[4 * jq + 1], s2 = b1[4 * jq + 2], s3 = b1[4 * jq + 3];
#pragma unroll 3
                for (int i = 0; i < 33; ++i) { const float fv = fts[i * 32 + tl4]; const float4 wv = *(const float4*)(w1 + i * 64 + 4 * jq); s0 += fv * wv.x; s1 += fv * wv.y; s2 += fv * wv.z; s3 += fv * wv.w; }
                const float4 fq = *(const float4*)(f1 + 4 * jq);
                s0 = sinf(fq.x * s0); s1 = sinf(fq.y * s1); s2 = sinf(fq.z * s2); s3 = sinf(fq.w * s3);
                __syncthreads();
                fts[(4 * jq) * 32 + tl4] = s0; fts[(4 * jq + 1) * 32 + tl4] = s1; fts[(4 * jq + 2) * 32 + tl4] = s2; fts[(4 * jq + 3) * 32 + tl4] = s3; }
              __syncthreads();
              { float s0 = b2[4 * jq], s1 = b2[4 * jq + 1], s2 = b2[4 * jq + 2], s3 = b2[4 * jq + 3];
#pragma unroll 4
                for (int i = 0; i < 64; ++i) { const float zv = fts[i * 32 + tl4]; const float4 wv = *(const float4*)(w2 + i * 64 + 4 * jq); s0 += zv * wv.x; s1 += zv * wv.y; s2 += zv * wv.z; s3 += zv * wv.w; }
                const float4 fq = *(const float4*)(f2 + 4 * jq);
                z2s[(4 * jq) * 32 + tl4] = sinf(fq.x * s0); z2s[(4 * jq + 1) * 32 + tl4] = sinf(fq.y * s1); z2s[(4 * jq + 2) * 32 + tl4] = sinf(fq.z * s2); z2s[(4 * jq + 3) * 32 + tl4] = sinf(fq.w * s3); }
              const float lo_ = logf(1e-2f) / 1.5f, hi_ = logf(1e-2f) / 0.3f;
              f32x4_t pre[4];
#pragma unroll
              for (int r = 0; r < 4; ++r) { const int q = tid + 512 * r; pre[r] = *(const f32x4_t*)(w3 + (size_t)(q >> 5) * 2048 + 4 * (q & 31)); }
              const int cq = tid & 31, tq = tid >> 5;
              for (int chunk = 0; chunk < 16; ++chunk) {
                  LAS float* wb_ = w3s + (chunk & 1) * 8192;
#pragma unroll
                  for (int r = 0; r < 4; ++r) { const int q = tid + 512 * r; *(LAS f32x4_t*)(wb_ + (q >> 5) * 128 + 4 * (q & 31)) = pre[r]; }
                  __syncthreads();
                  if (chunk < 15) {
#pragma unroll
                      for (int r = 0; r < 4; ++r) { const int q = tid + 512 * r; pre[r] = *(const f32x4_t*)(w3 + (size_t)(q >> 5) * 2048 + (chunk + 1) * 128 + 4 * (q & 31)); } }
                  f32x4_t acc0 = {0.f, 0.f, 0.f, 0.f}, acc1 = acc0;
#pragma unroll 8
                  for (int j = 0; j < 64; ++j) { const f32x4_t wv = *(const LAS f32x4_t*)(wb_ + j * 128 + 4 * cq); const float z0 = z2s[j * 32 + 2 * tq], z1v = z2s[j * 32 + 2 * tq + 1];
                      acc0 += wv * z0; acc1 += wv * z1v; }
#pragma unroll
                  for (int ci = 0; ci < 4; ++ci) { ot[(4 * cq + ci) * 33 + 2 * tq] = acc0[ci]; ot[(4 * cq + ci) * 33 + 2 * tq + 1] = acc1[ci]; }
                  __syncthreads();
                  { const int tl = lane & 31, half = lane >> 5; const int t = tile * 32 + tl; const float tn = (float)t / (float)(SEQ - 1);
#pragma unroll 4
                    for (int k = 0; k < 8; ++k) { const int cl = wave * 16 + 2 * k + half; const int col = chunk * 128 + cl; const int cc = col & 511;
                        const float delta = fabsf(lo_ + (float)cc * ((hi_ - lo_) / 511.0f));
                        hT[(size_t)col * SEQ + t] = (_Float16)(ot[cl * 33 + tl] * __expf(-tn * delta) * 64.0f); } }
              }
          } }
        __syncthreads();
        for (int m = gw; m < NTOK; m += NGW) rms_row_to_bf16(a.in[0] + (size_t)m * DM, a.in[1], hn1 + (size_t)m * DM, lane);
        }
        if (BOTH(0)) GRID_BAR();
    }
    if (IN(1)) {
#ifndef DUP_G1
#define DUP_G1 1
#endif
        { pg8::Gemm g{hn1, WinT, NTOK, 1024, DM}; pg8::StaticOrder S; S.init(NTOK, 1024, G, bid);
          pg8::EpiBf16<0> E{lru, 1024, nullptr, 0, 0, 1.f};
          pg8::gemm_phase<pg8::EpiBf16<0>, pg8::StaticOrder, true, true>(L, g, S, E); }
        { pg8::Gemm g{WinT + (size_t)1024 * DM, hn1, 1536, NTOK, DM}; pg8::StaticOrder S; S.init(1536, NTOK, G, bid);
          pg8::EpiBf16<0> E{hyuT, NTOK, nullptr, 0, 0, 1.f};
          pg8::gemm_phase<pg8::EpiBf16<0>, pg8::StaticOrder, true, true>(L, g, S, E); }
#if DUP_G1 > 1
        { pg8::Gemm g{hn1, WinT, NTOK, 1024, DM}; pg8::StaticOrder S; S.init(NTOK, 1024, G, bid);
          pg8::EpiBf16<0> E{lru, 1024, nullptr, 0, 0, 1.f};
          pg8::gemm_phase<pg8::EpiBf16<0>, pg8::StaticOrder, true, true>(L, g, S, E); }
        { pg8::Gemm g{WinT + (size_t)1024 * DM, hn1, 1536, NTOK, DM}; pg8::StaticOrder S; S.init(1536, NTOK, G, bid);
          pg8::EpiBf16<0> E{hyuT, NTOK, nullptr, 0, 0, 1.f};
          pg8::gemm_phase<pg8::EpiBf16<0>, pg8::StaticOrder, true, true>(L, g, S, E); }
#endif
        __syncthreads();
        fft_tables_init(L, tid);
#ifndef DUP_FILT
#define DUP_FILT 1
#endif
        for (int rep = 0; rep < DUP_FILT; ++rep)
        for (int c = bid; c < DH; c += G) filter_item(L, a, c, (const _Float16*)(ws + WS_HT), (unsigned*)(ws + WS_SPEC), tid, lane, wave);
        if (BOTH(1)) GRID_BAR();
    }

    if (IN(2)) {
        bf16* hf = (bf16*)(ws + WS_HF); bf16* hb = (bf16*)(ws + WS_HB);
#ifndef DUP_LRU
#define DUP_LRU 1
#endif
#ifndef DUP_HY
#define DUP_HY 1
#endif
        { bf16* xcb = (bf16*)(ws + WS_XCB); const float* cwp = a.in[3]; const float* cbp = a.in[4];
          for (int idx = bid * (NWAVES * 64) + tid; idx < NTOK * 64; idx += G * NWAVES * 64) {
              const int tok = idx >> 6, c8 = (idx & 63) * 8, t = tok & (SEQ - 1), bb = tok >> 13;
              float acc[8];
              { const float4 c0 = *(const float4*)(cbp + c8), c1 = *(const float4*)(cbp + c8 + 4); acc[0] = c0.x; acc[1] = c0.y; acc[2] = c0.z; acc[3] = c0.w; acc[4] = c1.x; acc[5] = c1.y; acc[6] = c1.z; acc[7] = c1.w; }
#pragma unroll
              for (int tap = 0; tap < 4; ++tap) { const int tt = t + tap - 2; const bool ok = tt >= 0 && tt < SEQ; const int tc = ok ? tt : t;
                  const v4u xv = *(const v4u*)(lru + (size_t)(bb * SEQ + tc) * 1024 + c8);
                  const float4 w0 = *(const float4*)(cwp + tap * DL + c8), w1 = *(const float4*)(cwp + tap * DL + c8 + 4);
                  const float m = ok ? 1.f : 0.f; const unsigned x0 = xv.x, x1 = xv.y, x2 = xv.z, x3 = xv.w;
                  acc[0] += m * w0.x * __uint_as_float(x0 << 16); acc[1] += m * w0.y * __uint_as_float(x0 & 0xffff0000u);
                  acc[2] += m * w0.z * __uint_as_float(x1 << 16); acc[3] += m * w0.w * __uint_as_float(x1 & 0xffff0000u);
                  acc[4] += m * w1.x * __uint_as_float(x2 << 16); acc[5] += m * w1.y * __uint_as_float(x2 & 0xffff0000u);
                  acc[6] += m * w1.z * __uint_as_float(x3 << 16); acc[7] += m * w1.w * __uint_as_float(x3 & 0xffff0000u); }
              v4u pk; pk.x = pk2(acc[0], acc[1]); pk.y = pk2(acc[2], acc[3]); pk.z = pk2(acc[4], acc[5]); pk.w = pk2(acc[6], acc[7]);
              const int hh = c8 >> 6, cl = c8 & 63;
              *(v4u*)(xcb + (((size_t)(bb * 8 + hh) * SEQ + t) * 64 + cl)) = pk; } }
        GRID_BAR();
        for (int rep = 0; rep < DUP_LRU; ++rep)
        for (int item = bid; item < 256; item += G) lru_item(L, a, item, (const bf16*)(ws + WS_XCB), hf, hb, tid, lane, wave);
        __syncthreads();
        fft_tables_init(L, tid);
        for (int rep = 0; rep < DUP_HY; ++rep)
        for (int item = bid; item < 2 * DH; item += G) hyena_item(L, a, item >> 1, item & 1, hyuT, (unsigned*)(ws + WS_SPEC), (bf16*)(ws + WS_YHYT), tid);
        if (BOTH(2)) GRID_BAR();
    }

    if (IN(3)) {
        const bf16* hf = (const bf16*)(ws + WS_HF); const bf16* hb = (const bf16*)(ws + WS_HB); const bf16* y_hyT = (const bf16*)(ws + WS_YHYT);
        const float* gA = a.in[25]; const float* gB = a.in[26];
#ifndef DUP_P3
#define DUP_P3 1
#endif
        for (int rep3 = 0; rep3 < DUP_P3; ++rep3) {
        for (int tok = gw; tok < NTOK; tok += NGW) {
            const v4u vf = *(const v4u*)(hf + (size_t)tok * DL + 8 * lane), vb = *(const v4u*)(hb + (size_t)tok * DL + 8 * lane), vg = *(const v4u*)(lru + (size_t)tok * 1024 + 512 + 8 * lane);
            const unsigned f0 = vf.x, f1 = vf.y, f2 = vf.z, f3 = vf.w, b0 = vb.x, b1 = vb.y, b2 = vb.z, b3 = vb.w, g0 = vg.x, g1 = vg.y, g2 = vg.z, g3 = vg.w;
            float y[8];
            y[0] = (__uint_as_float(f0 << 16) + __uint_as_float(b0 << 16)) * gelu_tanh(__uint_as_float(g0 << 16));
            y[1] = (__uint_as_float(f0 & 0xffff0000u) + __uint_as_float(b0 & 0xffff0000u)) * gelu_tanh(__uint_as_float(g0 & 0xffff0000u));
            y[2] = (__uint_as_float(f1 << 16) + __uint_as_float(b1 << 16)) * gelu_tanh(__uint_as_float(g1 << 16));
            y[3] = (__uint_as_float(f1 & 0xffff0000u) + __uint_as_float(b1 & 0xffff0000u)) * gelu_tanh(__uint_as_float(g1 & 0xffff0000u));
            y[4] = (__uint_as_float(f2 << 16) + __uint_as_float(b2 << 16)) * gelu_tanh(__uint_as_float(g2 << 16));
            y[5] = (__uint_as_float(f2 & 0xffff0000u) + __uint_as_float(b2 & 0xffff0000u)) * gelu_tanh(__uint_as_float(g2 & 0xffff0000u));
            y[6] = (__uint_as_float(f3 << 16) + __uint_as_float(b3 << 16)) * gelu_tanh(__uint_as_float(g3 << 16));
            y[7] = (__uint_as_float(f3 & 0xffff0000u) + __uint_as_float(b3 & 0xffff0000u)) * gelu_tanh(__uint_as_float(g3 & 0xffff0000u));
            float s = 0.f;
#pragma unroll
            for (int i = 0; i < 8; ++i) s += y[i] * y[i];
            s = wave_sum(s);
            const float rstd = rsqrtf(s * (1.0f / DL) + EPS);
            const float4 ga0 = *(const float4*)(gA + 8 * lane), ga1 = *(const float4*)(gA + 8 * lane + 4);
            v4u o; o.x = pk2(y[0] * rstd * ga0.x, y[1] * rstd * ga0.y); o.y = pk2(y[2] * rstd * ga0.z, y[3] * rstd * ga0.w);
            o.z = pk2(y[4] * rstd * ga1.x, y[5] * rstd * ga1.y); o.w = pk2(y[6] * rstd * ga1.z, y[7] * rstd * ga1.w);
            *(v4u*)(y_cat + (size_t)tok * 1024 + 8 * lane) = o;
        }
        for (int tile = bid; tile < NTOK / 64; tile += G) {
            __syncthreads();
            const int tok0 = tile * 64;
            for (int ch = tid; ch < 512 * 8; ch += NWAVES * 64) { const int c = ch >> 3, piece = ch & 7;
                const v4u v = *(const v4u*)(y_hyT + (size_t)c * NTOK + tok0 + 8 * piece);
                LAS unsigned* d = (LAS unsigned*)(L + c * 132 + piece * 16); d[0] = v.x; d[1] = v.y; d[2] = v.z; d[3] = v.w; }
            __syncthreads();
            for (int tl = wave; tl < 64; tl += NWAVES) {
                float v[8]; float s = 0.f;
#pragma unroll
                for (int i = 0; i < 4; ++i) { const int c = 2 * lane + 128 * i;
                    v[2 * i] = bf2f(*(const LAS bf16*)(L + c * 132 + tl * 2)); v[2 * i + 1] = bf2f(*(const LAS bf16*)(L + (c + 1) * 132 + tl * 2));
                    s += v[2 * i] * v[2 * i] + v[2 * i + 1] * v[2 * i + 1]; }
                s = wave_sum(s);
                const float rstd = rsqrtf(s * (1.0f / DH) + EPS);
#pragma unroll
                for (int i = 0; i < 4; ++i) { const int c = 2 * lane + 128 * i;
                    *(unsigned*)(y_cat + (size_t)(tok0 + tl) * 1024 + 512 + c) = pk2(v[2 * i] * rstd * gB[c], v[2 * i + 1] * rstd * gB[c + 1]); }
            }
        }
        }
        if (BOTH(3)) GRID_BAR();
    }
    if (IN(4)) {
        pg8::Gemm g{y_cat, WoutT, NTOK, DM, DM}; pg8::StaticOrder S; S.init(NTOK, DM, G, bid);
        pg8::EpiResF32 E{a.in[0], a.out, DM};
#ifndef DUP_P4
#define DUP_P4 1
#endif
        pg8::gemm_phase<pg8::EpiResF32, pg8::StaticOrder, true, true>(L, g, S, E);
#if DUP_P4 > 1
        pg8::gemm_phase<pg8::EpiResF32, pg8::StaticOrder, true, true>(L, g, S, E);
#endif
        if (BOTH(4)) GRID_BAR();
    }

#ifndef DUP_P5
#define DUP_P5 1
#endif
    for (int rep5 = 0; rep5 < DUP_P5; ++rep5)
    if (IN(5)) {
        const bool dummy = (rep5 + 1 < DUP_P5);
        unsigned* cntg = ctl + (dummy ? 3072 : CW_CNT);
        int* list_ = dummy ? (int*)(ws + 376 * MiB) : list; float* lgate_ = dummy ? (float*)(ws + 380 * MiB) : lgate; int4* tokinfo_ = dummy ? (int4*)(ws + 384 * MiB) : tokinfo;
        bf16* hn2_ = dummy ? (bf16*)(ws + 232 * MiB) : hn2;
        LAS float* lg = (LAS float*)(L + 98304);
        LAS int* cnt_l = (LAS int*)(L + LC_CNT); LAS int* base_l = (LAS int*)(L + LC_BASE);
        const float* xmid = a.out; const float* gff = a.in[28];
        for (int tile = bid; tile < NTOK / 128; tile += G) {
            __syncthreads();
            for (int ch = tid; ch < 48 * 128; ch += NWAVES * 64) { const int row = ch >> 7, c16 = ch & 127;
                *(LAS v4u*)(L + row * 2048 + ((c16 ^ (row & 15)) << 4)) = *(const v4u*)(WrT + (size_t)row * 1024 + c16 * 8); }
            if (tid < 32) cnt_l[tid] = 0;
            __syncthreads();
            const int tk = lane & 15, kg = lane >> 4;
            const int tokw = tile * 128 + wave * 16 + tk;
            const float* xr = xmid + (size_t)tokw * DM + 8 * kg;
            float s = 0.f;
#pragma unroll 8
            for (int st = 0; st < 32; ++st) { const float4 p = *(const float4*)(xr + 32 * st), q = *(const float4*)(xr + 32 * st + 4);
                s += (p.x * p.x + p.y * p.y) + (p.z * p.z + p.w * p.w) + (q.x * q.x + q.y * q.y) + (q.z * q.z + q.w * q.w); }
            s += __shfl_xor(s, 16); s += __shfl_xor(s, 32);
            const float rstd = rsqrtf(s * (1.0f / DM) + EPS);
            f32x4_t acc0 = {0.f, 0.f, 0.f, 0.f}, acc1 = acc0, acc2 = acc0;
            bf16* hrow = hn2_ + (size_t)tokw * DM + 8 * kg;
#pragma unroll 4
            for (int st = 0; st < 32; ++st) {
                const float4 p = *(const float4*)(xr + 32 * st), q = *(const float4*)(xr + 32 * st + 4);
                const float4 g0 = *(const float4*)(gff + 32 * st + 8 * kg), g1 = *(const float4*)(gff + 32 * st + 8 * kg + 4);
                v4u w; w.x = pk2(p.x * rstd * g0.x, p.y * rstd * g0.y); w.y = pk2(p.z * rstd * g0.z, p.w * rstd * g0.w);
                w.z = pk2(q.x * rstd * g1.x, q.y * rstd * g1.y); w.w = pk2(q.z * rstd * g1.z, q.w * rstd * g1.w);
                *(v4u*)(hrow + 32 * st) = w;
                const bf16x8_t B = __builtin_bit_cast(bf16x8_t, w);
                const int chs = ((4 * st + kg) ^ tk) << 4;
                const bf16x8_t A0 = *(const LAS bf16x8_t*)(L + (0 + tk) * 2048 + chs), A1 = *(const LAS bf16x8_t*)(L + (16 + tk) * 2048 + chs), A2 = *(const LAS bf16x8_t*)(L + (32 + tk) * 2048 + chs);
                acc0 = __builtin_amdgcn_mfma_f32_16x16x32_bf16(A0, B, acc0, 0, 0, 0);
                acc1 = __builtin_amdgcn_mfma_f32_16x16x32_bf16(A1, B, acc1, 0, 0, 0);
                acc2 = __builtin_amdgcn_mfma_f32_16x16x32_bf16(A2, B, acc2, 0, 0, 0);
            }
            { LAS float* lr = lg + (wave * 16 + tk) * 49 + 4 * kg;
#pragma unroll
              for (int r = 0; r < 4; ++r) { lr[r] = acc0[r]; lr[16 + r] = acc1[r]; lr[32 + r] = acc2[r]; } }
            __syncthreads();
            int e0 = 0, e1 = 0, r0l = 0, r1l = 0; float g0 = 0.f, g1 = 0.f;
            if (tid < 128) {
                const LAS float* lr = lg + tid * 49; const float* bgp = a.in[30]; const float* bep = a.in[32];
                int gi = 0; float gm = lr[0] + bgp[0];
                for (int i = 1; i < 4; ++i) { const float v = lr[i] + bgp[i]; if (v > gm) { gm = v; gi = i; } }
                float gs = 0.f; for (int i = 0; i < 4; ++i) gs += __expf(lr[i] + bgp[i] - gm);
                const float gp = 1.0f / gs;
                const LAS float* le = lr + 4 + gi * 8; const float* beg = bep + gi * 8;
                int i1 = 0; float m1 = le[0] + beg[0];
                for (int i = 1; i < 8; ++i) { const float v = le[i] + beg[i]; if (v > m1) { m1 = v; i1 = i; } }
                int i2 = -1; float m2 = -3.0e38f;
                for (int i = 0; i < 8; ++i) { const float v = le[i] + beg[i]; if (i != i1 && v > m2) { m2 = v; i2 = i; } }
                const float ex2 = __expf(m2 - m1);
                e0 = gi * 8 + i1; e1 = gi * 8 + i2; g0 = gp / (1.0f + ex2); g1 = gp * ex2 / (1.0f + ex2);
                r0l = atomicAdd((int*)(cnt_l + e0), 1); r1l = atomicAdd((int*)(cnt_l + e1), 1);
            }
            __syncthreads();
            if (tid < 32) { const int c = cnt_l[tid]; base_l[tid] = c ? (int)atomicAdd(cntg + tid, (unsigned)c) : 0; }
            __syncthreads();
            if (tid < 128) { const int tok = tile * 128 + tid; const int r0 = base_l[e0] + r0l, r1 = base_l[e1] + r1l;
                list_[e0 * NTOK + r0] = tok; lgate_[e0 * NTOK + r0] = g0; list_[e1 * NTOK + r1] = tok; lgate_[e1 * NTOK + r1] = g1;
                tokinfo_[tok] = make_int4(e0, r0, e1, r1); }
        }
        if (BOTH(5) && !dummy) GRID_BAR();
    }
    if (IN(6)) {
        const int T = moe_tables(L, ctl, tid);
        const LAS int* cnt = (const LAS int*)(L + LC_CNT); const LAS int* tstart = (const LAS int*)(L + LC_TSTART); const LAS int* tile_e = (const LAS int*)(L + LC_TILEE);
#ifndef DUP_P6
#define DUP_P6 1
#endif
        for (int rep6 = 0; rep6 < DUP_P6; ++rep6)
        for (int rho = gw; rho < T * 256; rho += NGW) {
            const int tau = rho >> 8, rl = rho & 255, e = tile_e[tau], r = (tau - tstart[e]) * 256 + rl;
            const bool valid = r < cnt[e];
            v4u v0 = {0u, 0u, 0u, 0u}, v1 = v0; float gt = 0.f;
            if (valid) { const int tok = list[e * NTOK + r]; gt = lgate[e * NTOK + r]; const v4u* src = (const v4u*)(hn2 + (size_t)tok * DM); v0 = src[lane]; v1 = src[lane + 64]; }
            v4u* dst = (v4u*)(xs + (size_t)rho * DM); dst[lane] = v0; dst[lane + 64] = v1;
            if (lane == 0) sgate[rho] = gt;
        }
        if (BOTH(6)) GRID_BAR();
    }
    if (IN(7)) {
        const int T = moe_tables(L, ctl, tid);
        pg8::Gemm g{xs, W13T, T * 256, 1024, DM};
        pg8::MoeOrder S{(const LAS int*)(L + LC_TILEE), T, 4, G, bid, (size_t)1024 * 1024 * 2};
        pg8::EpiSwiGLU E{Hb};
#ifndef DUP_P7
#define DUP_P7 1
#endif
        pg8::gemm_phase<pg8::EpiSwiGLU, pg8::MoeOrder, true, true>(L, g, S, E);
#if DUP_P7 > 1
        pg8::gemm_phase<pg8::EpiSwiGLU, pg8::MoeOrder, true, true>(L, g, S, E);
#endif
        if (BOTH(7)) GRID_BAR();
    }
    if (IN(8)) {
        const int T = moe_tables(L, ctl, tid);
        pg8::Gemm g{Hb, W2T, T * 256, 1024, 512};
        pg8::MoeOrder S{(const LAS int*)(L + LC_TILEE), T, 4, G, bid, (size_t)1024 * 512 * 2};
        pg8::EpiRowScaleBf16 E{Yb, 1024, sgate};
#ifndef DUP_P8
#define DUP_P8 1
#endif
        pg8::gemm_phase<pg8::EpiRowScaleBf16, pg8::MoeOrder, true, true>(L, g, S, E);
#if DUP_P8 > 1
        pg8::gemm_phase<pg8::EpiRowScaleBf16, pg8::MoeOrder, true, true>(L, g, S, E);
#endif
        if (BOTH(8)) GRID_BAR();
    }
#ifndef DUP_P9
#define DUP_P9 1
#endif
    for (int rep9 = 0; rep9 < DUP_P9; ++rep9)
    if (IN(9)) {
        float* outw = (rep9 + 1 < DUP_P9) ? (float*)(ws + 256 * MiB) : a.out;
        (void)moe_tables(L, ctl, tid);
        const LAS int* tstart = (const LAS int*)(L + LC_TSTART);
        const float* gfin = a.in[36];
        for (int tok0 = gw * 4; tok0 < NTOK; tok0 += NGW * 4) {
            float4 v[4][4]; uint2 p[4][4], q[4][4];
#pragma unroll
            for (int u = 0; u < 4; ++u) { const int4 ti = tokinfo[tok0 + u];
                const size_t s0 = (size_t)tstart[ti.x] * 256 + ti.y, s1 = (size_t)tstart[ti.z] * 256 + ti.w;
                const uint2* y0 = (const uint2*)(Yb + s0 * DM); const uint2* y1 = (const uint2*)(Yb + s1 * DM);
                const float4* xr = (const float4*)(a.out + (size_t)(tok0 + u) * DM);
#pragma unroll
                for (int j = 0; j < 4; ++j) { v[u][j] = xr[lane + 64 * j]; p[u][j] = y0[lane + 64 * j]; q[u][j] = y1[lane + 64 * j]; } }
#pragma unroll
            for (int u = 0; u < 4; ++u) { float s = 0.f;
#pragma unroll
                for (int j = 0; j < 4; ++j) { const uint2 pp = p[u][j], qq = q[u][j];
                    v[u][j].x += __uint_as_float(pp.x << 16) + __uint_as_float(qq.x << 16); v[u][j].y += __uint_as_float(pp.x & 0xffff0000u) + __uint_as_float(qq.x & 0xffff0000u);
                    v[u][j].z += __uint_as_float(pp.y << 16) + __uint_as_float(qq.y << 16); v[u][j].w += __uint_as_float(pp.y & 0xffff0000u) + __uint_as_float(qq.y & 0xffff0000u);
                    s += (v[u][j].x * v[u][j].x + v[u][j].y * v[u][j].y) + (v[u][j].z * v[u][j].z + v[u][j].w * v[u][j].w); }
                s = wave_sum(s);
                const float rstd = rsqrtf(s * (1.0f / DM) + EPS);
                float4* xw = (float4*)(outw + (size_t)(tok0 + u) * DM);
#pragma unroll
                for (int j = 0; j < 4; ++j) { const float4 gg = *(const float4*)(gfin + (lane + 64 * j) * 4);
                    xw[lane + 64 * j] = make_float4(v[u][j].x * rstd * gg.x, v[u][j].y * rstd * gg.y, v[u][j].z * rstd * gg.z, v[u][j].w * rstd * gg.w); } }
        }
    }
#undef IN
#undef BOTH
#undef GRID_BAR
}

static void launch_fwd(const Args& base, int lo, int hi, int li, int grid, hipStream_t stream) {
    Args a = base; a.ph_lo = lo; a.ph_hi = hi; a.li = li; a.pad = 0;
    hipLaunchKernelGGL(fwd, dim3(grid), dim3(NWAVES * 64), LDS_BYTES, stream, a);
}

extern "C" void kernel_launch(void* const* d_in, const int* in_sizes, int n_in, void* d_out, int out_size, void* d_ws, size_t ws_size, hipStream_t stream) {
    (void)in_sizes; (void)n_in; (void)out_size; (void)ws_size;
    static int grid = 0;
    if (grid == 0) {
        int dev = 0, cus = 0;
        (void)hipGetDevice(&dev); (void)hipDeviceGetAttribute(&cus, hipDeviceAttributeMultiprocessorCount, dev);
        (void)hipFuncSetAttribute((const void*)fwd, hipFuncAttributeMaxDynamicSharedMemorySize, LDS_BYTES);
        grid = cus > 0 ? cus : 256;
    }
    const float* const* in = (const float* const*)d_in;
    unsigned char* ws = (unsigned char*)d_ws;
    float* out = (float*)d_out;
    (void)hipMemsetAsync(ws, 0, CTL_ZERO_BYTES, stream);
    Args base{};
    for (int i = 0; i < 37; ++i) base.in[i] = in[i];
    base.out = out; base.ws = ws;

    bf16* lru = (bf16*)(ws + WS_LRU); bf16* hyuT = (bf16*)(ws + WS_HYUT); float* xc = (float*)(ws + WS_XC);
    bf16* hf = (bf16*)(ws + WS_HF); bf16* hb = (bf16*)(ws + WS_HB); float* kT = (float*)(ws + WS_KT); float* z2 = (float*)(ws + WS_Z2); float* z1T = out;
    bf16* y_hyT = (bf16*)(ws + WS_YHYT); bf16* y_cat = (bf16*)(ws + WS_YCAT); bf16* hn2 = (bf16*)(ws + WS_HN2); int* eid = (int*)(ws + WS_EID); float* gate = (float*)(ws + WS_GATE);

#ifndef MK_PER_PHASE
    launch_fwd(base, 0, 10, 0, grid, stream);
#else
    for (int ph = 0; ph < 10; ++ph) launch_fwd(base, ph, ph + 1, ph, grid, stream);
#endif
    (void)lru; (void)hyuT; (void)xc; (void)hf; (void)hb; (void)kT; (void)z2; (void)z1T; (void)y_hyT; (void)y_cat;
    (void)hn2; (void)eid; (void)gate;
}
```

```cpp
#include <hip/hip_runtime.h>
#include <stdint.h>

typedef unsigned short bf16;
__device__ __forceinline__ float bf2f(bf16 v) { return __uint_as_float(((unsigned)v) << 16); }
__device__ __forceinline__ bf16 f2bf(float f) { unsigned u = __float_as_uint(f); u += 0x7fffu + ((u >> 16) & 1u); return (bf16)(u >> 16); }

constexpr int NB = 4, SEQ = 8192, DM = 1024, NTOK = NB * SEQ, DIN = 2560, DL = 512, DH = 512;
constexpr float EPS = 1e-6f;

__device__ __forceinline__ float wave_sum(float v) {
#pragma unroll
    for (int o = 1; o < 64; o <<= 1) v += __shfl_xor(v, o);
    return v;
}
__device__ __forceinline__ float gelu_tanh(float x) { return 0.5f * x * (1.0f + tanhf(0.7978845608028654f * (x + 0.044715f * x * x * x))); }

__global__ __launch_bounds__(256) void k_rmsnorm_bf16(const float* __restrict__ x, const float* __restrict__ g, bf16* __restrict__ out) {
    const int wave = threadIdx.x >> 6, lane = threadIdx.x & 63;
    const int row = blockIdx.x * 4 + wave;
    const float4* xr = (const float4*)(x + (size_t)row * DM);
    float4 v[4]; float s = 0.f;
#pragma unroll
    for (int j = 0; j < 4; ++j) { v[j] = xr[lane + 64 * j]; s += v[j].x * v[j].x + v[j].y * v[j].y + v[j].z * v[j].z + v[j].w * v[j].w; }
    s = wave_sum(s);
    const float rstd = rsqrtf(s * (1.0f / DM) + EPS);
#pragma unroll
    for (int j = 0; j < 4; ++j) {
        const int c = (lane + 64 * j) * 4;
        const float4 gg = *(const float4*)(g + c);
        ushort4 o; o.x = f2bf(v[j].x * rstd * gg.x); o.y = f2bf(v[j].y * rstd * gg.y); o.z = f2bf(v[j].z * rstd * gg.z); o.w = f2bf(v[j].w * rstd * gg.w);
        *(ushort4*)(out + (size_t)row * DM + c) = o;
    }
}

template <int MODE>
__global__ __launch_bounds__(256) void k_gemm_naive(const bf16* __restrict__ A, const float* __restrict__ B, int M, int N, int K,
                                                    bf16* __restrict__ o_lru, bf16* __restrict__ o_hyT, const float* __restrict__ xres, float* __restrict__ o_f32) {
    __shared__ float As[16][68];
    __shared__ float Bs[16][64];
    const int tid = threadIdx.x, tx = tid & 15, ty = tid >> 4;
    const int m0 = blockIdx.y * 64, n0 = blockIdx.x * 64;
    float acc[4][4];
#pragma unroll
    for (int i = 0; i < 4; ++i)
#pragma unroll
        for (int j = 0; j < 4; ++j) acc[i][j] = 0.f;
    for (int k0 = 0; k0 < K; k0 += 16) {
        { const int r = tid >> 2, kq = (tid & 3) * 4; const ushort4 v = *(const ushort4*)(A + (size_t)(m0 + r) * K + k0 + kq);
          As[kq + 0][r] = bf2f(v.x); As[kq + 1][r] = bf2f(v.y); As[kq + 2][r] = bf2f(v.z); As[kq + 3][r] = bf2f(v.w); }
        { const int kr = tid >> 4, nq = (tid & 15) * 4; const float4 v = *(const float4*)(B + (size_t)(k0 + kr) * N + n0 + nq);
          Bs[kr][nq + 0] = v.x; Bs[kr][nq + 1] = v.y; Bs[kr][nq + 2] = v.z; Bs[kr][nq + 3] = v.w; }
        __syncthreads();
#pragma unroll
        for (int kk = 0; kk < 16; ++kk) {
            float a[4], b[4];
#pragma unroll
            for (int i = 0; i < 4; ++i) a[i] = As[kk][ty * 4 + i];
#pragma unroll
            for (int j = 0; j < 4; ++j) b[j] = Bs[kk][tx * 4 + j];
#pragma unroll
            for (int i = 0; i < 4; ++i)
#pragma unroll
                for (int j = 0; j < 4; ++j) acc[i][j] += a[i] * b[j];
        }
        __syncthreads();
    }
#pragma unroll
    for (int i = 0; i < 4; ++i)
#pragma unroll
        for (int j = 0; j < 4; ++j) {
            const int row = m0 + ty * 4 + i, col = n0 + tx * 4 + j;
            if (MODE == 0) {
                if (col < 1024) o_lru[(size_t)row * 1024 + col] = f2bf(acc[i][j]);
                else o_hyT[(size_t)(col - 1024) * NTOK + row] = f2bf(acc[i][j]);
            } else {
                o_f32[(size_t)row * N + col] = xres[(size_t)row * N + col] + acc[i][j];
            }
        }
}

__global__ __launch_bounds__(256) void k_lru_conv(const bf16* __restrict__ lru, const float* __restrict__ w, const float* __restrict__ bias, float* __restrict__ xc) {
    const size_t idx = (size_t)blockIdx.x * 256 + threadIdx.x;
    const int c = (int)(idx & 511); const int tok = (int)(idx >> 9); const int t = tok & (SEQ - 1);
    float s = bias[c];
#pragma unroll
    for (int j = 0; j < 4; ++j) { const int tt = t + j - 2; if (tt >= 0 && tt < SEQ) s += w[j * DL + c] * bf2f(lru[(size_t)(tok + j - 2) * 1024 + c]); }
    xc[idx] = s;
}

__global__ __launch_bounds__(64) void k_lru_scan(const float* __restrict__ xc,
        const float* __restrict__ wr_f, const float* __restrict__ br_f, const float* __restrict__ wi_f, const float* __restrict__ bi_f, const float* __restrict__ lam_f,
        const float* __restrict__ wr_b, const float* __restrict__ br_b, const float* __restrict__ wi_b, const float* __restrict__ bi_b, const float* __restrict__ lam_b,
        bf16* __restrict__ hf, bf16* __restrict__ hb) {
    __shared__ float wr_s[4096], wi_s[4096], xs[64];
    const int b = blockIdx.x >> 4, h = (blockIdx.x >> 1) & 7, dir = blockIdx.x & 1;
    const float* wr = dir ? wr_b : wr_f; const float* br = dir ? br_b : br_f; const float* wi = dir ? wi_b : wi_f; const float* bi = dir ? bi_b : bi_f; const float* lam = dir ? lam_b : lam_f;
    bf16* out = dir ? hb : hf;
    const int tid = threadIdx.x, c = h * 64 + tid;
    for (int i = tid; i < 4096; i += 64) { wr_s[i] = wr[h * 4096 + i]; wi_s[i] = wi[h * 4096 + i]; }
    const float br_ = br[c], bi_ = bi[c];
    const float sp = log1pf(expf(-lam[c]));
    float hs = 0.f;
    for (int step = 0; step < SEQ; ++step) {
        const int t = dir ? (SEQ - 1 - step) : step;
        const float xv = xc[((size_t)(b * SEQ + t)) * DL + c];
        __syncthreads(); xs[tid] = xv; __syncthreads();
        float dr = br_, di = bi_;
#pragma unroll 16
        for (int i = 0; i < 64; ++i) { const float xx = xs[i]; dr += xx * wr_s[i * 64 + tid]; di += xx * wi_s[i * 64 + tid]; }
        const float r = 1.0f / (1.0f + expf(-dr)), ig = 1.0f / (1.0f + expf(-di));
        const float la = -8.0f * r * sp;
        const float a = expf(la);
        const float bb = sqrtf(-expm1f(2.0f * la)) * (ig * xv);
        hs = a * hs + bb;
        out[((size_t)(b * SEQ + t)) * DL + c] = f2bf(hs);
    }
}

__global__ __launch_bounds__(64) void k_filt_z(const float* __restrict__ w1, const float* __restrict__ b1, const float* __restrict__ f1,
                                               const float* __restrict__ w2, const float* __restrict__ b2, const float* __restrict__ f2, float* __restrict__ z2out) {
    __shared__ float feats[33], z1[64];
    const int t = blockIdx.x, tid = threadIdx.x;
    const float tn = (float)t / (float)(SEQ - 1);
    const float w = (6.283185307179586f / (float)SEQ) * (float)t;
    if (tid == 0) feats[0] = tn;
    if (tid < 16) { const float band = 1e-4f + (float)tid * ((15.0f - 1e-4f) / 15.0f); const float ang = w * band; feats[1 + tid] = cosf(ang); feats[17 + tid] = sinf(ang); }
    __syncthreads();
    float s = b1[tid];
    for (int i = 0; i < 33; ++i) s += feats[i] * w1[i * 64 + tid];
    z1[tid] = sinf(f1[tid] * s);
    __syncthreads();
    s = b2[tid];
    for (int i = 0; i < 64; ++i) s += z1[i] * w2[i * 64 + tid];
    z2out[t * 64 + tid] = sinf(f2[tid] * s);
}
__global__ __launch_bounds__(256) void k_filt_h(const float* __restrict__ z2, const float* __restrict__ w3, float* __restrict__ kT) {
    __shared__ float zr[64];
    const int t = blockIdx.x, tid = threadIdx.x;
    if (tid < 64) zr[tid] = z2[t * 64 + tid];
    __syncthreads();
    const float tn = (float)t / (float)(SEQ - 1);
    const float lo = logf(1e-2f) / 1.5f, hi = logf(1e-2f) / 0.3f;
    for (int col = tid; col < 2048; col += 256) {
        float h = 0.f;
        for (int j = 0; j < 64; ++j) h += zr[j] * w3[j * 2048 + col];
        const int dir = col >> 10, o = (col >> 9) & 1, c = col & 511;
        const float delta = fabsf(lo + (float)c * ((hi - lo) / 511.0f));
        h *= expf(-tn * delta);
        const size_t row = (size_t)(o * 512 + c) * 16384;
        if (dir == 0) kT[row + 8192 + t] = h;
        else { if (t == 0) kT[row] = 0.f; else kT[row + 8192 - t] = h; }
    }
}
__global__ __launch_bounds__(256) void k_filt_norm(float* __restrict__ kT) {
    __shared__ float red[4];
    float* row = kT + (size_t)blockIdx.x * 16384;
    float s = 0.f;
    for (int i = threadIdx.x; i < 16384; i += 256) s += fabsf(row[i]);
    s = wave_sum(s);
    if ((threadIdx.x & 63) == 0) red[threadIdx.x >> 6] = s;
    __syncthreads();
    const float inv = 1.0f / (red[0] + red[1] + red[2] + red[3] + EPS);
    for (int i = threadIdx.x; i < 16384; i += 256) row[i] *= inv;
}

__device__ __forceinline__ float hy_dwconv(const bf16* __restrict__ hyuT, const float* __restrict__ cw, const float* __restrict__ cb, int ch, int b, int t) {
    const bf16* p = hyuT + (size_t)ch * NTOK + b * SEQ;
    float s = cb[ch] + cw[1 * 1536 + ch] * bf2f(p[t]);
    if (t > 0) s += cw[0 * 1536 + ch] * bf2f(p[t - 1]);
    if (t < SEQ - 1) s += cw[2 * 1536 + ch] * bf2f(p[t + 1]);
    return s;
}
template <int ORDER>
__global__ __launch_bounds__(256) void k_hy_conv(const bf16* __restrict__ hyuT, const float* __restrict__ cw, const float* __restrict__ cb, const float* __restrict__ kT,
                                                 const float* __restrict__ skip, float* __restrict__ z1T, bf16* __restrict__ y_hyT) {
    __shared__ float kk[16384];
    __shared__ float4 zs[1024];
    const int c = blockIdx.x >> 5, tile = blockIdx.x & 31, tid = threadIdx.x, t = tile * 256 + tid;
    const float* krow = kT + (size_t)((ORDER - 1) * 512 + c) * 16384;
    for (int i = tid; i < 16384; i += 256) kk[i] = krow[i];
    float acc0 = 0.f, acc1 = 0.f, acc2 = 0.f, acc3 = 0.f;
    for (int s0 = 0; s0 < SEQ; s0 += 1024) {
        __syncthreads();
        for (int i = tid; i < 1024; i += 256) {
            float4 v;
            if (ORDER == 1) { v.x = hy_dwconv(hyuT, cw, cb, c, 0, s0 + i); v.y = hy_dwconv(hyuT, cw, cb, c, 1, s0 + i); v.z = hy_dwconv(hyuT, cw, cb, c, 2, s0 + i); v.w = hy_dwconv(hyuT, cw, cb, c, 3, s0 + i); }
            else { const float* p = z1T + (size_t)c * NTOK + s0 + i; v.x = p[0]; v.y = p[SEQ]; v.z = p[2 * SEQ]; v.w = p[3 * SEQ]; }
            zs[i] = v;
        }
        __syncthreads();
        const float* kp = kk + 8192 + t - s0;
#pragma unroll 8
        for (int s = 0; s < 1024; ++s) { const float kv = kp[-s]; const float4 z = zs[s]; acc0 += kv * z.x; acc1 += kv * z.y; acc2 += kv * z.z; acc3 += kv * z.w; }
    }
    const float sk = skip[(ORDER - 1) * 512 + c];
    float accs[4] = {acc0, acc1, acc2, acc3};
#pragma unroll
    for (int b = 0; b < 4; ++b) {
        float zv, gate;
        if (ORDER == 1) { zv = hy_dwconv(hyuT, cw, cb, c, b, t); gate = hy_dwconv(hyuT, cw, cb, 512 + c, b, t); }
        else { zv = z1T[(size_t)c * NTOK + b * SEQ + t]; gate = hy_dwconv(hyuT, cw, cb, 1024 + c, b, t); }
        const float y = gate * (accs[b] + sk * zv);
        if (ORDER == 1) z1T[(size_t)c * NTOK + b * SEQ + t] = y; else y_hyT[(size_t)c * NTOK + b * SEQ + t] = f2bf(y);
    }
}

__device__ __forceinline__ float block_sum_256(float v, float* red) {
    v = wave_sum(v);
    __syncthreads();
    if ((threadIdx.x & 63) == 0) red[threadIdx.x >> 6] = v;
    __syncthreads();
    return red[0] + red[1] + red[2] + red[3];
}
__global__ __launch_bounds__(256) void k_combine(const bf16* __restrict__ hf, const bf16* __restrict__ hb, const bf16* __restrict__ lru, const bf16* __restrict__ y_hyT,
                                                 const float* __restrict__ gA, const float* __restrict__ gB, bf16* __restrict__ y_cat) {
    __shared__ float red[4];
    const int tok = blockIdx.x, tid = threadIdx.x;
    float ya[2], yb[2]; float sa = 0.f, sb = 0.f;
#pragma unroll
    for (int j = 0; j < 2; ++j) {
        const int c = tid + 256 * j;
        const float hsum = bf2f(hf[(size_t)tok * DL + c]) + bf2f(hb[(size_t)tok * DL + c]);
        const float gate = bf2f(lru[(size_t)tok * 1024 + 512 + c]);
        ya[j] = hsum * gelu_tanh(gate); sa += ya[j] * ya[j];
        yb[j] = bf2f(y_hyT[(size_t)c * NTOK + tok]); sb += yb[j] * yb[j];
    }
    sa = block_sum_256(sa, red); sb = block_sum_256(sb, red);
    const float ra = rsqrtf(sa * (1.0f / DL) + EPS), rb = rsqrtf(sb * (1.0f / DH) + EPS);
#pragma unroll
    for (int j = 0; j < 2; ++j) {
        const int c = tid + 256 * j;
        y_cat[(size_t)tok * 1024 + c] = f2bf(ya[j] * ra * gA[c]);
        y_cat[(size_t)tok * 1024 + 512 + c] = f2bf(yb[j] * rb * gB[c]);
    }
}

__global__ __launch_bounds__(256) void k_route(const float* __restrict__ xmid, const float* __restrict__ g, const float* __restrict__ wg, const float* __restrict__ bg,
                                               const float* __restrict__ we, const float* __restrict__ be, bf16* __restrict__ hn2, int* __restrict__ eid, float* __restrict__ gate) {
    __shared__ float hrow[1024];
    __shared__ float red[4];
    __shared__ float lg[36];
    const int tok = blockIdx.x, tid = threadIdx.x;
    const float4 v = *(const float4*)(xmid + (size_t)tok * DM + tid * 4);
    float s = v.x * v.x + v.y * v.y + v.z * v.z + v.w * v.w;
    s = block_sum_256(s, red);
    const float rstd = rsqrtf(s * (1.0f / DM) + EPS);
    const float4 gg = *(const float4*)(g + tid * 4);
    const float h0 = v.x * rstd * gg.x, h1 = v.y * rstd * gg.y, h2 = v.z * rstd * gg.z, h3 = v.w * rstd * gg.w;
    hrow[tid * 4 + 0] = h0; hrow[tid * 4 + 1] = h1; hrow[tid * 4 + 2] = h2; hrow[tid * 4 + 3] = h3;
    ushort4 o; o.x = f2bf(h0); o.y = f2bf(h1); o.z = f2bf(h2); o.w = f2bf(h3);
    *(ushort4*)(hn2 + (size_t)tok * DM + tid * 4) = o;
    __syncthreads();
    if (tid < 36) {
        float d;
        if (tid < 4) { d = bg[tid]; for (int k = 0; k < DM; ++k) d += hrow[k] * wg[k * 4 + tid]; }
        else { const int j = tid - 4; d = be[j]; for (int k = 0; k < DM; ++k) d += hrow[k] * we[k * 32 + j]; }
        lg[tid] = d;
    }
    __syncthreads();
    if (tid == 0) {
        int gi = 0; float gm = lg[0];
        for (int i = 1; i < 4; ++i) if (lg[i] > gm) { gm = lg[i]; gi = i; }
        float gs = 0.f; for (int i = 0; i < 4; ++i) gs += expf(lg[i] - gm);
        const float gp = 1.0f / gs;
        const float* le = lg + 4 + gi * 8;
        int i1 = 0; float m1 = le[0];
        for (int i = 1; i < 8; ++i) if (le[i] > m1) { m1 = le[i]; i1 = i; }
        int i2 = -1; float m2 = -3.0e38f;
        for (int i = 0; i < 8; ++i) if (i != i1 && le[i] > m2) { m2 = le[i]; i2 = i; }
        const float e1 = 1.0f, e2 = expf(m2 - m1);
        eid[tok * 2 + 0] = gi * 8 + i1; eid[tok * 2 + 1] = gi * 8 + i2;
        gate[tok * 2 + 0] = gp * e1 / (e1 + e2); gate[tok * 2 + 1] = gp * e2 / (e1 + e2);
    }
}

__global__ __launch_bounds__(512) void k_moe_final(const bf16* __restrict__ hn2, const int* __restrict__ eid, const float* __restrict__ gate,
                                                   const float* __restrict__ w1, const float* __restrict__ w3, const float* __restrict__ w2,
                                                   const float* __restrict__ gfin, float* __restrict__ out) {
    __shared__ float hrow[1024];
    __shared__ float act[512];
    __shared__ float red[8];
    const int tok = blockIdx.x, tid = threadIdx.x;
    hrow[tid] = bf2f(hn2[(size_t)tok * DM + tid]); hrow[tid + 512] = bf2f(hn2[(size_t)tok * DM + tid + 512]);
    float y0 = 0.f, y1 = 0.f;
    for (int k = 0; k < 2; ++k) {
        const int e = eid[tok * 2 + k]; const float gk = gate[tok * 2 + k];
        const float* W1 = w1 + (size_t)e * 1024 * 512; const float* W3 = w3 + (size_t)e * 1024 * 512; const float* W2 = w2 + (size_t)e * 512 * 1024;
        __syncthreads();
        float a = 0.f, b = 0.f;
#pragma unroll 8
        for (int i = 0; i < 1024; ++i) { const float hv = hrow[i]; a += hv * W1[(size_t)i * 512 + tid]; b += hv * W3[(size_t)i * 512 + tid]; }
        act[tid] = (a / (1.0f + expf(-a))) * b;
        __syncthreads();
        float p0 = 0.f, p1 = 0.f;
#pragma unroll 8
        for (int i = 0; i < 512; ++i) { const float av = act[i]; p0 += av * W2[(size_t)i * 1024 + tid]; p1 += av * W2[(size_t)i * 1024 + tid + 512]; }
        y0 += gk * p0; y1 += gk * p1;
    }
    const float v0 = out[(size_t)tok * DM + tid] + y0, v1 = out[(size_t)tok * DM + tid + 512] + y1;
    float s = v0 * v0 + v1 * v1;
    s = wave_sum(s);
    __syncthreads();
    if ((tid & 63) == 0) red[tid >> 6] = s;
    __syncthreads();
    float tot = 0.f;
#pragma unroll
    for (int i = 0; i < 8; ++i) tot += red[i];
    const float rstd = rsqrtf(tot * (1.0f / DM) + EPS);
    out[(size_t)tok * DM + tid] = v0 * rstd * gfin[tid];
    out[(size_t)tok * DM + tid + 512] = v1 * rstd * gfin[tid + 512];
}

constexpr size_t MiB = 1u << 20;
namespace pg8 {
#define PG8_LAS __attribute__((address_space(3)))
typedef unsigned short bf16_t;
typedef short bf16x8 __attribute__((ext_vector_type(8)));
typedef float f32x4 __attribute__((ext_vector_type(4)));
typedef unsigned u32x4 __attribute__((ext_vector_type(4)));
constexpr int BM = 256, BK = 64, HALF = 128, HTB = HALF * BK * 2  , STAGE_BYTES = 8 * HTB, NXCD = 8, WGM = 8;

__host__ __device__ __forceinline__ int lds_byte(int r, int c) { const int st = (r >> 4) * 2 + (c >> 5), rr = r & 15, cc = c & 31, ob = rr * 64 + cc * 2; return st * 1024 + (ob ^ (((ob >> 9) & 1) << 5)); }
__host__ __device__ __forceinline__ void stage_rc(int b, int& R, int& C) { const int st = b / 1024, sb = b % 1024, swz = sb ^ (((sb >> 9) & 1) << 5); R = (st >> 1) * 16 + swz / 64; C = (st & 1) * 32 + (swz % 64) / 2; }
__host__ __device__ __forceinline__ int perm32(int rho) { const int n = rho >> 4, i = rho & 15; return 8 * (i >> 2) + 4 * n + (i & 3); }

struct Unit { int pm, pn; };
struct Gemm { const bf16_t* A; const bf16_t* Bt; int M, N, K; };

struct StaticOrder {
    int nM, nN, nwg, G, c;
    __host__ __device__ void init(int M, int N, int G_, int c_) { nM = M / BM; nN = N / BM; nwg = nM * nN; G = G_; c = c_; }
    __host__ __device__ bool next(int i, Unit& u) const {
        const long L = (long)i * G + c; if (L >= nwg) return false;
        int wgid = (int)L; { const int q = nwg / NXCD, r = nwg % NXCD, xcd = wgid % NXCD, off = wgid / NXCD; wgid = (xcd < r ? xcd * (q + 1) : r * (q + 1) + (xcd - r) * q) + off; }
        const int nig = WGM * nN, gid = wgid / nig, fm = gid * WGM, gsz = (nM - fm) < WGM ? (nM - fm) : WGM;
        u.pm = fm + ((wgid % nig) % gsz); u.pn = (wgid % nig) / gsz; return true;
    }
    __device__ __forceinline__ void a_ready(const Unit&) const {}
    __device__ __forceinline__ void done(const Unit&) const {}
    __device__ __forceinline__ const char* a_base(const Gemm& g, const Unit& u) const { return (const char*)g.A + (size_t)u.pm * ((size_t)BM * g.K * 2); }
    __device__ __forceinline__ const char* b_base(const Gemm& g, const Unit& u) const { return (const char*)g.Bt + (size_t)u.pn * ((size_t)BM * g.K * 2); }
    __device__ __forceinline__ int src_row(const Unit&, int row) const { return row; }
};

__device__ __forceinline__ unsigned cvt_pk_bf16(float lo, float hi) { unsigned r; asm volatile("v_cvt_pk_bf16_f32 %0, %1, %2" : "=v"(r) : "v"(lo), "v"(hi)); return r; }
typedef float f32x2 __attribute__((ext_vector_type(2)));
__device__ __forceinline__ f32x2 gelu_pk(f32x2 v) {
    const f32x2 av = __builtin_elementwise_abs(v), d = av * 0.2316418882f + 1.0f;
    f32x2 t; t.x = __builtin_amdgcn_rcpf(d.x); t.y = __builtin_amdgcn_rcpf(d.y);
    f32x2 q = t * 0.5307027145f + (-0.7265760135f); q = q * t + 0.7107068705f; q = q * t + (-0.142248368f); q = q * t + 0.127414796f; q = q * t;
    const f32x2 s = (v * v) * (-0.72134752044f);
    f32x2 e; e.x = __builtin_amdgcn_exp2f(s.x); e.y = __builtin_amdgcn_exp2f(s.y);
    const f32x2 m = v * (q * e), r = v - m;
    f32x2 o; o.x = v.x < 0.f ? m.x : r.x; o.y = v.y < 0.f ? m.y : r.y; return o;
}

template <int ACT  > struct EpiBf16 {
    static constexpr bool PERM = true, AFTER_DRAIN = false; static_assert(ACT == 0 || ACT == 1, "EpiBf16: ACT is 0 (none) or 1 (gelu_pk)");
    bf16_t* O; int ldc; const float* bias; int split_cols; size_t split_stride; float scale0;
    __device__ __forceinline__ void operator()(const f32x4 (&acc)[2][2][4][2], const Unit& u, int wr, int wc, int fr, int fq) const {
        const int row0 = u.pm * BM + wr * 64 + fr; int colt = u.pn * BM; bf16_t* base = O;
        float sc = 1.f; if (split_cols) { const int t = colt / split_cols; base += (size_t)t * split_stride; colt -= t * split_cols; if (t == 0) sc = scale0; }
        const int col0 = colt + wc * 32 + 8 * fq, bcol0 = u.pn * BM + wc * 32 + 8 * fq;
        f32x4 bv[2][2];
#pragma unroll
        for (int bj = 0; bj < 2; ++bj)
#pragma unroll
            for (int n = 0; n < 2; ++n) bv[bj][n] = bias ? *(const f32x4*)(bias + bcol0 + bj * HALF + 4 * n) : (f32x4){0.f, 0.f, 0.f, 0.f};
#pragma unroll
        for (int ai = 0; ai < 2; ++ai)
#pragma unroll
            for (int m = 0; m < 4; ++m) { bf16_t* rowp = base + (size_t)(row0 + ai * HALF + m * 16) * ldc + col0;
#pragma unroll
                for (int bj = 0; bj < 2; ++bj) { f32x4 v0 = acc[ai][bj][m][0] + bv[bj][0], v1 = acc[ai][bj][m][1] + bv[bj][1];
                    if (ACT == 1) { f32x2 a = gelu_pk((f32x2){v0[0], v0[1]}), b = gelu_pk((f32x2){v0[2], v0[3]}), c = gelu_pk((f32x2){v1[0], v1[1]}), d = gelu_pk((f32x2){v1[2], v1[3]});
                        v0 = (f32x4){a.x, a.y, b.x, b.y}; v1 = (f32x4){c.x, c.y, d.x, d.y}; }
                    v0 = v0 * sc; v1 = v1 * sc; u32x4 w; w.x = cvt_pk_bf16(v0[0], v0[1]); w.y = cvt_pk_bf16(v0[2], v0[3]); w.z = cvt_pk_bf16(v1[0], v1[1]); w.w = cvt_pk_bf16(v1[2], v1[3]);
                    *(u32x4*)(rowp + bj * HALF) = w; } }
    }
};

struct EpiResF32 {
    static constexpr bool PERM = false, AFTER_DRAIN = false;
    const float* X; float* O; int ldc;
    __device__ __forceinline__ void operator()(const f32x4 (&acc)[2][2][4][2], const Unit& u, int wr, int wc, int fr, int fq) const {
        const int row0 = u.pm * BM + wr * 64 + fr, col0 = u.pn * BM + wc * 32 + 4 * fq;
#pragma unroll
        for (int ai = 0; ai < 2; ++ai)
#pragma unroll
            for (int m = 0; m < 4; ++m) { const size_t off = (size_t)(row0 + ai * HALF + m * 16) * ldc + col0;
#pragma unroll
                for (int bj = 0; bj < 2; ++bj)
#pragma unroll
                    for (int n = 0; n < 2; ++n) { const f32x4 xv = *(const f32x4*)(X + off + bj * HALF + n * 16); *(f32x4*)(O + off + bj * HALF + n * 16) = acc[ai][bj][m][n] + xv; } }
    }
};

struct MoeOrder {
    const PG8_LAS int* tile_e; int T, nN, G, c; size_t expert_stride_bytes;
    const PG8_LAS int* tstart; const PG8_LAS int* cnt; const int* list; int ntok; bool gather;
    __device__ __forceinline__ bool next(int i, Unit& u) const {
        const int L = i * G + c; if (L >= T * nN) return false;
        u.pm = L / nN; u.pn = L % nN; return true;
    }
    __device__ __forceinline__ void a_ready(const Unit&) const {}
    __device__ __forceinline__ void done(const Unit&) const {}
    __device__ __forceinline__ const char* a_base(const Gemm& g, const Unit& u) const { return gather ? (const char*)g.A : (const char*)g.A + (size_t)u.pm * ((size_t)BM * g.K * 2); }
    __device__ __forceinline__ const char* b_base(const Gemm& g, const Unit& u) const { return (const char*)g.Bt + (size_t)tile_e[u.pm] * expert_stride_bytes + (size_t)u.pn * ((size_t)BM * g.K * 2); }
    __device__ __forceinline__ int src_row(const Unit& u, int row) const {
        const int e = tile_e[u.pm]; const int r = (u.pm - tstart[e]) * BM + row;
        return r < cnt[e] ? list[e * ntok + r] : 0;
    }
};
__device__ __forceinline__ float silu_f(float a) { return a * __builtin_amdgcn_rcpf(1.0f + __builtin_amdgcn_exp2f(-1.4426950408889634f * a)); }
struct EpiSwiGLU {
    static constexpr bool PERM = true, AFTER_DRAIN = false;
    bf16_t* H;
    __device__ __forceinline__ void operator()(const f32x4 (&acc)[2][2][4][2], const Unit& u, int wr, int wc, int fr, int fq) const {
        const int row0 = u.pm * BM + wr * 64 + fr, col0 = u.pn * 128 + wc * 32 + 8 * fq;
#pragma unroll
        for (int ai = 0; ai < 2; ++ai)
#pragma unroll
            for (int m = 0; m < 4; ++m) { bf16_t* p = H + (size_t)(row0 + ai * HALF + m * 16) * 512 + col0;
                const f32x4 a0 = acc[ai][0][m][0], a1 = acc[ai][0][m][1], b0 = acc[ai][1][m][0], b1 = acc[ai][1][m][1];
                u32x4 w; w.x = cvt_pk_bf16(silu_f(a0[0]) * b0[0], silu_f(a0[1]) * b0[1]); w.y = cvt_pk_bf16(silu_f(a0[2]) * b0[2], silu_f(a0[3]) * b0[3]);
                w.z = cvt_pk_bf16(silu_f(a1[0]) * b1[0], silu_f(a1[1]) * b1[1]); w.w = cvt_pk_bf16(silu_f(a1[2]) * b1[2], silu_f(a1[3]) * b1[3]);
                *(u32x4*)p = w; }
    }
};
struct EpiRowScaleBf16 {
    static constexpr bool PERM = true, AFTER_DRAIN = false;
    bf16_t* O; int ldc; const float* lgate; const PG8_LAS int* tile_e; const PG8_LAS int* tstart; const PG8_LAS int* cnt; int ntok;
    __device__ __forceinline__ void operator()(const f32x4 (&acc)[2][2][4][2], const Unit& u, int wr, int wc, int fr, int fq) const {
        const int rl0 = wr * 64 + fr, col0 = u.pn * BM + wc * 32 + 8 * fq;
        const int e = tile_e[u.pm]; const int rbase = (u.pm - tstart[e]) * BM; const int ce = cnt[e];
#pragma unroll
        for (int ai = 0; ai < 2; ++ai)
#pragma unroll
            for (int m = 0; m < 4; ++m) { const int rl = rl0 + ai * HALF + m * 16; const int r = rbase + rl; const float sc = r < ce ? lgate[e * ntok + r] : 0.f;
                bf16_t* rowp = O + (size_t)(u.pm * BM + rl) * ldc + col0;
#pragma unroll
                for (int bj = 0; bj < 2; ++bj) { const f32x4 v0 = acc[ai][bj][m][0] * sc, v1 = acc[ai][bj][m][1] * sc;
                    u32x4 w; w.x = cvt_pk_bf16(v0[0], v0[1]); w.y = cvt_pk_bf16(v0[2], v0[3]); w.z = cvt_pk_bf16(v1[0], v1[1]); w.w = cvt_pk_bf16(v1[2], v1[3]);
                    *(u32x4*)(rowp + bj * HALF) = w; } }
    }
};
template <class Epi, class Sched, bool ALIGN_EPI = false, bool SP2 = false, bool GATHER = false>
__device__ __forceinline__ void gemm_phase(PG8_LAS unsigned char* lds, const Gemm g, const Sched& S, const Epi& E) {
    const int tid = threadIdx.x, wid = __builtin_amdgcn_readfirstlane(tid >> 6), lane = tid & 63, wr = wid >> 2, wc = wid & 3, fr = lane & 15, fq = lane >> 4;
    const int K = g.K, nt = K / BK;
    unsigned voffA[2], voffB[2];
#pragma unroll
    for (int i = 0; i < 2; ++i) { int R, C; stage_rc(tid * 16 + i * 8192, R, C); const int Rb = Epi::PERM ? ((R & ~31) + perm32(R & 31)) : R;
        voffA[i] = (unsigned)(R * K + C) * 2u; voffB[i] = (unsigned)(Rb * K + C) * 2u; }
    unsigned voA[2][2], voAn[2][2];
    int gR[2], gC[2];
#pragma unroll
    for (int i = 0; i < 2; ++i) { int R, C; stage_rc(tid * 16 + i * 8192, R, C); gR[i] = R; gC[i] = C; }
#pragma unroll
    for (int h = 0; h < 2; ++h)
#pragma unroll
        for (int i = 0; i < 2; ++i) { voA[h][i] = voffA[i] + (unsigned)h * (unsigned)(HALF * K * 2); voAn[h][i] = voA[h][i]; }
    const size_t kstep = (size_t)(BK * 2);
    const size_t hstep = (size_t)HALF * K * 2;
    const size_t tstep = 2 * hstep; (void)tstep;
    const unsigned ldsw = (unsigned)wid * 1024u;
    const int aoff = lds_byte(wr * 64 + fr, fq * 8), boff = lds_byte(wc * 32 + fr, fq * 8);
#define PG8_SA(b, h) (((b) * 2 + (h)) * HTB)
#define PG8_SB(b, h) ((4 + (b) * 2 + (h)) * HTB)
#define PG8_STAGE(bufoff, gbase, voff) do { _Pragma("unroll") for (int _i = 0; _i < 2; ++_i) \
        __builtin_amdgcn_global_load_lds((const unsigned*)((const char*)(gbase) + (voff)[_i]), (PG8_LAS unsigned*)(lds + (bufoff) + ldsw + _i * 8192), 16, 0, 0); } while (0)
#define PG8_STAGE_A(bufoff, gbase, h, vo) do { _Pragma("unroll") for (int _i = 0; _i < 2; ++_i) \
        __builtin_amdgcn_global_load_lds((const unsigned*)((const char*)(gbase) + (vo)[h][_i]), (PG8_LAS unsigned*)(lds + (bufoff) + ldsw + _i * 8192), 16, 0, 0); } while (0)
#define PG8_GATHER_OFFS(dst, unit) do { _Pragma("unroll") for (int _h = 0; _h < 2; ++_h) _Pragma("unroll") for (int _i = 0; _i < 2; ++_i) \
        (dst)[_h][_i] = (unsigned)(S.src_row(unit, _h * HALF + gR[_i]) * K + gC[_i]) * 2u; } while (0)
#define PG8_LDA(dst, b, h) do { _Pragma("unroll") for (int m = 0; m < 4; ++m) _Pragma("unroll") for (int k = 0; k < 2; ++k) dst[m][k] = *(const PG8_LAS bf16x8*)(lds + PG8_SA(b, h) + aoff + m * 2048 + k * 1024); } while (0)
#define PG8_LDB(dst, b, h) do { _Pragma("unroll") for (int n = 0; n < 2; ++n) _Pragma("unroll") for (int k = 0; k < 2; ++k) dst[n][k] = *(const PG8_LAS bf16x8*)(lds + PG8_SB(b, h) + boff + n * 2048 + k * 1024); } while (0)
#define PG8_MMA(ai, bj, At, Bt) do { __builtin_amdgcn_s_setprio(1); _Pragma("unroll") for (int m = 0; m < 4; ++m) _Pragma("unroll") for (int n = 0; n < 2; ++n) _Pragma("unroll") for (int k = 0; k < 2; ++k) \
        acc[ai][bj][m][n] = __builtin_amdgcn_mfma_f32_16x16x32_bf16(Bt[n][k], At[m][k], acc[ai][bj][m][n], 0, 0, 0); __builtin_amdgcn_s_setprio(0); } while (0)
#define PG8_WAIT_V(n) asm volatile("s_waitcnt vmcnt(" #n ")" ::: "memory")
#define PG8_WAIT_L(n) asm volatile("s_waitcnt lgkmcnt(" #n ")" ::: "memory")
#define PG8_BAR __builtin_amdgcn_s_barrier()
#define PG8_SCHED __builtin_amdgcn_sched_barrier(0)
    Unit cur, nxt; int ui = 0;
    if (!S.next(0, cur)) return;
    f32x4 acc[2][2][4][2];
#pragma unroll
    for (int a = 0; a < 2; ++a)
#pragma unroll
        for (int b = 0; b < 2; ++b)
#pragma unroll
            for (int m = 0; m < 4; ++m)
#pragma unroll
                for (int n = 0; n < 2; ++n) acc[a][b][m][n] = (f32x4){0.f, 0.f, 0.f, 0.f};
    bf16x8 At[4][2], B0[2][2], B1[2][2];
    const char* cA = S.a_base(g, cur); const char* cB = S.b_base(g, cur);
    if constexpr (GATHER) { PG8_GATHER_OFFS(voA, cur); }
    S.a_ready(cur);
    if constexpr (SP2) {
        PG8_STAGE(PG8_SB(0, 0), cB, voffB); PG8_STAGE(PG8_SB(0, 1), cB + hstep, voffB); PG8_STAGE_A(PG8_SA(0, 0), cA, 0, voA); PG8_STAGE_A(PG8_SA(0, 1), cA, 1, voA);
        if (wr == 1) PG8_BAR;
        PG8_WAIT_V(2); PG8_BAR;
        PG8_STAGE(PG8_SB(1, 0), cB + kstep, voffB); PG8_STAGE_A(PG8_SA(1, 0), cA + kstep, 0, voA); PG8_STAGE(PG8_SB(1, 1), cB + hstep + kstep, voffB);
        PG8_WAIT_V(6); PG8_BAR;
    } else {
        PG8_STAGE(PG8_SB(0, 0), cB, voffB); PG8_STAGE_A(PG8_SA(0, 0), cA, 0, voA); PG8_STAGE(PG8_SB(0, 1), cB + hstep, voffB); PG8_STAGE_A(PG8_SA(0, 1), cA, 1, voA);
        if (wr == 1) PG8_BAR;
        PG8_WAIT_V(4); PG8_BAR;
        PG8_STAGE(PG8_SB(1, 0), cB + kstep, voffB); PG8_STAGE_A(PG8_SA(1, 0), cA + kstep, 0, voA); PG8_STAGE(PG8_SB(1, 1), cB + hstep + kstep, voffB);
        PG8_WAIT_V(6); PG8_BAR;
    }
    for (;;) {
        const bool has_next = S.next(ui + 1, nxt);
        const char* nA = has_next ? S.a_base(g, nxt) : cA; const char* nB = has_next ? S.b_base(g, nxt) : cB;
        if constexpr (GATHER) { if (has_next) { PG8_GATHER_OFFS(voAn, nxt); } else {
#pragma unroll
            for (int _h = 0; _h < 2; ++_h) { voAn[_h][0] = voA[_h][0]; voAn[_h][1] = voA[_h][1]; } } }
        for (int t = 0; t < nt; t += 2) {
            const bool last = (t == nt - 2);
            const char* a1 = cA + (size_t)(t + 1) * kstep;
            const char* a2 = last ? nA : cA + (size_t)(t + 2) * kstep; const char* b2 = last ? nB : cB + (size_t)(t + 2) * kstep;
            const char* a3 = a2 + kstep; const char* b3 = b2 + kstep;
            if (last && has_next) S.a_ready(nxt);
            if constexpr (SP2) {
            PG8_LDB(B0, 0, 0); PG8_LDB(B1, 0, 1); PG8_SCHED; PG8_LDA(At, 0, 0); PG8_STAGE_A(PG8_SA(1, 1), a1, 1, voA);
            PG8_WAIT_V(8); PG8_WAIT_L(0); PG8_BAR; PG8_MMA(0, 0, At, B0); PG8_MMA(0, 1, At, B1); PG8_BAR; PG8_SCHED;
            PG8_LDA(At, 0, 1); PG8_STAGE(PG8_SB(0, 0), b2, voffB); PG8_STAGE(PG8_SB(0, 1), b2 + hstep, voffB); if (last) { PG8_STAGE_A(PG8_SA(0, 0), a2, 0, voAn); } else { PG8_STAGE_A(PG8_SA(0, 0), a2, 0, voA); }
            PG8_WAIT_V(8); PG8_WAIT_L(0); PG8_BAR; PG8_MMA(1, 0, At, B0); PG8_MMA(1, 1, At, B1); PG8_BAR; PG8_SCHED;
            PG8_LDB(B0, 1, 0); PG8_LDB(B1, 1, 1); PG8_SCHED; PG8_LDA(At, 1, 0); if (last) { PG8_STAGE_A(PG8_SA(0, 1), a2, 1, voAn); } else { PG8_STAGE_A(PG8_SA(0, 1), a2, 1, voA); }
            PG8_WAIT_V(8); PG8_WAIT_L(0); PG8_BAR; PG8_MMA(0, 0, At, B0); PG8_MMA(0, 1, At, B1); PG8_BAR; PG8_SCHED;
            PG8_LDA(At, 1, 1); PG8_STAGE(PG8_SB(1, 0), b3, voffB); PG8_STAGE(PG8_SB(1, 1), b3 + hstep, voffB); if (last) { PG8_STAGE_A(PG8_SA(1, 0), a3, 0, voAn); } else { PG8_STAGE_A(PG8_SA(1, 0), a3, 0, voA); }
            PG8_WAIT_V(8); PG8_WAIT_L(0); PG8_BAR; PG8_MMA(1, 0, At, B0); PG8_MMA(1, 1, At, B1); PG8_BAR; PG8_SCHED;
            } else {
            PG8_LDB(B0, 0, 0); PG8_SCHED; PG8_LDA(At, 0, 0); PG8_STAGE(PG8_SA(1, 1), a1 + hstep, voffA);
            PG8_WAIT_L(8); PG8_BAR; PG8_WAIT_L(0); PG8_MMA(0, 0, At, B0); PG8_BAR; PG8_SCHED;
            PG8_LDB(B1, 0, 1); PG8_STAGE(PG8_SB(0, 0), b2, voffB);
            PG8_BAR; PG8_WAIT_L(0); PG8_MMA(0, 1, At, B1); PG8_BAR;
            PG8_LDA(At, 0, 1); PG8_STAGE(PG8_SA(0, 0), a2, voffA);
            PG8_BAR; PG8_WAIT_L(0); PG8_MMA(1, 0, At, B0); PG8_BAR; PG8_SCHED;
            PG8_STAGE(PG8_SB(0, 1), b2 + hstep, voffB);
            PG8_WAIT_V(6); PG8_BAR; PG8_MMA(1, 1, At, B1); PG8_BAR;
            PG8_LDB(B0, 1, 0); PG8_SCHED; PG8_LDA(At, 1, 0); PG8_STAGE(PG8_SA(0, 1), a2 + hstep, voffA);
            PG8_WAIT_L(8); PG8_BAR; PG8_WAIT_L(0); PG8_MMA(0, 0, At, B0); PG8_BAR; PG8_SCHED;
            PG8_LDB(B1, 1, 1); PG8_STAGE(PG8_SB(1, 0), b3, voffB);
            PG8_BAR; PG8_WAIT_L(0); PG8_MMA(0, 1, At, B1); PG8_BAR;
            PG8_LDA(At, 1, 1); PG8_STAGE(PG8_SA(1, 0), a3, voffA);
            PG8_BAR; PG8_WAIT_L(0); PG8_MMA(1, 0, At, B0); PG8_BAR; PG8_SCHED;
            PG8_STAGE(PG8_SB(1, 1), b3 + hstep, voffB);
            PG8_WAIT_V(6); PG8_BAR; PG8_MMA(1, 1, At, B1); PG8_BAR;
            }
        }
        if constexpr (ALIGN_EPI) { if (wr == 0) PG8_BAR; }
        if constexpr (!Epi::AFTER_DRAIN) { E(acc, cur, wr, wc, fr, fq); S.done(cur); }
        if (!has_next) break;
#pragma unroll
        for (int a = 0; a < 2; ++a)
#pragma unroll
            for (int b = 0; b < 2; ++b)
#pragma unroll
                for (int m = 0; m < 4; ++m)
#pragma unroll
                    for (int n = 0; n < 2; ++n) acc[a][b][m][n] = (f32x4){0.f, 0.f, 0.f, 0.f};
        cur = nxt; cA = nA; cB = nB; ++ui;
        if constexpr (GATHER) {
#pragma unroll
            for (int _h = 0; _h < 2; ++_h) { voA[_h][0] = voAn[_h][0]; voA[_h][1] = voAn[_h][1]; } }
        if constexpr (ALIGN_EPI) { if (wr == 1) PG8_BAR; }
    }
    PG8_WAIT_V(0);
    if constexpr (!ALIGN_EPI) { if (wr == 0) PG8_BAR; }
    PG8_BAR;
    if constexpr (Epi::AFTER_DRAIN) { E.fused(acc, cur, wr, wc, fr, fq, lds, wid, lane); S.done(cur); }
#undef PG8_SA
#undef PG8_SB
#undef PG8_STAGE
#undef PG8_STAGE_A
#undef PG8_GATHER_OFFS
#undef PG8_LDA
#undef PG8_LDB
#undef PG8_MMA
#undef PG8_WAIT_V
#undef PG8_WAIT_L
#undef PG8_BAR
#undef PG8_SCHED
}
}
#define LAS __attribute__((address_space(3)))
#define XB_TMO      128
#define XB_XCNT(j)  (256  + 64 * (j))
#define XB_XSUB(j)  (1280 + 64 * (j))
#define XB_XGEN(j)  (2304 + 64 * (j))
#define XB_TOP      3328
#define XB_TOPGEN   3392
#define XCD_BAR_WORDS 3456
#define XB_SPIN_CAP (1u << 18)

__device__ __forceinline__ unsigned xb_ld(unsigned* p)              { return __hip_atomic_load(p, __ATOMIC_RELAXED, __HIP_MEMORY_SCOPE_AGENT); }
__device__ __forceinline__ unsigned xb_add(unsigned* p, unsigned v) { return __hip_atomic_fetch_add(p, v, __ATOMIC_RELAXED, __HIP_MEMORY_SCOPE_AGENT); }
__device__ __forceinline__ unsigned xb_xcc_id() { return (unsigned)__builtin_amdgcn_s_getreg((3 << 11) | 20) & 0xFu; }
#define XB_SPIN(cond, bar) do { unsigned _sp = 0; while (cond) { __builtin_amdgcn_s_sleep(1); \
    if ((++_sp & 255u) == 0u) { if (xb_ld(&(bar)[XB_TMO])) break; if (_sp > XB_SPIN_CAP) { atomicAdd(&(bar)[XB_TMO], 1u); break; } } } } while (0)

struct XcdBarrier {
    unsigned* bar; unsigned x;
    volatile LAS unsigned* st;
};

__device__ __forceinline__ XcdBarrier xcd_barrier_post(unsigned* bar, volatile LAS unsigned* st) {
    XcdBarrier b; b.bar = bar; b.x = xb_xcc_id(); b.st = st;
    if (threadIdx.x == 0) (void)xb_add(&bar[XB_XCNT(b.x)], 1u);
    return b;
}
__device__ __forceinline__ void xcd_barrier_complete(unsigned* bar, unsigned x, unsigned& nloc, unsigned& nx) {
    const unsigned G = gridDim.x * gridDim.y * gridDim.z;
    unsigned sum, cnt, mine, sp = 0u;
    for (;;) {
        sum = 0u; cnt = 0u; mine = 0u;
#pragma unroll
        for (unsigned j = 0; j < 16; ++j) { const unsigned c = xb_ld(&bar[XB_XCNT(j)]); sum += c; cnt += (c > 0u) ? 1u : 0u; mine = (j == x) ? c : mine; }
        if (sum == G) break;
        __builtin_amdgcn_s_sleep(1);
        if ((++sp & 255u) == 0u) { if (xb_ld(&bar[XB_TMO])) break; if (sp > XB_SPIN_CAP) { atomicAdd(&bar[XB_TMO], 1u); break; } }
    }
    nloc = mine > 0u ? mine : 1u; nx = cnt > 0u ? cnt : 1u;
}

__device__ __forceinline__ void xcd_barrier(const XcdBarrier& b) {
    asm volatile("s_waitcnt vmcnt(0)" ::: "memory");
    __syncthreads();
    if (threadIdx.x == 0) {
        unsigned* bar = b.bar;
        __builtin_amdgcn_s_waitcnt(0);
        unsigned nloc = b.st[0], nx = b.st[1];
        if (nloc == 0u) { xcd_barrier_complete(bar, b.x, nloc, nx); b.st[0] = nloc; b.st[1] = nx; }
        const unsigned old = xb_add(&bar[XB_XSUB(b.x)], 1u);
        const unsigned gen = old / nloc;
        if (old + 1u == (gen + 1u) * nloc) {
            __builtin_amdgcn_fence(__ATOMIC_RELEASE, "agent");
            asm volatile("s_waitcnt vmcnt(0)" ::: "memory");
            const unsigned og = xb_add(&bar[XB_TOP], 1u);
            const unsigned tg = og / nx;
            if (og + 1u == (tg + 1u) * nx) xb_add(&bar[XB_TOPGEN], 1u);
            else XB_SPIN(xb_ld(&bar[XB_TOPGEN]) == tg, bar);
            __builtin_amdgcn_fence(__ATOMIC_ACQUIRE, "agent");
            xb_add(&bar[XB_XGEN(b.x)], 1u);
            asm volatile("s_waitcnt vmcnt(0)" ::: "memory");
        } else {
            XB_SPIN(xb_ld(&bar[XB_XGEN(b.x)]) == gen, bar);
            __builtin_amdgcn_fence(__ATOMIC_ACQUIRE, "agent");
            asm volatile("s_waitcnt vmcnt(0)" ::: "memory");
        }
    }
    __syncthreads();
}

#define GAS __attribute__((address_space(1)))
typedef unsigned v4u __attribute__((ext_vector_type(4)));
#define LDS_WAIT() asm volatile("s_waitcnt lgkmcnt(0)" ::: "memory")
constexpr int NWAVES = 8;
constexpr int RING_BYTES = 139264, LDSCTL_OFF = RING_BYTES, MISC_OFF = LDSCTL_OFF + 320, LDS_BYTES = 155648;
constexpr size_t CTL_ZERO_BYTES = 1 * MiB;
constexpr int CW_BAR = 4096;
constexpr int MAX_LAUNCHES = 12;
static_assert((CW_BAR + MAX_LAUNCHES * XCD_BAR_WORDS) * 4 <= (int)CTL_ZERO_BYTES, "ctl");

constexpr size_t WS_WINT = 1 * MiB, WS_WOUTT = 6 * MiB, WS_W13T = 8 * MiB, WS_W2T = 72 * MiB;
constexpr size_t WS_HN1 = 104 * MiB, WS_LRU = 168 * MiB, WS_HYUT = 232 * MiB, WS_HF = 396 * MiB, WS_HB = 428 * MiB;
constexpr size_t WS_YHYT = 104 * MiB, WS_YCAT = 232 * MiB, WS_HN2 = 168 * MiB, WS_EID = 460 * MiB, WS_GATE = 461 * MiB;
constexpr size_t WS_LIST = 460 * MiB, WS_LGATE = 464 * MiB, WS_TOKINFO = 468 * MiB, WS_WRT = 469 * MiB, WS_SGATE = 470 * MiB;
constexpr size_t WS_XS = 232 * MiB, WS_H = 376 * MiB, WS_Y = 104 * MiB;
constexpr size_t WS_XC = 104 * MiB, WS_Z2 = 392 * MiB, WS_KT = 328 * MiB;
constexpr int CW_CNT = 2048;
constexpr int LC_CNT = RING_BYTES + 1024, LC_BASE = RING_BYTES + 1152, LC_TSTART = RING_BYTES + 1280, LC_TILEE = RING_BYTES + 2048;

struct Args { const float* in[37]; float* out; unsigned char* ws; int ph_lo, ph_hi, li, pad; };

__device__ __forceinline__ unsigned pk2(float lo, float hi) { return (unsigned)f2bf(lo) | ((unsigned)f2bf(hi) << 16); }

__device__ __forceinline__ void p0_transpose_item(const float* __restrict__ W, int K, int N, bf16* __restrict__ WT, int drow0, LAS float* scr, int k0, int n0, int lane) {
#pragma unroll 8
    for (int i = 0; i < 32; ++i) { const int kk = 2 * i + (lane >> 5); scr[kk * 33 + (lane & 31)] = W[(size_t)(k0 + kk) * N + n0 + (lane & 31)]; }
    LDS_WAIT(); asm volatile("" ::: "memory");
    const int c = lane & 7;
#pragma unroll
    for (int j = 0; j < 4; ++j) { const int n = (lane >> 3) + 8 * j; const LAS float* s = scr + (8 * c) * 33 + n;
        v4u o; o.x = pk2(s[0 * 33], s[1 * 33]); o.y = pk2(s[2 * 33], s[3 * 33]); o.z = pk2(s[4 * 33], s[5 * 33]); o.w = pk2(s[6 * 33], s[7 * 33]);
        *(v4u*)(WT + (size_t)(drow0 + n) * K + k0 + 8 * c) = o; }
    LDS_WAIT(); asm volatile("" ::: "memory");
}
__device__ __forceinline__ void rms_row_to_bf16(const float* __restrict__ xrow, const float* __restrict__ g, bf16* __restrict__ orow, int lane) {
    const float4* xr = (const float4*)xrow;
    float4 v[4]; float s = 0.f;
#pragma unroll
    for (int j = 0; j < 4; ++j) { v[j] = xr[lane + 64 * j]; s += (v[j].x * v[j].x + v[j].y * v[j].y) + (v[j].z * v[j].z + v[j].w * v[j].w); }
    s = wave_sum(s);
    const float rstd = rsqrtf(s * (1.0f / DM) + EPS);
#pragma unroll
    for (int j = 0; j < 4; ++j) { const int c = (lane + 64 * j) * 4; const float4 gg = *(const float4*)(g + c);
        uint2 o; o.x = pk2(v[j].x * rstd * gg.x, v[j].y * rstd * gg.y); o.y = pk2(v[j].z * rstd * gg.z, v[j].w * rstd * gg.w);
        *(uint2*)(orow + c) = o; }
}


typedef short bf16x8_t __attribute__((ext_vector_type(8)));
typedef float f32x4_t __attribute__((ext_vector_type(4)));
__device__ __forceinline__ int moe_tables(LAS unsigned char* L, unsigned* ctl, int tid) {
    LAS int* cnt = (LAS int*)(L + LC_CNT); LAS int* tstart = (LAS int*)(L + LC_TSTART); LAS int* tile_e = (LAS int*)(L + LC_TILEE);
    __syncthreads();
    if (tid < 32) cnt[tid] = (int)__hip_atomic_load(ctl + CW_CNT + tid, __ATOMIC_RELAXED, __HIP_MEMORY_SCOPE_AGENT);
    __syncthreads();
    if (tid == 0) { int ts = 0; for (int e = 0; e < 32; ++e) { tstart[e] = ts; const int nt = (cnt[e] + 255) >> 8; for (int i = 0; i < nt; ++i) tile_e[ts + i] = e; ts += nt; } tstart[32] = ts; }
    __syncthreads();
    return tstart[32];
}

__device__ __forceinline__ void lru_load_frags(const bf16* xrow0, int sg0, int jl, int dir, v4u (&fr)[4][2]) {
#pragma unroll
    for (int mt = 0; mt < 4; ++mt) { const int sg = 16 * (jl >> 2) + 4 * mt + (jl & 3); const int tau = sg0 + sg; const int t = dir ? (SEQ - 1 - tau) : tau;
#pragma unroll
        for (int s = 0; s < 2; ++s) fr[mt][s] = *(const v4u*)(xrow0 + (size_t)t * 64 + 32 * s); }
}
__device__ __forceinline__ void lru_item(LAS unsigned char* L, const Args& a, int item, const bf16* __restrict__ xcb, bf16* __restrict__ hf, bf16* __restrict__ hb, int tid, int lane, int wave) {
    const int b = item >> 6, h = (item >> 3) & 7, q4 = (item >> 1) & 3, dir = item & 1;
    const float* wr = dir ? a.in[10] : a.in[5]; const float* br = dir ? a.in[11] : a.in[6]; const float* wi = dir ? a.in[12] : a.in[7];
    const float* bi = dir ? a.in[13] : a.in[8]; const float* lam = dir ? a.in[14] : a.in[9];
    bf16* outp = dir ? hb : hf;
    LAS float* carry = (LAS float*)(L + 2048);
    const int jl = lane & 15, kg = lane >> 4;
    const int c = 64 * h + 16 * q4 + jl;
    bf16x8_t Br[2], Bi[2], Bid;
#pragma unroll
    for (int s = 0; s < 2; ++s)
#pragma unroll
        for (int j = 0; j < 8; ++j) { const int i = 32 * s + 8 * kg + j;
            Br[s][j] = (short)f2bf(wr[h * 4096 + i * 64 + 16 * q4 + jl]); Bi[s][j] = (short)f2bf(wi[h * 4096 + i * 64 + 16 * q4 + jl]); }
#pragma unroll
    for (int j = 0; j < 8; ++j) Bid[j] = (8 * kg + j == 16 * (q4 & 1) + jl) ? (short)0x3f80 : (short)0;
    const int sid = q4 >> 1;
    const float brc = br[c], bic = bi[c];
    const float sp8l = 8.0f * log1pf(expf(-lam[c])) * 1.4426950408889634f;
    __syncthreads();
    float Hblk = 0.f;
    const bf16* xrow0 = xcb + ((size_t)(b * 8 + h) * SEQ) * 64 + 8 * kg;
    v4u frn[4][2];
    lru_load_frags(xrow0, 64 * wave, jl, dir, frn);
    for (int it = 0; it < 16; ++it) {
        const int sg0 = 512 * it + 64 * wave;
        bf16x8_t Af[4][2];
#pragma unroll
        for (int mt = 0; mt < 4; ++mt)
#pragma unroll
            for (int s = 0; s < 2; ++s) Af[mt][s] = __builtin_bit_cast(bf16x8_t, frn[mt][s]);
        if (it < 15) lru_load_frags(xrow0, sg0 + 512, jl, dir, frn);
        float hloc[16], Ploc[16];
        float hl = 0.f, P = 1.f;
#pragma unroll
        for (int mt = 0; mt < 4; ++mt) {
            f32x4_t aR = {0.f, 0.f, 0.f, 0.f}, aI = aR, aX = aR;
            aR = __builtin_amdgcn_mfma_f32_16x16x32_bf16(Af[mt][0], Br[0], aR, 0, 0, 0); aR = __builtin_amdgcn_mfma_f32_16x16x32_bf16(Af[mt][1], Br[1], aR, 0, 0, 0);
            aI = __builtin_amdgcn_mfma_f32_16x16x32_bf16(Af[mt][0], Bi[0], aI, 0, 0, 0); aI = __builtin_amdgcn_mfma_f32_16x16x32_bf16(Af[mt][1], Bi[1], aI, 0, 0, 0);
            aX = __builtin_amdgcn_mfma_f32_16x16x32_bf16(sid ? Af[mt][1] : Af[mt][0], Bid, aX, 0, 0, 0);
#pragma unroll
            for (int r = 0; r < 4; ++r) {
                const float rg = __builtin_amdgcn_rcpf(1.0f + __builtin_amdgcn_exp2f(-1.4426950408889634f * (aR[r] + brc)));
                const float ig = __builtin_amdgcn_rcpf(1.0f + __builtin_amdgcn_exp2f(-1.4426950408889634f * (aI[r] + bic)));
                const float av = __builtin_amdgcn_exp2f(-rg * sp8l);
                const float bb = __builtin_amdgcn_sqrtf(fmaxf(1.0f - av * av, 0.f)) * (ig * aX[r]);
                hl = av * hl + bb; P *= av;
                hloc[4 * mt + r] = hl; Ploc[4 * mt + r] = P;
            }
        }
        const float A0 = __shfl(P, jl), B0 = __shfl(hl, jl), A1 = __shfl(P, jl + 16), B1 = __shfl(hl, jl + 16);
        const float A2 = __shfl(P, jl + 32), B2 = __shfl(hl, jl + 32), A3 = __shfl(P, jl + 48), B3 = __shfl(hl, jl + 48);
        LAS float* cbuf = carry + (it & 1) * 256;
        if (kg == 0) { cbuf[(wave * 16 + jl) * 2 + 0] = A0 * A1 * A2 * A3; cbuf[(wave * 16 + jl) * 2 + 1] = ((B0 * A1 + B1) * A2 + B2) * A3 + B3; }
        __syncthreads();
        float Hw = Hblk, Hn = Hblk;
#pragma unroll
        for (int w2 = 0; w2 < 8; ++w2) { const float Aq = cbuf[(w2 * 16 + jl) * 2 + 0], Bq = cbuf[(w2 * 16 + jl) * 2 + 1];
            if (w2 < wave) Hw = Aq * Hw + Bq;
            Hn = Aq * Hn + Bq; }
        Hblk = Hn;
        float Hin = Hw;
        if (kg >= 1) Hin = A0 * Hin + B0;
        if (kg >= 2) Hin = A1 * Hin + B1;
        if (kg >= 3) Hin = A2 * Hin + B2;
#pragma unroll
        for (int k = 0; k < 16; ++k) { const int tau = sg0 + 16 * kg + k; const int t = dir ? (SEQ - 1 - tau) : tau;
            outp[((size_t)b * SEQ + t) * DL + c] = f2bf(hloc[k] + Ploc[k] * Hin); }
    }
}

typedef float f32x2_t __attribute__((ext_vector_type(2)));
typedef _Float16 f16x2_t __attribute__((ext_vector_type(2)));
constexpr int LC_TW = RING_BYTES + 4096, LC_TA = RING_BYTES + 8192, LC_TB = RING_BYTES + 9216, LC_RED = RING_BYTES + 3328;
constexpr size_t WS_SPEC = 328 * MiB, WS_HT = 396 * MiB, WS_XCB = 136 * MiB;
__device__ __forceinline__ f32x2_t cmul(f32x2_t a, f32x2_t b) { f32x2_t r; r.x = a.x * b.x - a.y * b.y; r.y = a.x * b.y + a.y * b.x; return r; }
__device__ __forceinline__ f32x2_t h2_to_f2(unsigned u) { const f16x2_t h = __builtin_bit_cast(f16x2_t, u); f32x2_t k; k.x = (float)h.x; k.y = (float)h.y; return k; }
__device__ __forceinline__ f32x2_t cmulc(f32x2_t a, f32x2_t b) { f32x2_t r; r.x = a.x * b.x + a.y * b.y; r.y = a.y * b.x - a.x * b.y; return r; }
template <bool INV> __device__ __forceinline__ f32x2_t twc(f32x2_t d, int e) {
    constexpr float CT[16] = {1.000000000e+00f, 9.807852804e-01f, 9.238795325e-01f, 8.314696123e-01f, 7.071067812e-01f, 5.555702330e-01f, 3.826834324e-01f, 1.950903220e-01f, 6.123233996e-17f, -1.950903220e-01f, -3.826834324e-01f, -5.555702330e-01f, -7.071067812e-01f, -8.314696123e-01f, -9.238795325e-01f, -9.807852804e-01f};
    constexpr float ST[16] = {0.000000000e+00f, 1.950903220e-01f, 3.826834324e-01f, 5.555702330e-01f, 7.071067812e-01f, 8.314696123e-01f, 9.238795325e-01f, 9.807852804e-01f, 1.000000000e+00f, 9.807852804e-01f, 9.238795325e-01f, 8.314696123e-01f, 7.071067812e-01f, 5.555702330e-01f, 3.826834324e-01f, 1.950903220e-01f};
    f32x2_t r;
    if (e == 0) return d;
    if (e == 8) { if (INV) { r.x = -d.y; r.y = d.x; } else { r.x = d.y; r.y = -d.x; } return r; }
    const float c = CT[e], s = INV ? -ST[e] : ST[e];
    if (e == 4) { r.x = (d.x + (INV ? -d.y : d.y)) * c; r.y = (d.y - (INV ? -d.x : d.x)) * c; return r; }
    r.x = d.x * c + d.y * s; r.y = d.y * c - d.x * s; return r;
}
template <int R, bool INV> struct DFT {
    static __device__ __forceinline__ void run(f32x2_t (&x)[R]) {
        f32x2_t u[R / 2], v[R / 2];
#pragma unroll
        for (int k = 0; k < R / 2; ++k) { const f32x2_t p = x[k], q = x[k + R / 2]; u[k] = p + q; v[k] = twc<INV>(p - q, k * (32 / R)); }
        DFT<R / 2, INV>::run(u); DFT<R / 2, INV>::run(v);
#pragma unroll
        for (int q = 0; q < R / 2; ++q) { x[2 * q] = u[q]; x[2 * q + 1] = v[q]; }
    }
};
template <bool INV> struct DFT<1, INV> { static __device__ __forceinline__ void run(f32x2_t (&)[1]) {} };

typedef f16x2_t c16;
__device__ __forceinline__ c16 c16_from(f32x2_t v) { c16 r; r.x = (_Float16)v.x; r.y = (_Float16)v.y; return r; }
__device__ __forceinline__ c16 cmul16(c16 a, c16 w) { c16 wx; wx.x = w.x; wx.y = w.x; c16 wy; wy.x = w.y; wy.y = w.y; c16 at; at.x = -a.y; at.y = a.x; return a * wx + at * wy; }
__device__ __forceinline__ c16 cmulc16(c16 a, c16 w) { c16 wx; wx.x = w.x; wx.y = w.x; c16 wy; wy.x = w.y; wy.y = w.y; c16 at; at.x = a.y; at.y = -a.x; return a * wx + at * wy; }
template <bool INV> __device__ __forceinline__ c16 twc(c16 d, int e) {
    constexpr float CT[16] = {1.000000000e+00f, 9.807852804e-01f, 9.238795325e-01f, 8.314696123e-01f, 7.071067812e-01f, 5.555702330e-01f, 3.826834324e-01f, 1.950903220e-01f, 6.123233996e-17f, -1.950903220e-01f, -3.826834324e-01f, -5.555702330e-01f, -7.071067812e-01f, -8.314696123e-01f, -9.238795325e-01f, -9.807852804e-01f};
    constexpr float ST[16] = {0.000000000e+00f, 1.950903220e-01f, 3.826834324e-01f, 5.555702330e-01f, 7.071067812e-01f, 8.314696123e-01f, 9.238795325e-01f, 9.807852804e-01f, 1.000000000e+00f, 9.807852804e-01f, 9.238795325e-01f, 8.314696123e-01f, 7.071067812e-01f, 5.555702330e-01f, 3.826834324e-01f, 1.950903220e-01f};
    c16 r;
    if (e == 0) return d;
    if (e == 8) { if (INV) { r.x = -d.y; r.y = d.x; } else { r.x = d.y; r.y = -d.x; } return r; }
    const _Float16 c = (_Float16)CT[e], s = (_Float16)(INV ? -ST[e] : ST[e]);
    c16 cc; cc.x = c; cc.y = c; c16 ss; ss.x = s; ss.y = s; c16 dt; dt.x = d.y; dt.y = -d.x;
    return d * cc + dt * ss;
}
template <int R, bool INV> struct DFTH {
    static __device__ __forceinline__ void run(c16 (&x)[R]) {
        c16 u[R / 2], v[R / 2];
#pragma unroll
        for (int k = 0; k < R / 2; ++k) { const c16 p = x[k], q = x[k + R / 2]; u[k] = p + q; v[k] = twc<INV>(p - q, k * (32 / R)); }
        DFTH<R / 2, INV>::run(u); DFTH<R / 2, INV>::run(v);
#pragma unroll
        for (int q = 0; q < R / 2; ++q) { x[2 * q] = u[q]; x[2 * q + 1] = v[q]; }
    }
};
template <bool INV> struct DFTH<1, INV> { static __device__ __forceinline__ void run(c16 (&)[1]) {} };
template <bool CONJ> __device__ __forceinline__ void tw_apply16h(c16 (&x)[16], f32x2_t w1) {
    f32x2_t w = w1;
#pragma unroll
    for (int q = 1; q < 16; ++q) { const c16 wh = c16_from(w); x[q] = CONJ ? cmulc16(x[q], wh) : cmul16(x[q], wh); if (q < 15) w = cmul(w, w1); }
}
#define SWZ(p) ((p) + ((p) >> 5))
constexpr int FBUF = 8448;
template <bool CONJ> __device__ __forceinline__ void tw_apply16(f32x2_t (&x)[16], f32x2_t w1) {
    f32x2_t w = w1;
#pragma unroll
    for (int q = 1; q < 16; ++q) { x[q] = CONJ ? cmulc(x[q], w) : cmul(x[q], w); if (q < 15) w = cmul(w, w1); }
}
__device__ __forceinline__ void fft_tables_init(LAS unsigned char* L, int tid) {
    LAS f32x2_t* TW = (LAS f32x2_t*)(L + LC_TW); LAS f32x2_t* TA = (LAS f32x2_t*)(L + LC_TA); LAS f32x2_t* TB = (LAS f32x2_t*)(L + LC_TB);
    { float s, c; sincospif((float)tid * (1.0f / 4096.0f), &s, &c); f32x2_t w; w.x = c; w.y = -s; TW[tid] = w; }
    if (tid < 128) { float s, c; sincospif((float)tid * (1.0f / 128.0f), &s, &c); f32x2_t w; w.x = c; w.y = -s; TA[tid] = w; }
    if (tid < 64) { float s, c; sincospif((float)tid * (1.0f / 8192.0f), &s, &c); f32x2_t w; w.x = c; w.y = -s; TB[tid] = w; }
    __syncthreads();
}
#define OPAQUE(v) asm volatile("" : "+v"(v))
__device__ __forceinline__ void fwd_pass1(LAS f32x2_t* buf, const LAS f32x2_t* TW, int tid) {
    OPAQUE(tid);
    LAS f32x2_t* b0 = buf + tid + (tid >> 5);
    f32x2_t x[16];
#pragma unroll
    for (int m = 0; m < 16; ++m) x[m] = b0[528 * m];
    DFT<16, false>::run(x); tw_apply16<false>(x, TW[tid]);
#pragma unroll
    for (int q = 0; q < 16; ++q) b0[528 * q] = x[q];
}
__device__ __forceinline__ void fwd_pass2(LAS f32x2_t* buf, const LAS f32x2_t* TW, int tid) {
    OPAQUE(tid);
    LAS f32x2_t* b0 = buf + (tid >> 5) * 528 + (tid & 31);
    f32x2_t x[16];
#pragma unroll
    for (int m = 0; m < 16; ++m) x[m] = b0[33 * m];
    DFT<16, false>::run(x); tw_apply16<false>(x, TW[16 * (tid & 31)]);
#pragma unroll
    for (int q = 0; q < 16; ++q) b0[33 * q] = x[q];
}
__device__ __forceinline__ void inv_pass2(LAS f32x2_t* buf, const LAS f32x2_t* TW, int tid) {
    OPAQUE(tid);
    LAS f32x2_t* b0 = buf + (tid >> 5) * 528 + (tid & 31);
    f32x2_t x[16];
#pragma unroll
    for (int q = 0; q < 16; ++q) x[q] = b0[33 * q];
    tw_apply16<true>(x, TW[16 * (tid & 31)]); DFT<16, true>::run(x);
#pragma unroll
    for (int m = 0; m < 16; ++m) b0[33 * m] = x[m];
}
__device__ __forceinline__ void inv_pass1(LAS f32x2_t* buf, const LAS f32x2_t* TW, int tid) {
    OPAQUE(tid);
    LAS f32x2_t* b0 = buf + tid + (tid >> 5);
    f32x2_t x[16];
#pragma unroll
    for (int q = 0; q < 16; ++q) x[q] = b0[528 * q];
    tw_apply16<true>(x, TW[tid]); DFT<16, true>::run(x);
#pragma unroll
    for (int m = 0; m < 16; ++m) b0[528 * m] = x[m];
}
__device__ __forceinline__ void fft2_forward(LAS unsigned char* L) {
    const int tid = threadIdx.x;
    LAS f32x2_t* bufE = (LAS f32x2_t*)L; LAS f32x2_t* bufO = bufE + FBUF; const LAS f32x2_t* TW = (const LAS f32x2_t*)(L + LC_TW);
    fwd_pass1(bufE, TW, tid); fwd_pass1(bufO, TW, tid);
    __syncthreads();
    fwd_pass2(bufE, TW, tid); fwd_pass2(bufO, TW, tid);
    __syncthreads();
}
template <int MODE>
__device__ __forceinline__ void fft2_middle(LAS unsigned char* L, unsigned* specblk) {
    int tid = threadIdx.x; OPAQUE(tid); const int bsel = tid >> 8, blk = tid & 255;
    LAS f32x2_t* buf = (LAS f32x2_t*)L + (bsel ? FBUF : 0);
    f32x2_t x[32];
    LAS f32x2_t* bm = buf + 33 * blk;
#pragma unroll
    for (int q = 0; q < 32; ++q) x[q] = bm[q];
    DFT<32, false>::run(x);
    unsigned* sp = specblk + (size_t)bsel * 8192 + 32 * blk;
    if (MODE == 0) {
#pragma unroll
        for (int q = 0; q < 32; q += 4) { v4u w;
            { f16x2_t h; h.x = (_Float16)(16.0f * x[q].x); h.y = (_Float16)(16.0f * x[q].y); w.x = __builtin_bit_cast(unsigned, h); }
            { f16x2_t h; h.x = (_Float16)(16.0f * x[q + 1].x); h.y = (_Float16)(16.0f * x[q + 1].y); w.y = __builtin_bit_cast(unsigned, h); }
            { f16x2_t h; h.x = (_Float16)(16.0f * x[q + 2].x); h.y = (_Float16)(16.0f * x[q + 2].y); w.z = __builtin_bit_cast(unsigned, h); }
            { f16x2_t h; h.x = (_Float16)(16.0f * x[q + 3].x); h.y = (_Float16)(16.0f * x[q + 3].y); w.w = __builtin_bit_cast(unsigned, h); }
            *(v4u*)(sp + q) = w; }
    } else {
#pragma unroll
        for (int q = 0; q < 32; q += 4) { const v4u w = *(const v4u*)(sp + q);
            const unsigned w0 = w.x, w1 = w.y, w2 = w.z, w3 = w.w;
            x[q] = cmul(x[q], h2_to_f2(w0)); x[q + 1] = cmul(x[q + 1], h2_to_f2(w1)); x[q + 2] = cmul(x[q + 2], h2_to_f2(w2)); x[q + 3] = cmul(x[q + 3], h2_to_f2(w3)); }
        DFT<32, true>::run(x);
#pragma unroll
        for (int q = 0; q < 32; ++q) bm[q] = x[q];
    }
    __syncthreads();
}
__device__ __forceinline__ void fft2_inverse(LAS unsigned char* L) {
    const int tid = threadIdx.x;
    LAS f32x2_t* bufE = (LAS f32x2_t*)L; LAS f32x2_t* bufO = bufE + FBUF; const LAS f32x2_t* TW = (const LAS f32x2_t*)(L + LC_TW);
    inv_pass2(bufE, TW, tid); inv_pass2(bufO, TW, tid);
    __syncthreads();
    inv_pass1(bufE, TW, tid); inv_pass1(bufO, TW, tid);
}

__device__ __forceinline__ void fwd_pass1h(LAS c16* buf, const LAS f32x2_t* TW, int tid) {
    OPAQUE(tid);
    LAS c16* b0 = buf + tid + (tid >> 5);
    c16 x[16];
#pragma unroll
    for (int m = 0; m < 16; ++m) x[m] = b0[528 * m];
    DFTH<16, false>::run(x); tw_apply16h<false>(x, TW[tid]);
#pragma unroll
    for (int q = 0; q < 16; ++q) b0[528 * q] = x[q];
}
__device__ __forceinline__ void fwd_pass2h(LAS c16* buf, const LAS f32x2_t* TW, int tid) {
    OPAQUE(tid);
    LAS c16* b0 = buf + (tid >> 5) * 528 + (tid & 31);
    c16 x[16];
#pragma unroll
    for (int m = 0; m < 16; ++m) x[m] = b0[33 * m];
    DFTH<16, false>::run(x); tw_apply16h<false>(x, TW[16 * (tid & 31)]);
#pragma unroll
    for (int q = 0; q < 16; ++q) b0[33 * q] = x[q];
}
__device__ __forceinline__ void inv_pass2h(LAS c16* buf, const LAS f32x2_t* TW, int tid) {
    OPAQUE(tid);
    LAS c16* b0 = buf + (tid >> 5) * 528 + (tid & 31);
    c16 x[16];
#pragma unroll
    for (int q = 0; q < 16; ++q) x[q] = b0[33 * q];
    tw_apply16h<true>(x, TW[16 * (tid & 31)]); DFTH<16, true>::run(x);
    c16 sc; sc.x = (_Float16)0.0625f; sc.y = (_Float16)0.0625f;
#pragma unroll
    for (int m = 0; m < 16; ++m) b0[33 * m] = x[m] * sc;
}
__device__ __forceinline__ void inv_pass1h(LAS c16* buf, const LAS f32x2_t* TW, int tid) {
    OPAQUE(tid);
    LAS c16* b0 = buf + tid + (tid >> 5);
    c16 x[16];
#pragma unroll
    for (int q = 0; q < 16; ++q) x[q] = b0[528 * q];
    tw_apply16h<true>(x, TW[tid]); DFTH<16, true>::run(x);
#pragma unroll
    for (int m = 0; m < 16; ++m) b0[528 * m] = x[m];
}
__device__ __forceinline__ void fft2h_forward(LAS unsigned char* L) {
    const int tid = threadIdx.x;
    LAS c16* bufE = (LAS c16*)L; LAS c16* bufO = bufE + FBUF; const LAS f32x2_t* TW = (const LAS f32x2_t*)(L + LC_TW);
    fwd_pass1h(bufE, TW, tid); fwd_pass1h(bufO, TW, tid);
    __syncthreads();
    fwd_pass2h(bufE, TW, tid); fwd_pass2h(bufO, TW, tid);
    __syncthreads();
}
__device__ __forceinline__ void fft2h_middle(LAS unsigned char* L, const unsigned* specblk) {
    int tid = threadIdx.x; OPAQUE(tid); const int bsel = tid >> 8, blk = tid & 255;
    LAS c16* bm = (LAS c16*)L + (bsel ? FBUF : 0) + 33 * blk;
    c16 x[32];
#pragma unroll
    for (int q = 0; q < 32; ++q) x[q] = bm[q];
    DFTH<32, false>::run(x);
    const unsigned* sp = specblk + (size_t)bsel * 8192 + 32 * blk;
#pragma unroll
    for (int q = 0; q < 32; q += 4) { const v4u w = *(const v4u*)(sp + q);
        const unsigned w0 = w.x, w1 = w.y, w2 = w.z, w3 = w.w;
        x[q] = cmul16(x[q], __builtin_bit_cast(c16, w0)); x[q + 1] = cmul16(x[q + 1], __builtin_bit_cast(c16, w1));
        x[q + 2] = cmul16(x[q + 2], __builtin_bit_cast(c16, w2)); x[q + 3] = cmul16(x[q + 3], __builtin_bit_cast(c16, w3)); }
    DFTH<32, true>::run(x);
    c16 sc; sc.x = (_Float16)0.0625f; sc.y = (_Float16)0.0625f;
#pragma unroll
    for (int q = 0; q < 32; ++q) bm[q] = x[q] * sc;
    __syncthreads();
}

__device__ __forceinline__ void fft2h_middle_store(LAS unsigned char* L, unsigned* specblk) {
    int tid = threadIdx.x; OPAQUE(tid); const int bsel = tid >> 8, blk = tid & 255;
    LAS c16* bm = (LAS c16*)L + (bsel ? FBUF : 0) + 33 * blk;
    c16 x[32];
#pragma unroll
    for (int q = 0; q < 32; ++q) x[q] = bm[q];
    DFTH<32, false>::run(x);
    c16 sc; sc.x = (_Float16)(1.0f / 256.0f); sc.y = (_Float16)(1.0f / 256.0f);
    unsigned* sp = specblk + (size_t)bsel * 8192 + 32 * blk;
#pragma unroll
    for (int q = 0; q < 32; q += 4) { v4u w;
        { const c16 h = x[q] * sc; w.x = __builtin_bit_cast(unsigned, h); } { const c16 h = x[q + 1] * sc; w.y = __builtin_bit_cast(unsigned, h); }
        { const c16 h = x[q + 2] * sc; w.z = __builtin_bit_cast(unsigned, h); } { const c16 h = x[q + 3] * sc; w.w = __builtin_bit_cast(unsigned, h); }
        *(v4u*)(sp + q) = w; }
    __syncthreads();
}
__device__ __forceinline__ void fft2h_inverse(LAS unsigned char* L) {
    const int tid = threadIdx.x;
    LAS c16* bufE = (LAS c16*)L; LAS c16* bufO = bufE + FBUF; const LAS f32x2_t* TW = (const LAS f32x2_t*)(L + LC_TW);
    inv_pass2h(bufE, TW, tid); inv_pass2h(bufO, TW, tid);
    __syncthreads();
    inv_pass1h(bufE, TW, tid); inv_pass1h(bufO, TW, tid);
}
__device__ __forceinline__ f32x2_t wn16384(const LAS f32x2_t* TA, f32x2_t wb, int tid, int m) { return cmul(TA[(tid >> 6) + 8 * m], wb); }
__device__ __forceinline__ float hy_conv3(const bf16* row, float w0, float w1, float w2, float bias, int n) {
    const int nm = n > 0 ? n - 1 : 0, np = n < SEQ - 1 ? n + 1 : SEQ - 1;
    const float wl = n > 0 ? w0 : 0.f, wr = n < SEQ - 1 ? w2 : 0.f;
    return bias + w1 * bf2f(row[n]) + wl * bf2f(row[nm]) + wr * bf2f(row[np]);
}

__device__ __forceinline__ void load_conv16(const bf16* row, int n0, float w0, float w1, float w2, float bias, float (&out)[16]) {
    const v4u a = *(const v4u*)(row + n0), b = *(const v4u*)(row + n0 + 8);
    const int nl = n0 > 0 ? n0 - 1 : 0, nr = n0 + 16 < SEQ ? n0 + 16 : SEQ - 1;
    const float ul = n0 > 0 ? bf2f(row[nl]) : 0.f, ur = n0 + 16 < SEQ ? bf2f(row[nr]) : 0.f;
    const unsigned a0 = a.x, a1 = a.y, a2 = a.z, a3 = a.w, b0 = b.x, b1 = b.y, b2 = b.z, b3 = b.w;
    float u[18];
    u[0] = ul; u[17] = ur;
    u[1] = __uint_as_float(a0 << 16); u[2] = __uint_as_float(a0 & 0xffff0000u); u[3] = __uint_as_float(a1 << 16); u[4] = __uint_as_float(a1 & 0xffff0000u);
    u[5] = __uint_as_float(a2 << 16); u[6] = __uint_as_float(a2 & 0xffff0000u); u[7] = __uint_as_float(a3 << 16); u[8] = __uint_as_float(a3 & 0xffff0000u);
    u[9] = __uint_as_float(b0 << 16); u[10] = __uint_as_float(b0 & 0xffff0000u); u[11] = __uint_as_float(b1 << 16); u[12] = __uint_as_float(b1 & 0xffff0000u);
    u[13] = __uint_as_float(b2 << 16); u[14] = __uint_as_float(b2 & 0xffff0000u); u[15] = __uint_as_float(b3 << 16); u[16] = __uint_as_float(b3 & 0xffff0000u);
#pragma unroll
    for (int i = 0; i < 16; ++i) out[i] = bias + w0 * u[i] + w1 * u[i + 1] + w2 * u[i + 2];
}
__device__ __forceinline__ void load_f16x16(const _Float16* p, float (&out)[16]) {
    const v4u a = *(const v4u*)p, b = *(const v4u*)(p + 8);
    const unsigned w[8] = {a.x, a.y, a.z, a.w, b.x, b.y, b.z, b.w};
#pragma unroll
    for (int i = 0; i < 8; ++i) { const f32x2_t k = h2_to_f2(w[i]); out[2 * i] = k.x; out[2 * i + 1] = k.y; }
}
__device__ __forceinline__ void load_f32x16(const float* p, float (&out)[16]) {
#pragma unroll
    for (int i = 0; i < 4; ++i) { const float4 v = *(const float4*)(p + 4 * i); out[4 * i] = v.x; out[4 * i + 1] = v.y; out[4 * i + 2] = v.z; out[4 * i + 3] = v.w; }
}
__device__ __forceinline__ void filter_item(LAS unsigned char* L, const Args& a, int c, const _Float16* hT, unsigned* spec, int tid, int lane, int wave) {
    LAS f32x2_t* bufE = (LAS f32x2_t*)L; LAS f32x2_t* bufO = bufE + FBUF;
    const LAS f32x2_t* TA = (const LAS f32x2_t*)(L + LC_TA); const LAS f32x2_t* TB = (const LAS f32x2_t*)(L + LC_TB);
    LAS float* red = (LAS float*)(L + LC_RED); LAS float* sc = (LAS float*)L;
    const int n0 = 16 * tid;
#pragma unroll 1
    for (int o = 0; o < 2; ++o) {
        float hfv[16], hbv[16];
        load_f16x16(hT + (size_t)(o * 512 + c) * SEQ + n0, hfv);
        load_f16x16(hT + (size_t)(1024 + o * 512 + c) * SEQ + n0, hbv);
        float s = 0.f;
#pragma unroll
        for (int i = 0; i < 16; ++i) { s += fabsf(hfv[i]) + ((n0 + i) > 0 ? fabsf(hbv[i]) : 0.f); sc[n0 + i] = hbv[i]; }
        s = wave_sum(s);
        if (lane == 0) red[wave] = s;
        __syncthreads();
        float tot = 0.f;
#pragma unroll
        for (int i = 0; i < 8; ++i) tot += red[i];
        const float inv = 1.0f / (tot + EPS);
        float ev[16], dv[16];
#pragma unroll
        for (int i = 0; i < 16; ++i) { const int n = n0 + i; const float hbm = n > 0 ? sc[SEQ - n] : 0.f; ev[i] = (hfv[i] + hbm) * inv; dv[i] = (hfv[i] - hbm) * inv; }
        __syncthreads();
        const f32x2_t wa = TA[tid >> 2];
        { LAS c16* hE = (LAS c16*)L; LAS c16* hO = hE + FBUF; const int lb = 16 * tid + (tid >> 1);
#pragma unroll
          for (int i = 0; i < 16; ++i) { const f32x2_t wn = cmul(wa, TB[16 * (tid & 3) + i]);
              f32x2_t xe; xe.x = ev[i] * 4096.0f; xe.y = 0.f; f32x2_t xo; xo.x = dv[i] * 4096.0f * wn.x; xo.y = dv[i] * 4096.0f * wn.y;
              hE[lb + i] = c16_from(xe); hO[lb + i] = c16_from(xo); } }
        __syncthreads();
        fft2h_forward(L);
        fft2h_middle_store(L, spec + (size_t)(o * 512 + c) * 16384);
    }
}
template <int O>
__device__ __forceinline__ void hyena_pass(LAS unsigned char* L, const Args& a, int c, int bp, const bf16* hyuT, unsigned* spec, int tid, float (&xa)[16], float (&xb)[16]) {
    LAS c16* bufE = (LAS c16*)L; LAS c16* bufO = bufE + FBUF;
    const LAS f32x2_t* TA = (const LAS f32x2_t*)(L + LC_TA); const LAS f32x2_t* TB = (const LAS f32x2_t*)(L + LC_TB);
    const float* cw = a.in[15]; const float* cb = a.in[16];
    const int n0 = 16 * tid;
    const int lb = 16 * tid + (tid >> 1);
    {   const f32x2_t wa = TA[tid >> 2];
#pragma unroll
        for (int i = 0; i < 16; ++i) { f32x2_t x; x.x = xa[i] * 0.0625f; x.y = xb[i] * 0.0625f; bufE[lb + i] = c16_from(x); bufO[lb + i] = c16_from(cmul(x, cmul(wa, TB[16 * (tid & 3) + i]))); } }
    __syncthreads();
    fft2h_forward(L);
    fft2h_middle(L, spec + (size_t)(O * 512 + c) * 16384);
    fft2h_inverse(L);
    __syncthreads();
    const int grow = (O ? 1024 : 512) + c;
    const float w0 = cw[grow], w1 = cw[1536 + grow], w2 = cw[3072 + grow], bs = cb[grow];
    const float skip = a.in[24][O * 512 + c];
    const bf16* g0 = hyuT + (size_t)grow * NTOK + (size_t)(2 * bp) * SEQ; const bf16* g1 = g0 + SEQ;
    float ga[16], gb[16];
    load_conv16(g0, n0, w0, w1, w2, bs, ga); load_conv16(g1, n0, w0, w1, w2, bs, gb);
    const f32x2_t wa = TA[tid >> 2];
#pragma unroll
    for (int i = 0; i < 16; ++i) {
        const c16 he = bufE[lb + i], ho = bufO[lb + i]; f32x2_t fe; fe.x = (float)he.x; fe.y = (float)he.y; f32x2_t fo; fo.x = (float)ho.x; fo.y = (float)ho.y;
        const f32x2_t y = (fe + cmulc(fo, cmul(wa, TB[16 * (tid & 3) + i]))) * (1.0f / 64.0f);
        xa[i] = ga[i] * (y.x + skip * xa[i]); xb[i] = gb[i] * (y.y + skip * xb[i]); }
    __syncthreads();
}
__device__ __forceinline__ void hyena_item(LAS unsigned char* L, const Args& a, int c, int bp, const bf16* hyuT, unsigned* spec, bf16* y_hyT, int tid) {
    const float* cw = a.in[15]; const float* cb = a.in[16];
    const size_t seq0 = (size_t)c * NTOK + (size_t)(2 * bp) * SEQ;
    const int n0 = 16 * tid;
    float xa[16], xb[16];
    load_conv16(hyuT + seq0, n0, cw[c], cw[1536 + c], cw[3072 + c], cb[c], xa); load_conv16(hyuT + seq0 + SEQ, n0, cw[c], cw[1536 + c], cw[3072 + c], cb[c], xb);
    hyena_pass<0>(L, a, c, bp, hyuT, spec, tid, xa, xb);
    hyena_pass<1>(L, a, c, bp, hyuT, spec, tid, xa, xb);
    bf16* o0 = y_hyT + seq0; bf16* o1 = o0 + SEQ;
    v4u p0, p1, q0, q1;
    p0.x = pk2(xa[0], xa[1]); p0.y = pk2(xa[2], xa[3]); p0.z = pk2(xa[4], xa[5]); p0.w = pk2(xa[6], xa[7]); p1.x = pk2(xa[8], xa[9]); p1.y = pk2(xa[10], xa[11]); p1.z = pk2(xa[12], xa[13]); p1.w = pk2(xa[14], xa[15]);
    q0.x = pk2(xb[0], xb[1]); q0.y = pk2(xb[2], xb[3]); q0.z = pk2(xb[4], xb[5]); q0.w = pk2(xb[6], xb[7]); q1.x = pk2(xb[8], xb[9]); q1.y = pk2(xb[10], xb[11]); q1.z = pk2(xb[12], xb[13]); q1.w = pk2(xb[14], xb[15]);
    *(v4u*)(o0 + n0) = p0; *(v4u*)(o0 + n0 + 8) = p1; *(v4u*)(o1 + n0) = q0; *(v4u*)(o1 + n0 + 8) = q1;
}

__global__ void __launch_bounds__(NWAVES * 64, 2) fwd(Args a) {
    extern __shared__ __attribute__((aligned(16))) unsigned char lds_raw[];
    LAS unsigned char* L = (LAS unsigned char*)lds_raw;
    volatile LAS unsigned* MISC = (volatile LAS unsigned*)(L + MISC_OFF);
    const int tid = threadIdx.x, lane = tid & 63, wave = __builtin_amdgcn_readfirstlane(tid >> 6);
    const int G = gridDim.x, bid = blockIdx.x;
    unsigned char* ws = a.ws;
    unsigned* ctl = (unsigned*)ws;
    for (int u = tid; u < (LDS_BYTES - LDSCTL_OFF) / 4; u += NWAVES * 64) ((LAS unsigned*)(L + LDSCTL_OFF))[u] = 0u;
    __syncthreads();
    const int lo = a.ph_lo, hi = a.ph_hi;
    XcdBarrier bar; bar.bar = ctl + CW_BAR + a.li * XCD_BAR_WORDS; bar.x = 0; bar.st = nullptr;
    bar = xcd_barrier_post(ctl + CW_BAR + a.li * XCD_BAR_WORDS, MISC + 8);
#define IN(k) (lo <= (k) && (k) < hi)
#define BOTH(k) (IN(k) && IN((k) + 1))
#ifndef DUP_BAR
#define DUP_BAR 1
#endif
#define GRID_BAR() do { xcd_barrier(bar); if (DUP_BAR > 1) xcd_barrier(bar); } while (0)

    bf16* WinT = (bf16*)(ws + WS_WINT); bf16* WoutT = (bf16*)(ws + WS_WOUTT);
    bf16* hn1 = (bf16*)(ws + WS_HN1); bf16* lru = (bf16*)(ws + WS_LRU); bf16* hyuT = (bf16*)(ws + WS_HYUT);
    bf16* y_cat = (bf16*)(ws + WS_YCAT);
    bf16* W13T = (bf16*)(ws + WS_W13T); bf16* W2T = (bf16*)(ws + WS_W2T); bf16* WrT = (bf16*)(ws + WS_WRT);
    bf16* hn2 = (bf16*)(ws + WS_HN2); int* list = (int*)(ws + WS_LIST); float* lgate = (float*)(ws + WS_LGATE); int4* tokinfo = (int4*)(ws + WS_TOKINFO);
    bf16* xs = (bf16*)(ws + WS_XS); (void)xs; bf16* Hb = (bf16*)(ws + WS_H); bf16* Yb = (bf16*)(ws + WS_Y);
    const int gw = bid * NWAVES + wave, NGW = G * NWAVES;

    if (IN(0)) {
#ifndef DUP_P0
#define DUP_P0 1
#endif
        for (int rep0 = 0; rep0 < DUP_P0; ++rep0) {
        LAS float* scr = (LAS float*)(L + wave * 16384);
        constexpr int I_IN = (DM / 64) * (DIN / 32), I_OUT = (DM / 64) * (DM / 32), I_EXP = 768;
        for (int it = gw; it < I_IN + I_OUT + 32 * I_EXP; it += NGW) {
            if (it < I_IN) { const int nblk = DIN / 32, kb = it / nblk, nb = it % nblk; p0_transpose_item(a.in[2], DM, DIN, WinT, 32 * nb, scr, 64 * kb, 32 * nb, lane); }
            else if (it < I_IN + I_OUT) { const int r = it - I_IN; const int nblk = DM / 32, kb = r / nblk, nb = r % nblk; p0_transpose_item(a.in[27], DM, DM, WoutT, 32 * nb, scr, 64 * kb, 32 * nb, lane); }
            else { const int r = it - I_IN - I_OUT, e = r / I_EXP, q = r % I_EXP;
                if (q < 512) { const int w3 = q >> 8, qq = q & 255, kb = qq >> 4, nb = qq & 15, n0 = 32 * nb;
                    p0_transpose_item(a.in[w3 ? 34 : 33] + (size_t)e * 1024 * 512, 1024, 512, W13T, e * 1024 + (n0 >> 7) * 256 + (n0 & 127) + w3 * 128, scr, 64 * kb, n0, lane); }
                else { const int qq = q - 512, kb = qq >> 5, nb = qq & 31;
                    p0_transpose_item(a.in[35] + (size_t)e * 512 * 1024, 512, 1024, W2T, e * 1024 + 32 * nb, scr, 64 * kb, 32 * nb, lane); } }
        }
        for (int idx = bid * (NWAVES * 64) + tid; idx < 48 * 1024; idx += G * NWAVES * 64) { const int j = idx >> 10, k = idx & 1023;
            WrT[idx] = j < 4 ? f2bf(a.in[29][k * 4 + j]) : (j < 36 ? f2bf(a.in[31][k * 32 + (j - 4)]) : (bf16)0); }
        { _Float16* hT = (_Float16*)(ws + WS_HT);
          const float* w1 = a.in[17]; const float* b1 = a.in[18]; const float* f1 = a.in[19]; const float* w2 = a.in[20]; const float* b2 = a.in[21]; const float* f2 = a.in[22]; const float* w3 = a.in[23];
          LAS float* w3s = (LAS float*)L;
          LAS float* z2s = (LAS float*)(L + 65536);
          LAS float* fts = (LAS float*)(L + 73728);
          LAS float* ot  = (LAS float*)(L + 81920);
          for (int tile = bid; tile < SEQ / 32; tile += G) {
              __syncthreads();
              { const int tl = tid & 31, i = tid >> 5; const int t = tile * 32 + tl;
                const float wq = (6.283185307179586f / (float)SEQ) * (float)t; const float band = 1e-4f + (float)i * ((15.0f - 1e-4f) / 15.0f);
                fts[(1 + i) * 32 + tl] = cosf(wq * band); fts[(17 + i) * 32 + tl] = sinf(wq * band);
                if (i == 0) fts[tl] = (float)t / (float)(SEQ - 1); }
              __syncthreads();
              const int tl4 = tid & 31, jq = tid >> 5;
              { float s0 = b1[4 * jq], s1 = b1[4 * jq + 1], s2 = b1[4 * jq + 2], s3 = b1[4 * jq + 3];
#pragma unroll 3
                for (int i = 0; i < 33; ++i) { const float fv = fts[i * 32 + tl4]; const float4 wv = *(const float4*)(w1 + i * 64 + 4 * jq); s0 += fv * wv.x; s1 += fv * wv.y; s2 += fv * wv.z; s3 += fv * wv.w; }
                const float4 fq = *(const float4*)(f1 + 4 * jq);
                s0 = sinf(fq.x * s0); s1 = sinf(fq.y * s1); s2 = sinf(fq.z * s2); s3 = sinf(fq.w * s3);
                __syncthreads();
                fts[(4 * jq) * 32 + tl4] = s0; fts[(4 * jq + 1) * 32 + tl4] = s1; fts[(4 * jq + 2) * 32 + tl4] = s2; fts[(4 * jq + 3) * 32 + tl4] = s3; }
              __syncthreads();
              { float s0 = b2[4 * jq], s1 = b2[4 * jq + 1], s2 = b2[4 * jq + 2], s3 = b2[4 * jq + 3];
#pragma unroll 4
                for (int i = 0; i < 64; ++i) { const float zv = fts[i * 32 + tl4]; const float4 wv = *(const float4*)(w2 + i * 64 + 4 * jq); s0 += zv * wv.x; s1 += zv * wv.y; s2 += zv * wv.z; s3 += zv * wv.w; }
                const float4 fq = *(const float4*)(f2 + 4 * jq);
                z2s[(4 * jq) * 32 + tl4] = sinf(fq.x * s0); z2s[(4 * jq + 1) * 32 + tl4] = sinf(fq.y * s1); z2s[(4 * jq + 2) * 32 + tl4] = sinf(fq.z * s2); z2s[(4 * jq + 3) * 32 + tl4] = sinf(fq.w * s3); }
              __syncthreads();
              const float lo_ = logf(1e-2f) / 1.5f, hi_ = logf(1e-2f) / 0.3f;
              typedef float f32x16_t __attribute__((ext_vector_type(16)));
              bf16x8_t Az[4];
              { const int tr = lane & 31, kg2 = lane >> 5;
#pragma unroll
                for (int s = 0; s < 4; ++s) { v4u pk;
                    pk.x = pk2(z2s[(16 * s + 8 * kg2 + 0) * 32 + tr], z2s[(16 * s + 8 * kg2 + 1) * 32 + tr]); pk.y = pk2(z2s[(16 * s + 8 * kg2 + 2) * 32 + tr], z2s[(16 * s + 8 * kg2 + 3) * 32 + tr]);
                    pk.z = pk2(z2s[(16 * s + 8 * kg2 + 4) * 32 + tr], z2s[(16 * s + 8 * kg2 + 5) * 32 + tr]); pk.w = pk2(z2s[(16 * s + 8 * kg2 + 6) * 32 + tr], z2s[(16 * s + 8 * kg2 + 7) * 32 + tr]);
                    Az[s] = __builtin_bit_cast(bf16x8_t, pk); } }
              LAS unsigned char* wt = L;
              for (int chunk = 0; chunk < 8; ++chunk) {
                  __syncthreads();
#pragma unroll 4
                  for (int r = 0; r < 8; ++r) { const int q = tid + 512 * r; const int j = q >> 6, c4 = q & 63;
                      const f32x4_t wv = *(const f32x4_t*)(w3 + (size_t)j * 2048 + chunk * 256 + 4 * c4);
                      LAS bf16* d = (LAS bf16*)(wt + (4 * c4) * 144 + 2 * j);
                      d[0] = f2bf(wv.x); d[72] = f2bf(wv.y); d[144] = f2bf(wv.z); d[216] = f2bf(wv.w); }
                  __syncthreads();
                  { const int cl = wave * 32 + (lane & 31), kg2 = lane >> 5;
                    f32x16_t acc = {0.f, 0.f, 0.f, 0.f, 0.f, 0.f, 0.f, 0.f, 0.f, 0.f, 0.f, 0.f, 0.f, 0.f, 0.f, 0.f};
#pragma unroll
                    for (int s = 0; s < 4; ++s) { const bf16x8_t Bw = *(const LAS bf16x8_t*)(wt + cl * 144 + (16 * s + 8 * kg2) * 2);
                        acc = __builtin_amdgcn_mfma_f32_32x32x16_bf16(Az[s], Bw, acc, 0, 0, 0); }
                    const int col = chunk * 256 + cl; const int cc = col & 511;
                    const float delta = fabsf(lo_ + (float)cc * ((hi_ - lo_) / 511.0f));
#pragma unroll
                    for (int g4 = 0; g4 < 4; ++g4) { const int tl = 8 * g4 + 4 * kg2;
                        const int t0 = tile * 32 + tl;
                        f16x2_t h01, h23;
                        h01.x = (_Float16)(acc[4 * g4 + 0] * 64.0f * __expf(-((float)(t0 + 0) / (float)(SEQ - 1)) * delta)); h01.y = (_Float16)(acc[4 * g4 + 1] * 64.0f * __expf(-((float)(t0 + 1) / (float)(SEQ - 1)) * delta));
                        h23.x = (_Float16)(acc[4 * g4 + 2] * 64.0f * __expf(-((float)(t0 + 2) / (float)(SEQ - 1)) * delta)); h23.y = (_Float16)(acc[4 * g4 + 3] * 64.0f * __expf(-((float)(t0 + 3) / (float)(SEQ - 1)) * delta));
                        uint2 o; o.x = __builtin_bit_cast(unsigned, h01); o.y = __builtin_bit_cast(unsigned, h23);
                        *(uint2*)(hT + (size_t)col * SEQ + t0) = o; } }
              }
          } }
        __syncthreads();
        for (int m = gw; m < NTOK; m += NGW) rms_row_to_bf16(a.in[0] + (size_t)m * DM, a.in[1], hn1 + (size_t)m * DM, lane);
        }
        if (BOTH(0)) GRID_BAR();
    }
    if (IN(1)) {
#ifndef DUP_G1
#define DUP_G1 1
#endif
        { pg8::Gemm g{hn1, WinT, NTOK, 1024, DM}; pg8::StaticOrder S; S.init(NTOK, 1024, G, bid);
          pg8::EpiBf16<0> E{lru, 1024, nullptr, 0, 0, 1.f};
          pg8::gemm_phase<pg8::EpiBf16<0>, pg8::StaticOrder, true, true>(L, g, S, E); }
        { pg8::Gemm g{WinT + (size_t)1024 * DM, hn1, 1536, NTOK, DM}; pg8::StaticOrder S; S.init(1536, NTOK, G, bid);
          pg8::EpiBf16<0> E{hyuT, NTOK, nullptr, 0, 0, 1.f};
          pg8::gemm_phase<pg8::EpiBf16<0>, pg8::StaticOrder, true, true>(L, g, S, E); }
#if DUP_G1 > 1
        { pg8::Gemm g{hn1, WinT, NTOK, 1024, DM}; pg8::StaticOrder S; S.init(NTOK, 1024, G, bid);
          pg8::EpiBf16<0> E{lru, 1024, nullptr, 0, 0, 1.f};
          pg8::gemm_phase<pg8::EpiBf16<0>, pg8::StaticOrder, true, true>(L, g, S, E); }
        { pg8::Gemm g{WinT + (size_t)1024 * DM, hn1, 1536, NTOK, DM}; pg8::StaticOrder S; S.init(1536, NTOK, G, bid);
          pg8::EpiBf16<0> E{hyuT, NTOK, nullptr, 0, 0, 1.f};
          pg8::gemm_phase<pg8::EpiBf16<0>, pg8::StaticOrder, true, true>(L, g, S, E); }
#endif
        __syncthreads();
        fft_tables_init(L, tid);
#ifndef DUP_FILT
#define DUP_FILT 1
#endif
        for (int rep = 0; rep < DUP_FILT; ++rep)
        for (int c = bid; c < DH; c += G) filter_item(L, a, c, (const _Float16*)(ws + WS_HT), (unsigned*)(ws + WS_SPEC), tid, lane, wave);
        if (BOTH(1)) GRID_BAR();
    }

    if (IN(2)) {
        bf16* hf = (bf16*)(ws + WS_HF); bf16* hb = (bf16*)(ws + WS_HB);
#ifndef DUP_LRU
#define DUP_LRU 1
#endif
#ifndef DUP_HY
#define DUP_HY 1
#endif
        { bf16* xcb = (bf16*)(ws + WS_XCB); const float* cwp = a.in[3]; const float* cbp = a.in[4];
          for (int idx = bid * (NWAVES * 64) + tid; idx < NTOK * 64; idx += G * NWAVES * 64) {
              const int tok = idx >> 6, c8 = (idx & 63) * 8, t = tok & (SEQ - 1), bb = tok >> 13;
              float acc[8];
              { const float4 c0 = *(const float4*)(cbp + c8), c1 = *(const float4*)(cbp + c8 + 4); acc[0] = c0.x; acc[1] = c0.y; acc[2] = c0.z; acc[3] = c0.w; acc[4] = c1.x; acc[5] = c1.y; acc[6] = c1.z; acc[7] = c1.w; }
#pragma unroll
              for (int tap = 0; tap < 4; ++tap) { const int tt = t + tap - 2; const bool ok = tt >= 0 && tt < SEQ; const int tc = ok ? tt : t;
                  const v4u xv = *(const v4u*)(lru + (size_t)(bb * SEQ + tc) * 1024 + c8);
                  const float4 w0 = *(const float4*)(cwp + tap * DL + c8), w1 = *(const float4*)(cwp + tap * DL + c8 + 4);
                  const float m = ok ? 1.f : 0.f; const unsigned x0 = xv.x, x1 = xv.y, x2 = xv.z, x3 = xv.w;
                  acc[0] += m * w0.x * __uint_as_float(x0 << 16); acc[1] += m * w0.y * __uint_as_float(x0 & 0xffff0000u);
                  acc[2] += m * w0.z * __uint_as_float(x1 << 16); acc[3] += m * w0.w * __uint_as_float(x1 & 0xffff0000u);
                  acc[4] += m * w1.x * __uint_as_float(x2 << 16); acc[5] += m * w1.y * __uint_as_float(x2 & 0xffff0000u);
                  acc[6] += m * w1.z * __uint_as_float(x3 << 16); acc[7] += m * w1.w * __uint_as_float(x3 & 0xffff0000u); }
              v4u pk; pk.x = pk2(acc[0], acc[1]); pk.y = pk2(acc[2], acc[3]); pk.z = pk2(acc[4], acc[5]); pk.w = pk2(acc[6], acc[7]);
              const int hh = c8 >> 6, cl = c8 & 63;
              *(v4u*)(xcb + (((size_t)(bb * 8 + hh) * SEQ + t) * 64 + cl)) = pk; } }
        GRID_BAR();
        for (int rep = 0; rep < DUP_LRU; ++rep)
        for (int item = bid; item < 256; item += G) lru_item(L, a, item, (const bf16*)(ws + WS_XCB), hf, hb, tid, lane, wave);
        __syncthreads();
        fft_tables_init(L, tid);
        for (int rep = 0; rep < DUP_HY; ++rep)
        for (int item = bid; item < 2 * DH; item += G) hyena_item(L, a, item >> 1, item & 1, hyuT, (unsigned*)(ws + WS_SPEC), (bf16*)(ws + WS_YHYT), tid);
        if (BOTH(2)) GRID_BAR();
    }

    if (IN(3)) {
        const bf16* hf = (const bf16*)(ws + WS_HF); const bf16* hb = (const bf16*)(ws + WS_HB); const bf16* y_hyT = (const bf16*)(ws + WS_YHYT);
        const float* gA = a.in[25]; const float* gB = a.in[26];
#ifndef DUP_P3
#define DUP_P3 1
#endif
        for (int rep3 = 0; rep3 < DUP_P3; ++rep3) {
        for (int tok = gw; tok < NTOK; tok += NGW) {
            const v4u vf = *(const v4u*)(hf + (size_t)tok * DL + 8 * lane), vb = *(const v4u*)(hb + (size_t)tok * DL + 8 * lane), vg = *(const v4u*)(lru + (size_t)tok * 1024 + 512 + 8 * lane);
            const unsigned f0 = vf.x, f1 = vf.y, f2 = vf.z, f3 = vf.w, b0 = vb.x, b1 = vb.y, b2 = vb.z, b3 = vb.w, g0 = vg.x, g1 = vg.y, g2 = vg.z, g3 = vg.w;
            float y[8];
            y[0] = (__uint_as_float(f0 << 16) + __uint_as_float(b0 << 16)) * gelu_tanh(__uint_as_float(g0 << 16));
            y[1] = (__uint_as_float(f0 & 0xffff0000u) + __uint_as_float(b0 & 0xffff0000u)) * gelu_tanh(__uint_as_float(g0 & 0xffff0000u));
            y[2] = (__uint_as_float(f1 << 16) + __uint_as_float(b1 << 16)) * gelu_tanh(__uint_as_float(g1 << 16));
            y[3] = (__uint_as_float(f1 & 0xffff0000u) + __uint_as_float(b1 & 0xffff0000u)) * gelu_tanh(__uint_as_float(g1 & 0xffff0000u));
            y[4] = (__uint_as_float(f2 << 16) + __uint_as_float(b2 << 16)) * gelu_tanh(__uint_as_float(g2 << 16));
            y[5] = (__uint_as_float(f2 & 0xffff0000u) + __uint_as_float(b2 & 0xffff0000u)) * gelu_tanh(__uint_as_float(g2 & 0xffff0000u));
            y[6] = (__uint_as_float(f3 << 16) + __uint_as_float(b3 << 16)) * gelu_tanh(__uint_as_float(g3 << 16));
            y[7] = (__uint_as_float(f3 & 0xffff0000u) + __uint_as_float(b3 & 0xffff0000u)) * gelu_tanh(__uint_as_float(g3 & 0xffff0000u));
            float s = 0.f;
#pragma unroll
            for (int i = 0; i < 8; ++i) s += y[i] * y[i];
            s = wave_sum(s);
            const float rstd = rsqrtf(s * (1.0f / DL) + EPS);
            const float4 ga0 = *(const float4*)(gA + 8 * lane), ga1 = *(const float4*)(gA + 8 * lane + 4);
            v4u o; o.x = pk2(y[0] * rstd * ga0.x, y[1] * rstd * ga0.y); o.y = pk2(y[2] * rstd * ga0.z, y[3] * rstd * ga0.w);
            o.z = pk2(y[4] * rstd * ga1.x, y[5] * rstd * ga1.y); o.w = pk2(y[6] * rstd * ga1.z, y[7] * rstd * ga1.w);
            *(v4u*)(y_cat + (size_t)tok * 1024 + 8 * lane) = o;
        }
        for (int tile = bid; tile < NTOK / 64; tile += G) {
            __syncthreads();
            const int tok0 = tile * 64;
            for (int ch = tid; ch < 512 * 8; ch += NWAVES * 64) { const int c = ch >> 3, piece = ch & 7;
                const v4u v = *(const v4u*)(y_hyT + (size_t)c * NTOK + tok0 + 8 * piece);
                LAS unsigned* d = (LAS unsigned*)(L + c * 132 + piece * 16); d[0] = v.x; d[1] = v.y; d[2] = v.z; d[3] = v.w; }
            __syncthreads();
            for (int tl = wave; tl < 64; tl += NWAVES) {
                float v[8]; float s = 0.f;
#pragma unroll
                for (int i = 0; i < 4; ++i) { const int c = 2 * lane + 128 * i;
                    v[2 * i] = bf2f(*(const LAS bf16*)(L + c * 132 + tl * 2)); v[2 * i + 1] = bf2f(*(const LAS bf16*)(L + (c + 1) * 132 + tl * 2));
                    s += v[2 * i] * v[2 * i] + v[2 * i + 1] * v[2 * i + 1]; }
                s = wave_sum(s);
                const float rstd = rsqrtf(s * (1.0f / DH) + EPS);
#pragma unroll
                for (int i = 0; i < 4; ++i) { const int c = 2 * lane + 128 * i;
                    *(unsigned*)(y_cat + (size_t)(tok0 + tl) * 1024 + 512 + c) = pk2(v[2 * i] * rstd * gB[c], v[2 * i + 1] * rstd * gB[c + 1]); }
            }
        }
        }
        if (BOTH(3)) GRID_BAR();
    }
    if (IN(4)) {
        pg8::Gemm g{y_cat, WoutT, NTOK, DM, DM}; pg8::StaticOrder S; S.init(NTOK, DM, G, bid);
        pg8::EpiResF32 E{a.in[0], a.out, DM};
#ifndef DUP_P4
#define DUP_P4 1
#endif
        pg8::gemm_phase<pg8::EpiResF32, pg8::StaticOrder, true, true>(L, g, S, E);
#if DUP_P4 > 1
        pg8::gemm_phase<pg8::EpiResF32, pg8::StaticOrder, true, true>(L, g, S, E);
#endif
        if (BOTH(4)) GRID_BAR();
    }

#ifndef DUP_P5
#define DUP_P5 1
#endif
    for (int rep5 = 0; rep5 < DUP_P5; ++rep5)
    if (IN(5)) {
        const bool dummy = (rep5 + 1 < DUP_P5);
        unsigned* cntg = ctl + (dummy ? 3072 : CW_CNT);
        int* list_ = dummy ? (int*)(ws + 376 * MiB) : list; float* lgate_ = dummy ? (float*)(ws + 380 * MiB) : lgate; int4* tokinfo_ = dummy ? (int4*)(ws + 384 * MiB) : tokinfo;
        bf16* hn2_ = dummy ? (bf16*)(ws + 232 * MiB) : hn2;
        LAS float* lg = (LAS float*)(L + 98304);
        LAS int* cnt_l = (LAS int*)(L + LC_CNT); LAS int* base_l = (LAS int*)(L + LC_BASE);
        const float* xmid = a.out; const float* gff = a.in[28];
        for (int tile = bid; tile < NTOK / 128; tile += G) {
            __syncthreads();
            for (int ch = tid; ch < 48 * 128; ch += NWAVES * 64) { const int row = ch >> 7, c16 = ch & 127;
                *(LAS v4u*)(L + row * 2048 + ((c16 ^ (row & 15)) << 4)) = *(const v4u*)(WrT + (size_t)row * 1024 + c16 * 8); }
            if (tid < 32) cnt_l[tid] = 0;
            __syncthreads();
            const int tk = lane & 15, kg = lane >> 4;
            const int tokw = tile * 128 + wave * 16 + tk;
            const float* xr = xmid + (size_t)tokw * DM + 8 * kg;
            float s = 0.f;
#pragma unroll 8
            for (int st = 0; st < 32; ++st) { const float4 p = *(const float4*)(xr + 32 * st), q = *(const float4*)(xr + 32 * st + 4);
                s += (p.x * p.x + p.y * p.y) + (p.z * p.z + p.w * p.w) + (q.x * q.x + q.y * q.y) + (q.z * q.z + q.w * q.w); }
            s += __shfl_xor(s, 16); s += __shfl_xor(s, 32);
            const float rstd = rsqrtf(s * (1.0f / DM) + EPS);
            f32x4_t acc0 = {0.f, 0.f, 0.f, 0.f}, acc1 = acc0, acc2 = acc0;
            bf16* hrow = hn2_ + (size_t)tokw * DM + 8 * kg;
#pragma unroll 4
            for (int st = 0; st < 32; ++st) {
                const float4 p = *(const float4*)(xr + 32 * st), q = *(const float4*)(xr + 32 * st + 4);
                const float4 g0 = *(const float4*)(gff + 32 * st + 8 * kg), g1 = *(const float4*)(gff + 32 * st + 8 * kg + 4);
                v4u w; w.x = pk2(p.x * rstd * g0.x, p.y * rstd * g0.y); w.y = pk2(p.z * rstd * g0.z, p.w * rstd * g0.w);
                w.z = pk2(q.x * rstd * g1.x, q.y * rstd * g1.y); w.w = pk2(q.z * rstd * g1.z, q.w * rstd * g1.w);
                *(v4u*)(hrow + 32 * st) = w;
                const bf16x8_t B = __builtin_bit_cast(bf16x8_t, w);
                const int chs = ((4 * st + kg) ^ tk) << 4;
                const bf16x8_t A0 = *(const LAS bf16x8_t*)(L + (0 + tk) * 2048 + chs), A1 = *(const LAS bf16x8_t*)(L + (16 + tk) * 2048 + chs), A2 = *(const LAS bf16x8_t*)(L + (32 + tk) * 2048 + chs);
                acc0 = __builtin_amdgcn_mfma_f32_16x16x32_bf16(A0, B, acc0, 0, 0, 0);
                acc1 = __builtin_amdgcn_mfma_f32_16x16x32_bf16(A1, B, acc1, 0, 0, 0);
                acc2 = __builtin_amdgcn_mfma_f32_16x16x32_bf16(A2, B, acc2, 0, 0, 0);
            }
            { LAS float* lr = lg + (wave * 16 + tk) * 49 + 4 * kg;
#pragma unroll
              for (int r = 0; r < 4; ++r) { lr[r] = acc0[r]; lr[16 + r] = acc1[r]; lr[32 + r] = acc2[r]; } }
            __syncthreads();
            int e0 = 0, e1 = 0, r0l = 0, r1l = 0; float g0 = 0.f, g1 = 0.f;
            if (tid < 128) {
                const LAS float* lr = lg + tid * 49; const float* bgp = a.in[30]; const float* bep = a.in[32];
                int gi = 0; float gm = lr[0] + bgp[0];
                for (int i = 1; i < 4; ++i) { const float v = lr[i] + bgp[i]; if (v > gm) { gm = v; gi = i; } }
                float gs = 0.f; for (int i = 0; i < 4; ++i) gs += __expf(lr[i] + bgp[i] - gm);
                const float gp = 1.0f / gs;
                const LAS float* le = lr + 4 + gi * 8; const float* beg = bep + gi * 8;
                int i1 = 0; float m1 = le[0] + beg[0];
                for (int i = 1; i < 8; ++i) { const float v = le[i] + beg[i]; if (v > m1) { m1 = v; i1 = i; } }
                int i2 = -1; float m2 = -3.0e38f;
                for (int i = 0; i < 8; ++i) { const float v = le[i] + beg[i]; if (i != i1 && v > m2) { m2 = v; i2 = i; } }
                const float ex2 = __expf(m2 - m1);
                e0 = gi * 8 + i1; e1 = gi * 8 + i2; g0 = gp / (1.0f + ex2); g1 = gp * ex2 / (1.0f + ex2);
                r0l = atomicAdd((int*)(cnt_l + e0), 1); r1l = atomicAdd((int*)(cnt_l + e1), 1);
            }
            __syncthreads();
            if (tid < 32) { const int c = cnt_l[tid]; base_l[tid] = c ? (int)atomicAdd(cntg + tid, (unsigned)c) : 0; }
            __syncthreads();
            if (tid < 128) { const int tok = tile * 128 + tid; const int r0 = base_l[e0] + r0l, r1 = base_l[e1] + r1l;
                list_[e0 * NTOK + r0] = tok; lgate_[e0 * NTOK + r0] = g0; list_[e1 * NTOK + r1] = tok; lgate_[e1 * NTOK + r1] = g1;
                tokinfo_[tok] = make_int4(e0, r0, e1, r1); }
        }
        if (BOTH(5) && !dummy) GRID_BAR();
    }
    if (IN(7)) {
        const int T = moe_tables(L, ctl, tid);
        pg8::Gemm g{hn2, W13T, T * 256, 1024, DM};
        pg8::MoeOrder S{(const LAS int*)(L + LC_TILEE), T, 4, G, bid, (size_t)1024 * 1024 * 2, (const LAS int*)(L + LC_TSTART), (const LAS int*)(L + LC_CNT), list, NTOK, true};
        pg8::EpiSwiGLU E{Hb};
        pg8::gemm_phase<pg8::EpiSwiGLU, pg8::MoeOrder, true, true, true>(L, g, S, E);
        if (BOTH(7)) GRID_BAR();
    }
    if (IN(8)) {
        const int T = moe_tables(L, ctl, tid);
        pg8::Gemm g{Hb, W2T, T * 256, 1024, 512};
        pg8::MoeOrder S{(const LAS int*)(L + LC_TILEE), T, 4, G, bid, (size_t)1024 * 512 * 2, (const LAS int*)(L + LC_TSTART), (const LAS int*)(L + LC_CNT), list, NTOK, false};
        pg8::EpiRowScaleBf16 E{Yb, 1024, lgate, (const LAS int*)(L + LC_TILEE), (const LAS int*)(L + LC_TSTART), (const LAS int*)(L + LC_CNT), NTOK};
        pg8::gemm_phase<pg8::EpiRowScaleBf16, pg8::MoeOrder, true, true, false>(L, g, S, E);
        if (BOTH(8)) GRID_BAR();
    }
#ifndef DUP_P9
#define DUP_P9 1
#endif
    for (int rep9 = 0; rep9 < DUP_P9; ++rep9)
    if (IN(9)) {
        float* outw = (rep9 + 1 < DUP_P9) ? (float*)(ws + 256 * MiB) : a.out;
        (void)moe_tables(L, ctl, tid);
        const LAS int* tstart = (const LAS int*)(L + LC_TSTART);
        const float* gfin = a.in[36];
        for (int tok0 = gw * 4; tok0 < NTOK; tok0 += NGW * 4) {
            float4 v[4][4]; uint2 p[4][4], q[4][4];
#pragma unroll
            for (int u = 0; u < 4; ++u) { const int4 ti = tokinfo[tok0 + u];
                const size_t s0 = (size_t)tstart[ti.x] * 256 + ti.y, s1 = (size_t)tstart[ti.z] * 256 + ti.w;
                const uint2* y0 = (const uint2*)(Yb + s0 * DM); const uint2* y1 = (const uint2*)(Yb + s1 * DM);
                const float4* xr = (const float4*)(a.out + (size_t)(tok0 + u) * DM);
#pragma unroll
                for (int j = 0; j < 4; ++j) { v[u][j] = xr[lane + 64 * j]; p[u][j] = y0[lane + 64 * j]; q[u][j] = y1[lane + 64 * j]; } }
#pragma unroll
            for (int u = 0; u < 4; ++u) { float s = 0.f;
#pragma unroll
                for (int j = 0; j < 4; ++j) { const uint2 pp = p[u][j], qq = q[u][j];
                    v[u][j].x += __uint_as_float(pp.x << 16) + __uint_as_float(qq.x << 16); v[u][j].y += __uint_as_float(pp.x & 0xffff0000u) + __uint_as_float(qq.x & 0xffff0000u);
                    v[u][j].z += __uint_as_float(pp.y << 16) + __uint_as_float(qq.y << 16); v[u][j].w += __uint_as_float(pp.y & 0xffff0000u) + __uint_as_float(qq.y & 0xffff0000u);
                    s += (v[u][j].x * v[u][j].x + v[u][j].y * v[u][j].y) + (v[u][j].z * v[u][j].z + v[u][j].w * v[u][j].w); }
                s = wave_sum(s);
                const float rstd = rsqrtf(s * (1.0f / DM) + EPS);
                float4* xw = (float4*)(outw + (size_t)(tok0 + u) * DM);
#pragma unroll
                for (int j = 0; j < 4; ++j) { const float4 gg = *(const float4*)(gfin + (lane + 64 * j) * 4);
                    xw[lane + 64 * j] = make_float4(v[u][j].x * rstd * gg.x, v[u][j].y * rstd * gg.y, v[u][j].z * rstd * gg.z, v[u][j].w * rstd * gg.w); } }
        }
    }
#undef IN
#undef BOTH
#undef GRID_BAR
}

static void launch_fwd(const Args& base, int lo, int hi, int li, int grid, hipStream_t stream) {
    Args a = base; a.ph_lo = lo; a.ph_hi = hi; a.li = li; a.pad = 0;
    hipLaunchKernelGGL(fwd, dim3(grid), dim3(NWAVES * 64), LDS_BYTES, stream, a);
}

extern "C" void kernel_launch(void* const* d_in, const int* in_sizes, int n_in, void* d_out, int out_size, void* d_ws, size_t ws_size, hipStream_t stream) {
    (void)in_sizes; (void)n_in; (void)out_size; (void)ws_size;
    static int grid = 0;
    if (grid == 0) {
        int dev = 0, cus = 0;
        (void)hipGetDevice(&dev); (void)hipDeviceGetAttribute(&cus, hipDeviceAttributeMultiprocessorCount, dev);
        (void)hipFuncSetAttribute((const void*)fwd, hipFuncAttributeMaxDynamicSharedMemorySize, LDS_BYTES);
        grid = cus > 0 ? cus : 256;
    }
    const float* const* in = (const float* const*)d_in;
    unsigned char* ws = (unsigned char*)d_ws;
    float* out = (float*)d_out;
    (void)hipMemsetAsync(ws, 0, CTL_ZERO_BYTES, stream);
    Args base{};
    for (int i = 0; i < 37; ++i) base.in[i] = in[i];
    base.out = out; base.ws = ws;

    bf16* lru = (bf16*)(ws + WS_LRU); bf16* hyuT = (bf16*)(ws + WS_HYUT); float* xc = (float*)(ws + WS_XC);
    bf16* hf = (bf16*)(ws + WS_HF); bf16* hb = (bf16*)(ws + WS_HB); float* kT = (float*)(ws + WS_KT); float* z2 = (float*)(ws + WS_Z2); float* z1T = out;
    bf16* y_hyT = (bf16*)(ws + WS_YHYT); bf16* y_cat = (bf16*)(ws + WS_YCAT); bf16* hn2 = (bf16*)(ws + WS_HN2); int* eid = (int*)(ws + WS_EID); float* gate = (float*)(ws + WS_GATE);

#ifndef MK_PER_PHASE
    launch_fwd(base, 0, 10, 0, grid, stream);
#else
    for (int ph = 0; ph < 10; ++ph) launch_fwd(base, ph, ph + 1, ph, grid, stream);
#endif
    (void)lru; (void)hyuT; (void)xc; (void)hf; (void)hb; (void)kT; (void)z2; (void)z1T; (void)y_hyT; (void)y_cat;
    (void)hn2; (void)eid; (void)gate;
}
```

```cpp
#include <hip/hip_runtime.h>
#include <stdint.h>

typedef unsigned short bf16;
__device__ __forceinline__ float bf2f(bf16 v) { return __uint_as_float(((unsigned)v) << 16); }
__device__ __forceinline__ bf16 f2bf(float f) { unsigned u = __float_as_uint(f); u += 0x7fffu + ((u >> 16) & 1u); return (bf16)(u >> 16); }

constexpr int NB = 4, SEQ = 8192, DM = 1024, NTOK = NB * SEQ, DIN = 2560, DL = 512, DH = 512;
constexpr float EPS = 1e-6f;

__device__ __forceinline__ float wave_sum(float v) {
#pragma unroll
    for (int o = 1; o < 64; o <<= 1) v += __shfl_xor(v, o);
    return v;
}
__device__ __forceinline__ float gelu_tanh(float x) { return 0.5f * x * (1.0f + tanhf(0.7978845608028654f * (x + 0.044715f * x * x * x))); }

constexpr size_t MiB = 1u << 20;
namespace pg8 {
#define PG8_LAS __attribute__((address_space(3)))
typedef unsigned short bf16_t;
typedef short bf16x8 __attribute__((ext_vector_type(8)));
typedef float f32x4 __attribute__((ext_vector_type(4)));
typedef unsigned u32x4 __attribute__((ext_vector_type(4)));
constexpr int BM = 256, BK = 64, HALF = 128, HTB = HALF * BK * 2  , STAGE_BYTES = 8 * HTB, NXCD = 8, WGM = 8;

__host__ __device__ __forceinline__ int lds_byte(int r, int c) { const int st = (r >> 4) * 2 + (c >> 5), rr = r & 15, cc = c & 31, ob = rr * 64 + cc * 2; return st * 1024 + (ob ^ (((ob >> 9) & 1) << 5)); }
__host__ __device__ __forceinline__ void stage_rc(int b, int& R, int& C) { const int st = b / 1024, sb = b % 1024, swz = sb ^ (((sb >> 9) & 1) << 5); R = (st >> 1) * 16 + swz / 64; C = (st & 1) * 32 + (swz % 64) / 2; }
__host__ __device__ __forceinline__ int perm32(int rho) { const int n = rho >> 4, i = rho & 15; return 8 * (i >> 2) + 4 * n + (i & 3); }

struct Unit { int pm, pn; };
struct Gemm { const bf16_t* A; const bf16_t* Bt; int M, N, K; };

struct StaticOrder {
    int nM, nN, nwg, G, c;
    __host__ __device__ void init(int M, int N, int G_, int c_) { nM = M / BM; nN = N / BM; nwg = nM * nN; G = G_; c = c_; }
    __host__ __device__ bool next(int i, Unit& u) const {
        const long L = (long)i * G + c; if (L >= nwg) return false;
        int wgid = (int)L; { const int q = nwg / NXCD, r = nwg % NXCD, xcd = wgid % NXCD, off = wgid / NXCD; wgid = (xcd < r ? xcd * (q + 1) : r * (q + 1) + (xcd - r) * q) + off; }
        const int nig = WGM * nN, gid = wgid / nig, fm = gid * WGM, gsz = (nM - fm) < WGM ? (nM - fm) : WGM;
        u.pm = fm + ((wgid % nig) % gsz); u.pn = (wgid % nig) / gsz; return true;
    }
    __device__ __forceinline__ void a_ready(const Unit&) const {}
    __device__ __forceinline__ void done(const Unit&) const {}
    __device__ __forceinline__ const char* a_base(const Gemm& g, const Unit& u) const { return (const char*)g.A + (size_t)u.pm * ((size_t)BM * g.K * 2); }
    __device__ __forceinline__ const char* b_base(const Gemm& g, const Unit& u) const { return (const char*)g.Bt + (size_t)u.pn * ((size_t)BM * g.K * 2); }
    __device__ __forceinline__ int src_row(const Unit&, int row) const { return row; }
};

__device__ __forceinline__ unsigned cvt_pk_bf16(float lo, float hi) { unsigned r; asm volatile("v_cvt_pk_bf16_f32 %0, %1, %2" : "=v"(r) : "v"(lo), "v"(hi)); return r; }
typedef float f32x2 __attribute__((ext_vector_type(2)));
__device__ __forceinline__ f32x2 gelu_pk(f32x2 v) {
    const f32x2 av = __builtin_elementwise_abs(v), d = av * 0.2316418882f + 1.0f;
    f32x2 t; t.x = __builtin_amdgcn_rcpf(d.x); t.y = __builtin_amdgcn_rcpf(d.y);
    f32x2 q = t * 0.5307027145f + (-0.7265760135f); q = q * t + 0.7107068705f; q = q * t + (-0.142248368f); q = q * t + 0.127414796f; q = q * t;
    const f32x2 s = (v * v) * (-0.72134752044f);
    f32x2 e; e.x = __builtin_amdgcn_exp2f(s.x); e.y = __builtin_amdgcn_exp2f(s.y);
    const f32x2 m = v * (q * e), r = v - m;
    f32x2 o; o.x = v.x < 0.f ? m.x : r.x; o.y = v.y < 0.f ? m.y : r.y; return o;
}

template <int ACT  > struct EpiBf16 {
    static constexpr bool PERM = true, AFTER_DRAIN = false; static_assert(ACT == 0 || ACT == 1, "EpiBf16: ACT is 0 (none) or 1 (gelu_pk)");
    bf16_t* O; int ldc; const float* bias; int split_cols; size_t split_stride; float scale0;
    __device__ __forceinline__ void operator()(const f32x4 (&acc)[2][2][4][2], const Unit& u, int wr, int wc, int fr, int fq) const {
        const int row0 = u.pm * BM + wr * 64 + fr; int colt = u.pn * BM; bf16_t* base = O;
        float sc = 1.f; if (split_cols) { const int t = colt / split_cols; base += (size_t)t * split_stride; colt -= t * split_cols; if (t == 0) sc = scale0; }
        const int col0 = colt + wc * 32 + 8 * fq, bcol0 = u.pn * BM + wc * 32 + 8 * fq;
        f32x4 bv[2][2];
#pragma unroll
        for (int bj = 0; bj < 2; ++bj)
#pragma unroll
            for (int n = 0; n < 2; ++n) bv[bj][n] = bias ? *(const f32x4*)(bias + bcol0 + bj * HALF + 4 * n) : (f32x4){0.f, 0.f, 0.f, 0.f};
#pragma unroll
        for (int ai = 0; ai < 2; ++ai)
#pragma unroll
            for (int m = 0; m < 4; ++m) { bf16_t* rowp = base + (size_t)(row0 + ai * HALF + m * 16) * ldc + col0;
#pragma unroll
                for (int bj = 0; bj < 2; ++bj) { f32x4 v0 = acc[ai][bj][m][0] + bv[bj][0], v1 = acc[ai][bj][m][1] + bv[bj][1];
                    if (ACT == 1) { f32x2 a = gelu_pk((f32x2){v0[0], v0[1]}), b = gelu_pk((f32x2){v0[2], v0[3]}), c = gelu_pk((f32x2){v1[0], v1[1]}), d = gelu_pk((f32x2){v1[2], v1[3]});
                        v0 = (f32x4){a.x, a.y, b.x, b.y}; v1 = (f32x4){c.x, c.y, d.x, d.y}; }
                    v0 = v0 * sc; v1 = v1 * sc; u32x4 w; w.x = cvt_pk_bf16(v0[0], v0[1]); w.y = cvt_pk_bf16(v0[2], v0[3]); w.z = cvt_pk_bf16(v1[0], v1[1]); w.w = cvt_pk_bf16(v1[2], v1[3]);
                    *(u32x4*)(rowp + bj * HALF) = w; } }
    }
};

struct EpiResF32 {
    static constexpr bool PERM = false, AFTER_DRAIN = false;
    const float* X; float* O; int ldc;
    __device__ __forceinline__ void operator()(const f32x4 (&acc)[2][2][4][2], const Unit& u, int wr, int wc, int fr, int fq) const {
        const int row0 = u.pm * BM + wr * 64 + fr, col0 = u.pn * BM + wc * 32 + 4 * fq;
#pragma unroll
        for (int ai = 0; ai < 2; ++ai)
#pragma unroll
            for (int m = 0; m < 4; ++m) { const size_t off = (size_t)(row0 + ai * HALF + m * 16) * ldc + col0;
#pragma unroll
                for (int bj = 0; bj < 2; ++bj)
#pragma unroll
                    for (int n = 0; n < 2; ++n) { const f32x4 xv = *(const f32x4*)(X + off + bj * HALF + n * 16); *(f32x4*)(O + off + bj * HALF + n * 16) = acc[ai][bj][m][n] + xv; } }
    }
};

struct MoeOrder {
    const PG8_LAS int* tile_e; int T, nN, G, c; size_t expert_stride_bytes;
    const PG8_LAS int* tstart; const PG8_LAS int* cnt; const int* list; int ntok; bool gather;
    __device__ __forceinline__ bool next(int i, Unit& u) const {
        const int L = i * G + c; if (L >= T * nN) return false;
        u.pm = L / nN; u.pn = L % nN; return true;
    }
    __device__ __forceinline__ void a_ready(const Unit&) const {}
    __device__ __forceinline__ void done(const Unit&) const {}
    __device__ __forceinline__ const char* a_base(const Gemm& g, const Unit& u) const { return gather ? (const char*)g.A : (const char*)g.A + (size_t)u.pm * ((size_t)BM * g.K * 2); }
    __device__ __forceinline__ const char* b_base(const Gemm& g, const Unit& u) const { return (const char*)g.Bt + (size_t)tile_e[u.pm] * expert_stride_bytes + (size_t)u.pn * ((size_t)BM * g.K * 2); }
    __device__ __forceinline__ int src_row(const Unit& u, int row) const {
        const int e = tile_e[u.pm]; const int r = (u.pm - tstart[e]) * BM + row;
        return r < cnt[e] ? list[e * ntok + r] : 0;
    }
};
__device__ __forceinline__ float silu_f(float a) { return a * __builtin_amdgcn_rcpf(1.0f + __builtin_amdgcn_exp2f(-1.4426950408889634f * a)); }
struct EpiSwiGLU {
    static constexpr bool PERM = true, AFTER_DRAIN = false;
    bf16_t* H;
    __device__ __forceinline__ void operator()(const f32x4 (&acc)[2][2][4][2], const Unit& u, int wr, int wc, int fr, int fq) const {
        const int row0 = u.pm * BM + wr * 64 + fr, col0 = u.pn * 128 + wc * 32 + 8 * fq;
#pragma unroll
        for (int ai = 0; ai < 2; ++ai)
#pragma unroll
            for (int m = 0; m < 4; ++m) { bf16_t* p = H + (size_t)(row0 + ai * HALF + m * 16) * 512 + col0;
                const f32x4 a0 = acc[ai][0][m][0], a1 = acc[ai][0][m][1], b0 = acc[ai][1][m][0], b1 = acc[ai][1][m][1];
                u32x4 w; w.x = cvt_pk_bf16(silu_f(a0[0]) * b0[0], silu_f(a0[1]) * b0[1]); w.y = cvt_pk_bf16(silu_f(a0[2]) * b0[2], silu_f(a0[3]) * b0[3]);
                w.z = cvt_pk_bf16(silu_f(a1[0]) * b1[0], silu_f(a1[1]) * b1[1]); w.w = cvt_pk_bf16(silu_f(a1[2]) * b1[2], silu_f(a1[3]) * b1[3]);
                *(u32x4*)p = w; }
    }
};
struct EpiRowScaleBf16 {
    static constexpr bool PERM = true, AFTER_DRAIN = false;
    bf16_t* O; int ldc; const float* lgate; const PG8_LAS int* tile_e; const PG8_LAS int* tstart; const PG8_LAS int* cnt; int ntok;
    __device__ __forceinline__ void operator()(const f32x4 (&acc)[2][2][4][2], const Unit& u, int wr, int wc, int fr, int fq) const {
        const int rl0 = wr * 64 + fr, col0 = u.pn * BM + wc * 32 + 8 * fq;
        const int e = tile_e[u.pm]; const int rbase = (u.pm - tstart[e]) * BM; const int ce = cnt[e];
#pragma unroll
        for (int ai = 0; ai < 2; ++ai)
#pragma unroll
            for (int m = 0; m < 4; ++m) { const int rl = rl0 + ai * HALF + m * 16; const int r = rbase + rl; const float sc = r < ce ? lgate[e * ntok + r] : 0.f;
                bf16_t* rowp = O + (size_t)(u.pm * BM + rl) * ldc + col0;
#pragma unroll
                for (int bj = 0; bj < 2; ++bj) { const f32x4 v0 = acc[ai][bj][m][0] * sc, v1 = acc[ai][bj][m][1] * sc;
                    u32x4 w; w.x = cvt_pk_bf16(v0[0], v0[1]); w.y = cvt_pk_bf16(v0[2], v0[3]); w.z = cvt_pk_bf16(v1[0], v1[1]); w.w = cvt_pk_bf16(v1[2], v1[3]);
                    *(u32x4*)(rowp + bj * HALF) = w; } }
    }
};
template <class Epi, class Sched, bool ALIGN_EPI = false, bool SP2 = false, bool GATHER = false>
__device__ __forceinline__ void gemm_phase(PG8_LAS unsigned char* lds, const Gemm g, const Sched& S, const Epi& E) {
    const int tid = threadIdx.x, wid = __builtin_amdgcn_readfirstlane(tid >> 6), lane = tid & 63, wr = wid >> 2, wc = wid & 3, fr = lane & 15, fq = lane >> 4;
    const int K = g.K, nt = K / BK;
    unsigned voffA[2], voffB[2];
#pragma unroll
    for (int i = 0; i < 2; ++i) { int R, C; stage_rc(tid * 16 + i * 8192, R, C); const int Rb = Epi::PERM ? ((R & ~31) + perm32(R & 31)) : R;
        voffA[i] = (unsigned)(R * K + C) * 2u; voffB[i] = (unsigned)(Rb * K + C) * 2u; }
    unsigned voA[2][2], voAn[2][2];
    int gR[2], gC[2];
#pragma unroll
    for (int i = 0; i < 2; ++i) { int R, C; stage_rc(tid * 16 + i * 8192, R, C); gR[i] = R; gC[i] = C; }
#pragma unroll
    for (int h = 0; h < 2; ++h)
#pragma unroll
        for (int i = 0; i < 2; ++i) { voA[h][i] = voffA[i] + (unsigned)h * (unsigned)(HALF * K * 2); voAn[h][i] = voA[h][i]; }
    const size_t kstep = (size_t)(BK * 2);
    const size_t hstep = (size_t)HALF * K * 2;
    const size_t tstep = 2 * hstep; (void)tstep;
    const unsigned ldsw = (unsigned)wid * 1024u;
    const int aoff = lds_byte(wr * 64 + fr, fq * 8), boff = lds_byte(wc * 32 + fr, fq * 8);
#define PG8_SA(b, h) (((b) * 2 + (h)) * HTB)
#define PG8_SB(b, h) ((4 + (b) * 2 + (h)) * HTB)
#define PG8_STAGE(bufoff, gbase, voff) do { _Pragma("unroll") for (int _i = 0; _i < 2; ++_i) \
        __builtin_amdgcn_global_load_lds((const unsigned*)((const char*)(gbase) + (voff)[_i]), (PG8_LAS unsigned*)(lds + (bufoff) + ldsw + _i * 8192), 16, 0, 0); } while (0)
#define PG8_STAGE_A(bufoff, gbase, h, vo) do { _Pragma("unroll") for (int _i = 0; _i < 2; ++_i) \
        __builtin_amdgcn_global_load_lds((const unsigned*)((const char*)(gbase) + (vo)[h][_i]), (PG8_LAS unsigned*)(lds + (bufoff) + ldsw + _i * 8192), 16, 0, 0); } while (0)
#define PG8_GATHER_OFFS(dst, unit) do { _Pragma("unroll") for (int _h = 0; _h < 2; ++_h) _Pragma("unroll") for (int _i = 0; _i < 2; ++_i) \
        (dst)[_h][_i] = (unsigned)(S.src_row(unit, _h * HALF + gR[_i]) * K + gC[_i]) * 2u; } while (0)
#define PG8_LDA(dst, b, h) do { _Pragma("unroll") for (int m = 0; m < 4; ++m) _Pragma("unroll") for (int k = 0; k < 2; ++k) dst[m][k] = *(const PG8_LAS bf16x8*)(lds + PG8_SA(b, h) + aoff + m * 2048 + k * 1024); } while (0)
#define PG8_LDB(dst, b, h) do { _Pragma("unroll") for (int n = 0; n < 2; ++n) _Pragma("unroll") for (int k = 0; k < 2; ++k) dst[n][k] = *(const PG8_LAS bf16x8*)(lds + PG8_SB(b, h) + boff + n * 2048 + k * 1024); } while (0)
#define PG8_MMA(ai, bj, At, Bt) do { __builtin_amdgcn_s_setprio(1); _Pragma("unroll") for (int m = 0; m < 4; ++m) _Pragma("unroll") for (int n = 0; n < 2; ++n) _Pragma("unroll") for (int k = 0; k < 2; ++k) \
        acc[ai][bj][m][n] = __builtin_amdgcn_mfma_f32_16x16x32_bf16(Bt[n][k], At[m][k], acc[ai][bj][m][n], 0, 0, 0); __builtin_amdgcn_s_setprio(0); } while (0)
#define PG8_WAIT_V(n) asm volatile("s_waitcnt vmcnt(" #n ")" ::: "memory")
#define PG8_WAIT_L(n) asm volatile("s_waitcnt lgkmcnt(" #n ")" ::: "memory")
#define PG8_BAR __builtin_amdgcn_s_barrier()
#define PG8_SCHED __builtin_amdgcn_sched_barrier(0)
    Unit cur, nxt; int ui = 0;
    if (!S.next(0, cur)) return;
    f32x4 acc[2][2][4][2];
#pragma unroll
    for (int a = 0; a < 2; ++a)
#pragma unroll
        for (int b = 0; b < 2; ++b)
#pragma unroll
            for (int m = 0; m < 4; ++m)
#pragma unroll
                for (int n = 0; n < 2; ++n) acc[a][b][m][n] = (f32x4){0.f, 0.f, 0.f, 0.f};
    bf16x8 At[4][2], B0[2][2], B1[2][2];
    const char* cA = S.a_base(g, cur); const char* cB = S.b_base(g, cur);
    if constexpr (GATHER) { PG8_GATHER_OFFS(voA, cur); }
    S.a_ready(cur);
    if constexpr (SP2) {
        PG8_STAGE(PG8_SB(0, 0), cB, voffB); PG8_STAGE(PG8_SB(0, 1), cB + hstep, voffB); PG8_STAGE_A(PG8_SA(0, 0), cA, 0, voA); PG8_STAGE_A(PG8_SA(0, 1), cA, 1, voA);
        if (wr == 1) PG8_BAR;
        PG8_WAIT_V(2); PG8_BAR;
        PG8_STAGE(PG8_SB(1, 0), cB + kstep, voffB); PG8_STAGE_A(PG8_SA(1, 0), cA + kstep, 0, voA); PG8_STAGE(PG8_SB(1, 1), cB + hstep + kstep, voffB);
        PG8_WAIT_V(6); PG8_BAR;
    } else {
        PG8_STAGE(PG8_SB(0, 0), cB, voffB); PG8_STAGE_A(PG8_SA(0, 0), cA, 0, voA); PG8_STAGE(PG8_SB(0, 1), cB + hstep, voffB); PG8_STAGE_A(PG8_SA(0, 1), cA, 1, voA);
        if (wr == 1) PG8_BAR;
        PG8_WAIT_V(4); PG8_BAR;
        PG8_STAGE(PG8_SB(1, 0), cB + kstep, voffB); PG8_STAGE_A(PG8_SA(1, 0), cA + kstep, 0, voA); PG8_STAGE(PG8_SB(1, 1), cB + hstep + kstep, voffB);
        PG8_WAIT_V(6); PG8_BAR;
    }
    for (;;) {
        const bool has_next = S.next(ui + 1, nxt);
        const char* nA = has_next ? S.a_base(g, nxt) : cA; const char* nB = has_next ? S.b_base(g, nxt) : cB;
        if constexpr (GATHER) { if (has_next) { PG8_GATHER_OFFS(voAn, nxt); } else {
#pragma unroll
            for (int _h = 0; _h < 2; ++_h) { voAn[_h][0] = voA[_h][0]; voAn[_h][1] = voA[_h][1]; } } }
        for (int t = 0; t < nt; t += 2) {
            const bool last = (t == nt - 2);
            const char* a1 = cA + (size_t)(t + 1) * kstep;
            const char* a2 = last ? nA : cA + (size_t)(t + 2) * kstep; const char* b2 = last ? nB : cB + (size_t)(t + 2) * kstep;
            const char* a3 = a2 + kstep; const char* b3 = b2 + kstep;
            if (last && has_next) S.a_ready(nxt);
            if constexpr (SP2) {
            PG8_LDB(B0, 0, 0); PG8_LDB(B1, 0, 1); PG8_SCHED; PG8_LDA(At, 0, 0); PG8_STAGE_A(PG8_SA(1, 1), a1, 1, voA);
            PG8_WAIT_V(8); PG8_WAIT_L(0); PG8_BAR; PG8_MMA(0, 0, At, B0); PG8_MMA(0, 1, At, B1); PG8_BAR; PG8_SCHED;
            PG8_LDA(At, 0, 1); PG8_STAGE(PG8_SB(0, 0), b2, voffB); PG8_STAGE(PG8_SB(0, 1), b2 + hstep, voffB); if (last) { PG8_STAGE_A(PG8_SA(0, 0), a2, 0, voAn); } else { PG8_STAGE_A(PG8_SA(0, 0), a2, 0, voA); }
            PG8_WAIT_V(8); PG8_WAIT_L(0); PG8_BAR; PG8_MMA(1, 0, At, B0); PG8_MMA(1, 1, At, B1); PG8_BAR; PG8_SCHED;
            PG8_LDB(B0, 1, 0); PG8_LDB(B1, 1, 1); PG8_SCHED; PG8_LDA(At, 1, 0); if (last) { PG8_STAGE_A(PG8_SA(0, 1), a2, 1, voAn); } else { PG8_STAGE_A(PG8_SA(0, 1), a2, 1, voA); }
            PG8_WAIT_V(8); PG8_WAIT_L(0); PG8_BAR; PG8_MMA(0, 0, At, B0); PG8_MMA(0, 1, At, B1); PG8_BAR; PG8_SCHED;
            PG8_LDA(At, 1, 1); PG8_STAGE(PG8_SB(1, 0), b3, voffB); PG8_STAGE(PG8_SB(1, 1), b3 + hstep, voffB); if (last) { PG8_STAGE_A(PG8_SA(1, 0), a3, 0, voAn); } else { PG8_STAGE_A(PG8_SA(1, 0), a3, 0, voA); }
            PG8_WAIT_V(8); PG8_WAIT_L(0); PG8_BAR; PG8_MMA(1, 0, At, B0); PG8_MMA(1, 1, At, B1); PG8_BAR; PG8_SCHED;
            } else {
            PG8_LDB(B0, 0, 0); PG8_SCHED; PG8_LDA(At, 0, 0); PG8_STAGE(PG8_SA(1, 1), a1 + hstep, voffA);
            PG8_WAIT_L(8); PG8_BAR; PG8_WAIT_L(0); PG8_MMA(0, 0, At, B0); PG8_BAR; PG8_SCHED;
            PG8_LDB(B1, 0, 1); PG8_STAGE(PG8_SB(0, 0), b2, voffB);
            PG8_BAR; PG8_WAIT_L(0); PG8_MMA(0, 1, At, B1); PG8_BAR;
            PG8_LDA(At, 0, 1); PG8_STAGE(PG8_SA(0, 0), a2, voffA);
            PG8_BAR; PG8_WAIT_L(0); PG8_MMA(1, 0, At, B0); PG8_BAR; PG8_SCHED;
            PG8_STAGE(PG8_SB(0, 1), b2 + hstep, voffB);
            PG8_WAIT_V(6); PG8_BAR; PG8_MMA(1, 1, At, B1); PG8_BAR;
            PG8_LDB(B0, 1, 0); PG8_SCHED; PG8_LDA(At, 1, 0); PG8_STAGE(PG8_SA(0, 1), a2 + hstep, voffA);
            PG8_WAIT_L(8); PG8_BAR; PG8_WAIT_L(0); PG8_MMA(0, 0, At, B0); PG8_BAR; PG8_SCHED;
            PG8_LDB(B1, 1, 1); PG8_STAGE(PG8_SB(1, 0), b3, voffB);
            PG8_BAR; PG8_WAIT_L(0); PG8_MMA(0, 1, At, B1); PG8_BAR;
            PG8_LDA(At, 1, 1); PG8_STAGE(PG8_SA(1, 0), a3, voffA);
            PG8_BAR; PG8_WAIT_L(0); PG8_MMA(1, 0, At, B0); PG8_BAR; PG8_SCHED;
            PG8_STAGE(PG8_SB(1, 1), b3 + hstep, voffB);
            PG8_WAIT_V(6); PG8_BAR; PG8_MMA(1, 1, At, B1); PG8_BAR;
            }
        }
        if constexpr (ALIGN_EPI) { if (wr == 0) PG8_BAR; }
        if constexpr (!Epi::AFTER_DRAIN) { E(acc, cur, wr, wc, fr, fq); S.done(cur); }
        if (!has_next) break;
#pragma unroll
        for (int a = 0; a < 2; ++a)
#pragma unroll
            for (int b = 0; b < 2; ++b)
#pragma unroll
                for (int m = 0; m < 4; ++m)
#pragma unroll
                    for (int n = 0; n < 2; ++n) acc[a][b][m][n] = (f32x4){0.f, 0.f, 0.f, 0.f};
        cur = nxt; cA = nA; cB = nB; ++ui;
        if constexpr (GATHER) {
#pragma unroll
            for (int _h = 0; _h < 2; ++_h) { voA[_h][0] = voAn[_h][0]; voA[_h][1] = voAn[_h][1]; } }
        if constexpr (ALIGN_EPI) { if (wr == 1) PG8_BAR; }
    }
    PG8_WAIT_V(0);
    if constexpr (!ALIGN_EPI) { if (wr == 0) PG8_BAR; }
    PG8_BAR;
    if constexpr (Epi::AFTER_DRAIN) { E.fused(acc, cur, wr, wc, fr, fq, lds, wid, lane); S.done(cur); }
#undef PG8_SA
#undef PG8_SB
#undef PG8_STAGE
#undef PG8_STAGE_A
#undef PG8_GATHER_OFFS
#undef PG8_LDA
#undef PG8_LDB
#undef PG8_MMA
#undef PG8_WAIT_V
#undef PG8_WAIT_L
#undef PG8_BAR
#undef PG8_SCHED
}
}
#define LAS __attribute__((address_space(3)))
#define XB_TMO      128
#define XB_XCNT(j)  (256  + 64 * (j))
#define XB_XSUB(j)  (1280 + 64 * (j))
#define XB_XGEN(j)  (2304 + 64 * (j))
#define XB_TOP      3328
#define XB_TOPGEN   3392
#define XCD_BAR_WORDS 3456
#define XB_SPIN_CAP (1u << 18)

__device__ __forceinline__ unsigned xb_ld(unsigned* p)              { return __hip_atomic_load(p, __ATOMIC_RELAXED, __HIP_MEMORY_SCOPE_AGENT); }
__device__ __forceinline__ unsigned xb_add(unsigned* p, unsigned v) { return __hip_atomic_fetch_add(p, v, __ATOMIC_RELAXED, __HIP_MEMORY_SCOPE_AGENT); }
__device__ __forceinline__ unsigned xb_xcc_id() { return (unsigned)__builtin_amdgcn_s_getreg((3 << 11) | 20) & 0xFu; }
#define XB_SPIN(cond, bar) do { unsigned _sp = 0; while (cond) { __builtin_amdgcn_s_sleep(1); \
    if ((++_sp & 255u) == 0u) { if (xb_ld(&(bar)[XB_TMO])) break; if (_sp > XB_SPIN_CAP) { atomicAdd(&(bar)[XB_TMO], 1u); break; } } } } while (0)

struct XcdBarrier {
    unsigned* bar; unsigned x;
    volatile LAS unsigned* st;
};

__device__ __forceinline__ XcdBarrier xcd_barrier_post(unsigned* bar, volatile LAS unsigned* st) {
    XcdBarrier b; b.bar = bar; b.x = xb_xcc_id(); b.st = st;
    if (threadIdx.x == 0) (void)xb_add(&bar[XB_XCNT(b.x)], 1u);
    return b;
}
__device__ __forceinline__ void xcd_barrier_complete(unsigned* bar, unsigned x, unsigned& nloc, unsigned& nx) {
    const unsigned G = gridDim.x * gridDim.y * gridDim.z;
    unsigned sum, cnt, mine, sp = 0u;
    for (;;) {
        sum = 0u; cnt = 0u; mine = 0u;
#pragma unroll
        for (unsigned j = 0; j < 16; ++j) { const unsigned c = xb_ld(&bar[XB_XCNT(j)]); sum += c; cnt += (c > 0u) ? 1u : 0u; mine = (j == x) ? c : mine; }
        if (sum == G) break;
        __builtin_amdgcn_s_sleep(1);
        if ((++sp & 255u) == 0u) { if (xb_ld(&bar[XB_TMO])) break; if (sp > XB_SPIN_CAP) { atomicAdd(&bar[XB_TMO], 1u); break; } }
    }
    nloc = mine > 0u ? mine : 1u; nx = cnt > 0u ? cnt : 1u;
}

__device__ __forceinline__ void xcd_barrier(const XcdBarrier& b) {
    asm volatile("s_waitcnt vmcnt(0)" ::: "memory");
    __syncthreads();
    if (threadIdx.x == 0) {
        unsigned* bar = b.bar;
        __builtin_amdgcn_s_waitcnt(0);
        unsigned nloc = b.st[0], nx = b.st[1];
        if (nloc == 0u) { xcd_barrier_complete(bar, b.x, nloc, nx); b.st[0] = nloc; b.st[1] = nx; }
        const unsigned old = xb_add(&bar[XB_XSUB(b.x)], 1u);
        const unsigned gen = old / nloc;
        if (old + 1u == (gen + 1u) * nloc) {
            __builtin_amdgcn_fence(__ATOMIC_RELEASE, "agent");
            asm volatile("s_waitcnt vmcnt(0)" ::: "memory");
            const unsigned og = xb_add(&bar[XB_TOP], 1u);
            const unsigned tg = og / nx;
            if (og + 1u == (tg + 1u) * nx) xb_add(&bar[XB_TOPGEN], 1u);
            else XB_SPIN(xb_ld(&bar[XB_TOPGEN]) == tg, bar);
            __builtin_amdgcn_fence(__ATOMIC_ACQUIRE, "agent");
            xb_add(&bar[XB_XGEN(b.x)], 1u);
            asm volatile("s_waitcnt vmcnt(0)" ::: "memory");
        } else {
            XB_SPIN(xb_ld(&bar[XB_XGEN(b.x)]) == gen, bar);
            __builtin_amdgcn_fence(__ATOMIC_ACQUIRE, "agent");
            asm volatile("s_waitcnt vmcnt(0)" ::: "memory");
        }
    }
    __syncthreads();
}

#define GAS __attribute__((address_space(1)))
typedef unsigned v4u __attribute__((ext_vector_type(4)));
#define LDS_WAIT() asm volatile("s_waitcnt lgkmcnt(0)" ::: "memory")
constexpr int NWAVES = 8;
constexpr int RING_BYTES = 139264, LDSCTL_OFF = RING_BYTES, MISC_OFF = LDSCTL_OFF + 320, LDS_BYTES = 155648;
constexpr size_t CTL_ZERO_BYTES = 1 * MiB;
constexpr int CW_BAR = 4096;
constexpr int MAX_LAUNCHES = 12;
static_assert((CW_BAR + MAX_LAUNCHES * XCD_BAR_WORDS) * 4 <= (int)CTL_ZERO_BYTES, "ctl");

constexpr size_t WS_WINT = 1 * MiB, WS_WOUTT = 6 * MiB, WS_W13T = 8 * MiB, WS_W2T = 72 * MiB;
constexpr size_t WS_HN1 = 104 * MiB, WS_LRU = 168 * MiB, WS_HYUT = 232 * MiB, WS_HF = 396 * MiB, WS_HB = 428 * MiB;
constexpr size_t WS_YHYT = 104 * MiB, WS_YCAT = 232 * MiB, WS_HN2 = 168 * MiB, WS_EID = 460 * MiB, WS_GATE = 461 * MiB;
constexpr size_t WS_LIST = 460 * MiB, WS_LGATE = 464 * MiB, WS_TOKINFO = 468 * MiB, WS_WRT = 469 * MiB, WS_SGATE = 470 * MiB;
constexpr size_t WS_XS = 232 * MiB, WS_H = 376 * MiB, WS_Y = 104 * MiB;
constexpr size_t WS_XC = 104 * MiB, WS_Z2 = 392 * MiB, WS_KT = 328 * MiB;
constexpr int CW_CNT = 2048;
constexpr int LC_CNT = RING_BYTES + 1024, LC_BASE = RING_BYTES + 1152, LC_TSTART = RING_BYTES + 1280, LC_TILEE = RING_BYTES + 2048;

struct Args { const float* in[37]; float* out; unsigned char* ws; int ph_lo, ph_hi, li, pad; };

__device__ __forceinline__ unsigned pk2(float lo, float hi) { return (unsigned)f2bf(lo) | ((unsigned)f2bf(hi) << 16); }

__device__ __forceinline__ void p0_transpose_item(const float* __restrict__ W, int K, int N, bf16* __restrict__ WT, int drow0, LAS float* scr, int k0, int n0, int lane) {
#pragma unroll 8
    for (int i = 0; i < 32; ++i) { const int kk = 2 * i + (lane >> 5); scr[kk * 33 + (lane & 31)] = W[(size_t)(k0 + kk) * N + n0 + (lane & 31)]; }
    LDS_WAIT(); asm volatile("" ::: "memory");
    const int c = lane & 7;
#pragma unroll
    for (int j = 0; j < 4; ++j) { const int n = (lane >> 3) + 8 * j; const LAS float* s = scr + (8 * c) * 33 + n;
        v4u o; o.x = pk2(s[0 * 33], s[1 * 33]); o.y = pk2(s[2 * 33], s[3 * 33]); o.z = pk2(s[4 * 33], s[5 * 33]); o.w = pk2(s[6 * 33], s[7 * 33]);
        *(v4u*)(WT + (size_t)(drow0 + n) * K + k0 + 8 * c) = o; }
    LDS_WAIT(); asm volatile("" ::: "memory");
}
__device__ __forceinline__ void rms_row_to_bf16(const float* __restrict__ xrow, const float* __restrict__ g, bf16* __restrict__ orow, int lane) {
    const float4* xr = (const float4*)xrow;
    float4 v[4]; float s = 0.f;
#pragma unroll
    for (int j = 0; j < 4; ++j) { v[j] = xr[lane + 64 * j]; s += (v[j].x * v[j].x + v[j].y * v[j].y) + (v[j].z * v[j].z + v[j].w * v[j].w); }
    s = wave_sum(s);
    const float rstd = rsqrtf(s * (1.0f / DM) + EPS);
#pragma unroll
    for (int j = 0; j < 4; ++j) { const int c = (lane + 64 * j) * 4; const float4 gg = *(const float4*)(g + c);
        uint2 o; o.x = pk2(v[j].x * rstd * gg.x, v[j].y * rstd * gg.y); o.y = pk2(v[j].z * rstd * gg.z, v[j].w * rstd * gg.w);
        *(uint2*)(orow + c) = o; }
}


typedef short bf16x8_t __attribute__((ext_vector_type(8)));
typedef float f32x4_t __attribute__((ext_vector_type(4)));
__device__ __forceinline__ int moe_tables(LAS unsigned char* L, unsigned* ctl, int tid) {
    LAS int* cnt = (LAS int*)(L + LC_CNT); LAS int* tstart = (LAS int*)(L + LC_TSTART); LAS int* tile_e = (LAS int*)(L + LC_TILEE);
    __syncthreads();
    if (tid < 32) cnt[tid] = (int)__hip_atomic_load(ctl + CW_CNT + tid, __ATOMIC_RELAXED, __HIP_MEMORY_SCOPE_AGENT);
    __syncthreads();
    if (tid == 0) { int ts = 0; for (int e = 0; e < 32; ++e) { tstart[e] = ts; const int nt = (cnt[e] + 255) >> 8; for (int i = 0; i < nt; ++i) tile_e[ts + i] = e; ts += nt; } tstart[32] = ts; }
    __syncthreads();
    return tstart[32];
}

__device__ __forceinline__ void lru_load_frags(const bf16* xrow0, int sg0, int jl, int dir, v4u (&fr)[4][2]) {
#pragma unroll
    for (int mt = 0; mt < 4; ++mt) { const int sg = 16 * (jl >> 2) + 4 * mt + (jl & 3); const int tau = sg0 + sg; const int t = dir ? (SEQ - 1 - tau) : tau;
#pragma unroll
        for (int s = 0; s < 2; ++s) fr[mt][s] = *(const v4u*)(xrow0 + (size_t)t * 64 + 32 * s); }
}
__device__ __forceinline__ void lru_item(LAS unsigned char* L, const Args& a, int item, const bf16* __restrict__ xcb, bf16* __restrict__ hf, bf16* __restrict__ hb, int tid, int lane, int wave) {
    const int b = item >> 6, h = (item >> 3) & 7, q4 = (item >> 1) & 3, dir = item & 1;
    const float* wr = dir ? a.in[10] : a.in[5]; const float* br = dir ? a.in[11] : a.in[6]; const float* wi = dir ? a.in[12] : a.in[7];
    const float* bi = dir ? a.in[13] : a.in[8]; const float* lam = dir ? a.in[14] : a.in[9];
    bf16* outp = dir ? hb : hf;
    LAS float* carry = (LAS float*)(L + 2048);
    const int jl = lane & 15, kg = lane >> 4;
    const int c = 64 * h + 16 * q4 + jl;
    bf16x8_t Br[2], Bi[2], Bid;
#pragma unroll
    for (int s = 0; s < 2; ++s)
#pragma unroll
        for (int j = 0; j < 8; ++j) { const int i = 32 * s + 8 * kg + j;
            Br[s][j] = (short)f2bf(wr[h * 4096 + i * 64 + 16 * q4 + jl]); Bi[s][j] = (short)f2bf(wi[h * 4096 + i * 64 + 16 * q4 + jl]); }
#pragma unroll
    for (int j = 0; j < 8; ++j) Bid[j] = (8 * kg + j == 16 * (q4 & 1) + jl) ? (short)0x3f80 : (short)0;
    const int sid = q4 >> 1;
    const float brc = br[c], bic = bi[c];
    const float sp8l = 8.0f * log1pf(expf(-lam[c])) * 1.4426950408889634f;
    __syncthreads();
    float Hblk = 0.f;
    const bf16* xrow0 = xcb + ((size_t)(b * 8 + h) * SEQ) * 64 + 8 * kg;
    v4u frn[4][2];
    lru_load_frags(xrow0, 64 * wave, jl, dir, frn);
    for (int it = 0; it < 16; ++it) {
        const int sg0 = 512 * it + 64 * wave;
        bf16x8_t Af[4][2];
#pragma unroll
        for (int mt = 0; mt < 4; ++mt)
#pragma unroll
            for (int s = 0; s < 2; ++s) Af[mt][s] = __builtin_bit_cast(bf16x8_t, frn[mt][s]);
        if (it < 15) lru_load_frags(xrow0, sg0 + 512, jl, dir, frn);
        float hloc[16], Ploc[16];
        float hl = 0.f, P = 1.f;
#pragma unroll
        for (int mt = 0; mt < 4; ++mt) {
            f32x4_t aR = {0.f, 0.f, 0.f, 0.f}, aI = aR, aX = aR;
            aR = __builtin_amdgcn_mfma_f32_16x16x32_bf16(Af[mt][0], Br[0], aR, 0, 0, 0); aR = __builtin_amdgcn_mfma_f32_16x16x32_bf16(Af[mt][1], Br[1], aR, 0, 0, 0);
            aI = __builtin_amdgcn_mfma_f32_16x16x32_bf16(Af[mt][0], Bi[0], aI, 0, 0, 0); aI = __builtin_amdgcn_mfma_f32_16x16x32_bf16(Af[mt][1], Bi[1], aI, 0, 0, 0);
            aX = __builtin_amdgcn_mfma_f32_16x16x32_bf16(sid ? Af[mt][1] : Af[mt][0], Bid, aX, 0, 0, 0);
#pragma unroll
            for (int r = 0; r < 4; ++r) {
                const float rg = __builtin_amdgcn_rcpf(1.0f + __builtin_amdgcn_exp2f(-1.4426950408889634f * (aR[r] + brc)));
                const float ig = __builtin_amdgcn_rcpf(1.0f + __builtin_amdgcn_exp2f(-1.4426950408889634f * (aI[r] + bic)));
                const float av = __builtin_amdgcn_exp2f(-rg * sp8l);
                const float bb = __builtin_amdgcn_sqrtf(fmaxf(1.0f - av * av, 0.f)) * (ig * aX[r]);
                hl = av * hl + bb; P *= av;
                hloc[4 * mt + r] = hl; Ploc[4 * mt + r] = P;
            }
        }
        const float A0 = __shfl(P, jl), B0 = __shfl(hl, jl), A1 = __shfl(P, jl + 16), B1 = __shfl(hl, jl + 16);
        const float A2 = __shfl(P, jl + 32), B2 = __shfl(hl, jl + 32), A3 = __shfl(P, jl + 48), B3 = __shfl(hl, jl + 48);
        LAS float* cbuf = carry + (it & 1) * 256;
        if (kg == 0) { cbuf[(wave * 16 + jl) * 2 + 0] = A0 * A1 * A2 * A3; cbuf[(wave * 16 + jl) * 2 + 1] = ((B0 * A1 + B1) * A2 + B2) * A3 + B3; }
        __syncthreads();
        float Hw = Hblk, Hn = Hblk;
#pragma unroll
        for (int w2 = 0; w2 < 8; ++w2) { const float Aq = cbuf[(w2 * 16 + jl) * 2 + 0], Bq = cbuf[(w2 * 16 + jl) * 2 + 1];
            if (w2 < wave) Hw = Aq * Hw + Bq;
            Hn = Aq * Hn + Bq; }
        Hblk = Hn;
        float Hin = Hw;
        if (kg >= 1) Hin = A0 * Hin + B0;
        if (kg >= 2) Hin = A1 * Hin + B1;
        if (kg >= 3) Hin = A2 * Hin + B2;
#pragma unroll
        for (int k = 0; k < 16; ++k) { const int tau = sg0 + 16 * kg + k; const int t = dir ? (SEQ - 1 - tau) : tau;
            outp[((size_t)b * SEQ + t) * DL + c] = f2bf(hloc[k] + Ploc[k] * Hin); }
    }
}

typedef float f32x2_t __attribute__((ext_vector_type(2)));
typedef _Float16 f16x2_t __attribute__((ext_vector_type(2)));
constexpr int LC_TW = RING_BYTES + 4096, LC_TA = RING_BYTES + 8192, LC_TB = RING_BYTES + 9216, LC_RED = RING_BYTES + 3328;
constexpr size_t WS_SPEC = 328 * MiB, WS_HT = 396 * MiB, WS_XCB = 136 * MiB;
__device__ __forceinline__ f32x2_t cmul(f32x2_t a, f32x2_t b) { f32x2_t r; r.x = a.x * b.x - a.y * b.y; r.y = a.x * b.y + a.y * b.x; return r; }
__device__ __forceinline__ f32x2_t h2_to_f2(unsigned u) { const f16x2_t h = __builtin_bit_cast(f16x2_t, u); f32x2_t k; k.x = (float)h.x; k.y = (float)h.y; return k; }
__device__ __forceinline__ f32x2_t cmulc(f32x2_t a, f32x2_t b) { f32x2_t r; r.x = a.x * b.x + a.y * b.y; r.y = a.y * b.x - a.x * b.y; return r; }
template <bool INV> __device__ __forceinline__ f32x2_t twc(f32x2_t d, int e) {
    constexpr float CT[16] = {1.000000000e+00f, 9.807852804e-01f, 9.238795325e-01f, 8.314696123e-01f, 7.071067812e-01f, 5.555702330e-01f, 3.826834324e-01f, 1.950903220e-01f, 6.123233996e-17f, -1.950903220e-01f, -3.826834324e-01f, -5.555702330e-01f, -7.071067812e-01f, -8.314696123e-01f, -9.238795325e-01f, -9.807852804e-01f};
    constexpr float ST[16] = {0.000000000e+00f, 1.950903220e-01f, 3.826834324e-01f, 5.555702330e-01f, 7.071067812e-01f, 8.314696123e-01f, 9.238795325e-01f, 9.807852804e-01f, 1.000000000e+00f, 9.807852804e-01f, 9.238795325e-01f, 8.314696123e-01f, 7.071067812e-01f, 5.555702330e-01f, 3.826834324e-01f, 1.950903220e-01f};
    f32x2_t r;
    if (e == 0) return d;
    if (e == 8) { if (INV) { r.x = -d.y; r.y = d.x; } else { r.x = d.y; r.y = -d.x; } return r; }
    const float c = CT[e], s = INV ? -ST[e] : ST[e];
    if (e == 4) { r.x = (d.x + (INV ? -d.y : d.y)) * c; r.y = (d.y - (INV ? -d.x : d.x)) * c; return r; }
    r.x = d.x * c + d.y * s; r.y = d.y * c - d.x * s; return r;
}
template <int R, bool INV> struct DFT {
    static __device__ __forceinline__ void run(f32x2_t (&x)[R]) {
        f32x2_t u[R / 2], v[R / 2];
#pragma unroll
        for (int k = 0; k < R / 2; ++k) { const f32x2_t p = x[k], q = x[k + R / 2]; u[k] = p + q; v[k] = twc<INV>(p - q, k * (32 / R)); }
        DFT<R / 2, INV>::run(u); DFT<R / 2, INV>::run(v);
#pragma unroll
        for (int q = 0; q < R / 2; ++q) { x[2 * q] = u[q]; x[2 * q + 1] = v[q]; }
    }
};
template <bool INV> struct DFT<1, INV> { static __device__ __forceinline__ void run(f32x2_t (&)[1]) {} };

typedef f16x2_t c16;
__device__ __forceinline__ c16 c16_from(f32x2_t v) { c16 r; r.x = (_Float16)v.x; r.y = (_Float16)v.y; return r; }
__device__ __forceinline__ c16 cmul16(c16 a, c16 w) { c16 wx; wx.x = w.x; wx.y = w.x; c16 wy; wy.x = w.y; wy.y = w.y; c16 at; at.x = -a.y; at.y = a.x; return a * wx + at * wy; }
__device__ __forceinline__ c16 cmulc16(c16 a, c16 w) { c16 wx; wx.x = w.x; wx.y = w.x; c16 wy; wy.x = w.y; wy.y = w.y; c16 at; at.x = a.y; at.y = -a.x; return a * wx + at * wy; }
template <bool INV> __device__ __forceinline__ c16 twc(c16 d, int e) {
    constexpr float CT[16] = {1.000000000e+00f, 9.807852804e-01f, 9.238795325e-01f, 8.314696123e-01f, 7.071067812e-01f, 5.555702330e-01f, 3.826834324e-01f, 1.950903220e-01f, 6.123233996e-17f, -1.950903220e-01f, -3.826834324e-01f, -5.555702330e-01f, -7.071067812e-01f, -8.314696123e-01f, -9.238795325e-01f, -9.807852804e-01f};
    constexpr float ST[16] = {0.000000000e+00f, 1.950903220e-01f, 3.826834324e-01f, 5.555702330e-01f, 7.071067812e-01f, 8.314696123e-01f, 9.238795325e-01f, 9.807852804e-01f, 1.000000000e+00f, 9.807852804e-01f, 9.238795325e-01f, 8.314696123e-01f, 7.071067812e-01f, 5.555702330e-01f, 3.826834324e-01f, 1.950903220e-01f};
    c16 r;
    if (e == 0) return d;
    if (e == 8) { if (INV) { r.x = -d.y; r.y = d.x; } else { r.x = d.y; r.y = -d.x; } return r; }
    const _Float16 c = (_Float16)CT[e], s = (_Float16)(INV ? -ST[e] : ST[e]);
    c16 cc; cc.x = c; cc.y = c; c16 ss; ss.x = s; ss.y = s; c16 dt; dt.x = d.y; dt.y = -d.x;
    return d * cc + dt * ss;
}
template <int R, bool INV> struct DFTH {
    static __device__ __forceinline__ void run(c16 (&x)[R]) {
        c16 u[R / 2], v[R / 2];
#pragma unroll
        for (int k = 0; k < R / 2; ++k) { const c16 p = x[k], q = x[k + R / 2]; u[k] = p + q; v[k] = twc<INV>(p - q, k * (32 / R)); }
        DFTH<R / 2, INV>::run(u); DFTH<R / 2, INV>::run(v);
#pragma unroll
        for (int q = 0; q < R / 2; ++q) { x[2 * q] = u[q]; x[2 * q + 1] = v[q]; }
    }
};
template <bool INV> struct DFTH<1, INV> { static __device__ __forceinline__ void run(c16 (&)[1]) {} };
template <bool CONJ> __device__ __forceinline__ void tw_apply16h(c16 (&x)[16], f32x2_t w1) {
    f32x2_t w = w1;
#pragma unroll
    for (int q = 1; q < 16; ++q) { const c16 wh = c16_from(w); x[q] = CONJ ? cmulc16(x[q], wh) : cmul16(x[q], wh); if (q < 15) w = cmul(w, w1); }
}
#define SWZ(p) ((p) + ((p) >> 5))
constexpr int FBUF = 8448;
template <bool CONJ> __device__ __forceinline__ void tw_apply16(f32x2_t (&x)[16], f32x2_t w1) {
    f32x2_t w = w1;
#pragma unroll
    for (int q = 1; q < 16; ++q) { x[q] = CONJ ? cmulc(x[q], w) : cmul(x[q], w); if (q < 15) w = cmul(w, w1); }
}
__device__ __forceinline__ void fft_tables_init(LAS unsigned char* L, int tid) {
    LAS f32x2_t* TW = (LAS f32x2_t*)(L + LC_TW); LAS f32x2_t* TA = (LAS f32x2_t*)(L + LC_TA); LAS f32x2_t* TB = (LAS f32x2_t*)(L + LC_TB);
    { float s, c; sincospif((float)tid * (1.0f / 4096.0f), &s, &c); f32x2_t w; w.x = c; w.y = -s; TW[tid] = w; }
    if (tid < 128) { float s, c; sincospif((float)tid * (1.0f / 128.0f), &s, &c); f32x2_t w; w.x = c; w.y = -s; TA[tid] = w; }
    if (tid < 64) { float s, c; sincospif((float)tid * (1.0f / 8192.0f), &s, &c); f32x2_t w; w.x = c; w.y = -s; TB[tid] = w; }
    __syncthreads();
}
#define OPAQUE(v) asm volatile("" : "+v"(v))
__device__ __forceinline__ void fwd_pass1(LAS f32x2_t* buf, const LAS f32x2_t* TW, int tid) {
    OPAQUE(tid);
    LAS f32x2_t* b0 = buf + tid + (tid >> 5);
    f32x2_t x[16];
#pragma unroll
    for (int m = 0; m < 16; ++m) x[m] = b0[528 * m];
    DFT<16, false>::run(x); tw_apply16<false>(x, TW[tid]);
#pragma unroll
    for (int q = 0; q < 16; ++q) b0[528 * q] = x[q];
}
__device__ __forceinline__ void fwd_pass2(LAS f32x2_t* buf, const LAS f32x2_t* TW, int tid) {
    OPAQUE(tid);
    LAS f32x2_t* b0 = buf + (tid >> 5) * 528 + (tid & 31);
    f32x2_t x[16];
#pragma unroll
    for (int m = 0; m < 16; ++m) x[m] = b0[33 * m];
    DFT<16, false>::run(x); tw_apply16<false>(x, TW[16 * (tid & 31)]);
#pragma unroll
    for (int q = 0; q < 16; ++q) b0[33 * q] = x[q];
}
__device__ __forceinline__ void inv_pass2(LAS f32x2_t* buf, const LAS f32x2_t* TW, int tid) {
    OPAQUE(tid);
    LAS f32x2_t* b0 = buf + (tid >> 5) * 528 + (tid & 31);
    f32x2_t x[16];
#pragma unroll
    for (int q = 0; q < 16; ++q) x[q] = b0[33 * q];
    tw_apply16<true>(x, TW[16 * (tid & 31)]); DFT<16, true>::run(x);
#pragma unroll
    for (int m = 0; m < 16; ++m) b0[33 * m] = x[m];
}
__device__ __forceinline__ void inv_pass1(LAS f32x2_t* buf, const LAS f32x2_t* TW, int tid) {
    OPAQUE(tid);
    LAS f32x2_t* b0 = buf + tid + (tid >> 5);
    f32x2_t x[16];
#pragma unroll
    for (int q = 0; q < 16; ++q) x[q] = b0[528 * q];
    tw_apply16<true>(x, TW[tid]); DFT<16, true>::run(x);
#pragma unroll
    for (int m = 0; m < 16; ++m) b0[528 * m] = x[m];
}
__device__ __forceinline__ void fft2_forward(LAS unsigned char* L) {
    const int tid = threadIdx.x;
    LAS f32x2_t* bufE = (LAS f32x2_t*)L; LAS f32x2_t* bufO = bufE + FBUF; const LAS f32x2_t* TW = (const LAS f32x2_t*)(L + LC_TW);
    fwd_pass1(bufE, TW, tid); fwd_pass1(bufO, TW, tid);
    __syncthreads();
    fwd_pass2(bufE, TW, tid); fwd_pass2(bufO, TW, tid);
    __syncthreads();
}
template <int MODE>
__device__ __forceinline__ void fft2_middle(LAS unsigned char* L, unsigned* specblk) {
    int tid = threadIdx.x; OPAQUE(tid); const int bsel = tid >> 8, blk = tid & 255;
    LAS f32x2_t* buf = (LAS f32x2_t*)L + (bsel ? FBUF : 0);
    f32x2_t x[32];
    LAS f32x2_t* bm = buf + 33 * blk;
#pragma unroll
    for (int q = 0; q < 32; ++q) x[q] = bm[q];
    DFT<32, false>::run(x);
    unsigned* sp = specblk + (size_t)bsel * 8192 + 32 * blk;
    if (MODE == 0) {
#pragma unroll
        for (int q = 0; q < 32; q += 4) { v4u w;
            { f16x2_t h; h.x = (_Float16)(16.0f * x[q].x); h.y = (_Float16)(16.0f * x[q].y); w.x = __builtin_bit_cast(unsigned, h); }
            { f16x2_t h; h.x = (_Float16)(16.0f * x[q + 1].x); h.y = (_Float16)(16.0f * x[q + 1].y); w.y = __builtin_bit_cast(unsigned, h); }
            { f16x2_t h; h.x = (_Float16)(16.0f * x[q + 2].x); h.y = (_Float16)(16.0f * x[q + 2].y); w.z = __builtin_bit_cast(unsigned, h); }
            { f16x2_t h; h.x = (_Float16)(16.0f * x[q + 3].x); h.y = (_Float16)(16.0f * x[q + 3].y); w.w = __builtin_bit_cast(unsigned, h); }
            *(v4u*)(sp + q) = w; }
    } else {
#pragma unroll
        for (int q = 0; q < 32; q += 4) { const v4u w = *(const v4u*)(sp + q);
            const unsigned w0 = w.x, w1 = w.y, w2 = w.z, w3 = w.w;
            x[q] = cmul(x[q], h2_to_f2(w0)); x[q + 1] = cmul(x[q + 1], h2_to_f2(w1)); x[q + 2] = cmul(x[q + 2], h2_to_f2(w2)); x[q + 3] = cmul(x[q + 3], h2_to_f2(w3)); }
        DFT<32, true>::run(x);
#pragma unroll
        for (int q = 0; q < 32; ++q) bm[q] = x[q];
    }
    __syncthreads();
}
__device__ __forceinline__ void fft2_inverse(LAS unsigned char* L) {
    const int tid = threadIdx.x;
    LAS f32x2_t* bufE = (LAS f32x2_t*)L; LAS f32x2_t* bufO = bufE + FBUF; const LAS f32x2_t* TW = (const LAS f32x2_t*)(L + LC_TW);
    inv_pass2(bufE, TW, tid); inv_pass2(bufO, TW, tid);
    __syncthreads();
    inv_pass1(bufE, TW, tid); inv_pass1(bufO, TW, tid);
}

__device__ __forceinline__ void fwd_pass1h(LAS c16* buf, const LAS f32x2_t* TW, int tid) {
    OPAQUE(tid);
    LAS c16* b0 = buf + tid + (tid >> 5);
    c16 x[16];
#pragma unroll
    for (int m = 0; m < 16; ++m) x[m] = b0[528 * m];
    DFTH<16, false>::run(x); tw_apply16h<false>(x, TW[tid]);
#pragma unroll
    for (int q = 0; q < 16; ++q) b0[528 * q] = x[q];
}
__device__ __forceinline__ void fwd_pass2h(LAS c16* buf, const LAS f32x2_t* TW, int tid) {
    OPAQUE(tid);
    LAS c16* b0 = buf + (tid >> 5) * 528 + (tid & 31);
    c16 x[16];
#pragma unroll
    for (int m = 0; m < 16; ++m) x[m] = b0[33 * m];
    DFTH<16, false>::run(x); tw_apply16h<false>(x, TW[16 * (tid & 31)]);
#pragma unroll
    for (int q = 0; q < 16; ++q) b0[33 * q] = x[q];
}
__device__ __forceinline__ void inv_pass2h(LAS c16* buf, const LAS f32x2_t* TW, int tid) {
    OPAQUE(tid);
    LAS c16* b0 = buf + (tid >> 5) * 528 + (tid & 31);
    c16 x[16];
#pragma unroll
    for (int q = 0; q < 16; ++q) x[q] = b0[33 * q];
    tw_apply16h<true>(x, TW[16 * (tid & 31)]); DFTH<16, true>::run(x);
    c16 sc; sc.x = (_Float16)0.0625f; sc.y = (_Float16)0.0625f;
#pragma unroll
    for (int m = 0; m < 16; ++m) b0[33 * m] = x[m] * sc;
}
__device__ __forceinline__ void inv_pass1h(LAS c16* buf, const LAS f32x2_t* TW, int tid) {
    OPAQUE(tid);
    LAS c16* b0 = buf + tid + (tid >> 5);
    c16 x[16];
#pragma unroll
    for (int q = 0; q < 16; ++q) x[q] = b0[528 * q];
    tw_apply16h<true>(x, TW[tid]); DFTH<16, true>::run(x);
#pragma unroll
    for (int m = 0; m < 16; ++m) b0[528 * m] = x[m];
}
__device__ __forceinline__ void fft2h_forward(LAS unsigned char* L) {
    const int tid = threadIdx.x;
    LAS c16* bufE = (LAS c16*)L; LAS c16* bufO = bufE + FBUF; const LAS f32x2_t* TW = (const LAS f32x2_t*)(L + LC_TW);
    fwd_pass1h(bufE, TW, tid); fwd_pass1h(bufO, TW, tid);
    __syncthreads();
    fwd_pass2h(bufE, TW, tid); fwd_pass2h(bufO, TW, tid);
    __syncthreads();
}
__device__ __forceinline__ void fft2h_middle(LAS unsigned char* L, const unsigned* specblk) {
    int tid = threadIdx.x; OPAQUE(tid); const int bsel = tid >> 8, blk = tid & 255;
    LAS c16* bm = (LAS c16*)L + (bsel ? FBUF : 0) + 33 * blk;
    c16 x[32];
#pragma unroll
    for (int q = 0; q < 32; ++q) x[q] = bm[q];
    DFTH<32, false>::run(x);
    const unsigned* sp = specblk + (size_t)bsel * 8192 + 32 * blk;
#pragma unroll
    for (int q = 0; q < 32; q += 4) { const v4u w = *(const v4u*)(sp + q);
        const unsigned w0 = w.x, w1 = w.y, w2 = w.z, w3 = w.w;
        x[q] = cmul16(x[q], __builtin_bit_cast(c16, w0)); x[q + 1] = cmul16(x[q + 1], __builtin_bit_cast(c16, w1));
        x[q + 2] = cmul16(x[q + 2], __builtin_bit_cast(c16, w2)); x[q + 3] = cmul16(x[q + 3], __builtin_bit_cast(c16, w3)); }
    DFTH<32, true>::run(x);
    c16 sc; sc.x = (_Float16)0.0625f; sc.y = (_Float16)0.0625f;
#pragma unroll
    for (int q = 0; q < 32; ++q) bm[q] = x[q] * sc;
    __syncthreads();
}

__device__ __forceinline__ void fft2h_middle_store(LAS unsigned char* L, unsigned* specblk) {
    int tid = threadIdx.x; OPAQUE(tid); const int bsel = tid >> 8, blk = tid & 255;
    LAS c16* bm = (LAS c16*)L + (bsel ? FBUF : 0) + 33 * blk;
    c16 x[32];
#pragma unroll
    for (int q = 0; q < 32; ++q) x[q] = bm[q];
    DFTH<32, false>::run(x);
    c16 sc; sc.x = (_Float16)(1.0f / 256.0f); sc.y = (_Float16)(1.0f / 256.0f);
    unsigned* sp = specblk + (size_t)bsel * 8192 + 32 * blk;
#pragma unroll
    for (int q = 0; q < 32; q += 4) { v4u w;
        { const c16 h = x[q] * sc; w.x = __builtin_bit_cast(unsigned, h); } { const c16 h = x[q + 1] * sc; w.y = __builtin_bit_cast(unsigned, h); }
        { const c16 h = x[q + 2] * sc; w.z = __builtin_bit_cast(unsigned, h); } { const c16 h = x[q + 3] * sc; w.w = __builtin_bit_cast(unsigned, h); }
        *(v4u*)(sp + q) = w; }
    __syncthreads();
}
__device__ __forceinline__ void fft2h_inverse(LAS unsigned char* L) {
    const int tid = threadIdx.x;
    LAS c16* bufE = (LAS c16*)L; LAS c16* bufO = bufE + FBUF; const LAS f32x2_t* TW = (const LAS f32x2_t*)(L + LC_TW);
    inv_pass2h(bufE, TW, tid); inv_pass2h(bufO, TW, tid);
    __syncthreads();
    inv_pass1h(bufE, TW, tid); inv_pass1h(bufO, TW, tid);
}
__device__ __forceinline__ f32x2_t wn16384(const LAS f32x2_t* TA, f32x2_t wb, int tid, int m) { return cmul(TA[(tid >> 6) + 8 * m], wb); }
__device__ __forceinline__ float hy_conv3(const bf16* row, float w0, float w1, float w2, float bias, int n) {
    const int nm = n > 0 ? n - 1 : 0, np = n < SEQ - 1 ? n + 1 : SEQ - 1;
    const float wl = n > 0 ? w0 : 0.f, wr = n < SEQ - 1 ? w2 : 0.f;
    return bias + w1 * bf2f(row[n]) + wl * bf2f(row[nm]) + wr * bf2f(row[np]);
}

__device__ __forceinline__ void load_conv16(const bf16* row, int n0, float w0, float w1, float w2, float bias, float (&out)[16]) {
    const v4u a = *(const v4u*)(row + n0), b = *(const v4u*)(row + n0 + 8);
    const int nl = n0 > 0 ? n0 - 1 : 0, nr = n0 + 16 < SEQ ? n0 + 16 : SEQ - 1;
    const float ul = n0 > 0 ? bf2f(row[nl]) : 0.f, ur = n0 + 16 < SEQ ? bf2f(row[nr]) : 0.f;
    const unsigned a0 = a.x, a1 = a.y, a2 = a.z, a3 = a.w, b0 = b.x, b1 = b.y, b2 = b.z, b3 = b.w;
    float u[18];
    u[0] = ul; u[17] = ur;
    u[1] = __uint_as_float(a0 << 16); u[2] = __uint_as_float(a0 & 0xffff0000u); u[3] = __uint_as_float(a1 << 16); u[4] = __uint_as_float(a1 & 0xffff0000u);
    u[5] = __uint_as_float(a2 << 16); u[6] = __uint_as_float(a2 & 0xffff0000u); u[7] = __uint_as_float(a3 << 16); u[8] = __uint_as_float(a3 & 0xffff0000u);
    u[9] = __uint_as_float(b0 << 16); u[10] = __uint_as_float(b0 & 0xffff0000u); u[11] = __uint_as_float(b1 << 16); u[12] = __uint_as_float(b1 & 0xffff0000u);
    u[13] = __uint_as_float(b2 << 16); u[14] = __uint_as_float(b2 & 0xffff0000u); u[15] = __uint_as_float(b3 << 16); u[16] = __uint_as_float(b3 & 0xffff0000u);
#pragma unroll
    for (int i = 0; i < 16; ++i) out[i] = bias + w0 * u[i] + w1 * u[i + 1] + w2 * u[i + 2];
}
__device__ __forceinline__ void load_f16x16(const _Float16* p, float (&out)[16]) {
    const v4u a = *(const v4u*)p, b = *(const v4u*)(p + 8);
    const unsigned w[8] = {a.x, a.y, a.z, a.w, b.x, b.y, b.z, b.w};
#pragma unroll
    for (int i = 0; i < 8; ++i) { const f32x2_t k = h2_to_f2(w[i]); out[2 * i] = k.x; out[2 * i + 1] = k.y; }
}
__device__ __forceinline__ void load_f32x16(const float* p, float (&out)[16]) {
#pragma unroll
    for (int i = 0; i < 4; ++i) { const float4 v = *(const float4*)(p + 4 * i); out[4 * i] = v.x; out[4 * i + 1] = v.y; out[4 * i + 2] = v.z; out[4 * i + 3] = v.w; }
}
__device__ __forceinline__ void filter_item(LAS unsigned char* L, const Args& a, int c, const _Float16* hT, unsigned* spec, int tid, int lane, int wave) {
    LAS f32x2_t* bufE = (LAS f32x2_t*)L; LAS f32x2_t* bufO = bufE + FBUF;
    const LAS f32x2_t* TA = (const LAS f32x2_t*)(L + LC_TA); const LAS f32x2_t* TB = (const LAS f32x2_t*)(L + LC_TB);
    LAS float* red = (LAS float*)(L + LC_RED); LAS float* sc = (LAS float*)L;
    const int n0 = 16 * tid;
#pragma unroll 1
    for (int o = 0; o < 2; ++o) {
        float hfv[16], hbv[16];
        load_f16x16(hT + (size_t)(o * 512 + c) * SEQ + n0, hfv);
        load_f16x16(hT + (size_t)(1024 + o * 512 + c) * SEQ + n0, hbv);
        float s = 0.f;
#pragma unroll
        for (int i = 0; i < 16; ++i) { s += fabsf(hfv[i]) + ((n0 + i) > 0 ? fabsf(hbv[i]) : 0.f); sc[n0 + i] = hbv[i]; }
        s = wave_sum(s);
        if (lane == 0) red[wave] = s;
        __syncthreads();
        float tot = 0.f;
#pragma unroll
        for (int i = 0; i < 8; ++i) tot += red[i];
        const float inv = 1.0f / (tot + EPS);
        float ev[16], dv[16];
#pragma unroll
        for (int i = 0; i < 16; ++i) { const int n = n0 + i; const float hbm = n > 0 ? sc[SEQ - n] : 0.f; ev[i] = (hfv[i] + hbm) * inv; dv[i] = (hfv[i] - hbm) * inv; }
        __syncthreads();
        const f32x2_t wa = TA[tid >> 2];
        { LAS c16* hE = (LAS c16*)L; LAS c16* hO = hE + FBUF; const int lb = 16 * tid + (tid >> 1);
#pragma unroll
          for (int i = 0; i < 16; ++i) { const f32x2_t wn = cmul(wa, TB[16 * (tid & 3) + i]);
              f32x2_t xe; xe.x = ev[i] * 4096.0f; xe.y = 0.f; f32x2_t xo; xo.x = dv[i] * 4096.0f * wn.x; xo.y = dv[i] * 4096.0f * wn.y;
              hE[lb + i] = c16_from(xe); hO[lb + i] = c16_from(xo); } }
        __syncthreads();
        fft2h_forward(L);
        fft2h_middle_store(L, spec + (size_t)(o * 512 + c) * 16384);
    }
}
template <int O>
__device__ __forceinline__ void hyena_pass(LAS unsigned char* L, const Args& a, int c, int bp, const bf16* hyuT, unsigned* spec, int tid, float (&xa)[16], float (&xb)[16]) {
    LAS c16* bufE = (LAS c16*)L; LAS c16* bufO = bufE + FBUF;
    const LAS f32x2_t* TA = (const LAS f32x2_t*)(L + LC_TA); const LAS f32x2_t* TB = (const LAS f32x2_t*)(L + LC_TB);
    const float* cw = a.in[15]; const float* cb = a.in[16];
    const int n0 = 16 * tid;
    const int lb = 16 * tid + (tid >> 1);
    {   const f32x2_t wa = TA[tid >> 2];
#pragma unroll
        for (int i = 0; i < 16; ++i) { f32x2_t x; x.x = xa[i] * 0.0625f; x.y = xb[i] * 0.0625f; bufE[lb + i] = c16_from(x); bufO[lb + i] = c16_from(cmul(x, cmul(wa, TB[16 * (tid & 3) + i]))); } }
    __syncthreads();
    fft2h_forward(L);
    fft2h_middle(L, spec + (size_t)(O * 512 + c) * 16384);
    fft2h_inverse(L);
    __syncthreads();
    const int grow = (O ? 1024 : 512) + c;
    const float w0 = cw[grow], w1 = cw[1536 + grow], w2 = cw[3072 + grow], bs = cb[grow];
    const float skip = a.in[24][O * 512 + c];
    const bf16* g0 = hyuT + (size_t)grow * NTOK + (size_t)(2 * bp) * SEQ; const bf16* g1 = g0 + SEQ;
    float ga[16], gb[16];
    load_conv16(g0, n0, w0, w1, w2, bs, ga); load_conv16(g1, n0, w0, w1, w2, bs, gb);
    const f32x2_t wa = TA[tid >> 2];
#pragma unroll
    for (int i = 0; i < 16; ++i) {
        const c16 he = bufE[lb + i], ho = bufO[lb + i]; f32x2_t fe; fe.x = (float)he.x; fe.y = (float)he.y; f32x2_t fo; fo.x = (float)ho.x; fo.y = (float)ho.y;
        const f32x2_t y = (fe + cmulc(fo, cmul(wa, TB[16 * (tid & 3) + i]))) * (1.0f / 64.0f);
        xa[i] = ga[i] * (y.x + skip * xa[i]); xb[i] = gb[i] * (y.y + skip * xb[i]); }
    __syncthreads();
}
__device__ __forceinline__ void hyena_item(LAS unsigned char* L, const Args& a, int c, int bp, const bf16* hyuT, unsigned* spec, bf16* y_hyT, int tid) {
    const float* cw = a.in[15]; const float* cb = a.in[16];
    const size_t seq0 = (size_t)c * NTOK + (size_t)(2 * bp) * SEQ;
    const int n0 = 16 * tid;
    float xa[16], xb[16];
    load_conv16(hyuT + seq0, n0, cw[c], cw[1536 + c], cw[3072 + c], cb[c], xa); load_conv16(hyuT + seq0 + SEQ, n0, cw[c], cw[1536 + c], cw[3072 + c], cb[c], xb);
    hyena_pass<0>(L, a, c, bp, hyuT, spec, tid, xa, xb);
    hyena_pass<1>(L, a, c, bp, hyuT, spec, tid, xa, xb);
    bf16* o0 = y_hyT + seq0; bf16* o1 = o0 + SEQ;
    v4u p0, p1, q0, q1;
    p0.x = pk2(xa[0], xa[1]); p0.y = pk2(xa[2], xa[3]); p0.z = pk2(xa[4], xa[5]); p0.w = pk2(xa[6], xa[7]); p1.x = pk2(xa[8], xa[9]); p1.y = pk2(xa[10], xa[11]); p1.z = pk2(xa[12], xa[13]); p1.w = pk2(xa[14], xa[15]);
    q0.x = pk2(xb[0], xb[1]); q0.y = pk2(xb[2], xb[3]); q0.z = pk2(xb[4], xb[5]); q0.w = pk2(xb[6], xb[7]); q1.x = pk2(xb[8], xb[9]); q1.y = pk2(xb[10], xb[11]); q1.z = pk2(xb[12], xb[13]); q1.w = pk2(xb[14], xb[15]);
    *(v4u*)(o0 + n0) = p0; *(v4u*)(o0 + n0 + 8) = p1; *(v4u*)(o1 + n0) = q0; *(v4u*)(o1 + n0 + 8) = q1;
}

__global__ void __launch_bounds__(NWAVES * 64, 2) fwd(Args a) {
    extern __shared__ __attribute__((aligned(16))) unsigned char lds_raw[];
    LAS unsigned char* L = (LAS unsigned char*)lds_raw;
    volatile LAS unsigned* MISC = (volatile LAS unsigned*)(L + MISC_OFF);
    const int tid = threadIdx.x, lane = tid & 63, wave = __builtin_amdgcn_readfirstlane(tid >> 6);
    const int G = gridDim.x, bid = blockIdx.x;
    unsigned char* ws = a.ws;
    unsigned* ctl = (unsigned*)ws;
    for (int u = tid; u < (LDS_BYTES - LDSCTL_OFF) / 4; u += NWAVES * 64) ((LAS unsigned*)(L + LDSCTL_OFF))[u] = 0u;
    __syncthreads();
    const int lo = a.ph_lo, hi = a.ph_hi;
    XcdBarrier bar; bar.bar = ctl + CW_BAR + a.li * XCD_BAR_WORDS; bar.x = 0; bar.st = nullptr;
    bar = xcd_barrier_post(ctl + CW_BAR + a.li * XCD_BAR_WORDS, MISC + 8);
#define IN(k) (lo <= (k) && (k) < hi)
#define BOTH(k) (IN(k) && IN((k) + 1))
#ifndef DUP_BAR
#define DUP_BAR 1
#endif
#define GRID_BAR() do { xcd_barrier(bar); if (DUP_BAR > 1) xcd_barrier(bar); } while (0)

    bf16* WinT = (bf16*)(ws + WS_WINT); bf16* WoutT = (bf16*)(ws + WS_WOUTT);
    bf16* hn1 = (bf16*)(ws + WS_HN1); bf16* lru = (bf16*)(ws + WS_LRU); bf16* hyuT = (bf16*)(ws + WS_HYUT);
    bf16* y_cat = (bf16*)(ws + WS_YCAT);
    bf16* W13T = (bf16*)(ws + WS_W13T); bf16* W2T = (bf16*)(ws + WS_W2T); bf16* WrT = (bf16*)(ws + WS_WRT);
    bf16* hn2 = (bf16*)(ws + WS_HN2); int* list = (int*)(ws + WS_LIST); float* lgate = (float*)(ws + WS_LGATE); int4* tokinfo = (int4*)(ws + WS_TOKINFO);
    bf16* xs = (bf16*)(ws + WS_XS); (void)xs; bf16* Hb = (bf16*)(ws + WS_H); bf16* Yb = (bf16*)(ws + WS_Y);
    const int gw = bid * NWAVES + wave, NGW = G * NWAVES;

    if (IN(0)) {
#ifndef DUP_P0
#define DUP_P0 1
#endif
        for (int rep0 = 0; rep0 < DUP_P0; ++rep0) {
        LAS float* scr = (LAS float*)(L + wave * 16384);
        constexpr int I_IN = (DM / 64) * (DIN / 32), I_OUT = (DM / 64) * (DM / 32), I_EXP = 768;
        for (int it = gw; it < I_IN + I_OUT + 32 * I_EXP; it += NGW) {
            if (it < I_IN) { const int nblk = DIN / 32, kb = it / nblk, nb = it % nblk; p0_transpose_item(a.in[2], DM, DIN, WinT, 32 * nb, scr, 64 * kb, 32 * nb, lane); }
            else if (it < I_IN + I_OUT) { const int r = it - I_IN; const int nblk = DM / 32, kb = r / nblk, nb = r % nblk; p0_transpose_item(a.in[27], DM, DM, WoutT, 32 * nb, scr, 64 * kb, 32 * nb, lane); }
            else { const int r = it - I_IN - I_OUT, e = r / I_EXP, q = r % I_EXP;
                if (q < 512) { const int w3 = q >> 8, qq = q & 255, kb = qq >> 4, nb = qq & 15, n0 = 32 * nb;
                    p0_transpose_item(a.in[w3 ? 34 : 33] + (size_t)e * 1024 * 512, 1024, 512, W13T, e * 1024 + (n0 >> 7) * 256 + (n0 & 127) + w3 * 128, scr, 64 * kb, n0, lane); }
                else { const int qq = q - 512, kb = qq >> 5, nb = qq & 31;
                    p0_transpose_item(a.in[35] + (size_t)e * 512 * 1024, 512, 1024, W2T, e * 1024 + 32 * nb, scr, 64 * kb, 32 * nb, lane); } }
        }
        for (int idx = bid * (NWAVES * 64) + tid; idx < 48 * 1024; idx += G * NWAVES * 64) { const int j = idx >> 10, k = idx & 1023;
            WrT[idx] = j < 4 ? f2bf(a.in[29][k * 4 + j]) : (j < 36 ? f2bf(a.in[31][k * 32 + (j - 4)]) : (bf16)0); }
        { _Float16* hT = (_Float16*)(ws + WS_HT);
          const float* w1 = a.in[17]; const float* b1 = a.in[18]; const float* f1 = a.in[19]; const float* w2 = a.in[20]; const float* b2 = a.in[21]; const float* f2 = a.in[22]; const float* w3 = a.in[23];
          LAS float* w3s = (LAS float*)L;
          LAS float* z2s = (LAS float*)(L + 65536);
          LAS float* fts = (LAS float*)(L + 73728);
          LAS float* ot  = (LAS float*)(L + 81920);
          for (int tile = bid; tile < SEQ / 32; tile += G) {
              __syncthreads();
              { const int tl = tid & 31, i = tid >> 5; const int t = tile * 32 + tl;
                const float wq = (6.283185307179586f / (float)SEQ) * (float)t; const float band = 1e-4f + (float)i * ((15.0f - 1e-4f) / 15.0f);
                fts[(1 + i) * 32 + tl] = cosf(wq * band); fts[(17 + i) * 32 + tl] = sinf(wq * band);
                if (i == 0) fts[tl] = (float)t / (float)(SEQ - 1); }
              __syncthreads();
              const int tl4 = tid & 31, jq = tid >> 5;
              { float s0 = b1[4 * jq], s1 = b1[4 * jq + 1], s2 = b1[4 * jq + 2], s3 = b1[4 * jq + 3];
#pragma unroll 3
                for (int i = 0; i < 33; ++i) { const float fv = fts[i * 32 + tl4]; const float4 wv = *(const float4*)(w1 + i * 64 + 4 * jq); s0 += fv * wv.x; s1 += fv * wv.y; s2 += fv * wv.z; s3 += fv * wv.w; }
                const float4 fq = *(const float4*)(f1 + 4 * jq);
                s0 = sinf(fq.x * s0); s1 = sinf(fq.y * s1); s2 = sinf(fq.z * s2); s3 = sinf(fq.w * s3);
                __syncthreads();
                fts[(4 * jq) * 32 + tl4] = s0; fts[(4 * jq + 1) * 32 + tl4] = s1; fts[(4 * jq + 2) * 32 + tl4] = s2; fts[(4 * jq + 3) * 32 + tl4] = s3; }
              __syncthreads();
              { float s0 = b2[4 * jq], s1 = b2[4 * jq + 1], s2 = b2[4 * jq + 2], s3 = b2[4 * jq + 3];
#pragma unroll 4
                for (int i = 0; i < 64; ++i) { const float zv = fts[i * 32 + tl4]; const float4 wv = *(const float4*)(w2 + i * 64 + 4 * jq); s0 += zv * wv.x; s1 += zv * wv.y; s2 += zv * wv.z; s3 += zv * wv.w; }
                const float4 fq = *(const float4*)(f2 + 4 * jq);
                z2s[(4 * jq) * 32 + tl4] = sinf(fq.x * s0); z2s[(4 * jq + 1) * 32 + tl4] = sinf(fq.y * s1); z2s[(4 * jq + 2) * 32 + tl4] = sinf(fq.z * s2); z2s[(4 * jq + 3) * 32 + tl4] = sinf(fq.w * s3); }
              __syncthreads();
              const float lo_ = logf(1e-2f) / 1.5f, hi_ = logf(1e-2f) / 0.3f;
              typedef float f32x16_t __attribute__((ext_vector_type(16)));
              bf16x8_t Az[4];
              { const int tr = lane & 31, kg2 = lane >> 5;
#pragma unroll
                for (int s = 0; s < 4; ++s) { v4u pk;
                    pk.x = pk2(z2s[(16 * s + 8 * kg2 + 0) * 32 + tr], z2s[(16 * s + 8 * kg2 + 1) * 32 + tr]); pk.y = pk2(z2s[(16 * s + 8 * kg2 + 2) * 32 + tr], z2s[(16 * s + 8 * kg2 + 3) * 32 + tr]);
                    pk.z = pk2(z2s[(16 * s + 8 * kg2 + 4) * 32 + tr], z2s[(16 * s + 8 * kg2 + 5) * 32 + tr]); pk.w = pk2(z2s[(16 * s + 8 * kg2 + 6) * 32 + tr], z2s[(16 * s + 8 * kg2 + 7) * 32 + tr]);
                    Az[s] = __builtin_bit_cast(bf16x8_t, pk); } }
              LAS unsigned char* wt = L;
              for (int chunk = 0; chunk < 8; ++chunk) {
                  __syncthreads();
#pragma unroll 4
                  for (int r = 0; r < 8; ++r) { const int q = tid + 512 * r; const int j = q >> 6, c4 = q & 63;
                      const f32x4_t wv = *(const f32x4_t*)(w3 + (size_t)j * 2048 + chunk * 256 + 4 * c4);
                      LAS bf16* d = (LAS bf16*)(wt + (4 * c4) * 144 + 2 * j);
                      d[0] = f2bf(wv.x); d[72] = f2bf(wv.y); d[144] = f2bf(wv.z); d[216] = f2bf(wv.w); }
                  __syncthreads();
                  { const int cl = wave * 32 + (lane & 31), kg2 = lane >> 5;
                    f32x16_t acc = {0.f, 0.f, 0.f, 0.f, 0.f, 0.f, 0.f, 0.f, 0.f, 0.f, 0.f, 0.f, 0.f, 0.f, 0.f, 0.f};
#pragma unroll
                    for (int s = 0; s < 4; ++s) { const bf16x8_t Bw = *(const LAS bf16x8_t*)(wt + cl * 144 + (16 * s + 8 * kg2) * 2);
                        acc = __builtin_amdgcn_mfma_f32_32x32x16_bf16(Az[s], Bw, acc, 0, 0, 0); }
                    const int col = chunk * 256 + cl; const int cc = col & 511;
                    const float delta = fabsf(lo_ + (float)cc * ((hi_ - lo_) / 511.0f));
#pragma unroll
                    for (int g4 = 0; g4 < 4; ++g4) { const int tl = 8 * g4 + 4 * kg2;
                        const int t0 = tile * 32 + tl;
                        f16x2_t h01, h23;
                        h01.x = (_Float16)(acc[4 * g4 + 0] * 64.0f * __expf(-((float)(t0 + 0) / (float)(SEQ - 1)) * delta)); h01.y = (_Float16)(acc[4 * g4 + 1] * 64.0f * __expf(-((float)(t0 + 1) / (float)(SEQ - 1)) * delta));
                        h23.x = (_Float16)(acc[4 * g4 + 2] * 64.0f * __expf(-((float)(t0 + 2) / (float)(SEQ - 1)) * delta)); h23.y = (_Float16)(acc[4 * g4 + 3] * 64.0f * __expf(-((float)(t0 + 3) / (float)(SEQ - 1)) * delta));
                        uint2 o; o.x = __builtin_bit_cast(unsigned, h01); o.y = __builtin_bit_cast(unsigned, h23);
                        *(uint2*)(hT + (size_t)col * SEQ + t0) = o; } }
              }
          } }
        __syncthreads();
        for (int m = gw; m < NTOK; m += NGW) rms_row_to_bf16(a.in[0] + (size_t)m * DM, a.in[1], hn1 + (size_t)m * DM, lane);
        }
        if (BOTH(0)) GRID_BAR();
    }
    if (IN(1)) {
#ifndef DUP_G1
#define DUP_G1 1
#endif
        { pg8::Gemm g{hn1, WinT, NTOK, 1024, DM}; pg8::StaticOrder S; S.init(NTOK, 1024, G, bid);
          pg8::EpiBf16<0> E{lru, 1024, nullptr, 0, 0, 1.f};
          pg8::gemm_phase<pg8::EpiBf16<0>, pg8::StaticOrder, true, true>(L, g, S, E); }
        { pg8::Gemm g{WinT + (size_t)1024 * DM, hn1, 1536, NTOK, DM}; pg8::StaticOrder S; S.init(1536, NTOK, G, bid);
          pg8::EpiBf16<0> E{hyuT, NTOK, nullptr, 0, 0, 1.f};
          pg8::gemm_phase<pg8::EpiBf16<0>, pg8::StaticOrder, true, true>(L, g, S, E); }
#if DUP_G1 > 1
        { pg8::Gemm g{hn1, WinT, NTOK, 1024, DM}; pg8::StaticOrder S; S.init(NTOK, 1024, G, bid);
          pg8::EpiBf16<0> E{lru, 1024, nullptr, 0, 0, 1.f};
          pg8::gemm_phase<pg8::EpiBf16<0>, pg8::StaticOrder, true, true>(L, g, S, E); }
        { pg8::Gemm g{WinT + (size_t)1024 * DM, hn1, 1536, NTOK, DM}; pg8::StaticOrder S; S.init(1536, NTOK, G, bid);
          pg8::EpiBf16<0> E{hyuT, NTOK, nullptr, 0, 0, 1.f};
          pg8::gemm_phase<pg8::EpiBf16<0>, pg8::StaticOrder, true, true>(L, g, S, E); }
#endif
        __syncthreads();
        fft_tables_init(L, tid);
#ifndef DUP_FILT
#define DUP_FILT 1
#endif
        for (int rep = 0; rep < DUP_FILT; ++rep)
        for (int c = bid; c < DH; c += G) filter_item(L, a, c, (const _Float16*)(ws + WS_HT), (unsigned*)(ws + WS_SPEC), tid, lane, wave);
        if (BOTH(1)) GRID_BAR();
    }

    if (IN(2)) {
        bf16* hf = (bf16*)(ws + WS_HF); bf16* hb = (bf16*)(ws + WS_HB);
#ifndef DUP_LRU
#define DUP_LRU 1
#endif
#ifndef DUP_HY
#define DUP_HY 1
#endif
        { bf16* xcb = (bf16*)(ws + WS_XCB); const float* cwp = a.in[3]; const float* cbp = a.in[4];
          for (int idx = bid * (NWAVES * 64) + tid; idx < NTOK * 64; idx += G * NWAVES * 64) {
              const int tok = idx >> 6, c8 = (idx & 63) * 8, t = tok & (SEQ - 1), bb = tok >> 13;
              float acc[8];
              { const float4 c0 = *(const float4*)(cbp + c8), c1 = *(const float4*)(cbp + c8 + 4); acc[0] = c0.x; acc[1] = c0.y; acc[2] = c0.z; acc[3] = c0.w; acc[4] = c1.x; acc[5] = c1.y; acc[6] = c1.z; acc[7] = c1.w; }
#pragma unroll
              for (int tap = 0; tap < 4; ++tap) { const int tt = t + tap - 2; const bool ok = tt >= 0 && tt < SEQ; const int tc = ok ? tt : t;
                  const v4u xv = *(const v4u*)(lru + (size_t)(bb * SEQ + tc) * 1024 + c8);
                  const float4 w0 = *(const float4*)(cwp + tap * DL + c8), w1 = *(const float4*)(cwp + tap * DL + c8 + 4);
                  const float m = ok ? 1.f : 0.f; const unsigned x0 = xv.x, x1 = xv.y, x2 = xv.z, x3 = xv.w;
                  acc[0] += m * w0.x * __uint_as_float(x0 << 16); acc[1] += m * w0.y * __uint_as_float(x0 & 0xffff0000u);
                  acc[2] += m * w0.z * __uint_as_float(x1 << 16); acc[3] += m * w0.w * __uint_as_float(x1 & 0xffff0000u);
                  acc[4] += m * w1.x * __uint_as_float(x2 << 16); acc[5] += m * w1.y * __uint_as_float(x2 & 0xffff0000u);
                  acc[6] += m * w1.z * __uint_as_float(x3 << 16); acc[7] += m * w1.w * __uint_as_float(x3 & 0xffff0000u); }
              v4u pk; pk.x = pk2(acc[0], acc[1]); pk.y = pk2(acc[2], acc[3]); pk.z = pk2(acc[4], acc[5]); pk.w = pk2(acc[6], acc[7]);
              const int hh = c8 >> 6, cl = c8 & 63;
              *(v4u*)(xcb + (((size_t)(bb * 8 + hh) * SEQ + t) * 64 + cl)) = pk; } }
        GRID_BAR();
        for (int rep = 0; rep < DUP_LRU; ++rep)
        for (int item = bid; item < 256; item += G) lru_item(L, a, item, (const bf16*)(ws + WS_XCB), hf, hb, tid, lane, wave);
        __syncthreads();
        fft_tables_init(L, tid);
        for (int rep = 0; rep < DUP_HY; ++rep)
        for (int item = bid; item < 2 * DH; item += G) hyena_item(L, a, item >> 1, item & 1, hyuT, (unsigned*)(ws + WS_SPEC), (bf16*)(ws + WS_YHYT), tid);
        if (BOTH(2)) GRID_BAR();
    }

    if (IN(3)) {
        const bf16* hf = (const bf16*)(ws + WS_HF); const bf16* hb = (const bf16*)(ws + WS_HB); const bf16* y_hyT = (const bf16*)(ws + WS_YHYT);
        const float* gA = a.in[25]; const float* gB = a.in[26];
#ifndef DUP_P3
#define DUP_P3 1
#endif
        for (int rep3 = 0; rep3 < DUP_P3; ++rep3) {
        for (int tok = gw; tok < NTOK; tok += NGW) {
            const v4u vf = *(const v4u*)(hf + (size_t)tok * DL + 8 * lane), vb = *(const v4u*)(hb + (size_t)tok * DL + 8 * lane), vg = *(const v4u*)(lru + (size_t)tok * 1024 + 512 + 8 * lane);
            const unsigned f0 = vf.x, f1 = vf.y, f2 = vf.z, f3 = vf.w, b0 = vb.x, b1 = vb.y, b2 = vb.z, b3 = vb.w, g0 = vg.x, g1 = vg.y, g2 = vg.z, g3 = vg.w;
            float y[8];
            y[0] = (__uint_as_float(f0 << 16) + __uint_as_float(b0 << 16)) * gelu_tanh(__uint_as_float(g0 << 16));
            y[1] = (__uint_as_float(f0 & 0xffff0000u) + __uint_as_float(b0 & 0xffff0000u)) * gelu_tanh(__uint_as_float(g0 & 0xffff0000u));
            y[2] = (__uint_as_float(f1 << 16) + __uint_as_float(b1 << 16)) * gelu_tanh(__uint_as_float(g1 << 16));
            y[3] = (__uint_as_float(f1 & 0xffff0000u) + __uint_as_float(b1 & 0xffff0000u)) * gelu_tanh(__uint_as_float(g1 & 0xffff0000u));
            y[4] = (__uint_as_float(f2 << 16) + __uint_as_float(b2 << 16)) * gelu_tanh(__uint_as_float(g2 << 16));
            y[5] = (__uint_as_float(f2 & 0xffff0000u) + __uint_as_float(b2 & 0xffff0000u)) * gelu_tanh(__uint_as_float(g2 & 0xffff0000u));
            y[6] = (__uint_as_float(f3 << 16) + __uint_as_float(b3 << 16)) * gelu_tanh(__uint_as_float(g3 << 16));
            y[7] = (__uint_as_float(f3 & 0xffff0000u) + __uint_as_float(b3 & 0xffff0000u)) * gelu_tanh(__uint_as_float(g3 & 0xffff0000u));
            float s = 0.f;
#pragma unroll
            for (int i = 0; i < 8; ++i) s += y[i] * y[i];
            s = wave_sum(s);
            const float rstd = rsqrtf(s * (1.0f / DL) + EPS);
            const float4 ga0 = *(const float4*)(gA + 8 * lane), ga1 = *(const float4*)(gA + 8 * lane + 4);
            v4u o; o.x = pk2(y[0] * rstd * ga0.x, y[1] * rstd * ga0.y); o.y = pk2(y[2] * rstd * ga0.z, y[3] * rstd * ga0.w);
            o.z = pk2(y[4] * rstd * ga1.x, y[5] * rstd * ga1.y); o.w = pk2(y[6] * rstd * ga1.z, y[7] * rstd * ga1.w);
            *(v4u*)(y_cat + (size_t)tok * 1024 + 8 * lane) = o;
        }
        for (int tile = bid; tile < NTOK / 64; tile += G) {
            __syncthreads();
            const int tok0 = tile * 64;
            for (int ch = tid; ch < 512 * 8; ch += NWAVES * 64) { const int c = ch >> 3, piece = ch & 7;
                const v4u v = *(const v4u*)(y_hyT + (size_t)c * NTOK + tok0 + 8 * piece);
                LAS unsigned* d = (LAS unsigned*)(L + c * 132 + piece * 16); d[0] = v.x; d[1] = v.y; d[2] = v.z; d[3] = v.w; }
            __syncthreads();
            for (int tl = wave; tl < 64; tl += NWAVES) {
                float v[8]; float s = 0.f;
#pragma unroll
                for (int i = 0; i < 4; ++i) { const int c = 2 * lane + 128 * i;
                    v[2 * i] = bf2f(*(const LAS bf16*)(L + c * 132 + tl * 2)); v[2 * i + 1] = bf2f(*(const LAS bf16*)(L + (c + 1) * 132 + tl * 2));
                    s += v[2 * i] * v[2 * i] + v[2 * i + 1] * v[2 * i + 1]; }
                s = wave_sum(s);
                const float rstd = rsqrtf(s * (1.0f / DH) + EPS);
#pragma unroll
                for (int i = 0; i < 4; ++i) { const int c = 2 * lane + 128 * i;
                    *(unsigned*)(y_cat + (size_t)(tok0 + tl) * 1024 + 512 + c) = pk2(v[2 * i] * rstd * gB[c], v[2 * i + 1] * rstd * gB[c + 1]); }
            }
        }
        }
        if (BOTH(3)) GRID_BAR();
    }
    if (IN(4)) {
        pg8::Gemm g{y_cat, WoutT, NTOK, DM, DM}; pg8::StaticOrder S; S.init(NTOK, DM, G, bid);
        pg8::EpiResF32 E{a.in[0], a.out, DM};
#ifndef DUP_P4
#define DUP_P4 1
#endif
        pg8::gemm_phase<pg8::EpiResF32, pg8::StaticOrder, true, true>(L, g, S, E);
#if DUP_P4 > 1
        pg8::gemm_phase<pg8::EpiResF32, pg8::StaticOrder, true, true>(L, g, S, E);
#endif
        if (BOTH(4)) GRID_BAR();
    }

#ifndef DUP_P5
#define DUP_P5 1
#endif
    for (int rep5 = 0; rep5 < DUP_P5; ++rep5)
    if (IN(5)) {
        const bool dummy = (rep5 + 1 < DUP_P5);
        unsigned* cntg = ctl + (dummy ? 3072 : CW_CNT);
        int* list_ = dummy ? (int*)(ws + 376 * MiB) : list; float* lgate_ = dummy ? (float*)(ws + 380 * MiB) : lgate; int4* tokinfo_ = dummy ? (int4*)(ws + 384 * MiB) : tokinfo;
        bf16* hn2_ = dummy ? (bf16*)(ws + 232 * MiB) : hn2;
        LAS float* lg = (LAS float*)(L + 98304);
        LAS int* cnt_l = (LAS int*)(L + LC_CNT); LAS int* base_l = (LAS int*)(L + LC_BASE);
        const float* xmid = a.out; const float* gff = a.in[28];
        for (int tile = bid; tile < NTOK / 128; tile += G) {
            __syncthreads();
            for (int ch = tid; ch < 48 * 128; ch += NWAVES * 64) { const int row = ch >> 7, c16 = ch & 127;
                *(LAS v4u*)(L + row * 2048 + ((c16 ^ (row & 15)) << 4)) = *(const v4u*)(WrT + (size_t)row * 1024 + c16 * 8); }
            if (tid < 32) cnt_l[tid] = 0;
            __syncthreads();
            const int tk = lane & 15, kg = lane >> 4;
            const int tokw = tile * 128 + wave * 16 + tk;
            const float* xr = xmid + (size_t)tokw * DM + 8 * kg;
            float s = 0.f;
#pragma unroll 8
            for (int st = 0; st < 32; ++st) { const float4 p = *(const float4*)(xr + 32 * st), q = *(const float4*)(xr + 32 * st + 4);
                s += (p.x * p.x + p.y * p.y) + (p.z * p.z + p.w * p.w) + (q.x * q.x + q.y * q.y) + (q.z * q.z + q.w * q.w); }
            s += __shfl_xor(s, 16); s += __shfl_xor(s, 32);
            const float rstd = rsqrtf(s * (1.0f / DM) + EPS);
            f32x4_t acc0 = {0.f, 0.f, 0.f, 0.f}, acc1 = acc0, acc2 = acc0;
            bf16* hrow = hn2_ + (size_t)tokw * DM + 8 * kg;
#pragma unroll 4
            for (int st = 0; st < 32; ++st) {
                const float4 p = *(const float4*)(xr + 32 * st), q = *(const float4*)(xr + 32 * st + 4);
                const float4 g0 = *(const float4*)(gff + 32 * st + 8 * kg), g1 = *(const float4*)(gff + 32 * st + 8 * kg + 4);
                v4u w; w.x = pk2(p.x * rstd * g0.x, p.y * rstd * g0.y); w.y = pk2(p.z * rstd * g0.z, p.w * rstd * g0.w);
                w.z = pk2(q.x * rstd * g1.x, q.y * rstd * g1.y); w.w = pk2(q.z * rstd * g1.z, q.w * rstd * g1.w);
                *(v4u*)(hrow + 32 * st) = w;
                const bf16x8_t B = __builtin_bit_cast(bf16x8_t, w);
                const int chs = ((4 * st + kg) ^ tk) << 4;
                const bf16x8_t A0 = *(const LAS bf16x8_t*)(L + (0 + tk) * 2048 + chs), A1 = *(const LAS bf16x8_t*)(L + (16 + tk) * 2048 + chs), A2 = *(const LAS bf16x8_t*)(L + (32 + tk) * 2048 + chs);
                acc0 = __builtin_amdgcn_mfma_f32_16x16x32_bf16(A0, B, acc0, 0, 0, 0);
                acc1 = __builtin_amdgcn_mfma_f32_16x16x32_bf16(A1, B, acc1, 0, 0, 0);
                acc2 = __builtin_amdgcn_mfma_f32_16x16x32_bf16(A2, B, acc2, 0, 0, 0);
            }
            { LAS float* lr = lg + (wave * 16 + tk) * 49 + 4 * kg;
#pragma unroll
              for (int r = 0; r < 4; ++r) { lr[r] = acc0[r]; lr[16 + r] = acc1[r]; lr[32 + r] = acc2[r]; } }
            __syncthreads();
            int e0 = 0, e1 = 0, r0l = 0, r1l = 0; float g0 = 0.f, g1 = 0.f;
            if (tid < 128) {
                const LAS float* lr = lg + tid * 49; const float* bgp = a.in[30]; const float* bep = a.in[32];
                int gi = 0; float gm = lr[0] + bgp[0];
                for (int i = 1; i < 4; ++i) { const float v = lr[i] + bgp[i]; if (v > gm) { gm = v; gi = i; } }
                float gs = 0.f; for (int i = 0; i < 4; ++i) gs += __expf(lr[i] + bgp[i] - gm);
                const float gp = 1.0f / gs;
                const LAS float* le = lr + 4 + gi * 8; const float* beg = bep + gi * 8;
                int i1 = 0; float m1 = le[0] + beg[0];
                for (int i = 1; i < 8; ++i) { const float v = le[i] + beg[i]; if (v > m1) { m1 = v; i1 = i; } }
                int i2 = -1; float m2 = -3.0e38f;
                for (int i = 0; i < 8; ++i) { const float v = le[i] + beg[i]; if (i != i1 && v > m2) { m2 = v; i2 = i; } }
                const float ex2 = __expf(m2 - m1);
                e0 = gi * 8 + i1; e1 = gi * 8 + i2; g0 = gp / (1.0f + ex2); g1 = gp * ex2 / (1.0f + ex2);
                r0l = atomicAdd((int*)(cnt_l + e0), 1); r1l = atomicAdd((int*)(cnt_l + e1), 1);
            }
            __syncthreads();
            if (tid < 32) { const int c = cnt_l[tid]; base_l[tid] = c ? (int)atomicAdd(cntg + tid, (unsigned)c) : 0; }
            __syncthreads();
            if (tid < 128) { const int tok = tile * 128 + tid; const int r0 = base_l[e0] + r0l, r1 = base_l[e1] + r1l;
                list_[e0 * NTOK + r0] = tok; lgate_[e0 * NTOK + r0] = g0; list_[e1 * NTOK + r1] = tok; lgate_[e1 * NTOK + r1] = g1;
                tokinfo_[tok] = make_int4(e0, r0, e1, r1); }
        }
        if (BOTH(5) && !dummy) GRID_BAR();
    }
    if (IN(7)) {
        const int T = moe_tables(L, ctl, tid);
        pg8::Gemm g{hn2, W13T, T * 256, 1024, DM};
        pg8::MoeOrder S{(const LAS int*)(L + LC_TILEE), T, 4, G, bid, (size_t)1024 * 1024 * 2, (const LAS int*)(L + LC_TSTART), (const LAS int*)(L + LC_CNT), list, NTOK, true};
        pg8::EpiSwiGLU E{Hb};
        pg8::gemm_phase<pg8::EpiSwiGLU, pg8::MoeOrder, true, true, true>(L, g, S, E);
        if (BOTH(7)) GRID_BAR();
    }
    if (IN(8)) {
        const int T = moe_tables(L, ctl, tid);
        pg8::Gemm g{Hb, W2T, T * 256, 1024, 512};
        pg8::MoeOrder S{(const LAS int*)(L + LC_TILEE), T, 4, G, bid, (size_t)1024 * 512 * 2, (const LAS int*)(L + LC_TSTART), (const LAS int*)(L + LC_CNT), list, NTOK, false};
        pg8::EpiRowScaleBf16 E{Yb, 1024, lgate, (const LAS int*)(L + LC_TILEE), (const LAS int*)(L + LC_TSTART), (const LAS int*)(L + LC_CNT), NTOK};
        pg8::gemm_phase<pg8::EpiRowScaleBf16, pg8::MoeOrder, true, true, false>(L, g, S, E);
        if (BOTH(8)) GRID_BAR();
    }
#ifndef DUP_P9
#define DUP_P9 1
#endif
    for (int rep9 = 0; rep9 < DUP_P9; ++rep9)
    if (IN(9)) {
        float* outw = (rep9 + 1 < DUP_P9) ? (float*)(ws + 256 * MiB) : a.out;
        (void)moe_tables(L, ctl, tid);
        const LAS int* tstart = (const LAS int*)(L + LC_TSTART);
        const float* gfin = a.in[36];
        for (int tok0 = gw * 4; tok0 < NTOK; tok0 += NGW * 4) {
            float4 v[4][4]; uint2 p[4][4], q[4][4];
#pragma unroll
            for (int u = 0; u < 4; ++u) { const int4 ti = tokinfo[tok0 + u];
                const size_t s0 = (size_t)tstart[ti.x] * 256 + ti.y, s1 = (size_t)tstart[ti.z] * 256 + ti.w;
                const uint2* y0 = (const uint2*)(Yb + s0 * DM); const uint2* y1 = (const uint2*)(Yb + s1 * DM);
                const float4* xr = (const float4*)(a.out + (size_t)(tok0 + u) * DM);
#pragma unroll
                for (int j = 0; j < 4; ++j) { v[u][j] = xr[lane + 64 * j]; p[u][j] = y0[lane + 64 * j]; q[u][j] = y1[lane + 64 * j]; } }
#pragma unroll
            for (int u = 0; u < 4; ++u) { float s = 0.f;
#pragma unroll
                for (int j = 0; j < 4; ++j) { const uint2 pp = p[u][j], qq = q[u][j];
                    v[u][j].x += __uint_as_float(pp.x << 16) + __uint_as_float(qq.x << 16); v[u][j].y += __uint_as_float(pp.x & 0xffff0000u) + __uint_as_float(qq.x & 0xffff0000u);
                    v[u][j].z += __uint_as_float(pp.y << 16) + __uint_as_float(qq.y << 16); v[u][j].w += __uint_as_float(pp.y & 0xffff0000u) + __uint_as_float(qq.y & 0xffff0000u);
                    s += (v[u][j].x * v[u][j].x + v[u][j].y * v[u][j].y) + (v[u][j].z * v[u][j].z + v[u][j].w * v[u][j].w); }
                s = wave_sum(s);
                const float rstd = rsqrtf(s * (1.0f / DM) + EPS);
                float4* xw = (float4*)(outw + (size_t)(tok0 + u) * DM);
#pragma unroll
                for (int j = 0; j < 4; ++j) { const float4 gg = *(const float4*)(gfin + (lane + 64 * j) * 4);
                    xw[lane + 64 * j] = make_float4(v[u][j].x * rstd * gg.x, v[u][j].y * rstd * gg.y, v[u][j].z * rstd * gg.z, v[u][j].w * rstd * gg.w); } }
        }
    }
#undef IN
#undef BOTH
#undef GRID_BAR
}

static void launch_fwd(const Args& base, int lo, int hi, int li, int grid, hipStream_t stream) {
    Args a = base; a.ph_lo = lo; a.ph_hi = hi; a.li = li; a.pad = 0;
    hipLaunchKernelGGL(fwd, dim3(grid), dim3(NWAVES * 64), LDS_BYTES, stream, a);
}

extern "C" void kernel_launch(void* const* d_in, const int* in_sizes, int n_in, void* d_out, int out_size, void* d_ws, size_t ws_size, hipStream_t stream) {
    (void)in_sizes; (void)n_in; (void)out_size; (void)ws_size;
    static int grid = 0;
    if (grid == 0) {
        int dev = 0, cus = 0;
        (void)hipGetDevice(&dev); (void)hipDeviceGetAttribute(&cus, hipDeviceAttributeMultiprocessorCount, dev);
        (void)hipFuncSetAttribute((const void*)fwd, hipFuncAttributeMaxDynamicSharedMemorySize, LDS_BYTES);
        grid = cus > 0 ? cus : 256;
    }
    const float* const* in = (const float* const*)d_in;
    unsigned char* ws = (unsigned char*)d_ws;
    float* out = (float*)d_out;
    (void)hipMemsetAsync(ws, 0, CTL_ZERO_BYTES, stream);
    Args base{};
    for (int i = 0; i < 37; ++i) base.in[i] = in[i];
    base.out = out; base.ws = ws;

#ifndef MK_PER_PHASE
    launch_fwd(base, 0, 10, 0, grid, stream);
#else
    for (int ph = 0; ph < 10; ++ph) launch_fwd(base, ph, ph + 1, ph, grid, stream);
#endif
}
```

```cpp
#include <hip/hip_runtime.h>
#include <stdint.h>

typedef unsigned short bf16;
__device__ __forceinline__ float bf2f(bf16 v) { return __uint_as_float(((unsigned)v) << 16); }
__device__ __forceinline__ bf16 f2bf(float f) { unsigned u = __float_as_uint(f); u += 0x7fffu + ((u >> 16) & 1u); return (bf16)(u >> 16); }

constexpr int NB = 4, SEQ = 8192, DM = 1024, NTOK = NB * SEQ, DIN = 2560, DL = 512, DH = 512;
constexpr float EPS = 1e-6f;

__device__ __forceinline__ float wave_sum(float v) {
#pragma unroll
    for (int o = 1; o < 64; o <<= 1) v += __shfl_xor(v, o);
    return v;
}
__device__ __forceinline__ float gelu_tanh(float x) { return 0.5f * x * (1.0f + tanhf(0.7978845608028654f * (x + 0.044715f * x * x * x))); }

constexpr size_t MiB = 1u << 20;
namespace pg8 {
#define PG8_LAS __attribute__((address_space(3)))
typedef unsigned short bf16_t;
typedef short bf16x8 __attribute__((ext_vector_type(8)));
typedef float f32x4 __attribute__((ext_vector_type(4)));
typedef unsigned u32x4 __attribute__((ext_vector_type(4)));
constexpr int BM = 256, BK = 64, HALF = 128, HTB = HALF * BK * 2  , STAGE_BYTES = 8 * HTB, NXCD = 8, WGM = 8;

__host__ __device__ __forceinline__ int lds_byte(int r, int c) { const int st = (r >> 4) * 2 + (c >> 5), rr = r & 15, cc = c & 31, ob = rr * 64 + cc * 2; return st * 1024 + (ob ^ (((ob >> 9) & 1) << 5)); }
__host__ __device__ __forceinline__ void stage_rc(int b, int& R, int& C) { const int st = b / 1024, sb = b % 1024, swz = sb ^ (((sb >> 9) & 1) << 5); R = (st >> 1) * 16 + swz / 64; C = (st & 1) * 32 + (swz % 64) / 2; }
__host__ __device__ __forceinline__ int perm32(int rho) { const int n = rho >> 4, i = rho & 15; return 8 * (i >> 2) + 4 * n + (i & 3); }

struct Unit { int pm, pn; };
struct Gemm { const bf16_t* A; const bf16_t* Bt; int M, N, K; };

struct StaticOrder {
    int nM, nN, nwg, G, c;
    __host__ __device__ void init(int M, int N, int G_, int c_) { nM = M / BM; nN = N / BM; nwg = nM * nN; G = G_; c = c_; }
    __host__ __device__ bool next(int i, Unit& u) const {
        const long L = (long)i * G + c; if (L >= nwg) return false;
        int wgid = (int)L; { const int q = nwg / NXCD, r = nwg % NXCD, xcd = wgid % NXCD, off = wgid / NXCD; wgid = (xcd < r ? xcd * (q + 1) : r * (q + 1) + (xcd - r) * q) + off; }
        const int nig = WGM * nN, gid = wgid / nig, fm = gid * WGM, gsz = (nM - fm) < WGM ? (nM - fm) : WGM;
        u.pm = fm + ((wgid % nig) % gsz); u.pn = (wgid % nig) / gsz; return true;
    }
    __device__ __forceinline__ void a_ready(const Unit&) const {}
    __device__ __forceinline__ void done(const Unit&) const {}
    __device__ __forceinline__ const char* a_base(const Gemm& g, const Unit& u) const { return (const char*)g.A + (size_t)u.pm * ((size_t)BM * g.K * 2); }
    __device__ __forceinline__ const char* b_base(const Gemm& g, const Unit& u) const { return (const char*)g.Bt + (size_t)u.pn * ((size_t)BM * g.K * 2); }
    __device__ __forceinline__ int src_row(const Unit&, int row) const { return row; }
};

__device__ __forceinline__ unsigned cvt_pk_bf16(float lo, float hi) { unsigned r; asm volatile("v_cvt_pk_bf16_f32 %0, %1, %2" : "=v"(r) : "v"(lo), "v"(hi)); return r; }
typedef float f32x2 __attribute__((ext_vector_type(2)));
__device__ __forceinline__ f32x2 gelu_pk(f32x2 v) {
    const f32x2 av = __builtin_elementwise_abs(v), d = av * 0.2316418882f + 1.0f;
    f32x2 t; t.x = __builtin_amdgcn_rcpf(d.x); t.y = __builtin_amdgcn_rcpf(d.y);
    f32x2 q = t * 0.5307027145f + (-0.7265760135f); q = q * t + 0.7107068705f; q = q * t + (-0.142248368f); q = q * t + 0.127414796f; q = q * t;
    const f32x2 s = (v * v) * (-0.72134752044f);
    f32x2 e; e.x = __builtin_amdgcn_exp2f(s.x); e.y = __builtin_amdgcn_exp2f(s.y);
    const f32x2 m = v * (q * e), r = v - m;
    f32x2 o; o.x = v.x < 0.f ? m.x : r.x; o.y = v.y < 0.f ? m.y : r.y; return o;
}

template <int ACT  > struct EpiBf16 {
    static constexpr bool PERM = true, AFTER_DRAIN = false; static_assert(ACT == 0 || ACT == 1, "EpiBf16: ACT is 0 (none) or 1 (gelu_pk)");
    bf16_t* O; int ldc; const float* bias; int split_cols; size_t split_stride; float scale0;
    __device__ __forceinline__ void operator()(const f32x4 (&acc)[2][2][4][2], const Unit& u, int wr, int wc, int fr, int fq) const {
        const int row0 = u.pm * BM + wr * 64 + fr; int colt = u.pn * BM; bf16_t* base = O;
        float sc = 1.f; if (split_cols) { const int t = colt / split_cols; base += (size_t)t * split_stride; colt -= t * split_cols; if (t == 0) sc = scale0; }
        const int col0 = colt + wc * 32 + 8 * fq, bcol0 = u.pn * BM + wc * 32 + 8 * fq;
        f32x4 bv[2][2];
#pragma unroll
        for (int bj = 0; bj < 2; ++bj)
#pragma unroll
            for (int n = 0; n < 2; ++n) bv[bj][n] = bias ? *(const f32x4*)(bias + bcol0 + bj * HALF + 4 * n) : (f32x4){0.f, 0.f, 0.f, 0.f};
#pragma unroll
        for (int ai = 0; ai < 2; ++ai)
#pragma unroll
            for (int m = 0; m < 4; ++m) { bf16_t* rowp = base + (size_t)(row0 + ai * HALF + m * 16) * ldc + col0;
#pragma unroll
                for (int bj = 0; bj < 2; ++bj) { f32x4 v0 = acc[ai][bj][m][0] + bv[bj][0], v1 = acc[ai][bj][m][1] + bv[bj][1];
                    if (ACT == 1) { f32x2 a = gelu_pk((f32x2){v0[0], v0[1]}), b = gelu_pk((f32x2){v0[2], v0[3]}), c = gelu_pk((f32x2){v1[0], v1[1]}), d = gelu_pk((f32x2){v1[2], v1[3]});
                        v0 = (f32x4){a.x, a.y, b.x, b.y}; v1 = (f32x4){c.x, c.y, d.x, d.y}; }
                    v0 = v0 * sc; v1 = v1 * sc; u32x4 w; w.x = cvt_pk_bf16(v0[0], v0[1]); w.y = cvt_pk_bf16(v0[2], v0[3]); w.z = cvt_pk_bf16(v1[0], v1[1]); w.w = cvt_pk_bf16(v1[2], v1[3]);
                    *(u32x4*)(rowp + bj * HALF) = w; } }
    }
};

struct EpiResF32 {
    static constexpr bool PERM = false, AFTER_DRAIN = false;
    const float* X; float* O; int ldc;
    __device__ __forceinline__ void operator()(const f32x4 (&acc)[2][2][4][2], const Unit& u, int wr, int wc, int fr, int fq) const {
        const int row0 = u.pm * BM + wr * 64 + fr, col0 = u.pn * BM + wc * 32 + 4 * fq;
#pragma unroll
        for (int ai = 0; ai < 2; ++ai)
#pragma unroll
            for (int m = 0; m < 4; ++m) { const size_t off = (size_t)(row0 + ai * HALF + m * 16) * ldc + col0;
#pragma unroll
                for (int bj = 0; bj < 2; ++bj)
#pragma unroll
                    for (int n = 0; n < 2; ++n) { const f32x4 xv = *(const f32x4*)(X + off + bj * HALF + n * 16); *(f32x4*)(O + off + bj * HALF + n * 16) = acc[ai][bj][m][n] + xv; } }
    }
};

struct MoeOrder {
    const PG8_LAS int* tile_e; int T, nN, G, c; size_t expert_stride_bytes;
    const PG8_LAS int* tstart; const PG8_LAS int* cnt; const int* list; int ntok; bool gather;
    __device__ __forceinline__ bool next(int i, Unit& u) const {
        const int L = i * G + c; if (L >= T * nN) return false;
        u.pm = L / nN; u.pn = L % nN; return true;
    }
    __device__ __forceinline__ void a_ready(const Unit&) const {}
    __device__ __forceinline__ void done(const Unit&) const {}
    __device__ __forceinline__ const char* a_base(const Gemm& g, const Unit& u) const { return gather ? (const char*)g.A : (const char*)g.A + (size_t)u.pm * ((size_t)BM * g.K * 2); }
    __device__ __forceinline__ const char* b_base(const Gemm& g, const Unit& u) const { return (const char*)g.Bt + (size_t)tile_e[u.pm] * expert_stride_bytes + (size_t)u.pn * ((size_t)BM * g.K * 2); }
    __device__ __forceinline__ int src_row(const Unit& u, int row) const {
        const int e = tile_e[u.pm]; const int r = (u.pm - tstart[e]) * BM + row;
        return r < cnt[e] ? list[e * ntok + r] : 0;
    }
};
__device__ __forceinline__ float silu_f(float a) { return a * __builtin_amdgcn_rcpf(1.0f + __builtin_amdgcn_exp2f(-1.4426950408889634f * a)); }
struct EpiSwiGLU {
    static constexpr bool PERM = true, AFTER_DRAIN = false;
    bf16_t* H;
    __device__ __forceinline__ void operator()(const f32x4 (&acc)[2][2][4][2], const Unit& u, int wr, int wc, int fr, int fq) const {
        const int row0 = u.pm * BM + wr * 64 + fr, col0 = u.pn * 128 + wc * 32 + 8 * fq;
#pragma unroll
        for (int ai = 0; ai < 2; ++ai)
#pragma unroll
            for (int m = 0; m < 4; ++m) { bf16_t* p = H + (size_t)(row0 + ai * HALF + m * 16) * 512 + col0;
                const f32x4 a0 = acc[ai][0][m][0], a1 = acc[ai][0][m][1], b0 = acc[ai][1][m][0], b1 = acc[ai][1][m][1];
                u32x4 w; w.x = cvt_pk_bf16(silu_f(a0[0]) * b0[0], silu_f(a0[1]) * b0[1]); w.y = cvt_pk_bf16(silu_f(a0[2]) * b0[2], silu_f(a0[3]) * b0[3]);
                w.z = cvt_pk_bf16(silu_f(a1[0]) * b1[0], silu_f(a1[1]) * b1[1]); w.w = cvt_pk_bf16(silu_f(a1[2]) * b1[2], silu_f(a1[3]) * b1[3]);
                *(u32x4*)p = w; }
    }
};
struct EpiRowScaleBf16 {
    static constexpr bool PERM = true, AFTER_DRAIN = false;
    bf16_t* O; int ldc; const float* lgate; const PG8_LAS int* tile_e; const PG8_LAS int* tstart; const PG8_LAS int* cnt; int ntok;
    __device__ __forceinline__ void operator()(const f32x4 (&acc)[2][2][4][2], const Unit& u, int wr, int wc, int fr, int fq) const {
        const int rl0 = wr * 64 + fr, col0 = u.pn * BM + wc * 32 + 8 * fq;
        const int e = tile_e[u.pm]; const int rbase = (u.pm - tstart[e]) * BM; const int ce = cnt[e];
#pragma unroll
        for (int ai = 0; ai < 2; ++ai)
#pragma unroll
            for (int m = 0; m < 4; ++m) { const int rl = rl0 + ai * HALF + m * 16; const int r = rbase + rl; const float sc = r < ce ? lgate[e * ntok + r] : 0.f;
                bf16_t* rowp = O + (size_t)(u.pm * BM + rl) * ldc + col0;
#pragma unroll
                for (int bj = 0; bj < 2; ++bj) { const f32x4 v0 = acc[ai][bj][m][0] * sc, v1 = acc[ai][bj][m][1] * sc;
                    u32x4 w; w.x = cvt_pk_bf16(v0[0], v0[1]); w.y = cvt_pk_bf16(v0[2], v0[3]); w.z = cvt_pk_bf16(v1[0], v1[1]); w.w = cvt_pk_bf16(v1[2], v1[3]);
                    *(u32x4*)(rowp + bj * HALF) = w; } }
    }
};
template <class Epi, class Sched, bool ALIGN_EPI = false, bool SP2 = false, bool GATHER = false>
__device__ __forceinline__ void gemm_phase(PG8_LAS unsigned char* lds, const Gemm g, const Sched& S, const Epi& E) {
    const int tid = threadIdx.x, wid = __builtin_amdgcn_readfirstlane(tid >> 6), lane = tid & 63, wr = wid >> 2, wc = wid & 3, fr = lane & 15, fq = lane >> 4;
    const int K = g.K, nt = K / BK;
    unsigned voffA[2], voffB[2];
#pragma unroll
    for (int i = 0; i < 2; ++i) { int R, C; stage_rc(tid * 16 + i * 8192, R, C); const int Rb = Epi::PERM ? ((R & ~31) + perm32(R & 31)) : R;
        voffA[i] = (unsigned)(R * K + C) * 2u; voffB[i] = (unsigned)(Rb * K + C) * 2u; }
    unsigned voA[2][2], voAn[2][2];
    int gR[2], gC[2];
#pragma unroll
    for (int i = 0; i < 2; ++i) { int R, C; stage_rc(tid * 16 + i * 8192, R, C); gR[i] = R; gC[i] = C; }
#pragma unroll
    for (int h = 0; h < 2; ++h)
#pragma unroll
        for (int i = 0; i < 2; ++i) { voA[h][i] = voffA[i] + (unsigned)h * (unsigned)(HALF * K * 2); voAn[h][i] = voA[h][i]; }
    const size_t kstep = (size_t)(BK * 2);
    const size_t hstep = (size_t)HALF * K * 2;
    const size_t tstep = 2 * hstep; (void)tstep;
    const unsigned ldsw = (unsigned)wid * 1024u;
    const int aoff = lds_byte(wr * 64 + fr, fq * 8), boff = lds_byte(wc * 32 + fr, fq * 8);
#define PG8_SA(b, h) (((b) * 2 + (h)) * HTB)
#define PG8_SB(b, h) ((4 + (b) * 2 + (h)) * HTB)
#define PG8_STAGE(bufoff, gbase, voff) do { _Pragma("unroll") for (int _i = 0; _i < 2; ++_i) \
        __builtin_amdgcn_global_load_lds((const unsigned*)((const char*)(gbase) + (voff)[_i]), (PG8_LAS unsigned*)(lds + (bufoff) + ldsw + _i * 8192), 16, 0, 0); } while (0)
#define PG8_STAGE_A(bufoff, gbase, h, vo) do { _Pragma("unroll") for (int _i = 0; _i < 2; ++_i) \
        __builtin_amdgcn_global_load_lds((const unsigned*)((const char*)(gbase) + (vo)[h][_i]), (PG8_LAS unsigned*)(lds + (bufoff) + ldsw + _i * 8192), 16, 0, 0); } while (0)
#define PG8_GATHER_OFFS(dst, unit) do { _Pragma("unroll") for (int _h = 0; _h < 2; ++_h) _Pragma("unroll") for (int _i = 0; _i < 2; ++_i) \
        (dst)[_h][_i] = (unsigned)(S.src_row(unit, _h * HALF + gR[_i]) * K + gC[_i]) * 2u; } while (0)
#define PG8_LDA(dst, b, h) do { _Pragma("unroll") for (int m = 0; m < 4; ++m) _Pragma("unroll") for (int k = 0; k < 2; ++k) dst[m][k] = *(const PG8_LAS bf16x8*)(lds + PG8_SA(b, h) + aoff + m * 2048 + k * 1024); } while (0)
#define PG8_LDB(dst, b, h) do { _Pragma("unroll") for (int n = 0; n < 2; ++n) _Pragma("unroll") for (int k = 0; k < 2; ++k) dst[n][k] = *(const PG8_LAS bf16x8*)(lds + PG8_SB(b, h) + boff + n * 2048 + k * 1024); } while (0)
#define PG8_MMA(ai, bj, At, Bt) do { __builtin_amdgcn_s_setprio(1); _Pragma("unroll") for (int m = 0; m < 4; ++m) _Pragma("unroll") for (int n = 0; n < 2; ++n) _Pragma("unroll") for (int k = 0; k < 2; ++k) \
        acc[ai][bj][m][n] = __builtin_amdgcn_mfma_f32_16x16x32_bf16(Bt[n][k], At[m][k], acc[ai][bj][m][n], 0, 0, 0); __builtin_amdgcn_s_setprio(0); } while (0)
#define PG8_WAIT_V(n) asm volatile("s_waitcnt vmcnt(" #n ")" ::: "memory")
#define PG8_WAIT_L(n) asm volatile("s_waitcnt lgkmcnt(" #n ")" ::: "memory")
#define PG8_BAR __builtin_amdgcn_s_barrier()
#define PG8_SCHED __builtin_amdgcn_sched_barrier(0)
    Unit cur, nxt; int ui = 0;
    if (!S.next(0, cur)) return;
    f32x4 acc[2][2][4][2];
#pragma unroll
    for (int a = 0; a < 2; ++a)
#pragma unroll
        for (int b = 0; b < 2; ++b)
#pragma unroll
            for (int m = 0; m < 4; ++m)
#pragma unroll
                for (int n = 0; n < 2; ++n) acc[a][b][m][n] = (f32x4){0.f, 0.f, 0.f, 0.f};
    bf16x8 At[4][2], B0[2][2], B1[2][2];
    const char* cA = S.a_base(g, cur); const char* cB = S.b_base(g, cur);
    if constexpr (GATHER) { PG8_GATHER_OFFS(voA, cur); }
    S.a_ready(cur);
    if constexpr (SP2) {
        PG8_STAGE(PG8_SB(0, 0), cB, voffB); PG8_STAGE(PG8_SB(0, 1), cB + hstep, voffB); PG8_STAGE_A(PG8_SA(0, 0), cA, 0, voA); PG8_STAGE_A(PG8_SA(0, 1), cA, 1, voA);
        if (wr == 1) PG8_BAR;
        PG8_WAIT_V(2); PG8_BAR;
        PG8_STAGE(PG8_SB(1, 0), cB + kstep, voffB); PG8_STAGE_A(PG8_SA(1, 0), cA + kstep, 0, voA); PG8_STAGE(PG8_SB(1, 1), cB + hstep + kstep, voffB);
        PG8_WAIT_V(6); PG8_BAR;
    } else {
        PG8_STAGE(PG8_SB(0, 0), cB, voffB); PG8_STAGE_A(PG8_SA(0, 0), cA, 0, voA); PG8_STAGE(PG8_SB(0, 1), cB + hstep, voffB); PG8_STAGE_A(PG8_SA(0, 1), cA, 1, voA);
        if (wr == 1) PG8_BAR;
        PG8_WAIT_V(4); PG8_BAR;
        PG8_STAGE(PG8_SB(1, 0), cB + kstep, voffB); PG8_STAGE_A(PG8_SA(1, 0), cA + kstep, 0, voA); PG8_STAGE(PG8_SB(1, 1), cB + hstep + kstep, voffB);
        PG8_WAIT_V(6); PG8_BAR;
    }
    for (;;) {
        const bool has_next = S.next(ui + 1, nxt);
        const char* nA = has_next ? S.a_base(g, nxt) : cA; const char* nB = has_next ? S.b_base(g, nxt) : cB;
        if constexpr (GATHER) { if (has_next) { PG8_GATHER_OFFS(voAn, nxt); } else {
#pragma unroll
            for (int _h = 0; _h < 2; ++_h) { voAn[_h][0] = voA[_h][0]; voAn[_h][1] = voA[_h][1]; } } }
        for (int t = 0; t < nt; t += 2) {
            const bool last = (t == nt - 2);
            const char* a1 = cA + (size_t)(t + 1) * kstep;
            const char* a2 = last ? nA : cA + (size_t)(t + 2) * kstep; const char* b2 = last ? nB : cB + (size_t)(t + 2) * kstep;
            const char* a3 = a2 + kstep; const char* b3 = b2 + kstep;
            if (last && has_next) S.a_ready(nxt);
            if constexpr (SP2) {
            PG8_LDB(B0, 0, 0); PG8_LDB(B1, 0, 1); PG8_SCHED; PG8_LDA(At, 0, 0); PG8_STAGE_A(PG8_SA(1, 1), a1, 1, voA);
            PG8_WAIT_V(8); PG8_WAIT_L(0); PG8_BAR; PG8_MMA(0, 0, At, B0); PG8_MMA(0, 1, At, B1); PG8_BAR; PG8_SCHED;
            PG8_LDA(At, 0, 1); PG8_STAGE(PG8_SB(0, 0), b2, voffB); PG8_STAGE(PG8_SB(0, 1), b2 + hstep, voffB); if (last) { PG8_STAGE_A(PG8_SA(0, 0), a2, 0, voAn); } else { PG8_STAGE_A(PG8_SA(0, 0), a2, 0, voA); }
            PG8_WAIT_V(8); PG8_WAIT_L(0); PG8_BAR; PG8_MMA(1, 0, At, B0); PG8_MMA(1, 1, At, B1); PG8_BAR; PG8_SCHED;
            PG8_LDB(B0, 1, 0); PG8_LDB(B1, 1, 1); PG8_SCHED; PG8_LDA(At, 1, 0); if (last) { PG8_STAGE_A(PG8_SA(0, 1), a2, 1, voAn); } else { PG8_STAGE_A(PG8_SA(0, 1), a2, 1, voA); }
            PG8_WAIT_V(8); PG8_WAIT_L(0); PG8_BAR; PG8_MMA(0, 0, At, B0); PG8_MMA(0, 1, At, B1); PG8_BAR; PG8_SCHED;
            PG8_LDA(At, 1, 1); PG8_STAGE(PG8_SB(1, 0), b3, voffB); PG8_STAGE(PG8_SB(1, 1), b3 + hstep, voffB); if (last) { PG8_STAGE_A(PG8_SA(1, 0), a3, 0, voAn); } else { PG8_STAGE_A(PG8_SA(1, 0), a3, 0, voA); }
            PG8_WAIT_V(8); PG8_WAIT_L(0); PG8_BAR; PG8_MMA(1, 0, At, B0); PG8_MMA(1, 1, At, B1); PG8_BAR; PG8_SCHED;
            } else {
            PG8_LDB(B0, 0, 0); PG8_SCHED; PG8_LDA(At, 0, 0); PG8_STAGE(PG8_SA(1, 1), a1 + hstep, voffA);
            PG8_WAIT_L(8); PG8_BAR; PG8_WAIT_L(0); PG8_MMA(0, 0, At, B0); PG8_BAR; PG8_SCHED;
            PG8_LDB(B1, 0, 1); PG8_STAGE(PG8_SB(0, 0), b2, voffB);
            PG8_BAR; PG8_WAIT_L(0); PG8_MMA(0, 1, At, B1); PG8_BAR;
            PG8_LDA(At, 0, 1); PG8_STAGE(PG8_SA(0, 0), a2, voffA);
            PG8_BAR; PG8_WAIT_L(0); PG8_MMA(1, 0, At, B0); PG8_BAR; PG8_SCHED;
            PG8_STAGE(PG8_SB(0, 1), b2 + hstep, voffB);
            PG8_WAIT_V(6); PG8_BAR; PG8_MMA(1, 1, At, B1); PG8_BAR;
            PG8_LDB(B0, 1, 0); PG8_SCHED; PG8_LDA(At, 1, 0); PG8_STAGE(PG8_SA(0, 1), a2 + hstep, voffA);
            PG8_WAIT_L(8); PG8_BAR; PG8_WAIT_L(0); PG8_MMA(0, 0, At, B0); PG8_BAR; PG8_SCHED;
            PG8_LDB(B1, 1, 1); PG8_STAGE(PG8_SB(1, 0), b3, voffB);
            PG8_BAR; PG8_WAIT_L(0); PG8_MMA(0, 1, At, B1); PG8_BAR;
            PG8_LDA(At, 1, 1); PG8_STAGE(PG8_SA(1, 0), a3, voffA);
            PG8_BAR; PG8_WAIT_L(0); PG8_MMA(1, 0, At, B0); PG8_BAR; PG8_SCHED;
            PG8_STAGE(PG8_SB(1, 1), b3 + hstep, voffB);
            PG8_WAIT_V(6); PG8_BAR; PG8_MMA(1, 1, At, B1); PG8_BAR;
            }
        }
        if constexpr (ALIGN_EPI) { if (wr == 0) PG8_BAR; }
        if constexpr (!Epi::AFTER_DRAIN) { E(acc, cur, wr, wc, fr, fq); S.done(cur); }
        if (!has_next) break;
#pragma unroll
        for (int a = 0; a < 2; ++a)
#pragma unroll
            for (int b = 0; b < 2; ++b)
#pragma unroll
                for (int m = 0; m < 4; ++m)
#pragma unroll
                    for (int n = 0; n < 2; ++n) acc[a][b][m][n] = (f32x4){0.f, 0.f, 0.f, 0.f};
        cur = nxt; cA = nA; cB = nB; ++ui;
        if constexpr (GATHER) {
#pragma unroll
            for (int _h = 0; _h < 2; ++_h) { voA[_h][0] = voAn[_h][0]; voA[_h][1] = voAn[_h][1]; } }
        if constexpr (ALIGN_EPI) { if (wr == 1) PG8_BAR; }
    }
    PG8_WAIT_V(0);
    if constexpr (!ALIGN_EPI) { if (wr == 0) PG8_BAR; }
    PG8_BAR;
    if constexpr (Epi::AFTER_DRAIN) { E.fused(acc, cur, wr, wc, fr, fq, lds, wid, lane); S.done(cur); }
#undef PG8_SA
#undef PG8_SB
#undef PG8_STAGE
#undef PG8_STAGE_A
#undef PG8_GATHER_OFFS
#undef PG8_LDA
#undef PG8_LDB
#undef PG8_MMA
#undef PG8_WAIT_V
#undef PG8_WAIT_L
#undef PG8_BAR
#undef PG8_SCHED
}
}
#define LAS __attribute__((address_space(3)))
#define XB_TMO      128
#define XB_XCNT(j)  (256  + 64 * (j))
#define XB_XSUB(j)  (1280 + 64 * (j))
#define XB_XGEN(j)  (2304 + 64 * (j))
#define XB_TOP      3328
#define XB_TOPGEN   3392
#define XCD_BAR_WORDS 3456
#define XB_SPIN_CAP (1u << 18)

__device__ __forceinline__ unsigned xb_ld(unsigned* p)              { return __hip_atomic_load(p, __ATOMIC_RELAXED, __HIP_MEMORY_SCOPE_AGENT); }
__device__ __forceinline__ unsigned xb_add(unsigned* p, unsigned v) { return __hip_atomic_fetch_add(p, v, __ATOMIC_RELAXED, __HIP_MEMORY_SCOPE_AGENT); }
__device__ __forceinline__ unsigned xb_xcc_id() { return (unsigned)__builtin_amdgcn_s_getreg((3 << 11) | 20) & 0xFu; }
#define XB_SPIN(cond, bar) do { unsigned _sp = 0; while (cond) { __builtin_amdgcn_s_sleep(1); \
    if ((++_sp & 255u) == 0u) { if (xb_ld(&(bar)[XB_TMO])) break; if (_sp > XB_SPIN_CAP) { atomicAdd(&(bar)[XB_TMO], 1u); break; } } } } while (0)

struct XcdBarrier {
    unsigned* bar; unsigned x;
    volatile LAS unsigned* st;
};

__device__ __forceinline__ XcdBarrier xcd_barrier_post(unsigned* bar, volatile LAS unsigned* st) {
    XcdBarrier b; b.bar = bar; b.x = xb_xcc_id(); b.st = st;
    if (threadIdx.x == 0) (void)xb_add(&bar[XB_XCNT(b.x)], 1u);
    return b;
}
__device__ __forceinline__ void xcd_barrier_complete(unsigned* bar, unsigned x, unsigned& nloc, unsigned& nx) {
    const unsigned G = gridDim.x * gridDim.y * gridDim.z;
    unsigned sum, cnt, mine, sp = 0u;
    for (;;) {
        sum = 0u; cnt = 0u; mine = 0u;
#pragma unroll
        for (unsigned j = 0; j < 16; ++j) { const unsigned c = xb_ld(&bar[XB_XCNT(j)]); sum += c; cnt += (c > 0u) ? 1u : 0u; mine = (j == x) ? c : mine; }
        if (sum == G) break;
        __builtin_amdgcn_s_sleep(1);
        if ((++sp & 255u) == 0u) { if (xb_ld(&bar[XB_TMO])) break; if (sp > XB_SPIN_CAP) { atomicAdd(&bar[XB_TMO], 1u); break; } }
    }
    nloc = mine > 0u ? mine : 1u; nx = cnt > 0u ? cnt : 1u;
}

__device__ __forceinline__ void xcd_barrier(const XcdBarrier& b) {
    asm volatile("s_waitcnt vmcnt(0)" ::: "memory");
    __syncthreads();
    if (threadIdx.x == 0) {
        unsigned* bar = b.bar;
        __builtin_amdgcn_s_waitcnt(0);
        unsigned nloc = b.st[0], nx = b.st[1];
        if (nloc == 0u) { xcd_barrier_complete(bar, b.x, nloc, nx); b.st[0] = nloc; b.st[1] = nx; }
        const unsigned old = xb_add(&bar[XB_XSUB(b.x)], 1u);
        const unsigned gen = old / nloc;
        if (old + 1u == (gen + 1u) * nloc) {
            __builtin_amdgcn_fence(__ATOMIC_RELEASE, "agent");
            asm volatile("s_waitcnt vmcnt(0)" ::: "memory");
            const unsigned og = xb_add(&bar[XB_TOP], 1u);
            const unsigned tg = og / nx;
            if (og + 1u == (tg + 1u) * nx) xb_add(&bar[XB_TOPGEN], 1u);
            else XB_SPIN(xb_ld(&bar[XB_TOPGEN]) == tg, bar);
            __builtin_amdgcn_fence(__ATOMIC_ACQUIRE, "agent");
            xb_add(&bar[XB_XGEN(b.x)], 1u);
            asm volatile("s_waitcnt vmcnt(0)" ::: "memory");
        } else {
            XB_SPIN(xb_ld(&bar[XB_XGEN(b.x)]) == gen, bar);
            __builtin_amdgcn_fence(__ATOMIC_ACQUIRE, "agent");
            asm volatile("s_waitcnt vmcnt(0)" ::: "memory");
        }
    }
    __syncthreads();
}

#define GAS __attribute__((address_space(1)))
typedef unsigned v4u __attribute__((ext_vector_type(4)));
#define LDS_WAIT() asm volatile("s_waitcnt lgkmcnt(0)" ::: "memory")
constexpr int NWAVES = 8;
constexpr int RING_BYTES = 139264, LDSCTL_OFF = RING_BYTES, MISC_OFF = LDSCTL_OFF + 320, LDS_BYTES = 155648;
constexpr size_t CTL_ZERO_BYTES = 1 * MiB;
constexpr int CW_BAR = 4096;
constexpr int MAX_LAUNCHES = 12;
static_assert((CW_BAR + MAX_LAUNCHES * XCD_BAR_WORDS) * 4 <= (int)CTL_ZERO_BYTES, "ctl");

constexpr size_t WS_WINT = 1 * MiB, WS_WOUTT = 6 * MiB, WS_W13T = 8 * MiB, WS_W2T = 72 * MiB;
constexpr size_t WS_HN1 = 104 * MiB, WS_LRU = 168 * MiB, WS_HYUT = 232 * MiB, WS_HF = 396 * MiB, WS_HB = 428 * MiB;
constexpr size_t WS_YHYT = 104 * MiB, WS_YCAT = 232 * MiB, WS_HN2 = 168 * MiB, WS_EID = 460 * MiB, WS_GATE = 461 * MiB;
constexpr size_t WS_LIST = 460 * MiB, WS_LGATE = 464 * MiB, WS_TOKINFO = 468 * MiB, WS_WRT = 469 * MiB, WS_SGATE = 470 * MiB;
constexpr size_t WS_XS = 232 * MiB, WS_H = 376 * MiB, WS_Y = 104 * MiB;
constexpr size_t WS_XC = 104 * MiB, WS_Z2 = 392 * MiB, WS_KT = 328 * MiB;
constexpr int CW_CNT = 2048;
constexpr int LC_CNT = RING_BYTES + 1024, LC_BASE = RING_BYTES + 1152, LC_TSTART = RING_BYTES + 1280, LC_TILEE = RING_BYTES + 2048;

struct Args { const float* in[37]; float* out; unsigned char* ws; int ph_lo, ph_hi, li, pad; };

__device__ __forceinline__ unsigned pk2(float lo, float hi) { return (unsigned)f2bf(lo) | ((unsigned)f2bf(hi) << 16); }

__device__ __forceinline__ void p0_transpose_item(const float* __restrict__ W, int K, int N, bf16* __restrict__ WT, int drow0, LAS float* scr, int k0, int n0, int lane) {
#pragma unroll 8
    for (int i = 0; i < 32; ++i) { const int kk = 2 * i + (lane >> 5); scr[kk * 33 + (lane & 31)] = W[(size_t)(k0 + kk) * N + n0 + (lane & 31)]; }
    LDS_WAIT(); asm volatile("" ::: "memory");
    const int c = lane & 7;
#pragma unroll
    for (int j = 0; j < 4; ++j) { const int n = (lane >> 3) + 8 * j; const LAS float* s = scr + (8 * c) * 33 + n;
        v4u o; o.x = pk2(s[0 * 33], s[1 * 33]); o.y = pk2(s[2 * 33], s[3 * 33]); o.z = pk2(s[4 * 33], s[5 * 33]); o.w = pk2(s[6 * 33], s[7 * 33]);
        *(v4u*)(WT + (size_t)(drow0 + n) * K + k0 + 8 * c) = o; }
    LDS_WAIT(); asm volatile("" ::: "memory");
}
__device__ __forceinline__ void rms_row_to_bf16(const float* __restrict__ xrow, const float* __restrict__ g, bf16* __restrict__ orow, int lane) {
    const float4* xr = (const float4*)xrow;
    float4 v[4]; float s = 0.f;
#pragma unroll
    for (int j = 0; j < 4; ++j) { v[j] = xr[lane + 64 * j]; s += (v[j].x * v[j].x + v[j].y * v[j].y) + (v[j].z * v[j].z + v[j].w * v[j].w); }
    s = wave_sum(s);
    const float rstd = rsqrtf(s * (1.0f / DM) + EPS);
#pragma unroll
    for (int j = 0; j < 4; ++j) { const int c = (lane + 64 * j) * 4; const float4 gg = *(const float4*)(g + c);
        uint2 o; o.x = pk2(v[j].x * rstd * gg.x, v[j].y * rstd * gg.y); o.y = pk2(v[j].z * rstd * gg.z, v[j].w * rstd * gg.w);
        *(uint2*)(orow + c) = o; }
}


typedef short bf16x8_t __attribute__((ext_vector_type(8)));
typedef float f32x4_t __attribute__((ext_vector_type(4)));
__device__ __forceinline__ int moe_tables(LAS unsigned char* L, unsigned* ctl, int tid) {
    LAS int* cnt = (LAS int*)(L + LC_CNT); LAS int* tstart = (LAS int*)(L + LC_TSTART); LAS int* tile_e = (LAS int*)(L + LC_TILEE);
    __syncthreads();
    if (tid < 32) cnt[tid] = (int)__hip_atomic_load(ctl + CW_CNT + tid, __ATOMIC_RELAXED, __HIP_MEMORY_SCOPE_AGENT);
    __syncthreads();
    if (tid == 0) { int ts = 0; for (int e = 0; e < 32; ++e) { tstart[e] = ts; const int nt = (cnt[e] + 255) >> 8; for (int i = 0; i < nt; ++i) tile_e[ts + i] = e; ts += nt; } tstart[32] = ts; }
    __syncthreads();
    return tstart[32];
}

__device__ __forceinline__ void lru_load_frags(const bf16* xrow0, int sg0, int jl, int dir, v4u (&fr)[4][2]) {
#pragma unroll
    for (int mt = 0; mt < 4; ++mt) { const int sg = 16 * (jl >> 2) + 4 * mt + (jl & 3); const int tau = sg0 + sg; const int t = dir ? (SEQ - 1 - tau) : tau;
#pragma unroll
        for (int s = 0; s < 2; ++s) fr[mt][s] = *(const v4u*)(xrow0 + (size_t)t * 64 + 32 * s); }
}
__device__ __forceinline__ void lru_item(LAS unsigned char* L, const Args& a, int item, const bf16* __restrict__ xcb, bf16* __restrict__ hf, bf16* __restrict__ hb, int tid, int lane, int wave) {
    const int b = item >> 6, h = (item >> 3) & 7, q4 = (item >> 1) & 3, dir = item & 1;
    const float* wr = dir ? a.in[10] : a.in[5]; const float* br = dir ? a.in[11] : a.in[6]; const float* wi = dir ? a.in[12] : a.in[7];
    const float* bi = dir ? a.in[13] : a.in[8]; const float* lam = dir ? a.in[14] : a.in[9];
    bf16* outp = dir ? hb : hf;
    LAS float* carry = (LAS float*)(L + 2048);
    const int jl = lane & 15, kg = lane >> 4;
    const int c = 64 * h + 16 * q4 + jl;
    bf16x8_t Br[2], Bi[2], Bid;
#pragma unroll
    for (int s = 0; s < 2; ++s)
#pragma unroll
        for (int j = 0; j < 8; ++j) { const int i = 32 * s + 8 * kg + j;
            Br[s][j] = (short)f2bf(wr[h * 4096 + i * 64 + 16 * q4 + jl]); Bi[s][j] = (short)f2bf(wi[h * 4096 + i * 64 + 16 * q4 + jl]); }
#pragma unroll
    for (int j = 0; j < 8; ++j) Bid[j] = (8 * kg + j == 16 * (q4 & 1) + jl) ? (short)0x3f80 : (short)0;
    const int sid = q4 >> 1;
    const float brc = br[c], bic = bi[c];
    const float sp8l = 8.0f * log1pf(expf(-lam[c])) * 1.4426950408889634f;
    __syncthreads();
    float Hblk = 0.f;
    const bf16* xrow0 = xcb + ((size_t)(b * 8 + h) * SEQ) * 64 + 8 * kg;
    v4u frn[4][2];
    lru_load_frags(xrow0, 64 * wave, jl, dir, frn);
    for (int it = 0; it < 16; ++it) {
        const int sg0 = 512 * it + 64 * wave;
        bf16x8_t Af[4][2];
#pragma unroll
        for (int mt = 0; mt < 4; ++mt)
#pragma unroll
            for (int s = 0; s < 2; ++s) Af[mt][s] = __builtin_bit_cast(bf16x8_t, frn[mt][s]);
        if (it < 15) lru_load_frags(xrow0, sg0 + 512, jl, dir, frn);
        float hloc[16], Ploc[16];
        float hl = 0.f, P = 1.f;
#pragma unroll
        for (int mt = 0; mt < 4; ++mt) {
            f32x4_t aR = {0.f, 0.f, 0.f, 0.f}, aI = aR, aX = aR;
            aR = __builtin_amdgcn_mfma_f32_16x16x32_bf16(Af[mt][0], Br[0], aR, 0, 0, 0); aR = __builtin_amdgcn_mfma_f32_16x16x32_bf16(Af[mt][1], Br[1], aR, 0, 0, 0);
            aI = __builtin_amdgcn_mfma_f32_16x16x32_bf16(Af[mt][0], Bi[0], aI, 0, 0, 0); aI = __builtin_amdgcn_mfma_f32_16x16x32_bf16(Af[mt][1], Bi[1], aI, 0, 0, 0);
            aX = __builtin_amdgcn_mfma_f32_16x16x32_bf16(sid ? Af[mt][1] : Af[mt][0], Bid, aX, 0, 0, 0);
#pragma unroll
            for (int r = 0; r < 4; ++r) {
                const float rg = __builtin_amdgcn_rcpf(1.0f + __builtin_amdgcn_exp2f(-1.4426950408889634f * (aR[r] + brc)));
                const float ig = __builtin_amdgcn_rcpf(1.0f + __builtin_amdgcn_exp2f(-1.4426950408889634f * (aI[r] + bic)));
                const float av = __builtin_amdgcn_exp2f(-rg * sp8l);
                const float bb = __builtin_amdgcn_sqrtf(fmaxf(1.0f - av * av, 0.f)) * (ig * aX[r]);
                hl = av * hl + bb; P *= av;
                hloc[4 * mt + r] = hl; Ploc[4 * mt + r] = P;
            }
        }
        const float A0 = __shfl(P, jl), B0 = __shfl(hl, jl), A1 = __shfl(P, jl + 16), B1 = __shfl(hl, jl + 16);
        const float A2 = __shfl(P, jl + 32), B2 = __shfl(hl, jl + 32), A3 = __shfl(P, jl + 48), B3 = __shfl(hl, jl + 48);
        LAS float* cbuf = carry + (it & 1) * 256;
        if (kg == 0) { cbuf[(wave * 16 + jl) * 2 + 0] = A0 * A1 * A2 * A3; cbuf[(wave * 16 + jl) * 2 + 1] = ((B0 * A1 + B1) * A2 + B2) * A3 + B3; }
        __syncthreads();
        float Hw = Hblk, Hn = Hblk;
#pragma unroll
        for (int w2 = 0; w2 < 8; ++w2) { const float Aq = cbuf[(w2 * 16 + jl) * 2 + 0], Bq = cbuf[(w2 * 16 + jl) * 2 + 1];
            if (w2 < wave) Hw = Aq * Hw + Bq;
            Hn = Aq * Hn + Bq; }
        Hblk = Hn;
        float Hin = Hw;
        if (kg >= 1) Hin = A0 * Hin + B0;
        if (kg >= 2) Hin = A1 * Hin + B1;
        if (kg >= 3) Hin = A2 * Hin + B2;
#pragma unroll
        for (int k = 0; k < 16; ++k) { const int tau = sg0 + 16 * kg + k; const int t = dir ? (SEQ - 1 - tau) : tau;
            outp[((size_t)b * SEQ + t) * DL + c] = f2bf(hloc[k] + Ploc[k] * Hin); }
    }
}

typedef float f32x2_t __attribute__((ext_vector_type(2)));
typedef _Float16 f16x2_t __attribute__((ext_vector_type(2)));
constexpr int LC_TW = RING_BYTES + 4096, LC_TA = RING_BYTES + 8192, LC_TB = RING_BYTES + 9216, LC_RED = RING_BYTES + 3328;
constexpr size_t WS_SPEC = 328 * MiB, WS_HT = 396 * MiB, WS_XCB = 136 * MiB;
__device__ __forceinline__ f32x2_t cmul(f32x2_t a, f32x2_t b) { f32x2_t r; r.x = a.x * b.x - a.y * b.y; r.y = a.x * b.y + a.y * b.x; return r; }
__device__ __forceinline__ f32x2_t h2_to_f2(unsigned u) { const f16x2_t h = __builtin_bit_cast(f16x2_t, u); f32x2_t k; k.x = (float)h.x; k.y = (float)h.y; return k; }
__device__ __forceinline__ f32x2_t cmulc(f32x2_t a, f32x2_t b) { f32x2_t r; r.x = a.x * b.x + a.y * b.y; r.y = a.y * b.x - a.x * b.y; return r; }
template <bool INV> __device__ __forceinline__ f32x2_t twc(f32x2_t d, int e) {
    constexpr float CT[16] = {1.000000000e+00f, 9.807852804e-01f, 9.238795325e-01f, 8.314696123e-01f, 7.071067812e-01f, 5.555702330e-01f, 3.826834324e-01f, 1.950903220e-01f, 6.123233996e-17f, -1.950903220e-01f, -3.826834324e-01f, -5.555702330e-01f, -7.071067812e-01f, -8.314696123e-01f, -9.238795325e-01f, -9.807852804e-01f};
    constexpr float ST[16] = {0.000000000e+00f, 1.950903220e-01f, 3.826834324e-01f, 5.555702330e-01f, 7.071067812e-01f, 8.314696123e-01f, 9.238795325e-01f, 9.807852804e-01f, 1.000000000e+00f, 9.807852804e-01f, 9.238795325e-01f, 8.314696123e-01f, 7.071067812e-01f, 5.555702330e-01f, 3.826834324e-01f, 1.950903220e-01f};
    f32x2_t r;
    if (e == 0) return d;
    if (e == 8) { if (INV) { r.x = -d.y; r.y = d.x; } else { r.x = d.y; r.y = -d.x; } return r; }
    const float c = CT[e], s = INV ? -ST[e] : ST[e];
    if (e == 4) { r.x = (d.x + (INV ? -d.y : d.y)) * c; r.y = (d.y - (INV ? -d.x : d.x)) * c; return r; }
    r.x = d.x * c + d.y * s; r.y = d.y * c - d.x * s; return r;
}
template <int R, bool INV> struct DFT {
    static __device__ __forceinline__ void run(f32x2_t (&x)[R]) {
        f32x2_t u[R / 2], v[R / 2];
#pragma unroll
        for (int k = 0; k < R / 2; ++k) { const f32x2_t p = x[k], q = x[k + R / 2]; u[k] = p + q; v[k] = twc<INV>(p - q, k * (32 / R)); }
        DFT<R / 2, INV>::run(u); DFT<R / 2, INV>::run(v);
#pragma unroll
        for (int q = 0; q < R / 2; ++q) { x[2 * q] = u[q]; x[2 * q + 1] = v[q]; }
    }
};
template <bool INV> struct DFT<1, INV> { static __device__ __forceinline__ void run(f32x2_t (&)[1]) {} };

typedef f16x2_t c16;
__device__ __forceinline__ c16 c16_from(f32x2_t v) { c16 r; r.x = (_Float16)v.x; r.y = (_Float16)v.y; return r; }
__device__ __forceinline__ c16 cmul16(c16 a, c16 w) { c16 wx; wx.x = w.x; wx.y = w.x; c16 wy; wy.x = w.y; wy.y = w.y; c16 at; at.x = -a.y; at.y = a.x; return a * wx + at * wy; }
__device__ __forceinline__ c16 cmulc16(c16 a, c16 w) { c16 wx; wx.x = w.x; wx.y = w.x; c16 wy; wy.x = w.y; wy.y = w.y; c16 at; at.x = a.y; at.y = -a.x; return a * wx + at * wy; }
template <bool INV> __device__ __forceinline__ c16 twc(c16 d, int e) {
    constexpr float CT[16] = {1.000000000e+00f, 9.807852804e-01f, 9.238795325e-01f, 8.314696123e-01f, 7.071067812e-01f, 5.555702330e-01f, 3.826834324e-01f, 1.950903220e-01f, 6.123233996e-17f, -1.950903220e-01f, -3.826834324e-01f, -5.555702330e-01f, -7.071067812e-01f, -8.314696123e-01f, -9.238795325e-01f, -9.807852804e-01f};
    constexpr float ST[16] = {0.000000000e+00f, 1.950903220e-01f, 3.826834324e-01f, 5.555702330e-01f, 7.071067812e-01f, 8.314696123e-01f, 9.238795325e-01f, 9.807852804e-01f, 1.000000000e+00f, 9.807852804e-01f, 9.238795325e-01f, 8.314696123e-01f, 7.071067812e-01f, 5.555702330e-01f, 3.826834324e-01f, 1.950903220e-01f};
    c16 r;
    if (e == 0) return d;
    if (e == 8) { if (INV) { r.x = -d.y; r.y = d.x; } else { r.x = d.y; r.y = -d.x; } return r; }
    const _Float16 c = (_Float16)CT[e], s = (_Float16)(INV ? -ST[e] : ST[e]);
    c16 cc; cc.x = c; cc.y = c; c16 ss; ss.x = s; ss.y = s; c16 dt; dt.x = d.y; dt.y = -d.x;
    return d * cc + dt * ss;
}
template <int R, bool INV> struct DFTH {
    static __device__ __forceinline__ void run(c16 (&x)[R]) {
        c16 u[R / 2], v[R / 2];
#pragma unroll
        for (int k = 0; k < R / 2; ++k) { const c16 p = x[k], q = x[k + R / 2]; u[k] = p + q; v[k] = twc<INV>(p - q, k * (32 / R)); }
        DFTH<R / 2, INV>::run(u); DFTH<R / 2, INV>::run(v);
#pragma unroll
        for (int q = 0; q < R / 2; ++q) { x[2 * q] = u[q]; x[2 * q + 1] = v[q]; }
    }
};
template <bool INV> struct DFTH<1, INV> { static __device__ __forceinline__ void run(c16 (&)[1]) {} };
template <bool CONJ, int STRIDE> __device__ __forceinline__ void tw_apply16h(c16 (&x)[16], const LAS c16* T) {
#pragma unroll
    for (int q = 1; q < 16; ++q) { const c16 wh = T[q * STRIDE]; x[q] = CONJ ? cmulc16(x[q], wh) : cmul16(x[q], wh); }
}
#define SWZ(p) ((p) + ((p) >> 5))
constexpr int FBUF = 8448;
template <bool CONJ> __device__ __forceinline__ void tw_apply16(f32x2_t (&x)[16], f32x2_t w1) {
    f32x2_t w = w1;
#pragma unroll
    for (int q = 1; q < 16; ++q) { x[q] = CONJ ? cmulc(x[q], w) : cmul(x[q], w); if (q < 15) w = cmul(w, w1); }
}
constexpr int LT_P1 = 67584, LT_P2 = LT_P1 + 32768, LT_WN = LT_P2 + 2048;
static_assert(LT_WN + 8448 * 4 <= RING_BYTES, "fft tables");
__device__ __forceinline__ void fft_tables_init(LAS unsigned char* L, int tid) {
    LAS c16* P1 = (LAS c16*)(L + LT_P1); LAS c16* P2 = (LAS c16*)(L + LT_P2); LAS c16* WN = (LAS c16*)(L + LT_WN);
#pragma unroll 4
    for (int q = 0; q < 16; ++q) { float s, c; sincospif((float)(tid * q) * (1.0f / 4096.0f), &s, &c); c16 w; w.x = (_Float16)c; w.y = (_Float16)(-s); P1[q * 512 + tid] = w; }
    { const int q = tid >> 5, j = tid & 31; float s, c; sincospif((float)(j * q) * (1.0f / 256.0f), &s, &c); c16 w; w.x = (_Float16)c; w.y = (_Float16)(-s); P2[q * 32 + j] = w; }
#pragma unroll 4
    for (int i = 0; i < 16; ++i) { const int n = 16 * tid + i; float s, c; sincospif((float)n * (1.0f / 8192.0f), &s, &c); c16 w; w.x = (_Float16)c; w.y = (_Float16)(-s); WN[n + (n >> 5)] = w; }
    __syncthreads();
}
#define OPAQUE(v) asm volatile("" : "+v"(v))
__device__ __forceinline__ void fwd_pass1(LAS f32x2_t* buf, const LAS f32x2_t* TW, int tid) {
    OPAQUE(tid);
    LAS f32x2_t* b0 = buf + tid + (tid >> 5);
    f32x2_t x[16];
#pragma unroll
    for (int m = 0; m < 16; ++m) x[m] = b0[528 * m];
    DFT<16, false>::run(x); tw_apply16<false>(x, TW[tid]);
#pragma unroll
    for (int q = 0; q < 16; ++q) b0[528 * q] = x[q];
}
__device__ __forceinline__ void fwd_pass2(LAS f32x2_t* buf, const LAS f32x2_t* TW, int tid) {
    OPAQUE(tid);
    LAS f32x2_t* b0 = buf + (tid >> 5) * 528 + (tid & 31);
    f32x2_t x[16];
#pragma unroll
    for (int m = 0; m < 16; ++m) x[m] = b0[33 * m];
    DFT<16, false>::run(x); tw_apply16<false>(x, TW[16 * (tid & 31)]);
#pragma unroll
    for (int q = 0; q < 16; ++q) b0[33 * q] = x[q];
}
__device__ __forceinline__ void inv_pass2(LAS f32x2_t* buf, const LAS f32x2_t* TW, int tid) {
    OPAQUE(tid);
    LAS f32x2_t* b0 = buf + (tid >> 5) * 528 + (tid & 31);
    f32x2_t x[16];
#pragma unroll
    for (int q = 0; q < 16; ++q) x[q] = b0[33 * q];
    tw_apply16<true>(x, TW[16 * (tid & 31)]); DFT<16, true>::run(x);
#pragma unroll
    for (int m = 0; m < 16; ++m) b0[33 * m] = x[m];
}
__device__ __forceinline__ void inv_pass1(LAS f32x2_t* buf, const LAS f32x2_t* TW, int tid) {
    OPAQUE(tid);
    LAS f32x2_t* b0 = buf + tid + (tid >> 5);
    f32x2_t x[16];
#pragma unroll
    for (int q = 0; q < 16; ++q) x[q] = b0[528 * q];
    tw_apply16<true>(x, TW[tid]); DFT<16, true>::run(x);
#pragma unroll
    for (int m = 0; m < 16; ++m) b0[528 * m] = x[m];
}
__device__ __forceinline__ void fft2_forward(LAS unsigned char* L) {
    const int tid = threadIdx.x;
    LAS f32x2_t* bufE = (LAS f32x2_t*)L; LAS f32x2_t* bufO = bufE + FBUF; const LAS f32x2_t* TW = (const LAS f32x2_t*)(L + LC_TW);
    fwd_pass1(bufE, TW, tid); fwd_pass1(bufO, TW, tid);
    __syncthreads();
    fwd_pass2(bufE, TW, tid); fwd_pass2(bufO, TW, tid);
    __syncthreads();
}
template <int MODE>
__device__ __forceinline__ void fft2_middle(LAS unsigned char* L, unsigned* specblk) {
    int tid = threadIdx.x; OPAQUE(tid); const int bsel = tid >> 8, blk = tid & 255;
    LAS f32x2_t* buf = (LAS f32x2_t*)L + (bsel ? FBUF : 0);
    f32x2_t x[32];
    LAS f32x2_t* bm = buf + 33 * blk;
#pragma unroll
    for (int q = 0; q < 32; ++q) x[q] = bm[q];
    DFT<32, false>::run(x);
    unsigned* sp = specblk + (size_t)bsel * 8192 + 32 * blk;
    if (MODE == 0) {
#pragma unroll
        for (int q = 0; q < 32; q += 4) { v4u w;
            { f16x2_t h; h.x = (_Float16)(16.0f * x[q].x); h.y = (_Float16)(16.0f * x[q].y); w.x = __builtin_bit_cast(unsigned, h); }
            { f16x2_t h; h.x = (_Float16)(16.0f * x[q + 1].x); h.y = (_Float16)(16.0f * x[q + 1].y); w.y = __builtin_bit_cast(unsigned, h); }
            { f16x2_t h; h.x = (_Float16)(16.0f * x[q + 2].x); h.y = (_Float16)(16.0f * x[q + 2].y); w.z = __builtin_bit_cast(unsigned, h); }
            { f16x2_t h; h.x = (_Float16)(16.0f * x[q + 3].x); h.y = (_Float16)(16.0f * x[q + 3].y); w.w = __builtin_bit_cast(unsigned, h); }
            *(v4u*)(sp + q) = w; }
    } else {
#pragma unroll
        for (int q = 0; q < 32; q += 4) { const v4u w = *(const v4u*)(sp + q);
            const unsigned w0 = w.x, w1 = w.y, w2 = w.z, w3 = w.w;
            x[q] = cmul(x[q], h2_to_f2(w0)); x[q + 1] = cmul(x[q + 1], h2_to_f2(w1)); x[q + 2] = cmul(x[q + 2], h2_to_f2(w2)); x[q + 3] = cmul(x[q + 3], h2_to_f2(w3)); }
        DFT<32, true>::run(x);
#pragma unroll
        for (int q = 0; q < 32; ++q) bm[q] = x[q];
    }
    __syncthreads();
}
__device__ __forceinline__ void fft2_inverse(LAS unsigned char* L) {
    const int tid = threadIdx.x;
    LAS f32x2_t* bufE = (LAS f32x2_t*)L; LAS f32x2_t* bufO = bufE + FBUF; const LAS f32x2_t* TW = (const LAS f32x2_t*)(L + LC_TW);
    inv_pass2(bufE, TW, tid); inv_pass2(bufO, TW, tid);
    __syncthreads();
    inv_pass1(bufE, TW, tid); inv_pass1(bufO, TW, tid);
}

__device__ __forceinline__ void fwd_pass1h(LAS c16* buf, const LAS c16* TW, int tid) {
    OPAQUE(tid);
    LAS c16* b0 = buf + tid + (tid >> 5);
    c16 x[16];
#pragma unroll
    for (int m = 0; m < 16; ++m) x[m] = b0[528 * m];
    DFTH<16, false>::run(x); tw_apply16h<false, 512>(x, TW + tid);
#pragma unroll
    for (int q = 0; q < 16; ++q) b0[528 * q] = x[q];
}
__device__ __forceinline__ void fwd_pass2h(LAS c16* buf, const LAS c16* TW, int tid) {
    OPAQUE(tid);
    LAS c16* b0 = buf + (tid >> 5) * 528 + (tid & 31);
    c16 x[16];
#pragma unroll
    for (int m = 0; m < 16; ++m) x[m] = b0[33 * m];
    DFTH<16, false>::run(x); tw_apply16h<false, 32>(x, TW + (tid & 31));
#pragma unroll
    for (int q = 0; q < 16; ++q) b0[33 * q] = x[q];
}
__device__ __forceinline__ void inv_pass2h(LAS c16* buf, const LAS c16* TW, int tid) {
    OPAQUE(tid);
    LAS c16* b0 = buf + (tid >> 5) * 528 + (tid & 31);
    c16 x[16];
#pragma unroll
    for (int q = 0; q < 16; ++q) x[q] = b0[33 * q];
    tw_apply16h<true, 32>(x, TW + (tid & 31)); DFTH<16, true>::run(x);
    c16 sc; sc.x = (_Float16)0.0625f; sc.y = (_Float16)0.0625f;
#pragma unroll
    for (int m = 0; m < 16; ++m) b0[33 * m] = x[m] * sc;
}
__device__ __forceinline__ void inv_pass1h(LAS c16* buf, const LAS c16* TW, int tid) {
    OPAQUE(tid);
    LAS c16* b0 = buf + tid + (tid >> 5);
    c16 x[16];
#pragma unroll
    for (int q = 0; q < 16; ++q) x[q] = b0[528 * q];
    tw_apply16h<true, 512>(x, TW + tid); DFTH<16, true>::run(x);
#pragma unroll
    for (int m = 0; m < 16; ++m) b0[528 * m] = x[m];
}
__device__ __forceinline__ void fft2h_forward(LAS unsigned char* L) {
    const int tid = threadIdx.x;
    LAS c16* bufE = (LAS c16*)L; LAS c16* bufO = bufE + FBUF; const LAS c16* P1 = (const LAS c16*)(L + LT_P1); const LAS c16* P2 = (const LAS c16*)(L + LT_P2);
    fwd_pass1h(bufE, P1, tid); fwd_pass1h(bufO, P1, tid);
    __syncthreads();
    fwd_pass2h(bufE, P2, tid); fwd_pass2h(bufO, P2, tid);
    __syncthreads();
}
__device__ __forceinline__ void fft2h_middle(LAS unsigned char* L, const unsigned* specblk) {
    int tid = threadIdx.x; OPAQUE(tid); const int bsel = tid >> 8, blk = tid & 255;
    LAS c16* bm = (LAS c16*)L + (bsel ? FBUF : 0) + 33 * blk;
    c16 x[32];
#pragma unroll
    for (int q = 0; q < 32; ++q) x[q] = bm[q];
    DFTH<32, false>::run(x);
    const unsigned* sp = specblk + (size_t)bsel * 8192 + 32 * blk;
#pragma unroll
    for (int q = 0; q < 32; q += 4) { const v4u w = *(const v4u*)(sp + q);
        const unsigned w0 = w.x, w1 = w.y, w2 = w.z, w3 = w.w;
        x[q] = cmul16(x[q], __builtin_bit_cast(c16, w0)); x[q + 1] = cmul16(x[q + 1], __builtin_bit_cast(c16, w1));
        x[q + 2] = cmul16(x[q + 2], __builtin_bit_cast(c16, w2)); x[q + 3] = cmul16(x[q + 3], __builtin_bit_cast(c16, w3)); }
    DFTH<32, true>::run(x);
    c16 sc; sc.x = (_Float16)0.0625f; sc.y = (_Float16)0.0625f;
#pragma unroll
    for (int q = 0; q < 32; ++q) bm[q] = x[q] * sc;
    __syncthreads();
}

__device__ __forceinline__ void fft2h_middle_store(LAS unsigned char* L, unsigned* specblk) {
    int tid = threadIdx.x; OPAQUE(tid); const int bsel = tid >> 8, blk = tid & 255;
    LAS c16* bm = (LAS c16*)L + (bsel ? FBUF : 0) + 33 * blk;
    c16 x[32];
#pragma unroll
    for (int q = 0; q < 32; ++q) x[q] = bm[q];
    DFTH<32, false>::run(x);
    c16 sc; sc.x = (_Float16)(1.0f / 256.0f); sc.y = (_Float16)(1.0f / 256.0f);
    unsigned* sp = specblk + (size_t)bsel * 8192 + 32 * blk;
#pragma unroll
    for (int q = 0; q < 32; q += 4) { v4u w;
        { const c16 h = x[q] * sc; w.x = __builtin_bit_cast(unsigned, h); } { const c16 h = x[q + 1] * sc; w.y = __builtin_bit_cast(unsigned, h); }
        { const c16 h = x[q + 2] * sc; w.z = __builtin_bit_cast(unsigned, h); } { const c16 h = x[q + 3] * sc; w.w = __builtin_bit_cast(unsigned, h); }
        *(v4u*)(sp + q) = w; }
    __syncthreads();
}
__device__ __forceinline__ void fft2h_inverse(LAS unsigned char* L) {
    const int tid = threadIdx.x;
    LAS c16* bufE = (LAS c16*)L; LAS c16* bufO = bufE + FBUF; const LAS c16* P1 = (const LAS c16*)(L + LT_P1); const LAS c16* P2 = (const LAS c16*)(L + LT_P2);
    inv_pass2h(bufE, P2, tid); inv_pass2h(bufO, P2, tid);
    __syncthreads();
    inv_pass1h(bufE, P1, tid); inv_pass1h(bufO, P1, tid);
}
__device__ __forceinline__ f32x2_t wn16384(const LAS f32x2_t* TA, f32x2_t wb, int tid, int m) { return cmul(TA[(tid >> 6) + 8 * m], wb); }
__device__ __forceinline__ float hy_conv3(const bf16* row, float w0, float w1, float w2, float bias, int n) {
    const int nm = n > 0 ? n - 1 : 0, np = n < SEQ - 1 ? n + 1 : SEQ - 1;
    const float wl = n > 0 ? w0 : 0.f, wr = n < SEQ - 1 ? w2 : 0.f;
    return bias + w1 * bf2f(row[n]) + wl * bf2f(row[nm]) + wr * bf2f(row[np]);
}

__device__ __forceinline__ void load_conv16(const bf16* row, int n0, float w0, float w1, float w2, float bias, float (&out)[16]) {
    const v4u a = *(const v4u*)(row + n0), b = *(const v4u*)(row + n0 + 8);
    const int nl = n0 > 0 ? n0 - 1 : 0, nr = n0 + 16 < SEQ ? n0 + 16 : SEQ - 1;
    const float ul = n0 > 0 ? bf2f(row[nl]) : 0.f, ur = n0 + 16 < SEQ ? bf2f(row[nr]) : 0.f;
    const unsigned a0 = a.x, a1 = a.y, a2 = a.z, a3 = a.w, b0 = b.x, b1 = b.y, b2 = b.z, b3 = b.w;
    float u[18];
    u[0] = ul; u[17] = ur;
    u[1] = __uint_as_float(a0 << 16); u[2] = __uint_as_float(a0 & 0xffff0000u); u[3] = __uint_as_float(a1 << 16); u[4] = __uint_as_float(a1 & 0xffff0000u);
    u[5] = __uint_as_float(a2 << 16); u[6] = __uint_as_float(a2 & 0xffff0000u); u[7] = __uint_as_float(a3 << 16); u[8] = __uint_as_float(a3 & 0xffff0000u);
    u[9] = __uint_as_float(b0 << 16); u[10] = __uint_as_float(b0 & 0xffff0000u); u[11] = __uint_as_float(b1 << 16); u[12] = __uint_as_float(b1 & 0xffff0000u);
    u[13] = __uint_as_float(b2 << 16); u[14] = __uint_as_float(b2 & 0xffff0000u); u[15] = __uint_as_float(b3 << 16); u[16] = __uint_as_float(b3 & 0xffff0000u);
#pragma unroll
    for (int i = 0; i < 16; ++i) out[i] = bias + w0 * u[i] + w1 * u[i + 1] + w2 * u[i + 2];
}
__device__ __forceinline__ void load_f16x16(const _Float16* p, float (&out)[16]) {
    const v4u a = *(const v4u*)p, b = *(const v4u*)(p + 8);
    const unsigned w[8] = {a.x, a.y, a.z, a.w, b.x, b.y, b.z, b.w};
#pragma unroll
    for (int i = 0; i < 8; ++i) { const f32x2_t k = h2_to_f2(w[i]); out[2 * i] = k.x; out[2 * i + 1] = k.y; }
}
__device__ __forceinline__ void load_f32x16(const float* p, float (&out)[16]) {
#pragma unroll
    for (int i = 0; i < 4; ++i) { const float4 v = *(const float4*)(p + 4 * i); out[4 * i] = v.x; out[4 * i + 1] = v.y; out[4 * i + 2] = v.z; out[4 * i + 3] = v.w; }
}
__device__ __forceinline__ void filter_item(LAS unsigned char* L, const Args& a, int c, const _Float16* hT, unsigned* spec, int tid, int lane, int wave) {
    LAS f32x2_t* bufE = (LAS f32x2_t*)L; LAS f32x2_t* bufO = bufE + FBUF;
    LAS float* red = (LAS float*)(L + LC_RED); LAS float* sc = (LAS float*)L;
    const int n0 = 16 * tid;
#pragma unroll 1
    for (int o = 0; o < 2; ++o) {
        float hfv[16], hbv[16];
        load_f16x16(hT + (size_t)(o * 512 + c) * SEQ + n0, hfv);
        load_f16x16(hT + (size_t)(1024 + o * 512 + c) * SEQ + n0, hbv);
        float s = 0.f;
#pragma unroll
        for (int i = 0; i < 16; ++i) { s += fabsf(hfv[i]) + ((n0 + i) > 0 ? fabsf(hbv[i]) : 0.f); sc[n0 + i] = hbv[i]; }
        s = wave_sum(s);
        if (lane == 0) red[wave] = s;
        __syncthreads();
        float tot = 0.f;
#pragma unroll
        for (int i = 0; i < 8; ++i) tot += red[i];
        const float inv = 1.0f / (tot + EPS);
        float ev[16], dv[16];
#pragma unroll
        for (int i = 0; i < 16; ++i) { const int n = n0 + i; const float hbm = n > 0 ? sc[SEQ - n] : 0.f; ev[i] = (hfv[i] + hbm) * inv; dv[i] = (hfv[i] - hbm) * inv; }
        __syncthreads();
        { LAS c16* hE = (LAS c16*)L; LAS c16* hO = hE + FBUF; const LAS c16* WN = (const LAS c16*)(L + LT_WN); const int lb = 16 * tid + (tid >> 1);
#pragma unroll
          for (int i = 0; i < 16; ++i) { c16 xe; xe.x = (_Float16)(ev[i] * 4096.0f); xe.y = (_Float16)0.0f; const _Float16 dh = (_Float16)(dv[i] * 4096.0f); c16 dd; dd.x = dh; dd.y = dh;
              hE[lb + i] = xe; hO[lb + i] = WN[lb + i] * dd; } }
        __syncthreads();
        fft2h_forward(L);
        fft2h_middle_store(L, spec + (size_t)(o * 512 + c) * 16384);
    }
}
template <int O>
__device__ __forceinline__ void hyena_pass(LAS unsigned char* L, const Args& a, int c, int bp, const bf16* hyuT, unsigned* spec, int tid, float (&xa)[16], float (&xb)[16]) {
    LAS c16* bufE = (LAS c16*)L; LAS c16* bufO = bufE + FBUF; const LAS c16* WN = (const LAS c16*)(L + LT_WN);
    const float* cw = a.in[15]; const float* cb = a.in[16];
    const int n0 = 16 * tid;
    const int lb = 16 * tid + (tid >> 1);
#pragma unroll
    for (int i = 0; i < 16; ++i) { c16 x; x.x = (_Float16)(xa[i] * 0.0625f); x.y = (_Float16)(xb[i] * 0.0625f); bufE[lb + i] = x; bufO[lb + i] = cmul16(x, WN[lb + i]); }
    __syncthreads();
    fft2h_forward(L);
    fft2h_middle(L, spec + (size_t)(O * 512 + c) * 16384);
    fft2h_inverse(L);
    __syncthreads();
    const int grow = (O ? 1024 : 512) + c;
    const float w0 = cw[grow], w1 = cw[1536 + grow], w2 = cw[3072 + grow], bs = cb[grow];
    const float skip = a.in[24][O * 512 + c];
    const bf16* g0 = hyuT + (size_t)grow * NTOK + (size_t)(2 * bp) * SEQ; const bf16* g1 = g0 + SEQ;
    float ga[16], gb[16];
    load_conv16(g0, n0, w0, w1, w2, bs, ga); load_conv16(g1, n0, w0, w1, w2, bs, gb);
#pragma unroll
    for (int i = 0; i < 16; ++i) {
        const c16 he = bufE[lb + i], yo = cmulc16(bufO[lb + i], WN[lb + i]); f32x2_t y; y.x = ((float)he.x + (float)yo.x) * (1.0f / 64.0f); y.y = ((float)he.y + (float)yo.y) * (1.0f / 64.0f);
        xa[i] = ga[i] * (y.x + skip * xa[i]); xb[i] = gb[i] * (y.y + skip * xb[i]); }
    __syncthreads();
}
__device__ __forceinline__ void hyena_item(LAS unsigned char* L, const Args& a, int c, int bp, const bf16* hyuT, unsigned* spec, bf16* y_hyT, int tid) {
    const float* cw = a.in[15]; const float* cb = a.in[16];
    const size_t seq0 = (size_t)c * NTOK + (size_t)(2 * bp) * SEQ;
    const int n0 = 16 * tid;
    float xa[16], xb[16];
    load_conv16(hyuT + seq0, n0, cw[c], cw[1536 + c], cw[3072 + c], cb[c], xa); load_conv16(hyuT + seq0 + SEQ, n0, cw[c], cw[1536 + c], cw[3072 + c], cb[c], xb);
    hyena_pass<0>(L, a, c, bp, hyuT, spec, tid, xa, xb);
    hyena_pass<1>(L, a, c, bp, hyuT, spec, tid, xa, xb);
    bf16* o0 = y_hyT + seq0; bf16* o1 = o0 + SEQ;
    v4u p0, p1, q0, q1;
    p0.x = pk2(xa[0], xa[1]); p0.y = pk2(xa[2], xa[3]); p0.z = pk2(xa[4], xa[5]); p0.w = pk2(xa[6], xa[7]); p1.x = pk2(xa[8], xa[9]); p1.y = pk2(xa[10], xa[11]); p1.z = pk2(xa[12], xa[13]); p1.w = pk2(xa[14], xa[15]);
    q0.x = pk2(xb[0], xb[1]); q0.y = pk2(xb[2], xb[3]); q0.z = pk2(xb[4], xb[5]); q0.w = pk2(xb[6], xb[7]); q1.x = pk2(xb[8], xb[9]); q1.y = pk2(xb[10], xb[11]); q1.z = pk2(xb[12], xb[13]); q1.w = pk2(xb[14], xb[15]);
    *(v4u*)(o0 + n0) = p0; *(v4u*)(o0 + n0 + 8) = p1; *(v4u*)(o1 + n0) = q0; *(v4u*)(o1 + n0 + 8) = q1;
}

__global__ void __launch_bounds__(NWAVES * 64, 2) fwd(Args a) {
    extern __shared__ __attribute__((aligned(16))) unsigned char lds_raw[];
    LAS unsigned char* L = (LAS unsigned char*)lds_raw;
    volatile LAS unsigned* MISC = (volatile LAS unsigned*)(L + MISC_OFF);
    const int tid = threadIdx.x, lane = tid & 63, wave = __builtin_amdgcn_readfirstlane(tid >> 6);
    const int G = gridDim.x, bid = blockIdx.x;
    unsigned char* ws = a.ws;
    unsigned* ctl = (unsigned*)ws;
    for (int u = tid; u < (LDS_BYTES - LDSCTL_OFF) / 4; u += NWAVES * 64) ((LAS unsigned*)(L + LDSCTL_OFF))[u] = 0u;
    __syncthreads();
    const int lo = a.ph_lo, hi = a.ph_hi;
    XcdBarrier bar; bar.bar = ctl + CW_BAR + a.li * XCD_BAR_WORDS; bar.x = 0; bar.st = nullptr;
    bar = xcd_barrier_post(ctl + CW_BAR + a.li * XCD_BAR_WORDS, MISC + 8);
#define IN(k) (lo <= (k) && (k) < hi)
#define BOTH(k) (IN(k) && IN((k) + 1))
#ifndef DUP_BAR
#define DUP_BAR 1
#endif
#define GRID_BAR() do { xcd_barrier(bar); if (DUP_BAR > 1) xcd_barrier(bar); } while (0)

    bf16* WinT = (bf16*)(ws + WS_WINT); bf16* WoutT = (bf16*)(ws + WS_WOUTT);
    bf16* hn1 = (bf16*)(ws + WS_HN1); bf16* lru = (bf16*)(ws + WS_LRU); bf16* hyuT = (bf16*)(ws + WS_HYUT);
    bf16* y_cat = (bf16*)(ws + WS_YCAT);
    bf16* W13T = (bf16*)(ws + WS_W13T); bf16* W2T = (bf16*)(ws + WS_W2T); bf16* WrT = (bf16*)(ws + WS_WRT);
    bf16* hn2 = (bf16*)(ws + WS_HN2); int* list = (int*)(ws + WS_LIST); float* lgate = (float*)(ws + WS_LGATE); int4* tokinfo = (int4*)(ws + WS_TOKINFO);
    bf16* xs = (bf16*)(ws + WS_XS); (void)xs; bf16* Hb = (bf16*)(ws + WS_H); bf16* Yb = (bf16*)(ws + WS_Y);
    const int gw = bid * NWAVES + wave, NGW = G * NWAVES;

    if (IN(0)) {
#ifndef DUP_P0
#define DUP_P0 1
#endif
        for (int rep0 = 0; rep0 < DUP_P0; ++rep0) {
        LAS float* scr = (LAS float*)(L + wave * 16384);
        constexpr int I_IN = (DM / 64) * (DIN / 32), I_OUT = (DM / 64) * (DM / 32), I_EXP = 768;
        for (int it = gw; it < I_IN + I_OUT + 32 * I_EXP; it += NGW) {
            if (it < I_IN) { const int nblk = DIN / 32, kb = it / nblk, nb = it % nblk; p0_transpose_item(a.in[2], DM, DIN, WinT, 32 * nb, scr, 64 * kb, 32 * nb, lane); }
            else if (it < I_IN + I_OUT) { const int r = it - I_IN; const int nblk = DM / 32, kb = r / nblk, nb = r % nblk; p0_transpose_item(a.in[27], DM, DM, WoutT, 32 * nb, scr, 64 * kb, 32 * nb, lane); }
            else { const int r = it - I_IN - I_OUT, e = r / I_EXP, q = r % I_EXP;
                if (q < 512) { const int w3 = q >> 8, qq = q & 255, kb = qq >> 4, nb = qq & 15, n0 = 32 * nb;
                    p0_transpose_item(a.in[w3 ? 34 : 33] + (size_t)e * 1024 * 512, 1024, 512, W13T, e * 1024 + (n0 >> 7) * 256 + (n0 & 127) + w3 * 128, scr, 64 * kb, n0, lane); }
                else { const int qq = q - 512, kb = qq >> 5, nb = qq & 31;
                    p0_transpose_item(a.in[35] + (size_t)e * 512 * 1024, 512, 1024, W2T, e * 1024 + 32 * nb, scr, 64 * kb, 32 * nb, lane); } }
        }
        for (int idx = bid * (NWAVES * 64) + tid; idx < 48 * 1024; idx += G * NWAVES * 64) { const int j = idx >> 10, k = idx & 1023;
            WrT[idx] = j < 4 ? f2bf(a.in[29][k * 4 + j]) : (j < 36 ? f2bf(a.in[31][k * 32 + (j - 4)]) : (bf16)0); }
        { _Float16* hT = (_Float16*)(ws + WS_HT);
          const float* w1 = a.in[17]; const float* b1 = a.in[18]; const float* f1 = a.in[19]; const float* w2 = a.in[20]; const float* b2 = a.in[21]; const float* f2 = a.in[22]; const float* w3 = a.in[23];
          LAS float* w3s = (LAS float*)L;
          LAS float* z2s = (LAS float*)(L + 65536);
          LAS float* fts = (LAS float*)(L + 73728);
          LAS float* ot  = (LAS float*)(L + 81920);
          for (int tile = bid; tile < SEQ / 32; tile += G) {
              __syncthreads();
              { const int tl = tid & 31, i = tid >> 5; const int t = tile * 32 + tl;
                const float wq = (6.283185307179586f / (float)SEQ) * (float)t; const float band = 1e-4f + (float)i * ((15.0f - 1e-4f) / 15.0f);
                fts[(1 + i) * 32 + tl] = cosf(wq * band); fts[(17 + i) * 32 + tl] = sinf(wq * band);
                if (i == 0) fts[tl] = (float)t / (float)(SEQ - 1); }
              __syncthreads();
              const int tl4 = tid & 31, jq = tid >> 5;
              { float s0 = b1[4 * jq], s1 = b1[4 * jq + 1], s2 = b1[4 * jq + 2], s3 = b1[4 * jq + 3];
#pragma unroll 3
                for (int i = 0; i < 33; ++i) { const float fv = fts[i * 32 + tl4]; const float4 wv = *(const float4*)(w1 + i * 64 + 4 * jq); s0 += fv * wv.x; s1 += fv * wv.y; s2 += fv * wv.z; s3 += fv * wv.w; }
                const float4 fq = *(const float4*)(f1 + 4 * jq);
                s0 = sinf(fq.x * s0); s1 = sinf(fq.y * s1); s2 = sinf(fq.z * s2); s3 = sinf(fq.w * s3);
                __syncthreads();
                fts[(4 * jq) * 32 + tl4] = s0; fts[(4 * jq + 1) * 32 + tl4] = s1; fts[(4 * jq + 2) * 32 + tl4] = s2; fts[(4 * jq + 3) * 32 + tl4] = s3; }
              __syncthreads();
              { float s0 = b2[4 * jq], s1 = b2[4 * jq + 1], s2 = b2[4 * jq + 2], s3 = b2[4 * jq + 3];
#pragma unroll 4
                for (int i = 0; i < 64; ++i) { const float zv = fts[i * 32 + tl4]; const float4 wv = *(const float4*)(w2 + i * 64 + 4 * jq); s0 += zv * wv.x; s1 += zv * wv.y; s2 += zv * wv.z; s3 += zv * wv.w; }
                const float4 fq = *(const float4*)(f2 + 4 * jq);
                z2s[(4 * jq) * 32 + tl4] = sinf(fq.x * s0); z2s[(4 * jq + 1) * 32 + tl4] = sinf(fq.y * s1); z2s[(4 * jq + 2) * 32 + tl4] = sinf(fq.z * s2); z2s[(4 * jq + 3) * 32 + tl4] = sinf(fq.w * s3); }
              __syncthreads();
              const float lo_ = logf(1e-2f) / 1.5f, hi_ = logf(1e-2f) / 0.3f;
              typedef float f32x16_t __attribute__((ext_vector_type(16)));
              bf16x8_t Az[4];
              { const int tr = lane & 31, kg2 = lane >> 5;
#pragma unroll
                for (int s = 0; s < 4; ++s) { v4u pk;
                    pk.x = pk2(z2s[(16 * s + 8 * kg2 + 0) * 32 + tr], z2s[(16 * s + 8 * kg2 + 1) * 32 + tr]); pk.y = pk2(z2s[(16 * s + 8 * kg2 + 2) * 32 + tr], z2s[(16 * s + 8 * kg2 + 3) * 32 + tr]);
                    pk.z = pk2(z2s[(16 * s + 8 * kg2 + 4) * 32 + tr], z2s[(16 * s + 8 * kg2 + 5) * 32 + tr]); pk.w = pk2(z2s[(16 * s + 8 * kg2 + 6) * 32 + tr], z2s[(16 * s + 8 * kg2 + 7) * 32 + tr]);
                    Az[s] = __builtin_bit_cast(bf16x8_t, pk); } }
              LAS unsigned char* wt = L;
              for (int chunk = 0; chunk < 8; ++chunk) {
                  __syncthreads();
#pragma unroll 4
                  for (int r = 0; r < 8; ++r) { const int q = tid + 512 * r; const int j = q >> 6, c4 = q & 63;
                      const f32x4_t wv = *(const f32x4_t*)(w3 + (size_t)j * 2048 + chunk * 256 + 4 * c4);
                      LAS bf16* d = (LAS bf16*)(wt + (4 * c4) * 144 + 2 * j);
                      d[0] = f2bf(wv.x); d[72] = f2bf(wv.y); d[144] = f2bf(wv.z); d[216] = f2bf(wv.w); }
                  __syncthreads();
                  { const int cl = wave * 32 + (lane & 31), kg2 = lane >> 5;
                    f32x16_t acc = {0.f, 0.f, 0.f, 0.f, 0.f, 0.f, 0.f, 0.f, 0.f, 0.f, 0.f, 0.f, 0.f, 0.f, 0.f, 0.f};
#pragma unroll
                    for (int s = 0; s < 4; ++s) { const bf16x8_t Bw = *(const LAS bf16x8_t*)(wt + cl * 144 + (16 * s + 8 * kg2) * 2);
                        acc = __builtin_amdgcn_mfma_f32_32x32x16_bf16(Az[s], Bw, acc, 0, 0, 0); }
                    const int col = chunk * 256 + cl; const int cc = col & 511;
                    const float delta = fabsf(lo_ + (float)cc * ((hi_ - lo_) / 511.0f));
#pragma unroll
                    for (int g4 = 0; g4 < 4; ++g4) { const int tl = 8 * g4 + 4 * kg2;
                        const int t0 = tile * 32 + tl;
                        f16x2_t h01, h23;
                        h01.x = (_Float16)(acc[4 * g4 + 0] * 64.0f * __expf(-((float)(t0 + 0) / (float)(SEQ - 1)) * delta)); h01.y = (_Float16)(acc[4 * g4 + 1] * 64.0f * __expf(-((float)(t0 + 1) / (float)(SEQ - 1)) * delta));
                        h23.x = (_Float16)(acc[4 * g4 + 2] * 64.0f * __expf(-((float)(t0 + 2) / (float)(SEQ - 1)) * delta)); h23.y = (_Float16)(acc[4 * g4 + 3] * 64.0f * __expf(-((float)(t0 + 3) / (float)(SEQ - 1)) * delta));
                        uint2 o; o.x = __builtin_bit_cast(unsigned, h01); o.y = __builtin_bit_cast(unsigned, h23);
                        *(uint2*)(hT + (size_t)col * SEQ + t0) = o; } }
              }
          } }
        __syncthreads();
        for (int m = gw; m < NTOK; m += NGW) rms_row_to_bf16(a.in[0] + (size_t)m * DM, a.in[1], hn1 + (size_t)m * DM, lane);
        }
        if (BOTH(0)) GRID_BAR();
    }
    if (IN(1)) {
#ifndef DUP_G1
#define DUP_G1 1
#endif
        { pg8::Gemm g{hn1, WinT, NTOK, 1024, DM}; pg8::StaticOrder S; S.init(NTOK, 1024, G, bid);
          pg8::EpiBf16<0> E{lru, 1024, nullptr, 0, 0, 1.f};
          pg8::gemm_phase<pg8::EpiBf16<0>, pg8::StaticOrder, true, true>(L, g, S, E); }
        { pg8::Gemm g{WinT + (size_t)1024 * DM, hn1, 1536, NTOK, DM}; pg8::StaticOrder S; S.init(1536, NTOK, G, bid);
          pg8::EpiBf16<0> E{hyuT, NTOK, nullptr, 0, 0, 1.f};
          pg8::gemm_phase<pg8::EpiBf16<0>, pg8::StaticOrder, true, true>(L, g, S, E); }
#if DUP_G1 > 1
        { pg8::Gemm g{hn1, WinT, NTOK, 1024, DM}; pg8::StaticOrder S; S.init(NTOK, 1024, G, bid);
          pg8::EpiBf16<0> E{lru, 1024, nullptr, 0, 0, 1.f};
          pg8::gemm_phase<pg8::EpiBf16<0>, pg8::StaticOrder, true, true>(L, g, S, E); }
        { pg8::Gemm g{WinT + (size_t)1024 * DM, hn1, 1536, NTOK, DM}; pg8::StaticOrder S; S.init(1536, NTOK, G, bid);
          pg8::EpiBf16<0> E{hyuT, NTOK, nullptr, 0, 0, 1.f};
          pg8::gemm_phase<pg8::EpiBf16<0>, pg8::StaticOrder, true, true>(L, g, S, E); }
#endif
        __syncthreads();
        fft_tables_init(L, tid);
#ifndef DUP_FILT
#define DUP_FILT 1
#endif
        for (int rep = 0; rep < DUP_FILT; ++rep)
        for (int c = bid; c < DH; c += G) filter_item(L, a, c, (const _Float16*)(ws + WS_HT), (unsigned*)(ws + WS_SPEC), tid, lane, wave);
        if (BOTH(1)) GRID_BAR();
    }

    if (IN(2)) {
        bf16* hf = (bf16*)(ws + WS_HF); bf16* hb = (bf16*)(ws + WS_HB);
#ifndef DUP_LRU
#define DUP_LRU 1
#endif
#ifndef DUP_HY
#define DUP_HY 1
#endif
        { bf16* xcb = (bf16*)(ws + WS_XCB); const float* cwp = a.in[3]; const float* cbp = a.in[4];
          for (int idx = bid * (NWAVES * 64) + tid; idx < NTOK * 64; idx += G * NWAVES * 64) {
              const int tok = idx >> 6, c8 = (idx & 63) * 8, t = tok & (SEQ - 1), bb = tok >> 13;
              float acc[8];
              { const float4 c0 = *(const float4*)(cbp + c8), c1 = *(const float4*)(cbp + c8 + 4); acc[0] = c0.x; acc[1] = c0.y; acc[2] = c0.z; acc[3] = c0.w; acc[4] = c1.x; acc[5] = c1.y; acc[6] = c1.z; acc[7] = c1.w; }
#pragma unroll
              for (int tap = 0; tap < 4; ++tap) { const int tt = t + tap - 2; const bool ok = tt >= 0 && tt < SEQ; const int tc = ok ? tt : t;
                  const v4u xv = *(const v4u*)(lru + (size_t)(bb * SEQ + tc) * 1024 + c8);
                  const float4 w0 = *(const float4*)(cwp + tap * DL + c8), w1 = *(const float4*)(cwp + tap * DL + c8 + 4);
                  const float m = ok ? 1.f : 0.f; const unsigned x0 = xv.x, x1 = xv.y, x2 = xv.z, x3 = xv.w;
                  acc[0] += m * w0.x * __uint_as_float(x0 << 16); acc[1] += m * w0.y * __uint_as_float(x0 & 0xffff0000u);
                  acc[2] += m * w0.z * __uint_as_float(x1 << 16); acc[3] += m * w0.w * __uint_as_float(x1 & 0xffff0000u);
                  acc[4] += m * w1.x * __uint_as_float(x2 << 16); acc[5] += m * w1.y * __uint_as_float(x2 & 0xffff0000u);
                  acc[6] += m * w1.z * __uint_as_float(x3 << 16); acc[7] += m * w1.w * __uint_as_float(x3 & 0xffff0000u); }
              v4u pk; pk.x = pk2(acc[0], acc[1]); pk.y = pk2(acc[2], acc[3]); pk.z = pk2(acc[4], acc[5]); pk.w = pk2(acc[6], acc[7]);
              const int hh = c8 >> 6, cl = c8 & 63;
              *(v4u*)(xcb + (((size_t)(bb * 8 + hh) * SEQ + t) * 64 + cl)) = pk; } }
        GRID_BAR();
        for (int rep = 0; rep < DUP_LRU; ++rep)
        for (int item = bid; item < 256; item += G) lru_item(L, a, item, (const bf16*)(ws + WS_XCB), hf, hb, tid, lane, wave);
        __syncthreads();
        fft_tables_init(L, tid);
        for (int rep = 0; rep < DUP_HY; ++rep)
        for (int item = bid; item < 2 * DH; item += G) hyena_item(L, a, item >> 1, item & 1, hyuT, (unsigned*)(ws + WS_SPEC), (bf16*)(ws + WS_YHYT), tid);
        if (BOTH(2)) GRID_BAR();
    }

    if (IN(3)) {
        const bf16* hf = (const bf16*)(ws + WS_HF); const bf16* hb = (const bf16*)(ws + WS_HB); const bf16* y_hyT = (const bf16*)(ws + WS_YHYT);
        const float* gA = a.in[25]; const float* gB = a.in[26];
#ifndef DUP_P3
#define DUP_P3 1
#endif
        for (int rep3 = 0; rep3 < DUP_P3; ++rep3) {
        for (int tok = gw; tok < NTOK; tok += NGW) {
            const v4u vf = *(const v4u*)(hf + (size_t)tok * DL + 8 * lane), vb = *(const v4u*)(hb + (size_t)tok * DL + 8 * lane), vg = *(const v4u*)(lru + (size_t)tok * 1024 + 512 + 8 * lane);
            const unsigned f0 = vf.x, f1 = vf.y, f2 = vf.z, f3 = vf.w, b0 = vb.x, b1 = vb.y, b2 = vb.z, b3 = vb.w, g0 = vg.x, g1 = vg.y, g2 = vg.z, g3 = vg.w;
            float y[8];
            y[0] = (__uint_as_float(f0 << 16) + __uint_as_float(b0 << 16)) * gelu_tanh(__uint_as_float(g0 << 16));
            y[1] = (__uint_as_float(f0 & 0xffff0000u) + __uint_as_float(b0 & 0xffff0000u)) * gelu_tanh(__uint_as_float(g0 & 0xffff0000u));
            y[2] = (__uint_as_float(f1 << 16) + __uint_as_float(b1 << 16)) * gelu_tanh(__uint_as_float(g1 << 16));
            y[3] = (__uint_as_float(f1 & 0xffff0000u) + __uint_as_float(b1 & 0xffff0000u)) * gelu_tanh(__uint_as_float(g1 & 0xffff0000u));
            y[4] = (__uint_as_float(f2 << 16) + __uint_as_float(b2 << 16)) * gelu_tanh(__uint_as_float(g2 << 16));
            y[5] = (__uint_as_float(f2 & 0xffff0000u) + __uint_as_float(b2 & 0xffff0000u)) * gelu_tanh(__uint_as_float(g2 & 0xffff0000u));
            y[6] = (__uint_as_float(f3 << 16) + __uint_as_float(b3 << 16)) * gelu_tanh(__uint_as_float(g3 << 16));
            y[7] = (__uint_as_float(f3 & 0xffff0000u) + __uint_as_float(b3 & 0xffff0000u)) * gelu_tanh(__uint_as_float(g3 & 0xffff0000u));
            float s = 0.f;
#pragma unroll
            for (int i = 0; i < 8; ++i) s += y[i] * y[i];
            s = wave_sum(s);
            const float rstd = rsqrtf(s * (1.0f / DL) + EPS);
            const float4 ga0 = *(const float4*)(gA + 8 * lane), ga1 = *(const float4*)(gA + 8 * lane + 4);
            v4u o; o.x = pk2(y[0] * rstd * ga0.x, y[1] * rstd * ga0.y); o.y = pk2(y[2] * rstd * ga0.z, y[3] * rstd * ga0.w);
            o.z = pk2(y[4] * rstd * ga1.x, y[5] * rstd * ga1.y); o.w = pk2(y[6] * rstd * ga1.z, y[7] * rstd * ga1.w);
            *(v4u*)(y_cat + (size_t)tok * 1024 + 8 * lane) = o;
        }
        for (int tile = bid; tile < NTOK / 64; tile += G) {
            __syncthreads();
            const int tok0 = tile * 64;
            for (int ch = tid; ch < 512 * 8; ch += NWAVES * 64) { const int c = ch >> 3, piece = ch & 7;
                const v4u v = *(const v4u*)(y_hyT + (size_t)c * NTOK + tok0 + 8 * piece);
                LAS unsigned* d = (LAS unsigned*)(L + c * 132 + piece * 16); d[0] = v.x; d[1] = v.y; d[2] = v.z; d[3] = v.w; }
            __syncthreads();
            for (int tl = wave; tl < 64; tl += NWAVES) {
                float v[8]; float s = 0.f;
#pragma unroll
                for (int i = 0; i < 4; ++i) { const int c = 2 * lane + 128 * i;
                    v[2 * i] = bf2f(*(const LAS bf16*)(L + c * 132 + tl * 2)); v[2 * i + 1] = bf2f(*(const LAS bf16*)(L + (c + 1) * 132 + tl * 2));
                    s += v[2 * i] * v[2 * i] + v[2 * i + 1] * v[2 * i + 1]; }
                s = wave_sum(s);
                const float rstd = rsqrtf(s * (1.0f / DH) + EPS);
#pragma unroll
                for (int i = 0; i < 4; ++i) { const int c = 2 * lane + 128 * i;
                    *(unsigned*)(y_cat + (size_t)(tok0 + tl) * 1024 + 512 + c) = pk2(v[2 * i] * rstd * gB[c], v[2 * i + 1] * rstd * gB[c + 1]); }
            }
        }
        }
        if (BOTH(3)) GRID_BAR();
    }
    if (IN(4)) {
        pg8::Gemm g{y_cat, WoutT, NTOK, DM, DM}; pg8::StaticOrder S; S.init(NTOK, DM, G, bid);
        pg8::EpiResF32 E{a.in[0], a.out, DM};
#ifndef DUP_P4
#define DUP_P4 1
#endif
        pg8::gemm_phase<pg8::EpiResF32, pg8::StaticOrder, true, true>(L, g, S, E);
#if DUP_P4 > 1
        pg8::gemm_phase<pg8::EpiResF32, pg8::StaticOrder, true, true>(L, g, S, E);
#endif
        if (BOTH(4)) GRID_BAR();
    }

#ifndef DUP_P5
#define DUP_P5 1
#endif
    for (int rep5 = 0; rep5 < DUP_P5; ++rep5)
    if (IN(5)) {
        const bool dummy = (rep5 + 1 < DUP_P5);
        unsigned* cntg = ctl + (dummy ? 3072 : CW_CNT);
        int* list_ = dummy ? (int*)(ws + 376 * MiB) : list; float* lgate_ = dummy ? (float*)(ws + 380 * MiB) : lgate; int4* tokinfo_ = dummy ? (int4*)(ws + 384 * MiB) : tokinfo;
        bf16* hn2_ = dummy ? (bf16*)(ws + 232 * MiB) : hn2;
        LAS float* lg = (LAS float*)(L + 98304);
        LAS int* cnt_l = (LAS int*)(L + LC_CNT); LAS int* base_l = (LAS int*)(L + LC_BASE);
        const float* xmid = a.out; const float* gff = a.in[28];
        for (int tile = bid; tile < NTOK / 128; tile += G) {
            __syncthreads();
            for (int ch = tid; ch < 48 * 128; ch += NWAVES * 64) { const int row = ch >> 7, c16 = ch & 127;
                *(LAS v4u*)(L + row * 2048 + ((c16 ^ (row & 15)) << 4)) = *(const v4u*)(WrT + (size_t)row * 1024 + c16 * 8); }
            if (tid < 32) cnt_l[tid] = 0;
            __syncthreads();
            const int tk = lane & 15, kg = lane >> 4;
            const int tokw = tile * 128 + wave * 16 + tk;
            const float* xr = xmid + (size_t)tokw * DM + 8 * kg;
            float s = 0.f;
#pragma unroll 8
            for (int st = 0; st < 32; ++st) { const float4 p = *(const float4*)(xr + 32 * st), q = *(const float4*)(xr + 32 * st + 4);
                s += (p.x * p.x + p.y * p.y) + (p.z * p.z + p.w * p.w) + (q.x * q.x + q.y * q.y) + (q.z * q.z + q.w * q.w); }
            s += __shfl_xor(s, 16); s += __shfl_xor(s, 32);
            const float rstd = rsqrtf(s * (1.0f / DM) + EPS);
            f32x4_t acc0 = {0.f, 0.f, 0.f, 0.f}, acc1 = acc0, acc2 = acc0;
            bf16* hrow = hn2_ + (size_t)tokw * DM + 8 * kg;
#pragma unroll 4
            for (int st = 0; st < 32; ++st) {
                const float4 p = *(const float4*)(xr + 32 * st), q = *(const float4*)(xr + 32 * st + 4);
                const float4 g0 = *(const float4*)(gff + 32 * st + 8 * kg), g1 = *(const float4*)(gff + 32 * st + 8 * kg + 4);
                v4u w; w.x = pk2(p.x * rstd * g0.x, p.y * rstd * g0.y); w.y = pk2(p.z * rstd * g0.z, p.w * rstd * g0.w);
                w.z = pk2(q.x * rstd * g1.x, q.y * rstd * g1.y); w.w = pk2(q.z * rstd * g1.z, q.w * rstd * g1.w);
                *(v4u*)(hrow + 32 * st) = w;
                const bf16x8_t B = __builtin_bit_cast(bf16x8_t, w);
                const int chs = ((4 * st + kg) ^ tk) << 4;
                const bf16x8_t A0 = *(const LAS bf16x8_t*)(L + (0 + tk) * 2048 + chs), A1 = *(const LAS bf16x8_t*)(L + (16 + tk) * 2048 + chs), A2 = *(const LAS bf16x8_t*)(L + (32 + tk) * 2048 + chs);
                acc0 = __builtin_amdgcn_mfma_f32_16x16x32_bf16(A0, B, acc0, 0, 0, 0);
                acc1 = __builtin_amdgcn_mfma_f32_16x16x32_bf16(A1, B, acc1, 0, 0, 0);
                acc2 = __builtin_amdgcn_mfma_f32_16x16x32_bf16(A2, B, acc2, 0, 0, 0);
            }
            { LAS float* lr = lg + (wave * 16 + tk) * 49 + 4 * kg;
#pragma unroll
              for (int r = 0; r < 4; ++r) { lr[r] = acc0[r]; lr[16 + r] = acc1[r]; lr[32 + r] = acc2[r]; } }
            __syncthreads();
            int e0 = 0, e1 = 0, r0l = 0, r1l = 0; float g0 = 0.f, g1 = 0.f;
            if (tid < 128) {
                const LAS float* lr = lg + tid * 49; const float* bgp = a.in[30]; const float* bep = a.in[32];
                int gi = 0; float gm = lr[0] + bgp[0];
                for (int i = 1; i < 4; ++i) { const float v = lr[i] + bgp[i]; if (v > gm) { gm = v; gi = i; } }
                float gs = 0.f; for (int i = 0; i < 4; ++i) gs += __expf(lr[i] + bgp[i] - gm);
                const float gp = 1.0f / gs;
                const LAS float* le = lr + 4 + gi * 8; const float* beg = bep + gi * 8;
                int i1 = 0; float m1 = le[0] + beg[0];
                for (int i = 1; i < 8; ++i) { const float v = le[i] + beg[i]; if (v > m1) { m1 = v; i1 = i; } }
                int i2 = -1; float m2 = -3.0e38f;
                for (int i = 0; i < 8; ++i) { const float v = le[i] + beg[i]; if (i != i1 && v > m2) { m2 = v; i2 = i; } }
                const float ex2 = __expf(m2 - m1);
                e0 = gi * 8 + i1; e1 = gi * 8 + i2; g0 = gp / (1.0f + ex2); g1 = gp * ex2 / (1.0f + ex2);
                r0l = atomicAdd((int*)(cnt_l + e0), 1); r1l = atomicAdd((int*)(cnt_l + e1), 1);
            }
            __syncthreads();
            if (tid < 32) { const int c = cnt_l[tid]; base_l[tid] = c ? (int)atomicAdd(cntg + tid, (unsigned)c) : 0; }
            __syncthreads();
            if (tid < 128) { const int tok = tile * 128 + tid; const int r0 = base_l[e0] + r0l, r1 = base_l[e1] + r1l;
                list_[e0 * NTOK + r0] = tok; lgate_[e0 * NTOK + r0] = g0; list_[e1 * NTOK + r1] = tok; lgate_[e1 * NTOK + r1] = g1;
                tokinfo_[tok] = make_int4(e0, r0, e1, r1); }
        }
        if (BOTH(5) && !dummy) GRID_BAR();
    }
    if (IN(7)) {
        const int T = moe_tables(L, ctl, tid);
        pg8::Gemm g{hn2, W13T, T * 256, 1024, DM};
        pg8::MoeOrder S{(const LAS int*)(L + LC_TILEE), T, 4, G, bid, (size_t)1024 * 1024 * 2, (const LAS int*)(L + LC_TSTART), (const LAS int*)(L + LC_CNT), list, NTOK, true};
        pg8::EpiSwiGLU E{Hb};
        pg8::gemm_phase<pg8::EpiSwiGLU, pg8::MoeOrder, true, true, true>(L, g, S, E);
        if (BOTH(7)) GRID_BAR();
    }
    if (IN(8)) {
        const int T = moe_tables(L, ctl, tid);
        pg8::Gemm g{Hb, W2T, T * 256, 1024, 512};
        pg8::MoeOrder S{(const LAS int*)(L + LC_TILEE), T, 4, G, bid, (size_t)1024 * 512 * 2, (const LAS int*)(L + LC_TSTART), (const LAS int*)(L + LC_CNT), list, NTOK, false};
        pg8::EpiRowScaleBf16 E{Yb, 1024, lgate, (const LAS int*)(L + LC_TILEE), (const LAS int*)(L + LC_TSTART), (const LAS int*)(L + LC_CNT), NTOK};
        pg8::gemm_phase<pg8::EpiRowScaleBf16, pg8::MoeOrder, true, true, false>(L, g, S, E);
        if (BOTH(8)) GRID_BAR();
    }
#ifndef DUP_P9
#define DUP_P9 1
#endif
    for (int rep9 = 0; rep9 < DUP_P9; ++rep9)
    if (IN(9)) {
        float* outw = (rep9 + 1 < DUP_P9) ? (float*)(ws + 256 * MiB) : a.out;
        (void)moe_tables(L, ctl, tid);
        const LAS int* tstart = (const LAS int*)(L + LC_TSTART);
        const float* gfin = a.in[36];
        for (int tok0 = gw * 4; tok0 < NTOK; tok0 += NGW * 4) {
            float4 v[4][4]; uint2 p[4][4], q[4][4];
#pragma unroll
            for (int u = 0; u < 4; ++u) { const int4 ti = tokinfo[tok0 + u];
                const size_t s0 = (size_t)tstart[ti.x] * 256 + ti.y, s1 = (size_t)tstart[ti.z] * 256 + ti.w;
                const uint2* y0 = (const uint2*)(Yb + s0 * DM); const uint2* y1 = (const uint2*)(Yb + s1 * DM);
                const float4* xr = (const float4*)(a.out + (size_t)(tok0 + u) * DM);
#pragma unroll
                for (int j = 0; j < 4; ++j) { v[u][j] = xr[lane + 64 * j]; p[u][j] = y0[lane + 64 * j]; q[u][j] = y1[lane + 64 * j]; } }
#pragma unroll
            for (int u = 0; u < 4; ++u) { float s = 0.f;
#pragma unroll
                for (int j = 0; j < 4; ++j) { const uint2 pp = p[u][j], qq = q[u][j];
                    v[u][j].x += __uint_as_float(pp.x << 16) + __uint_as_float(qq.x << 16); v[u][j].y += __uint_as_float(pp.x & 0xffff0000u) + __uint_as_float(qq.x & 0xffff0000u);
                    v[u][j].z += __uint_as_float(pp.y << 16) + __uint_as_float(qq.y << 16); v[u][j].w += __uint_as_float(pp.y & 0xffff0000u) + __uint_as_float(qq.y & 0xffff0000u);
                    s += (v[u][j].x * v[u][j].x + v[u][j].y * v[u][j].y) + (v[u][j].z * v[u][j].z + v[u][j].w * v[u][j].w); }
                s = wave_sum(s);
                const float rstd = rsqrtf(s * (1.0f / DM) + EPS);
                float4* xw = (float4*)(outw + (size_t)(tok0 + u) * DM);
#pragma unroll
                for (int j = 0; j < 4; ++j) { const float4 gg = *(const float4*)(gfin + (lane + 64 * j) * 4);
                    xw[lane + 64 * j] = make_float4(v[u][j].x * rstd * gg.x, v[u][j].y * rstd * gg.y, v[u][j].z * rstd * gg.z, v[u][j].w * rstd * gg.w); } }
        }
    }
#undef IN
#undef BOTH
#undef GRID_BAR
}

static void launch_fwd(const Args& base, int lo, int hi, int li, int grid, hipStream_t stream) {
    Args a = base; a.ph_lo = lo; a.ph_hi = hi; a.li = li; a.pad = 0;
    hipLaunchKernelGGL(fwd, dim3(grid), dim3(NWAVES * 64), LDS_BYTES, stream, a);
}

extern "C" void kernel_launch(void* const* d_in, const int* in_sizes, int n_in, void* d_out, int out_size, void* d_ws, size_t ws_size, hipStream_t stream) {
    (void)in_sizes; (void)n_in; (void)out_size; (void)ws_size;
    static int grid = 0;
    if (grid == 0) {
        int dev = 0, cus = 0;
        (void)hipGetDevice(&dev); (void)hipDeviceGetAttribute(&cus, hipDeviceAttributeMultiprocessorCount, dev);
        (void)hipFuncSetAttribute((const void*)fwd, hipFuncAttributeMaxDynamicSharedMemorySize, LDS_BYTES);
        grid = cus > 0 ? cus : 256;
    }
    const float* const* in = (const float* const*)d_in;
    unsigned char* ws = (unsigned char*)d_ws;
    float* out = (float*)d_out;
    (void)hipMemsetAsync(ws, 0, CTL_ZERO_BYTES, stream);
    Args base{};
    for (int i = 0; i < 37; ++i) base.in[i] = in[i];
    base.out = out; base.ws = ws;

#ifndef MK_PER_PHASE
    launch_fwd(base, 0, 10, 0, grid, stream);
#else
    for (int ph = 0; ph < 10; ++ph) launch_fwd(base, ph, ph + 1, ph, grid, stream);
#endif
}
```

```cpp
#include <hip/hip_runtime.h>
#include <stdint.h>

typedef unsigned short bf16;
__device__ __forceinline__ float bf2f(bf16 v) { return __uint_as_float(((unsigned)v) << 16); }
__device__ __forceinline__ bf16 f2bf(float f) { unsigned u = __float_as_uint(f); u += 0x7fffu + ((u >> 16) & 1u); return (bf16)(u >> 16); }

constexpr int NB = 4, SEQ = 8192, DM = 1024, NTOK = NB * SEQ, DIN = 2560, DL = 512, DH = 512;
constexpr float EPS = 1e-6f;

__device__ __forceinline__ float wave_sum(float v) {
#pragma unroll
    for (int o = 1; o < 64; o <<= 1) v += __shfl_xor(v, o);
    return v;
}
__device__ __forceinline__ float gelu_tanh(float x) { return 0.5f * x * (1.0f + tanhf(0.7978845608028654f * (x + 0.044715f * x * x * x))); }

constexpr size_t MiB = 1u << 20;
namespace pg8 {
#define PG8_LAS __attribute__((address_space(3)))
typedef unsigned short bf16_t;
typedef short bf16x8 __attribute__((ext_vector_type(8)));
typedef float f32x4 __attribute__((ext_vector_type(4)));
typedef unsigned u32x4 __attribute__((ext_vector_type(4)));
constexpr int BM = 256, BK = 64, HALF = 128, HTB = HALF * BK * 2  , STAGE_BYTES = 8 * HTB, NXCD = 8, WGM = 8;

__host__ __device__ __forceinline__ int lds_byte(int r, int c) { const int st = (r >> 4) * 2 + (c >> 5), rr = r & 15, cc = c & 31, ob = rr * 64 + cc * 2; return st * 1024 + (ob ^ (((ob >> 9) & 1) << 5)); }
__host__ __device__ __forceinline__ void stage_rc(int b, int& R, int& C) { const int st = b / 1024, sb = b % 1024, swz = sb ^ (((sb >> 9) & 1) << 5); R = (st >> 1) * 16 + swz / 64; C = (st & 1) * 32 + (swz % 64) / 2; }
__host__ __device__ __forceinline__ int perm32(int rho) { const int n = rho >> 4, i = rho & 15; return 8 * (i >> 2) + 4 * n + (i & 3); }

struct Unit { int pm, pn; };
struct Gemm { const bf16_t* A; const bf16_t* Bt; int M, N, K; };

struct StaticOrder {
    int nM, nN, nwg, G, c;
    __host__ __device__ void init(int M, int N, int G_, int c_) { nM = M / BM; nN = N / BM; nwg = nM * nN; G = G_; c = c_; }
    __host__ __device__ bool next(int i, Unit& u) const {
        const long L = (long)i * G + c; if (L >= nwg) return false;
        int wgid = (int)L; { const int q = nwg / NXCD, r = nwg % NXCD, xcd = wgid % NXCD, off = wgid / NXCD; wgid = (xcd < r ? xcd * (q + 1) : r * (q + 1) + (xcd - r) * q) + off; }
        const int nig = WGM * nN, gid = wgid / nig, fm = gid * WGM, gsz = (nM - fm) < WGM ? (nM - fm) : WGM;
        u.pm = fm + ((wgid % nig) % gsz); u.pn = (wgid % nig) / gsz; return true;
    }
    __device__ __forceinline__ void a_ready(const Unit&) const {}
    __device__ __forceinline__ void done(const Unit&) const {}
    __device__ __forceinline__ const char* a_base(const Gemm& g, const Unit& u) const { return (const char*)g.A + (size_t)u.pm * ((size_t)BM * g.K * 2); }
    __device__ __forceinline__ const char* b_base(const Gemm& g, const Unit& u) const { return (const char*)g.Bt + (size_t)u.pn * ((size_t)BM * g.K * 2); }
    __device__ __forceinline__ int src_row(const Unit&, int row) const { return row; }
};

__device__ __forceinline__ unsigned cvt_pk_bf16(float lo, float hi) { unsigned r; asm volatile("v_cvt_pk_bf16_f32 %0, %1, %2" : "=v"(r) : "v"(lo), "v"(hi)); return r; }
typedef float f32x2 __attribute__((ext_vector_type(2)));
__device__ __forceinline__ f32x2 gelu_pk(f32x2 v) {
    const f32x2 av = __builtin_elementwise_abs(v), d = av * 0.2316418882f + 1.0f;
    f32x2 t; t.x = __builtin_amdgcn_rcpf(d.x); t.y = __builtin_amdgcn_rcpf(d.y);
    f32x2 q = t * 0.5307027145f + (-0.7265760135f); q = q * t + 0.7107068705f; q = q * t + (-0.142248368f); q = q * t + 0.127414796f; q = q * t;
    const f32x2 s = (v * v) * (-0.72134752044f);
    f32x2 e; e.x = __builtin_amdgcn_exp2f(s.x); e.y = __builtin_amdgcn_exp2f(s.y);
    const f32x2 m = v * (q * e), r = v - m;
    f32x2 o; o.x = v.x < 0.f ? m.x : r.x; o.y = v.y < 0.f ? m.y : r.y; return o;
}

template <int ACT  > struct EpiBf16 {
    static constexpr bool PERM = true, AFTER_DRAIN = false; static_assert(ACT == 0 || ACT == 1, "EpiBf16: ACT is 0 (none) or 1 (gelu_pk)");
    bf16_t* O; int ldc; const float* bias; int split_cols; size_t split_stride; float scale0;
    __device__ __forceinline__ void operator()(const f32x4 (&acc)[2][2][4][2], const Unit& u, int wr, int wc, int fr, int fq) const {
        const int row0 = u.pm * BM + wr * 64 + fr; int colt = u.pn * BM; bf16_t* base = O;
        float sc = 1.f; if (split_cols) { const int t = colt / split_cols; base += (size_t)t * split_stride; colt -= t * split_cols; if (t == 0) sc = scale0; }
        const int col0 = colt + wc * 32 + 8 * fq, bcol0 = u.pn * BM + wc * 32 + 8 * fq;
        f32x4 bv[2][2];
#pragma unroll
        for (int bj = 0; bj < 2; ++bj)
#pragma unroll
            for (int n = 0; n < 2; ++n) bv[bj][n] = bias ? *(const f32x4*)(bias + bcol0 + bj * HALF + 4 * n) : (f32x4){0.f, 0.f, 0.f, 0.f};
#pragma unroll
        for (int ai = 0; ai < 2; ++ai)
#pragma unroll
            for (int m = 0; m < 4; ++m) { bf16_t* rowp = base + (size_t)(row0 + ai * HALF + m * 16) * ldc + col0;
#pragma unroll
                for (int bj = 0; bj < 2; ++bj) { f32x4 v0 = acc[ai][bj][m][0] + bv[bj][0], v1 = acc[ai][bj][m][1] + bv[bj][1];
                    if (ACT == 1) { f32x2 a = gelu_pk((f32x2){v0[0], v0[1]}), b = gelu_pk((f32x2){v0[2], v0[3]}), c = gelu_pk((f32x2){v1[0], v1[1]}), d = gelu_pk((f32x2){v1[2], v1[3]});
                        v0 = (f32x4){a.x, a.y, b.x, b.y}; v1 = (f32x4){c.x, c.y, d.x, d.y}; }
                    v0 = v0 * sc; v1 = v1 * sc; u32x4 w; w.x = cvt_pk_bf16(v0[0], v0[1]); w.y = cvt_pk_bf16(v0[2], v0[3]); w.z = cvt_pk_bf16(v1[0], v1[1]); w.w = cvt_pk_bf16(v1[2], v1[3]);
                    *(u32x4*)(rowp + bj * HALF) = w; } }
    }
};

struct EpiResF32 {
    static constexpr bool PERM = false, AFTER_DRAIN = false;
    const float* X; float* O; int ldc;
    __device__ __forceinline__ void operator()(const f32x4 (&acc)[2][2][4][2], const Unit& u, int wr, int wc, int fr, int fq) const {
        const int row0 = u.pm * BM + wr * 64 + fr, col0 = u.pn * BM + wc * 32 + 4 * fq;
#pragma unroll
        for (int ai = 0; ai < 2; ++ai)
#pragma unroll
            for (int m = 0; m < 4; ++m) { const size_t off = (size_t)(row0 + ai * HALF + m * 16) * ldc + col0;
#pragma unroll
                for (int bj = 0; bj < 2; ++bj)
#pragma unroll
                    for (int n = 0; n < 2; ++n) { const f32x4 xv = *(const f32x4*)(X + off + bj * HALF + n * 16); *(f32x4*)(O + off + bj * HALF + n * 16) = acc[ai][bj][m][n] + xv; } }
    }
};

struct EpiResBf16 {
    static constexpr bool PERM = true, AFTER_DRAIN = false;
    const float* X; bf16_t* O; int ldc;
    __device__ __forceinline__ void operator()(const f32x4 (&acc)[2][2][4][2], const Unit& u, int wr, int wc, int fr, int fq) const {
        const int row0 = u.pm * BM + wr * 64 + fr, col0 = u.pn * BM + wc * 32 + 8 * fq;
#pragma unroll
        for (int ai = 0; ai < 2; ++ai)
#pragma unroll
            for (int m = 0; m < 4; ++m) { const size_t off = (size_t)(row0 + ai * HALF + m * 16) * ldc + col0;
#pragma unroll
                for (int bj = 0; bj < 2; ++bj) { const f32x4 x0 = *(const f32x4*)(X + off + bj * HALF), x1 = *(const f32x4*)(X + off + bj * HALF + 4);
                    const f32x4 v0 = acc[ai][bj][m][0] + x0, v1 = acc[ai][bj][m][1] + x1;
                    u32x4 w; w.x = cvt_pk_bf16(v0[0], v0[1]); w.y = cvt_pk_bf16(v0[2], v0[3]); w.z = cvt_pk_bf16(v1[0], v1[1]); w.w = cvt_pk_bf16(v1[2], v1[3]);
                    *(u32x4*)(O + off + bj * HALF) = w; } }
    }
};
struct MoeOrder {
    const PG8_LAS int* tile_e; int T, nN, G, c; size_t expert_stride_bytes;
    const PG8_LAS int* tstart; const PG8_LAS int* cnt; const int* list; int ntok; bool gather;
    __device__ __forceinline__ bool next(int i, Unit& u) const {
        const int L = i * G + c; if (L >= T * nN) return false;
        u.pm = L / nN; u.pn = L % nN; return true;
    }
    __device__ __forceinline__ void a_ready(const Unit&) const {}
    __device__ __forceinline__ void done(const Unit&) const {}
    __device__ __forceinline__ const char* a_base(const Gemm& g, const Unit& u) const { return gather ? (const char*)g.A : (const char*)g.A + (size_t)u.pm * ((size_t)BM * g.K * 2); }
    __device__ __forceinline__ const char* b_base(const Gemm& g, const Unit& u) const { return (const char*)g.Bt + (size_t)tile_e[u.pm] * expert_stride_bytes + (size_t)u.pn * ((size_t)BM * g.K * 2); }
    __device__ __forceinline__ int src_row(const Unit& u, int row) const {
        const int e = tile_e[u.pm]; const int r = (u.pm - tstart[e]) * BM + row;
        return r < cnt[e] ? list[e * ntok + r] : 0;
    }
};
__device__ __forceinline__ float silu_f(float a) { return a * __builtin_amdgcn_rcpf(1.0f + __builtin_amdgcn_exp2f(-1.4426950408889634f * a)); }
struct EpiSwiGLU {
    static constexpr bool PERM = true, AFTER_DRAIN = false;
    bf16_t* H;
    __device__ __forceinline__ void operator()(const f32x4 (&acc)[2][2][4][2], const Unit& u, int wr, int wc, int fr, int fq) const {
        const int row0 = u.pm * BM + wr * 64 + fr, col0 = u.pn * 128 + wc * 32 + 8 * fq;
#pragma unroll
        for (int ai = 0; ai < 2; ++ai)
#pragma unroll
            for (int m = 0; m < 4; ++m) { bf16_t* p = H + (size_t)(row0 + ai * HALF + m * 16) * 512 + col0;
                const f32x4 a0 = acc[ai][0][m][0], a1 = acc[ai][0][m][1], b0 = acc[ai][1][m][0], b1 = acc[ai][1][m][1];
                u32x4 w; w.x = cvt_pk_bf16(silu_f(a0[0]) * b0[0], silu_f(a0[1]) * b0[1]); w.y = cvt_pk_bf16(silu_f(a0[2]) * b0[2], silu_f(a0[3]) * b0[3]);
                w.z = cvt_pk_bf16(silu_f(a1[0]) * b1[0], silu_f(a1[1]) * b1[1]); w.w = cvt_pk_bf16(silu_f(a1[2]) * b1[2], silu_f(a1[3]) * b1[3]);
                *(u32x4*)p = w; }
    }
};
struct EpiRowScaleBf16 {
    static constexpr bool PERM = true, AFTER_DRAIN = false;
    bf16_t* O; int ldc; const float* lgate; const PG8_LAS int* tile_e; const PG8_LAS int* tstart; const PG8_LAS int* cnt; int ntok;
    __device__ __forceinline__ void operator()(const f32x4 (&acc)[2][2][4][2], const Unit& u, int wr, int wc, int fr, int fq) const {
        const int rl0 = wr * 64 + fr, col0 = u.pn * BM + wc * 32 + 8 * fq;
        const int e = tile_e[u.pm]; const int rbase = (u.pm - tstart[e]) * BM; const int ce = cnt[e];
#pragma unroll
        for (int ai = 0; ai < 2; ++ai)
#pragma unroll
            for (int m = 0; m < 4; ++m) { const int rl = rl0 + ai * HALF + m * 16; const int r = rbase + rl; const float sc = r < ce ? lgate[e * ntok + r] : 0.f;
                bf16_t* rowp = O + (size_t)(u.pm * BM + rl) * ldc + col0;
#pragma unroll
                for (int bj = 0; bj < 2; ++bj) { const f32x4 v0 = acc[ai][bj][m][0] * sc, v1 = acc[ai][bj][m][1] * sc;
                    u32x4 w; w.x = cvt_pk_bf16(v0[0], v0[1]); w.y = cvt_pk_bf16(v0[2], v0[3]); w.z = cvt_pk_bf16(v1[0], v1[1]); w.w = cvt_pk_bf16(v1[2], v1[3]);
                    *(u32x4*)(rowp + bj * HALF) = w; } }
    }
};
template <class Epi, class Sched, bool ALIGN_EPI = false, bool SP2 = false, bool GATHER = false>
__device__ __forceinline__ void gemm_phase(PG8_LAS unsigned char* lds, const Gemm g, const Sched& S, const Epi& E) {
    const int tid = threadIdx.x, wid = __builtin_amdgcn_readfirstlane(tid >> 6), lane = tid & 63, wr = wid >> 2, wc = wid & 3, fr = lane & 15, fq = lane >> 4;
    const int K = g.K, nt = K / BK;
    unsigned voffA[2], voffB[2];
#pragma unroll
    for (int i = 0; i < 2; ++i) { int R, C; stage_rc(tid * 16 + i * 8192, R, C); const int Rb = Epi::PERM ? ((R & ~31) + perm32(R & 31)) : R;
        voffA[i] = (unsigned)(R * K + C) * 2u; voffB[i] = (unsigned)(Rb * K + C) * 2u; }
    unsigned voA[2][2], voAn[2][2];
    int gR[2], gC[2];
#pragma unroll
    for (int i = 0; i < 2; ++i) { int R, C; stage_rc(tid * 16 + i * 8192, R, C); gR[i] = R; gC[i] = C; }
#pragma unroll
    for (int h = 0; h < 2; ++h)
#pragma unroll
        for (int i = 0; i < 2; ++i) { voA[h][i] = voffA[i] + (unsigned)h * (unsigned)(HALF * K * 2); voAn[h][i] = voA[h][i]; }
    const size_t kstep = (size_t)(BK * 2);
    const size_t hstep = (size_t)HALF * K * 2;
    const size_t tstep = 2 * hstep; (void)tstep;
    const unsigned ldsw = (unsigned)wid * 1024u;
    const int aoff = lds_byte(wr * 64 + fr, fq * 8), boff = lds_byte(wc * 32 + fr, fq * 8);
#define PG8_SA(b, h) (((b) * 2 + (h)) * HTB)
#define PG8_SB(b, h) ((4 + (b) * 2 + (h)) * HTB)
#define PG8_STAGE(bufoff, gbase, voff) do { _Pragma("unroll") for (int _i = 0; _i < 2; ++_i) \
        __builtin_amdgcn_global_load_lds((const unsigned*)((const char*)(gbase) + (voff)[_i]), (PG8_LAS unsigned*)(lds + (bufoff) + ldsw + _i * 8192), 16, 0, 0); } while (0)
#define PG8_STAGE_A(bufoff, gbase, h, vo) do { _Pragma("unroll") for (int _i = 0; _i < 2; ++_i) \
        __builtin_amdgcn_global_load_lds((const unsigned*)((const char*)(gbase) + (vo)[h][_i]), (PG8_LAS unsigned*)(lds + (bufoff) + ldsw + _i * 8192), 16, 0, 0); } while (0)
#define PG8_GATHER_OFFS(dst, unit) do { _Pragma("unroll") for (int _h = 0; _h < 2; ++_h) _Pragma("unroll") for (int _i = 0; _i < 2; ++_i) \
        (dst)[_h][_i] = (unsigned)(S.src_row(unit, _h * HALF + gR[_i]) * K + gC[_i]) * 2u; } while (0)
#define PG8_LDA(dst, b, h) do { _Pragma("unroll") for (int m = 0; m < 4; ++m) _Pragma("unroll") for (int k = 0; k < 2; ++k) dst[m][k] = *(const PG8_LAS bf16x8*)(lds + PG8_SA(b, h) + aoff + m * 2048 + k * 1024); } while (0)
#define PG8_LDB(dst, b, h) do { _Pragma("unroll") for (int n = 0; n < 2; ++n) _Pragma("unroll") for (int k = 0; k < 2; ++k) dst[n][k] = *(const PG8_LAS bf16x8*)(lds + PG8_SB(b, h) + boff + n * 2048 + k * 1024); } while (0)
#define PG8_MMA(ai, bj, At, Bt) do { __builtin_amdgcn_s_setprio(1); _Pragma("unroll") for (int m = 0; m < 4; ++m) _Pragma("unroll") for (int n = 0; n < 2; ++n) _Pragma("unroll") for (int k = 0; k < 2; ++k) \
        acc[ai][bj][m][n] = __builtin_amdgcn_mfma_f32_16x16x32_bf16(Bt[n][k], At[m][k], acc[ai][bj][m][n], 0, 0, 0); __builtin_amdgcn_s_setprio(0); } while (0)
#define PG8_WAIT_V(n) asm volatile("s_waitcnt vmcnt(" #n ")" ::: "memory")
#define PG8_WAIT_L(n) asm volatile("s_waitcnt lgkmcnt(" #n ")" ::: "memory")
#define PG8_BAR __builtin_amdgcn_s_barrier()
#define PG8_SCHED __builtin_amdgcn_sched_barrier(0)
    Unit cur, nxt; int ui = 0;
    if (!S.next(0, cur)) return;
    f32x4 acc[2][2][4][2];
#pragma unroll
    for (int a = 0; a < 2; ++a)
#pragma unroll
        for (int b = 0; b < 2; ++b)
#pragma unroll
            for (int m = 0; m < 4; ++m)
#pragma unroll
                for (int n = 0; n < 2; ++n) acc[a][b][m][n] = (f32x4){0.f, 0.f, 0.f, 0.f};
    bf16x8 At[4][2], B0[2][2], B1[2][2];
    const char* cA = S.a_base(g, cur); const char* cB = S.b_base(g, cur);
    if constexpr (GATHER) { PG8_GATHER_OFFS(voA, cur); }
    S.a_ready(cur);
    if constexpr (SP2) {
        PG8_STAGE(PG8_SB(0, 0), cB, voffB); PG8_STAGE(PG8_SB(0, 1), cB + hstep, voffB); PG8_STAGE_A(PG8_SA(0, 0), cA, 0, voA); PG8_STAGE_A(PG8_SA(0, 1), cA, 1, voA);
        if (wr == 1) PG8_BAR;
        PG8_WAIT_V(2); PG8_BAR;
        PG8_STAGE(PG8_SB(1, 0), cB + kstep, voffB); PG8_STAGE_A(PG8_SA(1, 0), cA + kstep, 0, voA); PG8_STAGE(PG8_SB(1, 1), cB + hstep + kstep, voffB);
        PG8_WAIT_V(6); PG8_BAR;
    } else {
        PG8_STAGE(PG8_SB(0, 0), cB, voffB); PG8_STAGE_A(PG8_SA(0, 0), cA, 0, voA); PG8_STAGE(PG8_SB(0, 1), cB + hstep, voffB); PG8_STAGE_A(PG8_SA(0, 1), cA, 1, voA);
        if (wr == 1) PG8_BAR;
        PG8_WAIT_V(4); PG8_BAR;
        PG8_STAGE(PG8_SB(1, 0), cB + kstep, voffB); PG8_STAGE_A(PG8_SA(1, 0), cA + kstep, 0, voA); PG8_STAGE(PG8_SB(1, 1), cB + hstep + kstep, voffB);
        PG8_WAIT_V(6); PG8_BAR;
    }
    for (;;) {
        const bool has_next = S.next(ui + 1, nxt);
        const char* nA = has_next ? S.a_base(g, nxt) : cA; const char* nB = has_next ? S.b_base(g, nxt) : cB;
        if constexpr (GATHER) { if (has_next) { PG8_GATHER_OFFS(voAn, nxt); } else {
#pragma unroll
            for (int _h = 0; _h < 2; ++_h) { voAn[_h][0] = voA[_h][0]; voAn[_h][1] = voA[_h][1]; } } }
        for (int t = 0; t < nt; t += 2) {
            const bool last = (t == nt - 2);
            const char* a1 = cA + (size_t)(t + 1) * kstep;
            const char* a2 = last ? nA : cA + (size_t)(t + 2) * kstep; const char* b2 = last ? nB : cB + (size_t)(t + 2) * kstep;
            const char* a3 = a2 + kstep; const char* b3 = b2 + kstep;
            if (last && has_next) S.a_ready(nxt);
            if constexpr (SP2) {
            PG8_LDB(B0, 0, 0); PG8_LDB(B1, 0, 1); PG8_SCHED; PG8_LDA(At, 0, 0); PG8_STAGE_A(PG8_SA(1, 1), a1, 1, voA);
            PG8_WAIT_V(8); PG8_WAIT_L(0); PG8_BAR; PG8_MMA(0, 0, At, B0); PG8_MMA(0, 1, At, B1); PG8_BAR; PG8_SCHED;
            PG8_LDA(At, 0, 1); PG8_STAGE(PG8_SB(0, 0), b2, voffB); PG8_STAGE(PG8_SB(0, 1), b2 + hstep, voffB); if (last) { PG8_STAGE_A(PG8_SA(0, 0), a2, 0, voAn); } else { PG8_STAGE_A(PG8_SA(0, 0), a2, 0, voA); }
            PG8_WAIT_V(8); PG8_WAIT_L(0); PG8_BAR; PG8_MMA(1, 0, At, B0); PG8_MMA(1, 1, At, B1); PG8_BAR; PG8_SCHED;
            PG8_LDB(B0, 1, 0); PG8_LDB(B1, 1, 1); PG8_SCHED; PG8_LDA(At, 1, 0); if (last) { PG8_STAGE_A(PG8_SA(0, 1), a2, 1, voAn); } else { PG8_STAGE_A(PG8_SA(0, 1), a2, 1, voA); }
            PG8_WAIT_V(8); PG8_WAIT_L(0); PG8_BAR; PG8_MMA(0, 0, At, B0); PG8_MMA(0, 1, At, B1); PG8_BAR; PG8_SCHED;
            PG8_LDA(At, 1, 1); PG8_STAGE(PG8_SB(1, 0), b3, voffB); PG8_STAGE(PG8_SB(1, 1), b3 + hstep, voffB); if (last) { PG8_STAGE_A(PG8_SA(1, 0), a3, 0, voAn); } else { PG8_STAGE_A(PG8_SA(1, 0), a3, 0, voA); }
            PG8_WAIT_V(8); PG8_WAIT_L(0); PG8_BAR; PG8_MMA(1, 0, At, B0); PG8_MMA(1, 1, At, B1); PG8_BAR; PG8_SCHED;
            } else {
            PG8_LDB(B0, 0, 0); PG8_SCHED; PG8_LDA(At, 0, 0); PG8_STAGE(PG8_SA(1, 1), a1 + hstep, voffA);
            PG8_WAIT_L(8); PG8_BAR; PG8_WAIT_L(0); PG8_MMA(0, 0, At, B0); PG8_BAR; PG8_SCHED;
            PG8_LDB(B1, 0, 1); PG8_STAGE(PG8_SB(0, 0), b2, voffB);
            PG8_BAR; PG8_WAIT_L(0); PG8_MMA(0, 1, At, B1); PG8_BAR;
            PG8_LDA(At, 0, 1); PG8_STAGE(PG8_SA(0, 0), a2, voffA);
            PG8_BAR; PG8_WAIT_L(0); PG8_MMA(1, 0, At, B0); PG8_BAR; PG8_SCHED;
            PG8_STAGE(PG8_SB(0, 1), b2 + hstep, voffB);
            PG8_WAIT_V(6); PG8_BAR; PG8_MMA(1, 1, At, B1); PG8_BAR;
            PG8_LDB(B0, 1, 0); PG8_SCHED; PG8_LDA(At, 1, 0); PG8_STAGE(PG8_SA(0, 1), a2 + hstep, voffA);
            PG8_WAIT_L(8); PG8_BAR; PG8_WAIT_L(0); PG8_MMA(0, 0, At, B0); PG8_BAR; PG8_SCHED;
            PG8_LDB(B1, 1, 1); PG8_STAGE(PG8_SB(1, 0), b3, voffB);
            PG8_BAR; PG8_WAIT_L(0); PG8_MMA(0, 1, At, B1); PG8_BAR;
            PG8_LDA(At, 1, 1); PG8_STAGE(PG8_SA(1, 0), a3, voffA);
            PG8_BAR; PG8_WAIT_L(0); PG8_MMA(1, 0, At, B0); PG8_BAR; PG8_SCHED;
            PG8_STAGE(PG8_SB(1, 1), b3 + hstep, voffB);
            PG8_WAIT_V(6); PG8_BAR; PG8_MMA(1, 1, At, B1); PG8_BAR;
            }
        }
        if constexpr (ALIGN_EPI) { if (wr == 0) PG8_BAR; }
        if constexpr (!Epi::AFTER_DRAIN) { E(acc, cur, wr, wc, fr, fq); S.done(cur); }
        if (!has_next) break;
#pragma unroll
        for (int a = 0; a < 2; ++a)
#pragma unroll
            for (int b = 0; b < 2; ++b)
#pragma unroll
                for (int m = 0; m < 4; ++m)
#pragma unroll
                    for (int n = 0; n < 2; ++n) acc[a][b][m][n] = (f32x4){0.f, 0.f, 0.f, 0.f};
        cur = nxt; cA = nA; cB = nB; ++ui;
        if constexpr (GATHER) {
#pragma unroll
            for (int _h = 0; _h < 2; ++_h) { voA[_h][0] = voAn[_h][0]; voA[_h][1] = voAn[_h][1]; } }
        if constexpr (ALIGN_EPI) { if (wr == 1) PG8_BAR; }
    }
    PG8_WAIT_V(0);
    if constexpr (!ALIGN_EPI) { if (wr == 0) PG8_BAR; }
    PG8_BAR;
    if constexpr (Epi::AFTER_DRAIN) { E.fused(acc, cur, wr, wc, fr, fq, lds, wid, lane); S.done(cur); }
#undef PG8_SA
#undef PG8_SB
#undef PG8_STAGE
#undef PG8_STAGE_A
#undef PG8_GATHER_OFFS
#undef PG8_LDA
#undef PG8_LDB
#undef PG8_MMA
#undef PG8_WAIT_V
#undef PG8_WAIT_L
#undef PG8_BAR
#undef PG8_SCHED
}
}
#define LAS __attribute__((address_space(3)))
#define XB_TMO      128
#define XB_XCNT(j)  (256  + 64 * (j))
#define XB_XSUB(j)  (1280 + 64 * (j))
#define XB_XGEN(j)  (2304 + 64 * (j))
#define XB_TOP      3328
#define XB_TOPGEN   3392
#define XCD_BAR_WORDS 3456
#define XB_SPIN_CAP (1u << 18)

__device__ __forceinline__ unsigned xb_ld(unsigned* p)              { return __hip_atomic_load(p, __ATOMIC_RELAXED, __HIP_MEMORY_SCOPE_AGENT); }
__device__ __forceinline__ unsigned xb_add(unsigned* p, unsigned v) { return __hip_atomic_fetch_add(p, v, __ATOMIC_RELAXED, __HIP_MEMORY_SCOPE_AGENT); }
__device__ __forceinline__ unsigned xb_xcc_id() { return (unsigned)__builtin_amdgcn_s_getreg((3 << 11) | 20) & 0xFu; }
#define XB_SPIN(cond, bar) do { unsigned _sp = 0; while (cond) { __builtin_amdgcn_s_sleep(1); \
    if ((++_sp & 255u) == 0u) { if (xb_ld(&(bar)[XB_TMO])) break; if (_sp > XB_SPIN_CAP) { atomicAdd(&(bar)[XB_TMO], 1u); break; } } } } while (0)

struct XcdBarrier {
    unsigned* bar; unsigned x;
    volatile LAS unsigned* st;
};

__device__ __forceinline__ XcdBarrier xcd_barrier_post(unsigned* bar, volatile LAS unsigned* st) {
    XcdBarrier b; b.bar = bar; b.x = xb_xcc_id(); b.st = st;
    if (threadIdx.x == 0) (void)xb_add(&bar[XB_XCNT(b.x)], 1u);
    return b;
}
__device__ __forceinline__ void xcd_barrier_complete(unsigned* bar, unsigned x, unsigned& nloc, unsigned& nx) {
    const unsigned G = gridDim.x * gridDim.y * gridDim.z;
    unsigned sum, cnt, mine, sp = 0u;
    for (;;) {
        sum = 0u; cnt = 0u; mine = 0u;
#pragma unroll
        for (unsigned j = 0; j < 16; ++j) { const unsigned c = xb_ld(&bar[XB_XCNT(j)]); sum += c; cnt += (c > 0u) ? 1u : 0u; mine = (j == x) ? c : mine; }
        if (sum == G) break;
        __builtin_amdgcn_s_sleep(1);
        if ((++sp & 255u) == 0u) { if (xb_ld(&bar[XB_TMO])) break; if (sp > XB_SPIN_CAP) { atomicAdd(&bar[XB_TMO], 1u); break; } }
    }
    nloc = mine > 0u ? mine : 1u; nx = cnt > 0u ? cnt : 1u;
}

__device__ __forceinline__ void xcd_barrier(const XcdBarrier& b) {
    asm volatile("s_waitcnt vmcnt(0)" ::: "memory");
    __syncthreads();
    if (threadIdx.x == 0) {
        unsigned* bar = b.bar;
        __builtin_amdgcn_s_waitcnt(0);
        unsigned nloc = b.st[0], nx = b.st[1];
        if (nloc == 0u) { xcd_barrier_complete(bar, b.x, nloc, nx); b.st[0] = nloc; b.st[1] = nx; }
        const unsigned old = xb_add(&bar[XB_XSUB(b.x)], 1u);
        const unsigned gen = old / nloc;
        if (old + 1u == (gen + 1u) * nloc) {
            __builtin_amdgcn_fence(__ATOMIC_RELEASE, "agent");
            asm volatile("s_waitcnt vmcnt(0)" ::: "memory");
            const unsigned og = xb_add(&bar[XB_TOP], 1u);
            const unsigned tg = og / nx;
            if (og + 1u == (tg + 1u) * nx) xb_add(&bar[XB_TOPGEN], 1u);
            else XB_SPIN(xb_ld(&bar[XB_TOPGEN]) == tg, bar);
            __builtin_amdgcn_fence(__ATOMIC_ACQUIRE, "agent");
            xb_add(&bar[XB_XGEN(b.x)], 1u);
            asm volatile("s_waitcnt vmcnt(0)" ::: "memory");
        } else {
            XB_SPIN(xb_ld(&bar[XB_XGEN(b.x)]) == gen, bar);
            __builtin_amdgcn_fence(__ATOMIC_ACQUIRE, "agent");
            asm volatile("s_waitcnt vmcnt(0)" ::: "memory");
        }
    }
    __syncthreads();
}

#define GAS __attribute__((address_space(1)))
typedef unsigned v4u __attribute__((ext_vector_type(4)));
#define LDS_WAIT() asm volatile("s_waitcnt lgkmcnt(0)" ::: "memory")
constexpr int NWAVES = 8;
constexpr int RING_BYTES = 139264, LDSCTL_OFF = RING_BYTES, MISC_OFF = LDSCTL_OFF + 320, LDS_BYTES = 155648;
constexpr size_t CTL_ZERO_BYTES = 1 * MiB;
constexpr int CW_BAR = 4096;
constexpr int MAX_LAUNCHES = 12;
static_assert((CW_BAR + MAX_LAUNCHES * XCD_BAR_WORDS) * 4 <= (int)CTL_ZERO_BYTES, "ctl");

constexpr size_t WS_WINT = 1 * MiB, WS_WOUTT = 6 * MiB, WS_W13T = 8 * MiB, WS_W2T = 72 * MiB;
constexpr size_t WS_HN1 = 104 * MiB, WS_LRU = 168 * MiB, WS_HYUT = 232 * MiB, WS_HF = 396 * MiB, WS_HB = 428 * MiB;
constexpr size_t WS_YHYT = 104 * MiB, WS_YCAT = 232 * MiB, WS_HN2 = 168 * MiB, WS_EID = 460 * MiB, WS_GATE = 461 * MiB;
constexpr size_t WS_LIST = 460 * MiB, WS_LGATE = 464 * MiB, WS_TOKINFO = 468 * MiB, WS_WRT = 469 * MiB, WS_SGATE = 470 * MiB;
constexpr size_t WS_XS = 232 * MiB, WS_H = 376 * MiB, WS_Y = 168 * MiB, WS_XMID = 104 * MiB;
constexpr size_t WS_XC = 104 * MiB, WS_Z2 = 392 * MiB, WS_KT = 328 * MiB;
constexpr int CW_CNT = 2048;
constexpr int LC_CNT = RING_BYTES + 1024, LC_BASE = RING_BYTES + 1152, LC_TSTART = RING_BYTES + 1280, LC_TILEE = RING_BYTES + 2048;

struct Args { const float* in[37]; float* out; unsigned char* ws; int ph_lo, ph_hi, li, pad; };

__device__ __forceinline__ unsigned pk2(float lo, float hi) { return (unsigned)f2bf(lo) | ((unsigned)f2bf(hi) << 16); }

__device__ __forceinline__ void p0_transpose_item(const float* __restrict__ W, int K, int N, bf16* __restrict__ WT, int drow0, LAS float* scr, int k0, int n0, int lane) {
#pragma unroll 8
    for (int i = 0; i < 32; ++i) { const int kk = 2 * i + (lane >> 5); scr[kk * 33 + (lane & 31)] = W[(size_t)(k0 + kk) * N + n0 + (lane & 31)]; }
    LDS_WAIT(); asm volatile("" ::: "memory");
    const int c = lane & 7;
#pragma unroll
    for (int j = 0; j < 4; ++j) { const int n = (lane >> 3) + 8 * j; const LAS float* s = scr + (8 * c) * 33 + n;
        v4u o; o.x = pk2(s[0 * 33], s[1 * 33]); o.y = pk2(s[2 * 33], s[3 * 33]); o.z = pk2(s[4 * 33], s[5 * 33]); o.w = pk2(s[6 * 33], s[7 * 33]);
        *(v4u*)(WT + (size_t)(drow0 + n) * K + k0 + 8 * c) = o; }
    LDS_WAIT(); asm volatile("" ::: "memory");
}
__device__ __forceinline__ void rms_row_to_bf16(const float* __restrict__ xrow, const float* __restrict__ g, bf16* __restrict__ orow, int lane) {
    const float4* xr = (const float4*)xrow;
    float4 v[4]; float s = 0.f;
#pragma unroll
    for (int j = 0; j < 4; ++j) { v[j] = xr[lane + 64 * j]; s += (v[j].x * v[j].x + v[j].y * v[j].y) + (v[j].z * v[j].z + v[j].w * v[j].w); }
    s = wave_sum(s);
    const float rstd = rsqrtf(s * (1.0f / DM) + EPS);
#pragma unroll
    for (int j = 0; j < 4; ++j) { const int c = (lane + 64 * j) * 4; const float4 gg = *(const float4*)(g + c);
        uint2 o; o.x = pk2(v[j].x * rstd * gg.x, v[j].y * rstd * gg.y); o.y = pk2(v[j].z * rstd * gg.z, v[j].w * rstd * gg.w);
        *(uint2*)(orow + c) = o; }
}


typedef short bf16x8_t __attribute__((ext_vector_type(8)));
typedef float f32x4_t __attribute__((ext_vector_type(4)));
__device__ __forceinline__ int moe_tables(LAS unsigned char* L, unsigned* ctl, int tid) {
    LAS int* cnt = (LAS int*)(L + LC_CNT); LAS int* tstart = (LAS int*)(L + LC_TSTART); LAS int* tile_e = (LAS int*)(L + LC_TILEE);
    __syncthreads();
    if (tid < 32) cnt[tid] = (int)__hip_atomic_load(ctl + CW_CNT + tid, __ATOMIC_RELAXED, __HIP_MEMORY_SCOPE_AGENT);
    __syncthreads();
    if (tid == 0) { int ts = 0; for (int e = 0; e < 32; ++e) { tstart[e] = ts; const int nt = (cnt[e] + 255) >> 8; for (int i = 0; i < nt; ++i) tile_e[ts + i] = e; ts += nt; } tstart[32] = ts; }
    __syncthreads();
    return tstart[32];
}

__device__ __forceinline__ void lru_load_frags(const bf16* xrow0, int sg0, int jl, int dir, v4u (&fr)[4][2]) {
#pragma unroll
    for (int mt = 0; mt < 4; ++mt) { const int sg = 16 * (jl >> 2) + 4 * mt + (jl & 3); const int tau = sg0 + sg; const int t = dir ? (SEQ - 1 - tau) : tau;
#pragma unroll
        for (int s = 0; s < 2; ++s) fr[mt][s] = *(const v4u*)(xrow0 + (size_t)t * 64 + 32 * s); }
}
__device__ __forceinline__ void lru_item(LAS unsigned char* L, const Args& a, int item, const bf16* __restrict__ xcb, bf16* __restrict__ hf, bf16* __restrict__ hb, int tid, int lane, int wave) {
    const int b = item >> 6, h = (item >> 3) & 7, q4 = (item >> 1) & 3, dir = item & 1;
    const float* wr = dir ? a.in[10] : a.in[5]; const float* br = dir ? a.in[11] : a.in[6]; const float* wi = dir ? a.in[12] : a.in[7];
    const float* bi = dir ? a.in[13] : a.in[8]; const float* lam = dir ? a.in[14] : a.in[9];
    bf16* outp = dir ? hb : hf;
    LAS float* carry = (LAS float*)(L + 2048);
    const int jl = lane & 15, kg = lane >> 4;
    const int c = 64 * h + 16 * q4 + jl;
    bf16x8_t Br[2], Bi[2], Bid;
#pragma unroll
    for (int s = 0; s < 2; ++s)
#pragma unroll
        for (int j = 0; j < 8; ++j) { const int i = 32 * s + 8 * kg + j;
            Br[s][j] = (short)f2bf(wr[h * 4096 + i * 64 + 16 * q4 + jl]); Bi[s][j] = (short)f2bf(wi[h * 4096 + i * 64 + 16 * q4 + jl]); }
#pragma unroll
    for (int j = 0; j < 8; ++j) Bid[j] = (8 * kg + j == 16 * (q4 & 1) + jl) ? (short)0x3f80 : (short)0;
    const int sid = q4 >> 1;
    const float brc = br[c], bic = bi[c];
    const float sp8l = 8.0f * log1pf(expf(-lam[c])) * 1.4426950408889634f;
    __syncthreads();
    float Hblk = 0.f;
    const bf16* xrow0 = xcb + ((size_t)(b * 8 + h) * SEQ) * 64 + 8 * kg;
    v4u frn[4][2];
    lru_load_frags(xrow0, 64 * wave, jl, dir, frn);
    for (int it = 0; it < 16; ++it) {
        const int sg0 = 512 * it + 64 * wave;
        bf16x8_t Af[4][2];
#pragma unroll
        for (int mt = 0; mt < 4; ++mt)
#pragma unroll
            for (int s = 0; s < 2; ++s) Af[mt][s] = __builtin_bit_cast(bf16x8_t, frn[mt][s]);
        if (it < 15) lru_load_frags(xrow0, sg0 + 512, jl, dir, frn);
        float hloc[16], Ploc[16];
        float hl = 0.f, P = 1.f;
#pragma unroll
        for (int mt = 0; mt < 4; ++mt) {
            f32x4_t aR = {0.f, 0.f, 0.f, 0.f}, aI = aR, aX = aR;
            aR = __builtin_amdgcn_mfma_f32_16x16x32_bf16(Af[mt][0], Br[0], aR, 0, 0, 0); aR = __builtin_amdgcn_mfma_f32_16x16x32_bf16(Af[mt][1], Br[1], aR, 0, 0, 0);
            aI = __builtin_amdgcn_mfma_f32_16x16x32_bf16(Af[mt][0], Bi[0], aI, 0, 0, 0); aI = __builtin_amdgcn_mfma_f32_16x16x32_bf16(Af[mt][1], Bi[1], aI, 0, 0, 0);
            aX = __builtin_amdgcn_mfma_f32_16x16x32_bf16(sid ? Af[mt][1] : Af[mt][0], Bid, aX, 0, 0, 0);
#pragma unroll
            for (int r = 0; r < 4; ++r) {
                const float rg = __builtin_amdgcn_rcpf(1.0f + __builtin_amdgcn_exp2f(-1.4426950408889634f * (aR[r] + brc)));
                const float ig = __builtin_amdgcn_rcpf(1.0f + __builtin_amdgcn_exp2f(-1.4426950408889634f * (aI[r] + bic)));
                const float av = __builtin_amdgcn_exp2f(-rg * sp8l);
                const float bb = __builtin_amdgcn_sqrtf(fmaxf(1.0f - av * av, 0.f)) * (ig * aX[r]);
                hl = av * hl + bb; P *= av;
                hloc[4 * mt + r] = hl; Ploc[4 * mt + r] = P;
            }
        }
        const float A0 = __shfl(P, jl), B0 = __shfl(hl, jl), A1 = __shfl(P, jl + 16), B1 = __shfl(hl, jl + 16);
        const float A2 = __shfl(P, jl + 32), B2 = __shfl(hl, jl + 32), A3 = __shfl(P, jl + 48), B3 = __shfl(hl, jl + 48);
        LAS float* cbuf = carry + (it & 1) * 256;
        if (kg == 0) { cbuf[(wave * 16 + jl) * 2 + 0] = A0 * A1 * A2 * A3; cbuf[(wave * 16 + jl) * 2 + 1] = ((B0 * A1 + B1) * A2 + B2) * A3 + B3; }
        __syncthreads();
        float Hw = Hblk, Hn = Hblk;
#pragma unroll
        for (int w2 = 0; w2 < 8; ++w2) { const float Aq = cbuf[(w2 * 16 + jl) * 2 + 0], Bq = cbuf[(w2 * 16 + jl) * 2 + 1];
            if (w2 < wave) Hw = Aq * Hw + Bq;
            Hn = Aq * Hn + Bq; }
        Hblk = Hn;
        float Hin = Hw;
        if (kg >= 1) Hin = A0 * Hin + B0;
        if (kg >= 2) Hin = A1 * Hin + B1;
        if (kg >= 3) Hin = A2 * Hin + B2;
#pragma unroll
        for (int k = 0; k < 16; ++k) { const int tau = sg0 + 16 * kg + k; const int t = dir ? (SEQ - 1 - tau) : tau;
            outp[((size_t)b * SEQ + t) * DL + c] = f2bf(hloc[k] + Ploc[k] * Hin); }
    }
}

typedef float f32x2_t __attribute__((ext_vector_type(2)));
typedef _Float16 f16x2_t __attribute__((ext_vector_type(2)));
constexpr int LC_TW = RING_BYTES + 4096, LC_TA = RING_BYTES + 8192, LC_TB = RING_BYTES + 9216, LC_RED = RING_BYTES + 3328;
constexpr size_t WS_SPEC = 328 * MiB, WS_HT = 396 * MiB, WS_XCB = 136 * MiB;
__device__ __forceinline__ f32x2_t cmul(f32x2_t a, f32x2_t b) { f32x2_t r; r.x = a.x * b.x - a.y * b.y; r.y = a.x * b.y + a.y * b.x; return r; }
__device__ __forceinline__ f32x2_t h2_to_f2(unsigned u) { const f16x2_t h = __builtin_bit_cast(f16x2_t, u); f32x2_t k; k.x = (float)h.x; k.y = (float)h.y; return k; }
__device__ __forceinline__ f32x2_t cmulc(f32x2_t a, f32x2_t b) { f32x2_t r; r.x = a.x * b.x + a.y * b.y; r.y = a.y * b.x - a.x * b.y; return r; }
template <bool INV> __device__ __forceinline__ f32x2_t twc(f32x2_t d, int e) {
    constexpr float CT[16] = {1.000000000e+00f, 9.807852804e-01f, 9.238795325e-01f, 8.314696123e-01f, 7.071067812e-01f, 5.555702330e-01f, 3.826834324e-01f, 1.950903220e-01f, 6.123233996e-17f, -1.950903220e-01f, -3.826834324e-01f, -5.555702330e-01f, -7.071067812e-01f, -8.314696123e-01f, -9.238795325e-01f, -9.807852804e-01f};
    constexpr float ST[16] = {0.000000000e+00f, 1.950903220e-01f, 3.826834324e-01f, 5.555702330e-01f, 7.071067812e-01f, 8.314696123e-01f, 9.238795325e-01f, 9.807852804e-01f, 1.000000000e+00f, 9.807852804e-01f, 9.238795325e-01f, 8.314696123e-01f, 7.071067812e-01f, 5.555702330e-01f, 3.826834324e-01f, 1.950903220e-01f};
    f32x2_t r;
    if (e == 0) return d;
    if (e == 8) { if (INV) { r.x = -d.y; r.y = d.x; } else { r.x = d.y; r.y = -d.x; } return r; }
    const float c = CT[e], s = INV ? -ST[e] : ST[e];
    if (e == 4) { r.x = (d.x + (INV ? -d.y : d.y)) * c; r.y = (d.y - (INV ? -d.x : d.x)) * c; return r; }
    r.x = d.x * c + d.y * s; r.y = d.y * c - d.x * s; return r;
}
template <int R, bool INV> struct DFT {
    static __device__ __forceinline__ void run(f32x2_t (&x)[R]) {
        f32x2_t u[R / 2], v[R / 2];
#pragma unroll
        for (int k = 0; k < R / 2; ++k) { const f32x2_t p = x[k], q = x[k + R / 2]; u[k] = p + q; v[k] = twc<INV>(p - q, k * (32 / R)); }
        DFT<R / 2, INV>::run(u); DFT<R / 2, INV>::run(v);
#pragma unroll
        for (int q = 0; q < R / 2; ++q) { x[2 * q] = u[q]; x[2 * q + 1] = v[q]; }
    }
};
template <bool INV> struct DFT<1, INV> { static __device__ __forceinline__ void run(f32x2_t (&)[1]) {} };

typedef f16x2_t c16;
__device__ __forceinline__ c16 c16_from(f32x2_t v) { c16 r; r.x = (_Float16)v.x; r.y = (_Float16)v.y; return r; }
__device__ __forceinline__ c16 cmul16(c16 a, c16 w) { c16 wx; wx.x = w.x; wx.y = w.x; c16 wy; wy.x = w.y; wy.y = w.y; c16 at; at.x = -a.y; at.y = a.x; return a * wx + at * wy; }
__device__ __forceinline__ c16 cmulc16(c16 a, c16 w) { c16 wx; wx.x = w.x; wx.y = w.x; c16 wy; wy.x = w.y; wy.y = w.y; c16 at; at.x = a.y; at.y = -a.x; return a * wx + at * wy; }
template <bool INV> __device__ __forceinline__ c16 twc(c16 d, int e) {
    constexpr float CT[16] = {1.000000000e+00f, 9.807852804e-01f, 9.238795325e-01f, 8.314696123e-01f, 7.071067812e-01f, 5.555702330e-01f, 3.826834324e-01f, 1.950903220e-01f, 6.123233996e-17f, -1.950903220e-01f, -3.826834324e-01f, -5.555702330e-01f, -7.071067812e-01f, -8.314696123e-01f, -9.238795325e-01f, -9.807852804e-01f};
    constexpr float ST[16] = {0.000000000e+00f, 1.950903220e-01f, 3.826834324e-01f, 5.555702330e-01f, 7.071067812e-01f, 8.314696123e-01f, 9.238795325e-01f, 9.807852804e-01f, 1.000000000e+00f, 9.807852804e-01f, 9.238795325e-01f, 8.314696123e-01f, 7.071067812e-01f, 5.555702330e-01f, 3.826834324e-01f, 1.950903220e-01f};
    c16 r;
    if (e == 0) return d;
    if (e == 8) { if (INV) { r.x = -d.y; r.y = d.x; } else { r.x = d.y; r.y = -d.x; } return r; }
    const _Float16 c = (_Float16)CT[e], s = (_Float16)(INV ? -ST[e] : ST[e]);
    c16 cc; cc.x = c; cc.y = c; c16 ss; ss.x = s; ss.y = s; c16 dt; dt.x = d.y; dt.y = -d.x;
    return d * cc + dt * ss;
}
template <int R, bool INV> struct DFTH {
    static __device__ __forceinline__ void run(c16 (&x)[R]) {
        c16 u[R / 2], v[R / 2];
#pragma unroll
        for (int k = 0; k < R / 2; ++k) { const c16 p = x[k], q = x[k + R / 2]; u[k] = p + q; v[k] = twc<INV>(p - q, k * (32 / R)); }
        DFTH<R / 2, INV>::run(u); DFTH<R / 2, INV>::run(v);
#pragma unroll
        for (int q = 0; q < R / 2; ++q) { x[2 * q] = u[q]; x[2 * q + 1] = v[q]; }
    }
};
template <bool INV> struct DFTH<1, INV> { static __device__ __forceinline__ void run(c16 (&)[1]) {} };
template <bool CONJ, int STRIDE> __device__ __forceinline__ void tw_apply16h(c16 (&x)[16], const LAS c16* T) {
#pragma unroll
    for (int q = 1; q < 16; ++q) { const c16 wh = T[q * STRIDE]; x[q] = CONJ ? cmulc16(x[q], wh) : cmul16(x[q], wh); }
}
#define SWZ(p) ((p) + ((p) >> 5))
constexpr int FBUF = 8448;
template <bool CONJ> __device__ __forceinline__ void tw_apply16(f32x2_t (&x)[16], f32x2_t w1) {
    f32x2_t w = w1;
#pragma unroll
    for (int q = 1; q < 16; ++q) { x[q] = CONJ ? cmulc(x[q], w) : cmul(x[q], w); if (q < 15) w = cmul(w, w1); }
}
constexpr int LT_P1 = 67584, LT_P2 = LT_P1 + 32768, LT_WN = LT_P2 + 2048;
static_assert(LT_WN + 8448 * 4 <= RING_BYTES, "fft tables");
__device__ __forceinline__ void fft_tables_init(LAS unsigned char* L, int tid) {
    LAS c16* P1 = (LAS c16*)(L + LT_P1); LAS c16* P2 = (LAS c16*)(L + LT_P2); LAS c16* WN = (LAS c16*)(L + LT_WN);
#pragma unroll 4
    for (int q = 0; q < 16; ++q) { float s, c; sincospif((float)(tid * q) * (1.0f / 4096.0f), &s, &c); c16 w; w.x = (_Float16)c; w.y = (_Float16)(-s); P1[q * 512 + tid] = w; }
    { const int q = tid >> 5, j = tid & 31; float s, c; sincospif((float)(j * q) * (1.0f / 256.0f), &s, &c); c16 w; w.x = (_Float16)c; w.y = (_Float16)(-s); P2[q * 32 + j] = w; }
#pragma unroll 4
    for (int i = 0; i < 16; ++i) { const int n = 16 * tid + i; float s, c; sincospif((float)n * (1.0f / 8192.0f), &s, &c); c16 w; w.x = (_Float16)c; w.y = (_Float16)(-s); WN[n + (n >> 5)] = w; }
    __syncthreads();
}
#define OPAQUE(v) asm volatile("" : "+v"(v))
__device__ __forceinline__ void fwd_pass1(LAS f32x2_t* buf, const LAS f32x2_t* TW, int tid) {
    OPAQUE(tid);
    LAS f32x2_t* b0 = buf + tid + (tid >> 5);
    f32x2_t x[16];
#pragma unroll
    for (int m = 0; m < 16; ++m) x[m] = b0[528 * m];
    DFT<16, false>::run(x); tw_apply16<false>(x, TW[tid]);
#pragma unroll
    for (int q = 0; q < 16; ++q) b0[528 * q] = x[q];
}
__device__ __forceinline__ void fwd_pass2(LAS f32x2_t* buf, const LAS f32x2_t* TW, int tid) {
    OPAQUE(tid);
    LAS f32x2_t* b0 = buf + (tid >> 5) * 528 + (tid & 31);
    f32x2_t x[16];
#pragma unroll
    for (int m = 0; m < 16; ++m) x[m] = b0[33 * m];
    DFT<16, false>::run(x); tw_apply16<false>(x, TW[16 * (tid & 31)]);
#pragma unroll
    for (int q = 0; q < 16; ++q) b0[33 * q] = x[q];
}
__device__ __forceinline__ void inv_pass2(LAS f32x2_t* buf, const LAS f32x2_t* TW, int tid) {
    OPAQUE(tid);
    LAS f32x2_t* b0 = buf + (tid >> 5) * 528 + (tid & 31);
    f32x2_t x[16];
#pragma unroll
    for (int q = 0; q < 16; ++q) x[q] = b0[33 * q];
    tw_apply16<true>(x, TW[16 * (tid & 31)]); DFT<16, true>::run(x);
#pragma unroll
    for (int m = 0; m < 16; ++m) b0[33 * m] = x[m];
}
__device__ __forceinline__ void inv_pass1(LAS f32x2_t* buf, const LAS f32x2_t* TW, int tid) {
    OPAQUE(tid);
    LAS f32x2_t* b0 = buf + tid + (tid >> 5);
    f32x2_t x[16];
#pragma unroll
    for (int q = 0; q < 16; ++q) x[q] = b0[528 * q];
    tw_apply16<true>(x, TW[tid]); DFT<16, true>::run(x);
#pragma unroll
    for (int m = 0; m < 16; ++m) b0[528 * m] = x[m];
}
__device__ __forceinline__ void fft2_forward(LAS unsigned char* L) {
    const int tid = threadIdx.x;
    LAS f32x2_t* bufE = (LAS f32x2_t*)L; LAS f32x2_t* bufO = bufE + FBUF; const LAS f32x2_t* TW = (const LAS f32x2_t*)(L + LC_TW);
    fwd_pass1(bufE, TW, tid); fwd_pass1(bufO, TW, tid);
    __syncthreads();
    fwd_pass2(bufE, TW, tid); fwd_pass2(bufO, TW, tid);
    __syncthreads();
}
template <int MODE>
__device__ __forceinline__ void fft2_middle(LAS unsigned char* L, unsigned* specblk) {
    int tid = threadIdx.x; OPAQUE(tid); const int bsel = tid >> 8, blk = tid & 255;
    LAS f32x2_t* buf = (LAS f32x2_t*)L + (bsel ? FBUF : 0);
    f32x2_t x[32];
    LAS f32x2_t* bm = buf + 33 * blk;
#pragma unroll
    for (int q = 0; q < 32; ++q) x[q] = bm[q];
    DFT<32, false>::run(x);
    unsigned* sp = specblk + (size_t)bsel * 8192 + 32 * blk;
    if (MODE == 0) {
#pragma unroll
        for (int q = 0; q < 32; q += 4) { v4u w;
            { f16x2_t h; h.x = (_Float16)(16.0f * x[q].x); h.y = (_Float16)(16.0f * x[q].y); w.x = __builtin_bit_cast(unsigned, h); }
            { f16x2_t h; h.x = (_Float16)(16.0f * x[q + 1].x); h.y = (_Float16)(16.0f * x[q + 1].y); w.y = __builtin_bit_cast(unsigned, h); }
            { f16x2_t h; h.x = (_Float16)(16.0f * x[q + 2].x); h.y = (_Float16)(16.0f * x[q + 2].y); w.z = __builtin_bit_cast(unsigned, h); }
            { f16x2_t h; h.x = (_Float16)(16.0f * x[q + 3].x); h.y = (_Float16)(16.0f * x[q + 3].y); w.w = __builtin_bit_cast(unsigned, h); }
            *(v4u*)(sp + q) = w; }
    } else {
#pragma unroll
        for (int q = 0; q < 32; q += 4) { const v4u w = *(const v4u*)(sp + q);
            const unsigned w0 = w.x, w1 = w.y, w2 = w.z, w3 = w.w;
            x[q] = cmul(x[q], h2_to_f2(w0)); x[q + 1] = cmul(x[q + 1], h2_to_f2(w1)); x[q + 2] = cmul(x[q + 2], h2_to_f2(w2)); x[q + 3] = cmul(x[q + 3], h2_to_f2(w3)); }
        DFT<32, true>::run(x);
#pragma unroll
        for (int q = 0; q < 32; ++q) bm[q] = x[q];
    }
    __syncthreads();
}
__device__ __forceinline__ void fft2_inverse(LAS unsigned char* L) {
    const int tid = threadIdx.x;
    LAS f32x2_t* bufE = (LAS f32x2_t*)L; LAS f32x2_t* bufO = bufE + FBUF; const LAS f32x2_t* TW = (const LAS f32x2_t*)(L + LC_TW);
    inv_pass2(bufE, TW, tid); inv_pass2(bufO, TW, tid);
    __syncthreads();
    inv_pass1(bufE, TW, tid); inv_pass1(bufO, TW, tid);
}

__device__ __forceinline__ void fwd_pass1h(LAS c16* buf, const LAS c16* TW, int tid) {
    OPAQUE(tid);
    LAS c16* b0 = buf + tid + (tid >> 5);
    c16 x[16];
#pragma unroll
    for (int m = 0; m < 16; ++m) x[m] = b0[528 * m];
    DFTH<16, false>::run(x); tw_apply16h<false, 512>(x, TW + tid);
#pragma unroll
    for (int q = 0; q < 16; ++q) b0[528 * q] = x[q];
}
__device__ __forceinline__ void fwd_pass2h(LAS c16* buf, const LAS c16* TW, int tid) {
    OPAQUE(tid);
    LAS c16* b0 = buf + (tid >> 5) * 528 + (tid & 31);
    c16 x[16];
#pragma unroll
    for (int m = 0; m < 16; ++m) x[m] = b0[33 * m];
    DFTH<16, false>::run(x); tw_apply16h<false, 32>(x, TW + (tid & 31));
#pragma unroll
    for (int q = 0; q < 16; ++q) b0[33 * q] = x[q];
}
__device__ __forceinline__ void inv_pass2h(LAS c16* buf, const LAS c16* TW, int tid) {
    OPAQUE(tid);
    LAS c16* b0 = buf + (tid >> 5) * 528 + (tid & 31);
    c16 x[16];
#pragma unroll
    for (int q = 0; q < 16; ++q) x[q] = b0[33 * q];
    tw_apply16h<true, 32>(x, TW + (tid & 31)); DFTH<16, true>::run(x);
    c16 sc; sc.x = (_Float16)0.0625f; sc.y = (_Float16)0.0625f;
#pragma unroll
    for (int m = 0; m < 16; ++m) b0[33 * m] = x[m] * sc;
}
__device__ __forceinline__ void inv_pass1h(LAS c16* buf, const LAS c16* TW, int tid) {
    OPAQUE(tid);
    LAS c16* b0 = buf + tid + (tid >> 5);
    c16 x[16];
#pragma unroll
    for (int q = 0; q < 16; ++q) x[q] = b0[528 * q];
    tw_apply16h<true, 512>(x, TW + tid); DFTH<16, true>::run(x);
#pragma unroll
    for (int m = 0; m < 16; ++m) b0[528 * m] = x[m];
}
__device__ __forceinline__ void fft2h_forward(LAS unsigned char* L) {
    const int tid = threadIdx.x;
    LAS c16* bufE = (LAS c16*)L; LAS c16* bufO = bufE + FBUF; const LAS c16* P1 = (const LAS c16*)(L + LT_P1); const LAS c16* P2 = (const LAS c16*)(L + LT_P2);
    fwd_pass1h(bufE, P1, tid); fwd_pass1h(bufO, P1, tid);
    __syncthreads();
    fwd_pass2h(bufE, P2, tid); fwd_pass2h(bufO, P2, tid);
    __syncthreads();
}
__device__ __forceinline__ void fft2h_middle(LAS unsigned char* L, const unsigned* specblk) {
    int tid = threadIdx.x; OPAQUE(tid); const int bsel = tid >> 8, blk = tid & 255;
    LAS c16* bm = (LAS c16*)L + (bsel ? FBUF : 0) + 33 * blk;
    c16 x[32];
#pragma unroll
    for (int q = 0; q < 32; ++q) x[q] = bm[q];
    DFTH<32, false>::run(x);
    const unsigned* sp = specblk + (size_t)bsel * 8192 + 32 * blk;
#pragma unroll
    for (int q = 0; q < 32; q += 4) { const v4u w = *(const v4u*)(sp + q);
        const unsigned w0 = w.x, w1 = w.y, w2 = w.z, w3 = w.w;
        x[q] = cmul16(x[q], __builtin_bit_cast(c16, w0)); x[q + 1] = cmul16(x[q + 1], __builtin_bit_cast(c16, w1));
        x[q + 2] = cmul16(x[q + 2], __builtin_bit_cast(c16, w2)); x[q + 3] = cmul16(x[q + 3], __builtin_bit_cast(c16, w3)); }
    DFTH<32, true>::run(x);
    c16 sc; sc.x = (_Float16)0.0625f; sc.y = (_Float16)0.0625f;
#pragma unroll
    for (int q = 0; q < 32; ++q) bm[q] = x[q] * sc;
    __syncthreads();
}

__device__ __forceinline__ void fft2h_middle_store(LAS unsigned char* L, unsigned* specblk) {
    int tid = threadIdx.x; OPAQUE(tid); const int bsel = tid >> 8, blk = tid & 255;
    LAS c16* bm = (LAS c16*)L + (bsel ? FBUF : 0) + 33 * blk;
    c16 x[32];
#pragma unroll
    for (int q = 0; q < 32; ++q) x[q] = bm[q];
    DFTH<32, false>::run(x);
    c16 sc; sc.x = (_Float16)(1.0f / 256.0f); sc.y = (_Float16)(1.0f / 256.0f);
    unsigned* sp = specblk + (size_t)bsel * 8192 + 32 * blk;
#pragma unroll
    for (int q = 0; q < 32; q += 4) { v4u w;
        { const c16 h = x[q] * sc; w.x = __builtin_bit_cast(unsigned, h); } { const c16 h = x[q + 1] * sc; w.y = __builtin_bit_cast(unsigned, h); }
        { const c16 h = x[q + 2] * sc; w.z = __builtin_bit_cast(unsigned, h); } { const c16 h = x[q + 3] * sc; w.w = __builtin_bit_cast(unsigned, h); }
        *(v4u*)(sp + q) = w; }
    __syncthreads();
}
__device__ __forceinline__ void fft2h_inverse(LAS unsigned char* L) {
    const int tid = threadIdx.x;
    LAS c16* bufE = (LAS c16*)L; LAS c16* bufO = bufE + FBUF; const LAS c16* P1 = (const LAS c16*)(L + LT_P1); const LAS c16* P2 = (const LAS c16*)(L + LT_P2);
    inv_pass2h(bufE, P2, tid); inv_pass2h(bufO, P2, tid);
    __syncthreads();
    inv_pass1h(bufE, P1, tid); inv_pass1h(bufO, P1, tid);
}
__device__ __forceinline__ f32x2_t wn16384(const LAS f32x2_t* TA, f32x2_t wb, int tid, int m) { return cmul(TA[(tid >> 6) + 8 * m], wb); }
__device__ __forceinline__ float hy_conv3(const bf16* row, float w0, float w1, float w2, float bias, int n) {
    const int nm = n > 0 ? n - 1 : 0, np = n < SEQ - 1 ? n + 1 : SEQ - 1;
    const float wl = n > 0 ? w0 : 0.f, wr = n < SEQ - 1 ? w2 : 0.f;
    return bias + w1 * bf2f(row[n]) + wl * bf2f(row[nm]) + wr * bf2f(row[np]);
}

__device__ __forceinline__ void load_conv16(const bf16* row, int n0, float w0, float w1, float w2, float bias, float (&out)[16]) {
    const v4u a = *(const v4u*)(row + n0), b = *(const v4u*)(row + n0 + 8);
    const int nl = n0 > 0 ? n0 - 1 : 0, nr = n0 + 16 < SEQ ? n0 + 16 : SEQ - 1;
    const float ul = n0 > 0 ? bf2f(row[nl]) : 0.f, ur = n0 + 16 < SEQ ? bf2f(row[nr]) : 0.f;
    const unsigned a0 = a.x, a1 = a.y, a2 = a.z, a3 = a.w, b0 = b.x, b1 = b.y, b2 = b.z, b3 = b.w;
    float u[18];
    u[0] = ul; u[17] = ur;
    u[1] = __uint_as_float(a0 << 16); u[2] = __uint_as_float(a0 & 0xffff0000u); u[3] = __uint_as_float(a1 << 16); u[4] = __uint_as_float(a1 & 0xffff0000u);
    u[5] = __uint_as_float(a2 << 16); u[6] = __uint_as_float(a2 & 0xffff0000u); u[7] = __uint_as_float(a3 << 16); u[8] = __uint_as_float(a3 & 0xffff0000u);
    u[9] = __uint_as_float(b0 << 16); u[10] = __uint_as_float(b0 & 0xffff0000u); u[11] = __uint_as_float(b1 << 16); u[12] = __uint_as_float(b1 & 0xffff0000u);
    u[13] = __uint_as_float(b2 << 16); u[14] = __uint_as_float(b2 & 0xffff0000u); u[15] = __uint_as_float(b3 << 16); u[16] = __uint_as_float(b3 & 0xffff0000u);
#pragma unroll
    for (int i = 0; i < 16; ++i) out[i] = bias + w0 * u[i] + w1 * u[i + 1] + w2 * u[i + 2];
}
__device__ __forceinline__ void load_f16x16(const _Float16* p, float (&out)[16]) {
    const v4u a = *(const v4u*)p, b = *(const v4u*)(p + 8);
    const unsigned w[8] = {a.x, a.y, a.z, a.w, b.x, b.y, b.z, b.w};
#pragma unroll
    for (int i = 0; i < 8; ++i) { const f32x2_t k = h2_to_f2(w[i]); out[2 * i] = k.x; out[2 * i + 1] = k.y; }
}
__device__ __forceinline__ void load_f32x16(const float* p, float (&out)[16]) {
#pragma unroll
    for (int i = 0; i < 4; ++i) { const float4 v = *(const float4*)(p + 4 * i); out[4 * i] = v.x; out[4 * i + 1] = v.y; out[4 * i + 2] = v.z; out[4 * i + 3] = v.w; }
}
__device__ __forceinline__ void filter_item(LAS unsigned char* L, const Args& a, int c, const _Float16* hT, unsigned* spec, int tid, int lane, int wave) {
    LAS f32x2_t* bufE = (LAS f32x2_t*)L; LAS f32x2_t* bufO = bufE + FBUF;
    LAS float* red = (LAS float*)(L + LC_RED); LAS float* sc = (LAS float*)L;
    const int n0 = 16 * tid;
#pragma unroll 1
    for (int o = 0; o < 2; ++o) {
        float hfv[16], hbv[16];
        load_f16x16(hT + (size_t)(o * 512 + c) * SEQ + n0, hfv);
        load_f16x16(hT + (size_t)(1024 + o * 512 + c) * SEQ + n0, hbv);
        float s = 0.f;
#pragma unroll
        for (int i = 0; i < 16; ++i) { s += fabsf(hfv[i]) + ((n0 + i) > 0 ? fabsf(hbv[i]) : 0.f); sc[n0 + i] = hbv[i]; }
        s = wave_sum(s);
        if (lane == 0) red[wave] = s;
        __syncthreads();
        float tot = 0.f;
#pragma unroll
        for (int i = 0; i < 8; ++i) tot += red[i];
        const float inv = 1.0f / (tot + EPS);
        float ev[16], dv[16];
#pragma unroll
        for (int i = 0; i < 16; ++i) { const int n = n0 + i; const float hbm = n > 0 ? sc[SEQ - n] : 0.f; ev[i] = (hfv[i] + hbm) * inv; dv[i] = (hfv[i] - hbm) * inv; }
        __syncthreads();
        { LAS c16* hE = (LAS c16*)L; LAS c16* hO = hE + FBUF; const LAS c16* WN = (const LAS c16*)(L + LT_WN); const int lb = 16 * tid + (tid >> 1);
#pragma unroll
          for (int i = 0; i < 16; ++i) { c16 xe; xe.x = (_Float16)(ev[i] * 4096.0f); xe.y = (_Float16)0.0f; const _Float16 dh = (_Float16)(dv[i] * 4096.0f); c16 dd; dd.x = dh; dd.y = dh;
              hE[lb + i] = xe; hO[lb + i] = WN[lb + i] * dd; } }
        __syncthreads();
        fft2h_forward(L);
        fft2h_middle_store(L, spec + (size_t)(o * 512 + c) * 16384);
    }
}
template <int O>
__device__ __forceinline__ void hyena_pass(LAS unsigned char* L, const Args& a, int c, int bp, const bf16* hyuT, unsigned* spec, int tid, float (&xa)[16], float (&xb)[16]) {
    LAS c16* bufE = (LAS c16*)L; LAS c16* bufO = bufE + FBUF; const LAS c16* WN = (const LAS c16*)(L + LT_WN);
    const float* cw = a.in[15]; const float* cb = a.in[16];
    const int n0 = 16 * tid;
    const int lb = 16 * tid + (tid >> 1);
#pragma unroll
    for (int i = 0; i < 16; ++i) { c16 x; x.x = (_Float16)(xa[i] * 0.0625f); x.y = (_Float16)(xb[i] * 0.0625f); bufE[lb + i] = x; bufO[lb + i] = cmul16(x, WN[lb + i]); }
    __syncthreads();
    fft2h_forward(L);
    fft2h_middle(L, spec + (size_t)(O * 512 + c) * 16384);
    fft2h_inverse(L);
    __syncthreads();
    const int grow = (O ? 1024 : 512) + c;
    const float w0 = cw[grow], w1 = cw[1536 + grow], w2 = cw[3072 + grow], bs = cb[grow];
    const float skip = a.in[24][O * 512 + c];
    const bf16* g0 = hyuT + (size_t)grow * NTOK + (size_t)(2 * bp) * SEQ; const bf16* g1 = g0 + SEQ;
    float ga[16], gb[16];
    load_conv16(g0, n0, w0, w1, w2, bs, ga); load_conv16(g1, n0, w0, w1, w2, bs, gb);
#pragma unroll
    for (int i = 0; i < 16; ++i) {
        const c16 he = bufE[lb + i], yo = cmulc16(bufO[lb + i], WN[lb + i]); f32x2_t y; y.x = ((float)he.x + (float)yo.x) * (1.0f / 64.0f); y.y = ((float)he.y + (float)yo.y) * (1.0f / 64.0f);
        xa[i] = ga[i] * (y.x + skip * xa[i]); xb[i] = gb[i] * (y.y + skip * xb[i]); }
    __syncthreads();
}
__device__ __forceinline__ void hyena_item(LAS unsigned char* L, const Args& a, int c, int bp, const bf16* hyuT, unsigned* spec, bf16* y_hyT, int tid) {
    const float* cw = a.in[15]; const float* cb = a.in[16];
    const size_t seq0 = (size_t)c * NTOK + (size_t)(2 * bp) * SEQ;
    const int n0 = 16 * tid;
    float xa[16], xb[16];
    load_conv16(hyuT + seq0, n0, cw[c], cw[1536 + c], cw[3072 + c], cb[c], xa); load_conv16(hyuT + seq0 + SEQ, n0, cw[c], cw[1536 + c], cw[3072 + c], cb[c], xb);
    hyena_pass<0>(L, a, c, bp, hyuT, spec, tid, xa, xb);
    hyena_pass<1>(L, a, c, bp, hyuT, spec, tid, xa, xb);
    bf16* o0 = y_hyT + seq0; bf16* o1 = o0 + SEQ;
    v4u p0, p1, q0, q1;
    p0.x = pk2(xa[0], xa[1]); p0.y = pk2(xa[2], xa[3]); p0.z = pk2(xa[4], xa[5]); p0.w = pk2(xa[6], xa[7]); p1.x = pk2(xa[8], xa[9]); p1.y = pk2(xa[10], xa[11]); p1.z = pk2(xa[12], xa[13]); p1.w = pk2(xa[14], xa[15]);
    q0.x = pk2(xb[0], xb[1]); q0.y = pk2(xb[2], xb[3]); q0.z = pk2(xb[4], xb[5]); q0.w = pk2(xb[6], xb[7]); q1.x = pk2(xb[8], xb[9]); q1.y = pk2(xb[10], xb[11]); q1.z = pk2(xb[12], xb[13]); q1.w = pk2(xb[14], xb[15]);
    *(v4u*)(o0 + n0) = p0; *(v4u*)(o0 + n0 + 8) = p1; *(v4u*)(o1 + n0) = q0; *(v4u*)(o1 + n0 + 8) = q1;
}

__global__ void __launch_bounds__(NWAVES * 64, 2) fwd(Args a) {
    extern __shared__ __attribute__((aligned(16))) unsigned char lds_raw[];
    LAS unsigned char* L = (LAS unsigned char*)lds_raw;
    volatile LAS unsigned* MISC = (volatile LAS unsigned*)(L + MISC_OFF);
    const int tid = threadIdx.x, lane = tid & 63, wave = __builtin_amdgcn_readfirstlane(tid >> 6);
    const int G = gridDim.x, bid = blockIdx.x;
    unsigned char* ws = a.ws;
    unsigned* ctl = (unsigned*)ws;
    for (int u = tid; u < (LDS_BYTES - LDSCTL_OFF) / 4; u += NWAVES * 64) ((LAS unsigned*)(L + LDSCTL_OFF))[u] = 0u;
    __syncthreads();
    const int lo = a.ph_lo, hi = a.ph_hi;
    XcdBarrier bar; bar.bar = ctl + CW_BAR + a.li * XCD_BAR_WORDS; bar.x = 0; bar.st = nullptr;
    bar = xcd_barrier_post(ctl + CW_BAR + a.li * XCD_BAR_WORDS, MISC + 8);
#define IN(k) (lo <= (k) && (k) < hi)
#define BOTH(k) (IN(k) && IN((k) + 1))
#ifndef DUP_BAR
#define DUP_BAR 1
#endif
#define GRID_BAR() do { xcd_barrier(bar); if (DUP_BAR > 1) xcd_barrier(bar); } while (0)

    bf16* WinT = (bf16*)(ws + WS_WINT); bf16* WoutT = (bf16*)(ws + WS_WOUTT);
    bf16* hn1 = (bf16*)(ws + WS_HN1); bf16* lru = (bf16*)(ws + WS_LRU); bf16* hyuT = (bf16*)(ws + WS_HYUT);
    bf16* y_cat = (bf16*)(ws + WS_YCAT);
    bf16* W13T = (bf16*)(ws + WS_W13T); bf16* W2T = (bf16*)(ws + WS_W2T); bf16* WrT = (bf16*)(ws + WS_WRT);
    bf16* hn2 = (bf16*)(ws + WS_HN2); bf16* xmidb = (bf16*)(ws + WS_XMID); int* list = (int*)(ws + WS_LIST); float* lgate = (float*)(ws + WS_LGATE); int4* tokinfo = (int4*)(ws + WS_TOKINFO);
    bf16* xs = (bf16*)(ws + WS_XS); (void)xs; bf16* Hb = (bf16*)(ws + WS_H); bf16* Yb = (bf16*)(ws + WS_Y);
    const int gw = bid * NWAVES + wave, NGW = G * NWAVES;

    if (IN(0)) {
#ifndef DUP_P0
#define DUP_P0 1
#endif
        for (int rep0 = 0; rep0 < DUP_P0; ++rep0) {
        LAS float* scr = (LAS float*)(L + wave * 16384);
        constexpr int I_IN = (DM / 64) * (DIN / 32), I_OUT = (DM / 64) * (DM / 32), I_EXP = 768;
        for (int it = gw; it < I_IN + I_OUT + 32 * I_EXP; it += NGW) {
            if (it < I_IN) { const int nblk = DIN / 32, kb = it / nblk, nb = it % nblk; p0_transpose_item(a.in[2], DM, DIN, WinT, 32 * nb, scr, 64 * kb, 32 * nb, lane); }
            else if (it < I_IN + I_OUT) { const int r = it - I_IN; const int nblk = DM / 32, kb = r / nblk, nb = r % nblk; p0_transpose_item(a.in[27], DM, DM, WoutT, 32 * nb, scr, 64 * kb, 32 * nb, lane); }
            else { const int r = it - I_IN - I_OUT, e = r / I_EXP, q = r % I_EXP;
                if (q < 512) { const int w3 = q >> 8, qq = q & 255, kb = qq >> 4, nb = qq & 15, n0 = 32 * nb;
                    p0_transpose_item(a.in[w3 ? 34 : 33] + (size_t)e * 1024 * 512, 1024, 512, W13T, e * 1024 + (n0 >> 7) * 256 + (n0 & 127) + w3 * 128, scr, 64 * kb, n0, lane); }
                else { const int qq = q - 512, kb = qq >> 5, nb = qq & 31;
                    p0_transpose_item(a.in[35] + (size_t)e * 512 * 1024, 512, 1024, W2T, e * 1024 + 32 * nb, scr, 64 * kb, 32 * nb, lane); } }
        }
        for (int idx = bid * (NWAVES * 64) + tid; idx < 48 * 1024; idx += G * NWAVES * 64) { const int j = idx >> 10, k = idx & 1023;
            WrT[idx] = j < 4 ? f2bf(a.in[29][k * 4 + j]) : (j < 36 ? f2bf(a.in[31][k * 32 + (j - 4)]) : (bf16)0); }
        { _Float16* hT = (_Float16*)(ws + WS_HT);
          const float* w1 = a.in[17]; const float* b1 = a.in[18]; const float* f1 = a.in[19]; const float* w2 = a.in[20]; const float* b2 = a.in[21]; const float* f2 = a.in[22]; const float* w3 = a.in[23];
          LAS float* w3s = (LAS float*)L;
          LAS float* z2s = (LAS float*)(L + 65536);
          LAS float* fts = (LAS float*)(L + 73728);
          LAS float* ot  = (LAS float*)(L + 81920);
          for (int tile = bid; tile < SEQ / 32; tile += G) {
              __syncthreads();
              { const int tl = tid & 31, i = tid >> 5; const int t = tile * 32 + tl;
                const float wq = (6.283185307179586f / (float)SEQ) * (float)t; const float band = 1e-4f + (float)i * ((15.0f - 1e-4f) / 15.0f);
                fts[(1 + i) * 32 + tl] = cosf(wq * band); fts[(17 + i) * 32 + tl] = sinf(wq * band);
                if (i == 0) fts[tl] = (float)t / (float)(SEQ - 1); }
              __syncthreads();
              const int tl4 = tid & 31, jq = tid >> 5;
              { float s0 = b1[4 * jq], s1 = b1[4 * jq + 1], s2 = b1[4 * jq + 2], s3 = b1[4 * jq + 3];
#pragma unroll 3
                for (int i = 0; i < 33; ++i) { const float fv = fts[i * 32 + tl4]; const float4 wv = *(const float4*)(w1 + i * 64 + 4 * jq); s0 += fv * wv.x; s1 += fv * wv.y; s2 += fv * wv.z; s3 += fv * wv.w; }
                const float4 fq = *(const float4*)(f1 + 4 * jq);
                s0 = sinf(fq.x * s0); s1 = sinf(fq.y * s1); s2 = sinf(fq.z * s2); s3 = sinf(fq.w * s3);
                __syncthreads();
                fts[(4 * jq) * 32 + tl4] = s0; fts[(4 * jq + 1) * 32 + tl4] = s1; fts[(4 * jq + 2) * 32 + tl4] = s2; fts[(4 * jq + 3) * 32 + tl4] = s3; }
              __syncthreads();
              { float s0 = b2[4 * jq], s1 = b2[4 * jq + 1], s2 = b2[4 * jq + 2], s3 = b2[4 * jq + 3];
#pragma unroll 4
                for (int i = 0; i < 64; ++i) { const float zv = fts[i * 32 + tl4]; const float4 wv = *(const float4*)(w2 + i * 64 + 4 * jq); s0 += zv * wv.x; s1 += zv * wv.y; s2 += zv * wv.z; s3 += zv * wv.w; }
                const float4 fq = *(const float4*)(f2 + 4 * jq);
                z2s[(4 * jq) * 32 + tl4] = sinf(fq.x * s0); z2s[(4 * jq + 1) * 32 + tl4] = sinf(fq.y * s1); z2s[(4 * jq + 2) * 32 + tl4] = sinf(fq.z * s2); z2s[(4 * jq + 3) * 32 + tl4] = sinf(fq.w * s3); }
              __syncthreads();
              const float lo_ = logf(1e-2f) / 1.5f, hi_ = logf(1e-2f) / 0.3f;
              typedef float f32x16_t __attribute__((ext_vector_type(16)));
              bf16x8_t Az[4];
              { const int tr = lane & 31, kg2 = lane >> 5;
#pragma unroll
                for (int s = 0; s < 4; ++s) { v4u pk;
                    pk.x = pk2(z2s[(16 * s + 8 * kg2 + 0) * 32 + tr], z2s[(16 * s + 8 * kg2 + 1) * 32 + tr]); pk.y = pk2(z2s[(16 * s + 8 * kg2 + 2) * 32 + tr], z2s[(16 * s + 8 * kg2 + 3) * 32 + tr]);
                    pk.z = pk2(z2s[(16 * s + 8 * kg2 + 4) * 32 + tr], z2s[(16 * s + 8 * kg2 + 5) * 32 + tr]); pk.w = pk2(z2s[(16 * s + 8 * kg2 + 6) * 32 + tr], z2s[(16 * s + 8 * kg2 + 7) * 32 + tr]);
                    Az[s] = __builtin_bit_cast(bf16x8_t, pk); } }
              LAS unsigned char* wt = L;
              for (int chunk = 0; chunk < 8; ++chunk) {
                  __syncthreads();
#pragma unroll 4
                  for (int r = 0; r < 8; ++r) { const int q = tid + 512 * r; const int j = q >> 6, c4 = q & 63;
                      const f32x4_t wv = *(const f32x4_t*)(w3 + (size_t)j * 2048 + chunk * 256 + 4 * c4);
                      LAS bf16* d = (LAS bf16*)(wt + (4 * c4) * 144 + 2 * j);
                      d[0] = f2bf(wv.x); d[72] = f2bf(wv.y); d[144] = f2bf(wv.z); d[216] = f2bf(wv.w); }
                  __syncthreads();
                  { const int cl = wave * 32 + (lane & 31), kg2 = lane >> 5;
                    f32x16_t acc = {0.f, 0.f, 0.f, 0.f, 0.f, 0.f, 0.f, 0.f, 0.f, 0.f, 0.f, 0.f, 0.f, 0.f, 0.f, 0.f};
#pragma unroll
                    for (int s = 0; s < 4; ++s) { const bf16x8_t Bw = *(const LAS bf16x8_t*)(wt + cl * 144 + (16 * s + 8 * kg2) * 2);
                        acc = __builtin_amdgcn_mfma_f32_32x32x16_bf16(Az[s], Bw, acc, 0, 0, 0); }
                    const int col = chunk * 256 + cl; const int cc = col & 511;
                    const float delta = fabsf(lo_ + (float)cc * ((hi_ - lo_) / 511.0f));
#pragma unroll
                    for (int g4 = 0; g4 < 4; ++g4) { const int tl = 8 * g4 + 4 * kg2;
                        const int t0 = tile * 32 + tl;
                        f16x2_t h01, h23;
                        h01.x = (_Float16)(acc[4 * g4 + 0] * 64.0f * __expf(-((float)(t0 + 0) / (float)(SEQ - 1)) * delta)); h01.y = (_Float16)(acc[4 * g4 + 1] * 64.0f * __expf(-((float)(t0 + 1) / (float)(SEQ - 1)) * delta));
                        h23.x = (_Float16)(acc[4 * g4 + 2] * 64.0f * __expf(-((float)(t0 + 2) / (float)(SEQ - 1)) * delta)); h23.y = (_Float16)(acc[4 * g4 + 3] * 64.0f * __expf(-((float)(t0 + 3) / (float)(SEQ - 1)) * delta));
                        uint2 o; o.x = __builtin_bit_cast(unsigned, h01); o.y = __builtin_bit_cast(unsigned, h23);
                        *(uint2*)(hT + (size_t)col * SEQ + t0) = o; } }
              }
          } }
        __syncthreads();
        for (int m = gw; m < NTOK; m += NGW) rms_row_to_bf16(a.in[0] + (size_t)m * DM, a.in[1], hn1 + (size_t)m * DM, lane);
        }
        if (BOTH(0)) GRID_BAR();
    }
    if (IN(1)) {
#ifndef DUP_G1
#define DUP_G1 1
#endif
        { pg8::Gemm g{hn1, WinT, NTOK, 1024, DM}; pg8::StaticOrder S; S.init(NTOK, 1024, G, bid);
          pg8::EpiBf16<0> E{lru, 1024, nullptr, 0, 0, 1.f};
          pg8::gemm_phase<pg8::EpiBf16<0>, pg8::StaticOrder, true, true>(L, g, S, E); }
        { pg8::Gemm g{WinT + (size_t)1024 * DM, hn1, 1536, NTOK, DM}; pg8::StaticOrder S; S.init(1536, NTOK, G, bid);
          pg8::EpiBf16<0> E{hyuT, NTOK, nullptr, 0, 0, 1.f};
          pg8::gemm_phase<pg8::EpiBf16<0>, pg8::StaticOrder, true, true>(L, g, S, E); }
#if DUP_G1 > 1
        { pg8::Gemm g{hn1, WinT, NTOK, 1024, DM}; pg8::StaticOrder S; S.init(NTOK, 1024, G, bid);
          pg8::EpiBf16<0> E{lru, 1024, nullptr, 0, 0, 1.f};
          pg8::gemm_phase<pg8::EpiBf16<0>, pg8::StaticOrder, true, true>(L, g, S, E); }
        { pg8::Gemm g{WinT + (size_t)1024 * DM, hn1, 1536, NTOK, DM}; pg8::StaticOrder S; S.init(1536, NTOK, G, bid);
          pg8::EpiBf16<0> E{hyuT, NTOK, nullptr, 0, 0, 1.f};
          pg8::gemm_phase<pg8::EpiBf16<0>, pg8::StaticOrder, true, true>(L, g, S, E); }
#endif
        __syncthreads();
        fft_tables_init(L, tid);
#ifndef DUP_FILT
#define DUP_FILT 1
#endif
        for (int rep = 0; rep < DUP_FILT; ++rep)
        for (int c = bid; c < DH; c += G) filter_item(L, a, c, (const _Float16*)(ws + WS_HT), (unsigned*)(ws + WS_SPEC), tid, lane, wave);
        if (BOTH(1)) GRID_BAR();
    }

    if (IN(2)) {
        bf16* hf = (bf16*)(ws + WS_HF); bf16* hb = (bf16*)(ws + WS_HB);
#ifndef DUP_LRU
#define DUP_LRU 1
#endif
#ifndef DUP_HY
#define DUP_HY 1
#endif
        { bf16* xcb = (bf16*)(ws + WS_XCB); const float* cwp = a.in[3]; const float* cbp = a.in[4];
          for (int idx = bid * (NWAVES * 64) + tid; idx < NTOK * 64; idx += G * NWAVES * 64) {
              const int tok = idx >> 6, c8 = (idx & 63) * 8, t = tok & (SEQ - 1), bb = tok >> 13;
              float acc[8];
              { const float4 c0 = *(const float4*)(cbp + c8), c1 = *(const float4*)(cbp + c8 + 4); acc[0] = c0.x; acc[1] = c0.y; acc[2] = c0.z; acc[3] = c0.w; acc[4] = c1.x; acc[5] = c1.y; acc[6] = c1.z; acc[7] = c1.w; }
#pragma unroll
              for (int tap = 0; tap < 4; ++tap) { const int tt = t + tap - 2; const bool ok = tt >= 0 && tt < SEQ; const int tc = ok ? tt : t;
                  const v4u xv = *(const v4u*)(lru + (size_t)(bb * SEQ + tc) * 1024 + c8);
                  const float4 w0 = *(const float4*)(cwp + tap * DL + c8), w1 = *(const float4*)(cwp + tap * DL + c8 + 4);
                  const float m = ok ? 1.f : 0.f; const unsigned x0 = xv.x, x1 = xv.y, x2 = xv.z, x3 = xv.w;
                  acc[0] += m * w0.x * __uint_as_float(x0 << 16); acc[1] += m * w0.y * __uint_as_float(x0 & 0xffff0000u);
                  acc[2] += m * w0.z * __uint_as_float(x1 << 16); acc[3] += m * w0.w * __uint_as_float(x1 & 0xffff0000u);
                  acc[4] += m * w1.x * __uint_as_float(x2 << 16); acc[5] += m * w1.y * __uint_as_float(x2 & 0xffff0000u);
                  acc[6] += m * w1.z * __uint_as_float(x3 << 16); acc[7] += m * w1.w * __uint_as_float(x3 & 0xffff0000u); }
              v4u pk; pk.x = pk2(acc[0], acc[1]); pk.y = pk2(acc[2], acc[3]); pk.z = pk2(acc[4], acc[5]); pk.w = pk2(acc[6], acc[7]);
              const int hh = c8 >> 6, cl = c8 & 63;
              *(v4u*)(xcb + (((size_t)(bb * 8 + hh) * SEQ + t) * 64 + cl)) = pk; } }
        GRID_BAR();
        for (int rep = 0; rep < DUP_LRU; ++rep)
        for (int item = bid; item < 256; item += G) lru_item(L, a, item, (const bf16*)(ws + WS_XCB), hf, hb, tid, lane, wave);
        __syncthreads();
        fft_tables_init(L, tid);
        for (int rep = 0; rep < DUP_HY; ++rep)
        for (int item = bid; item < 2 * DH; item += G) hyena_item(L, a, item >> 1, item & 1, hyuT, (unsigned*)(ws + WS_SPEC), (bf16*)(ws + WS_YHYT), tid);
        if (BOTH(2)) GRID_BAR();
    }

    if (IN(3)) {
        const bf16* hf = (const bf16*)(ws + WS_HF); const bf16* hb = (const bf16*)(ws + WS_HB); const bf16* y_hyT = (const bf16*)(ws + WS_YHYT);
        const float* gA = a.in[25]; const float* gB = a.in[26];
#ifndef DUP_P3
#define DUP_P3 1
#endif
        for (int rep3 = 0; rep3 < DUP_P3; ++rep3) {
        for (int tok = gw; tok < NTOK; tok += NGW) {
            const v4u vf = *(const v4u*)(hf + (size_t)tok * DL + 8 * lane), vb = *(const v4u*)(hb + (size_t)tok * DL + 8 * lane), vg = *(const v4u*)(lru + (size_t)tok * 1024 + 512 + 8 * lane);
            const unsigned f0 = vf.x, f1 = vf.y, f2 = vf.z, f3 = vf.w, b0 = vb.x, b1 = vb.y, b2 = vb.z, b3 = vb.w, g0 = vg.x, g1 = vg.y, g2 = vg.z, g3 = vg.w;
            float y[8];
            y[0] = (__uint_as_float(f0 << 16) + __uint_as_float(b0 << 16)) * gelu_tanh(__uint_as_float(g0 << 16));
            y[1] = (__uint_as_float(f0 & 0xffff0000u) + __uint_as_float(b0 & 0xffff0000u)) * gelu_tanh(__uint_as_float(g0 & 0xffff0000u));
            y[2] = (__uint_as_float(f1 << 16) + __uint_as_float(b1 << 16)) * gelu_tanh(__uint_as_float(g1 << 16));
            y[3] = (__uint_as_float(f1 & 0xffff0000u) + __uint_as_float(b1 & 0xffff0000u)) * gelu_tanh(__uint_as_float(g1 & 0xffff0000u));
            y[4] = (__uint_as_float(f2 << 16) + __uint_as_float(b2 << 16)) * gelu_tanh(__uint_as_float(g2 << 16));
            y[5] = (__uint_as_float(f2 & 0xffff0000u) + __uint_as_float(b2 & 0xffff0000u)) * gelu_tanh(__uint_as_float(g2 & 0xffff0000u));
            y[6] = (__uint_as_float(f3 << 16) + __uint_as_float(b3 << 16)) * gelu_tanh(__uint_as_float(g3 << 16));
            y[7] = (__uint_as_float(f3 & 0xffff0000u) + __uint_as_float(b3 & 0xffff0000u)) * gelu_tanh(__uint_as_float(g3 & 0xffff0000u));
            float s = 0.f;
#pragma unroll
            for (int i = 0; i < 8; ++i) s += y[i] * y[i];
            s = wave_sum(s);
            const float rstd = rsqrtf(s * (1.0f / DL) + EPS);
            const float4 ga0 = *(const float4*)(gA + 8 * lane), ga1 = *(const float4*)(gA + 8 * lane + 4);
            v4u o; o.x = pk2(y[0] * rstd * ga0.x, y[1] * rstd * ga0.y); o.y = pk2(y[2] * rstd * ga0.z, y[3] * rstd * ga0.w);
            o.z = pk2(y[4] * rstd * ga1.x, y[5] * rstd * ga1.y); o.w = pk2(y[6] * rstd * ga1.z, y[7] * rstd * ga1.w);
            *(v4u*)(y_cat + (size_t)tok * 1024 + 8 * lane) = o;
        }
        for (int tile = bid; tile < NTOK / 64; tile += G) {
            __syncthreads();
            const int tok0 = tile * 64;
            for (int ch = tid; ch < 512 * 8; ch += NWAVES * 64) { const int c = ch >> 3, piece = ch & 7;
                const v4u v = *(const v4u*)(y_hyT + (size_t)c * NTOK + tok0 + 8 * piece);
                LAS unsigned* d = (LAS unsigned*)(L + c * 132 + piece * 16); d[0] = v.x; d[1] = v.y; d[2] = v.z; d[3] = v.w; }
            __syncthreads();
            for (int tl = wave; tl < 64; tl += NWAVES) {
                float v[8]; float s = 0.f;
#pragma unroll
                for (int i = 0; i < 4; ++i) { const int c = 2 * lane + 128 * i;
                    v[2 * i] = bf2f(*(const LAS bf16*)(L + c * 132 + tl * 2)); v[2 * i + 1] = bf2f(*(const LAS bf16*)(L + (c + 1) * 132 + tl * 2));
                    s += v[2 * i] * v[2 * i] + v[2 * i + 1] * v[2 * i + 1]; }
                s = wave_sum(s);
                const float rstd = rsqrtf(s * (1.0f / DH) + EPS);
#pragma unroll
                for (int i = 0; i < 4; ++i) { const int c = 2 * lane + 128 * i;
                    *(unsigned*)(y_cat + (size_t)(tok0 + tl) * 1024 + 512 + c) = pk2(v[2 * i] * rstd * gB[c], v[2 * i + 1] * rstd * gB[c + 1]); }
            }
        }
        }
        if (BOTH(3)) GRID_BAR();
    }
    if (IN(4)) {
        pg8::Gemm g{y_cat, WoutT, NTOK, DM, DM}; pg8::StaticOrder S; S.init(NTOK, DM, G, bid);
        pg8::EpiResBf16 E{a.in[0], xmidb, DM};
        pg8::gemm_phase<pg8::EpiResBf16, pg8::StaticOrder, true, true>(L, g, S, E);
        if (BOTH(4)) GRID_BAR();
    }

#ifndef DUP_P5
#define DUP_P5 1
#endif
    for (int rep5 = 0; rep5 < DUP_P5; ++rep5)
    if (IN(5)) {
        const bool dummy = (rep5 + 1 < DUP_P5);
        unsigned* cntg = ctl + (dummy ? 3072 : CW_CNT);
        int* list_ = dummy ? (int*)(ws + 376 * MiB) : list; float* lgate_ = dummy ? (float*)(ws + 380 * MiB) : lgate; int4* tokinfo_ = dummy ? (int4*)(ws + 384 * MiB) : tokinfo;
        bf16* hn2_ = dummy ? (bf16*)(ws + 232 * MiB) : hn2;
        LAS float* lg = (LAS float*)(L + 98304);
        LAS int* cnt_l = (LAS int*)(L + LC_CNT); LAS int* base_l = (LAS int*)(L + LC_BASE);
        const float* gff = a.in[28];
        for (int tile = bid; tile < NTOK / 128; tile += G) {
            __syncthreads();
            for (int ch = tid; ch < 48 * 128; ch += NWAVES * 64) { const int row = ch >> 7, c16 = ch & 127;
                *(LAS v4u*)(L + row * 2048 + ((c16 ^ (row & 15)) << 4)) = *(const v4u*)(WrT + (size_t)row * 1024 + c16 * 8); }
            if (tid < 32) cnt_l[tid] = 0;
            __syncthreads();
            const int tk = lane & 15, kg = lane >> 4;
            const int tokw = tile * 128 + wave * 16 + tk;
            const bf16* xr = xmidb + (size_t)tokw * DM + 8 * kg;
            float s = 0.f;
#pragma unroll 8
            for (int st = 0; st < 32; ++st) { const v4u w = *(const v4u*)(xr + 32 * st); const unsigned w0 = w.x, w1 = w.y, w2 = w.z, w3 = w.w;
                const float e0 = __uint_as_float(w0 << 16), e1 = __uint_as_float(w0 & 0xffff0000u), e2 = __uint_as_float(w1 << 16), e3 = __uint_as_float(w1 & 0xffff0000u);
                const float e4 = __uint_as_float(w2 << 16), e5 = __uint_as_float(w2 & 0xffff0000u), e6 = __uint_as_float(w3 << 16), e7 = __uint_as_float(w3 & 0xffff0000u);
                s += (e0 * e0 + e1 * e1) + (e2 * e2 + e3 * e3) + (e4 * e4 + e5 * e5) + (e6 * e6 + e7 * e7); }
            s += __shfl_xor(s, 16); s += __shfl_xor(s, 32);
            const float rstd = rsqrtf(s * (1.0f / DM) + EPS);
            f32x4_t acc0 = {0.f, 0.f, 0.f, 0.f}, acc1 = acc0, acc2 = acc0;
            bf16* hrow = hn2_ + (size_t)tokw * DM + 8 * kg;
#pragma unroll 4
            for (int st = 0; st < 32; ++st) {
                const v4u xw = *(const v4u*)(xr + 32 * st); const unsigned x0 = xw.x, x1 = xw.y, x2 = xw.z, x3 = xw.w;
                const float4 g0 = *(const float4*)(gff + 32 * st + 8 * kg), g1 = *(const float4*)(gff + 32 * st + 8 * kg + 4);
                v4u w; w.x = pk2(__uint_as_float(x0 << 16) * rstd * g0.x, __uint_as_float(x0 & 0xffff0000u) * rstd * g0.y); w.y = pk2(__uint_as_float(x1 << 16) * rstd * g0.z, __uint_as_float(x1 & 0xffff0000u) * rstd * g0.w);
                w.z = pk2(__uint_as_float(x2 << 16) * rstd * g1.x, __uint_as_float(x2 & 0xffff0000u) * rstd * g1.y); w.w = pk2(__uint_as_float(x3 << 16) * rstd * g1.z, __uint_as_float(x3 & 0xffff0000u) * rstd * g1.w);
                *(v4u*)(hrow + 32 * st) = w;
                const bf16x8_t B = __builtin_bit_cast(bf16x8_t, w);
                const int chs = ((4 * st + kg) ^ tk) << 4;
                const bf16x8_t A0 = *(const LAS bf16x8_t*)(L + (0 + tk) * 2048 + chs), A1 = *(const LAS bf16x8_t*)(L + (16 + tk) * 2048 + chs), A2 = *(const LAS bf16x8_t*)(L + (32 + tk) * 2048 + chs);
                acc0 = __builtin_amdgcn_mfma_f32_16x16x32_bf16(A0, B, acc0, 0, 0, 0);
                acc1 = __builtin_amdgcn_mfma_f32_16x16x32_bf16(A1, B, acc1, 0, 0, 0);
                acc2 = __builtin_amdgcn_mfma_f32_16x16x32_bf16(A2, B, acc2, 0, 0, 0);
            }
            { LAS float* lr = lg + (wave * 16 + tk) * 49 + 4 * kg;
#pragma unroll
              for (int r = 0; r < 4; ++r) { lr[r] = acc0[r]; lr[16 + r] = acc1[r]; lr[32 + r] = acc2[r]; } }
            __syncthreads();
            int e0 = 0, e1 = 0, r0l = 0, r1l = 0; float g0 = 0.f, g1 = 0.f;
            if (tid < 128) {
                const LAS float* lr = lg + tid * 49; const float* bgp = a.in[30]; const float* bep = a.in[32];
                int gi = 0; float gm = lr[0] + bgp[0];
                for (int i = 1; i < 4; ++i) { const float v = lr[i] + bgp[i]; if (v > gm) { gm = v; gi = i; } }
                float gs = 0.f; for (int i = 0; i < 4; ++i) gs += __expf(lr[i] + bgp[i] - gm);
                const float gp = 1.0f / gs;
                const LAS float* le = lr + 4 + gi * 8; const float* beg = bep + gi * 8;
                int i1 = 0; float m1 = le[0] + beg[0];
                for (int i = 1; i < 8; ++i) { const float v = le[i] + beg[i]; if (v > m1) { m1 = v; i1 = i; } }
                int i2 = -1; float m2 = -3.0e38f;
                for (int i = 0; i < 8; ++i) { const float v = le[i] + beg[i]; if (i != i1 && v > m2) { m2 = v; i2 = i; } }
                const float ex2 = __expf(m2 - m1);
                e0 = gi * 8 + i1; e1 = gi * 8 + i2; g0 = gp / (1.0f + ex2); g1 = gp * ex2 / (1.0f + ex2);
                r0l = atomicAdd((int*)(cnt_l + e0), 1); r1l = atomicAdd((int*)(cnt_l + e1), 1);
            }
            __syncthreads();
            if (tid < 32) { const int c = cnt_l[tid]; base_l[tid] = c ? (int)atomicAdd(cntg + tid, (unsigned)c) : 0; }
            __syncthreads();
            if (tid < 128) { const int tok = tile * 128 + tid; const int r0 = base_l[e0] + r0l, r1 = base_l[e1] + r1l;
                list_[e0 * NTOK + r0] = tok; lgate_[e0 * NTOK + r0] = g0; list_[e1 * NTOK + r1] = tok; lgate_[e1 * NTOK + r1] = g1;
                tokinfo_[tok] = make_int4(e0, r0, e1, r1); }
        }
        if (BOTH(5) && !dummy) GRID_BAR();
    }
    if (IN(7)) {
        const int T = moe_tables(L, ctl, tid);
        pg8::Gemm g{hn2, W13T, T * 256, 1024, DM};
        pg8::MoeOrder S{(const LAS int*)(L + LC_TILEE), T, 4, G, bid, (size_t)1024 * 1024 * 2, (const LAS int*)(L + LC_TSTART), (const LAS int*)(L + LC_CNT), list, NTOK, true};
        pg8::EpiSwiGLU E{Hb};
        pg8::gemm_phase<pg8::EpiSwiGLU, pg8::MoeOrder, true, true, true>(L, g, S, E);
        if (BOTH(7)) GRID_BAR();
    }
    if (IN(8)) {
        const int T = moe_tables(L, ctl, tid);
        pg8::Gemm g{Hb, W2T, T * 256, 1024, 512};
        pg8::MoeOrder S{(const LAS int*)(L + LC_TILEE), T, 4, G, bid, (size_t)1024 * 512 * 2, (const LAS int*)(L + LC_TSTART), (const LAS int*)(L + LC_CNT), list, NTOK, false};
        pg8::EpiRowScaleBf16 E{Yb, 1024, lgate, (const LAS int*)(L + LC_TILEE), (const LAS int*)(L + LC_TSTART), (const LAS int*)(L + LC_CNT), NTOK};
        pg8::gemm_phase<pg8::EpiRowScaleBf16, pg8::MoeOrder, true, true, false>(L, g, S, E);
        if (BOTH(8)) GRID_BAR();
    }
#ifndef DUP_P9
#define DUP_P9 1
#endif
    for (int rep9 = 0; rep9 < DUP_P9; ++rep9)
    if (IN(9)) {
        float* outw = (rep9 + 1 < DUP_P9) ? (float*)(ws + 256 * MiB) : a.out;
        (void)moe_tables(L, ctl, tid);
        const LAS int* tstart = (const LAS int*)(L + LC_TSTART);
        const float* gfin = a.in[36];
        for (int tok0 = gw * 4; tok0 < NTOK; tok0 += NGW * 4) {
            float4 v[4][4]; uint2 p[4][4], q[4][4];
#pragma unroll
            for (int u = 0; u < 4; ++u) { const int4 ti = tokinfo[tok0 + u];
                const size_t s0 = (size_t)tstart[ti.x] * 256 + ti.y, s1 = (size_t)tstart[ti.z] * 256 + ti.w;
                const uint2* y0 = (const uint2*)(Yb + s0 * DM); const uint2* y1 = (const uint2*)(Yb + s1 * DM);
                const uint2* xr = (const uint2*)(xmidb + (size_t)(tok0 + u) * DM);
#pragma unroll
                for (int j = 0; j < 4; ++j) { const uint2 xx = xr[lane + 64 * j];
                    v[u][j] = make_float4(__uint_as_float(xx.x << 16), __uint_as_float(xx.x & 0xffff0000u), __uint_as_float(xx.y << 16), __uint_as_float(xx.y & 0xffff0000u));
                    p[u][j] = y0[lane + 64 * j]; q[u][j] = y1[lane + 64 * j]; } }
#pragma unroll
            for (int u = 0; u < 4; ++u) { float s = 0.f;
#pragma unroll
                for (int j = 0; j < 4; ++j) { const uint2 pp = p[u][j], qq = q[u][j];
                    v[u][j].x += __uint_as_float(pp.x << 16) + __uint_as_float(qq.x << 16); v[u][j].y += __uint_as_float(pp.x & 0xffff0000u) + __uint_as_float(qq.x & 0xffff0000u);
                    v[u][j].z += __uint_as_float(pp.y << 16) + __uint_as_float(qq.y << 16); v[u][j].w += __uint_as_float(pp.y & 0xffff0000u) + __uint_as_float(qq.y & 0xffff0000u);
                    s += (v[u][j].x * v[u][j].x + v[u][j].y * v[u][j].y) + (v[u][j].z * v[u][j].z + v[u][j].w * v[u][j].w); }
                s = wave_sum(s);
                const float rstd = rsqrtf(s * (1.0f / DM) + EPS);
                float4* xw = (float4*)(outw + (size_t)(tok0 + u) * DM);
#pragma unroll
                for (int j = 0; j < 4; ++j) { const float4 gg = *(const float4*)(gfin + (lane + 64 * j) * 4);
                    xw[lane + 64 * j] = make_float4(v[u][j].x * rstd * gg.x, v[u][j].y * rstd * gg.y, v[u][j].z * rstd * gg.z, v[u][j].w * rstd * gg.w); } }
        }
    }
#undef IN
#undef BOTH
#undef GRID_BAR
}

static void launch_fwd(const Args& base, int lo, int hi, int li, int grid, hipStream_t stream) {
    Args a = base; a.ph_lo = lo; a.ph_hi = hi; a.li = li; a.pad = 0;
    hipLaunchKernelGGL(fwd, dim3(grid), dim3(NWAVES * 64), LDS_BYTES, stream, a);
}

extern "C" void kernel_launch(void* const* d_in, const int* in_sizes, int n_in, void* d_out, int out_size, void* d_ws, size_t ws_size, hipStream_t stream) {
    (void)in_sizes; (void)n_in; (void)out_size; (void)ws_size;
    static int grid = 0;
    if (grid == 0) {
        int dev = 0, cus = 0;
        (void)hipGetDevice(&dev); (void)hipDeviceGetAttribute(&cus, hipDeviceAttributeMultiprocessorCount, dev);
        (void)hipFuncSetAttribute((const void*)fwd, hipFuncAttributeMaxDynamicSharedMemorySize, LDS_BYTES);
        grid = cus > 0 ? cus : 256;
    }
    const float* const* in = (const float* const*)d_in;
    unsigned char* ws = (unsigned char*)d_ws;
    float* out = (float*)d_out;
    (void)hipMemsetAsync(ws, 0, CTL_ZERO_BYTES, stream);
    Args base{};
    for (int i = 0; i < 37; ++i) base.in[i] = in[i];
    base.out = out; base.ws = ws;

#ifndef MK_PER_PHASE
    launch_fwd(base, 0, 10, 0, grid, stream);
#else
    for (int ph = 0; ph < 10; ++ph) launch_fwd(base, ph, ph + 1, ph, grid, stream);
#endif
}
```

```cpp
#include <hip/hip_runtime.h>
#include <stdint.h>

typedef unsigned short bf16;
__device__ __forceinline__ float bf2f(bf16 v) { return __uint_as_float(((unsigned)v) << 16); }
__device__ __forceinline__ bf16 f2bf(float f) { unsigned u = __float_as_uint(f); u += 0x7fffu + ((u >> 16) & 1u); return (bf16)(u >> 16); }

constexpr int NB = 4, SEQ = 8192, DM = 1024, NTOK = NB * SEQ, DIN = 2560, DL = 512, DH = 512;
constexpr float EPS = 1e-6f;

__device__ __forceinline__ float wave_sum(float v) {
#pragma unroll
    for (int o = 1; o < 64; o <<= 1) v += __shfl_xor(v, o);
    return v;
}
__device__ __forceinline__ float gelu_tanh(float x) { return 0.5f * x * (1.0f + tanhf(0.7978845608028654f * (x + 0.044715f * x * x * x))); }

constexpr size_t MiB = 1u << 20;
namespace pg8 {
#define PG8_LAS __attribute__((address_space(3)))
typedef unsigned short bf16_t;
typedef short bf16x8 __attribute__((ext_vector_type(8)));
typedef float f32x4 __attribute__((ext_vector_type(4)));
typedef unsigned u32x4 __attribute__((ext_vector_type(4)));
constexpr int BM = 256, BK = 64, HALF = 128, HTB = HALF * BK * 2  , STAGE_BYTES = 8 * HTB, NXCD = 8, WGM = 8;

__host__ __device__ __forceinline__ int lds_byte(int r, int c) { const int st = (r >> 4) * 2 + (c >> 5), rr = r & 15, cc = c & 31, ob = rr * 64 + cc * 2; return st * 1024 + (ob ^ (((ob >> 9) & 1) << 5)); }
__host__ __device__ __forceinline__ void stage_rc(int b, int& R, int& C) { const int st = b / 1024, sb = b % 1024, swz = sb ^ (((sb >> 9) & 1) << 5); R = (st >> 1) * 16 + swz / 64; C = (st & 1) * 32 + (swz % 64) / 2; }
__host__ __device__ __forceinline__ int perm32(int rho) { const int n = rho >> 4, i = rho & 15; return 8 * (i >> 2) + 4 * n + (i & 3); }

struct Unit { int pm, pn; };
struct Gemm { const bf16_t* A; const bf16_t* Bt; int M, N, K; };

struct StaticOrder {
    int nM, nN, nwg, G, c;
    __host__ __device__ void init(int M, int N, int G_, int c_) { nM = M / BM; nN = N / BM; nwg = nM * nN; G = G_; c = c_; }
    __host__ __device__ bool next(int i, Unit& u) const {
        const long L = (long)i * G + c; if (L >= nwg) return false;
        int wgid = (int)L; { const int q = nwg / NXCD, r = nwg % NXCD, xcd = wgid % NXCD, off = wgid / NXCD; wgid = (xcd < r ? xcd * (q + 1) : r * (q + 1) + (xcd - r) * q) + off; }
        const int nig = WGM * nN, gid = wgid / nig, fm = gid * WGM, gsz = (nM - fm) < WGM ? (nM - fm) : WGM;
        u.pm = fm + ((wgid % nig) % gsz); u.pn = (wgid % nig) / gsz; return true;
    }
    __device__ __forceinline__ void a_ready(const Unit&) const {}
    __device__ __forceinline__ void done(const Unit&) const {}
    __device__ __forceinline__ const char* a_base(const Gemm& g, const Unit& u) const { return (const char*)g.A + (size_t)u.pm * ((size_t)BM * g.K * 2); }
    __device__ __forceinline__ const char* b_base(const Gemm& g, const Unit& u) const { return (const char*)g.Bt + (size_t)u.pn * ((size_t)BM * g.K * 2); }
    __device__ __forceinline__ int src_row(const Unit&, int row) const { return row; }
};

__device__ __forceinline__ unsigned cvt_pk_bf16(float lo, float hi) { unsigned r; asm volatile("v_cvt_pk_bf16_f32 %0, %1, %2" : "=v"(r) : "v"(lo), "v"(hi)); return r; }
typedef float f32x2 __attribute__((ext_vector_type(2)));
__device__ __forceinline__ f32x2 gelu_pk(f32x2 v) {
    const f32x2 av = __builtin_elementwise_abs(v), d = av * 0.2316418882f + 1.0f;
    f32x2 t; t.x = __builtin_amdgcn_rcpf(d.x); t.y = __builtin_amdgcn_rcpf(d.y);
    f32x2 q = t * 0.5307027145f + (-0.7265760135f); q = q * t + 0.7107068705f; q = q * t + (-0.142248368f); q = q * t + 0.127414796f; q = q * t;
    const f32x2 s = (v * v) * (-0.72134752044f);
    f32x2 e; e.x = __builtin_amdgcn_exp2f(s.x); e.y = __builtin_amdgcn_exp2f(s.y);
    const f32x2 m = v * (q * e), r = v - m;
    f32x2 o; o.x = v.x < 0.f ? m.x : r.x; o.y = v.y < 0.f ? m.y : r.y; return o;
}

template <int ACT  > struct EpiBf16 {
    static constexpr bool PERM = true, AFTER_DRAIN = false, ACC_INIT = false; static_assert(ACT == 0 || ACT == 1, "EpiBf16: ACT is 0 (none) or 1 (gelu_pk)");
    bf16_t* O; int ldc; const float* bias; int split_cols; size_t split_stride; float scale0;
    __device__ __forceinline__ void operator()(const f32x4 (&acc)[2][2][4][2], const Unit& u, int wr, int wc, int fr, int fq) const {
        const int row0 = u.pm * BM + wr * 64 + fr; int colt = u.pn * BM; bf16_t* base = O;
        float sc = 1.f; if (split_cols) { const int t = colt / split_cols; base += (size_t)t * split_stride; colt -= t * split_cols; if (t == 0) sc = scale0; }
        const int col0 = colt + wc * 32 + 8 * fq, bcol0 = u.pn * BM + wc * 32 + 8 * fq;
        f32x4 bv[2][2];
#pragma unroll
        for (int bj = 0; bj < 2; ++bj)
#pragma unroll
            for (int n = 0; n < 2; ++n) bv[bj][n] = bias ? *(const f32x4*)(bias + bcol0 + bj * HALF + 4 * n) : (f32x4){0.f, 0.f, 0.f, 0.f};
#pragma unroll
        for (int ai = 0; ai < 2; ++ai)
#pragma unroll
            for (int m = 0; m < 4; ++m) { bf16_t* rowp = base + (size_t)(row0 + ai * HALF + m * 16) * ldc + col0;
#pragma unroll
                for (int bj = 0; bj < 2; ++bj) { f32x4 v0 = acc[ai][bj][m][0] + bv[bj][0], v1 = acc[ai][bj][m][1] + bv[bj][1];
                    if (ACT == 1) { f32x2 a = gelu_pk((f32x2){v0[0], v0[1]}), b = gelu_pk((f32x2){v0[2], v0[3]}), c = gelu_pk((f32x2){v1[0], v1[1]}), d = gelu_pk((f32x2){v1[2], v1[3]});
                        v0 = (f32x4){a.x, a.y, b.x, b.y}; v1 = (f32x4){c.x, c.y, d.x, d.y}; }
                    v0 = v0 * sc; v1 = v1 * sc; u32x4 w; w.x = cvt_pk_bf16(v0[0], v0[1]); w.y = cvt_pk_bf16(v0[2], v0[3]); w.z = cvt_pk_bf16(v1[0], v1[1]); w.w = cvt_pk_bf16(v1[2], v1[3]);
                    *(u32x4*)(rowp + bj * HALF) = w; } }
    }
};

struct EpiResF32 {
    static constexpr bool PERM = false, AFTER_DRAIN = false, ACC_INIT = false;
    const float* X; float* O; int ldc;
    __device__ __forceinline__ void operator()(const f32x4 (&acc)[2][2][4][2], const Unit& u, int wr, int wc, int fr, int fq) const {
        const int row0 = u.pm * BM + wr * 64 + fr, col0 = u.pn * BM + wc * 32 + 4 * fq;
#pragma unroll
        for (int ai = 0; ai < 2; ++ai)
#pragma unroll
            for (int m = 0; m < 4; ++m) { const size_t off = (size_t)(row0 + ai * HALF + m * 16) * ldc + col0;
#pragma unroll
                for (int bj = 0; bj < 2; ++bj)
#pragma unroll
                    for (int n = 0; n < 2; ++n) { const f32x4 xv = *(const f32x4*)(X + off + bj * HALF + n * 16); *(f32x4*)(O + off + bj * HALF + n * 16) = acc[ai][bj][m][n] + xv; } }
    }
};

struct EpiResBf16 {
    static constexpr bool PERM = true, AFTER_DRAIN = false, ACC_INIT = true;
    const float* __restrict__ X; bf16_t* __restrict__ O; int ldc;
    __device__ __forceinline__ void init(f32x4 (&acc)[2][2][4][2], const Unit& u, int wr, int wc, int fr, int fq) const {
        const int row0 = u.pm * BM + wr * 64 + fr, col0 = u.pn * BM + wc * 32 + 8 * fq;
#pragma unroll
        for (int ai = 0; ai < 2; ++ai)
#pragma unroll
            for (int m = 0; m < 4; ++m) { const size_t off = (size_t)(row0 + ai * HALF + m * 16) * ldc + col0;
#pragma unroll
                for (int bj = 0; bj < 2; ++bj) { acc[ai][bj][m][0] = *(const f32x4*)(X + off + bj * HALF); acc[ai][bj][m][1] = *(const f32x4*)(X + off + bj * HALF + 4); } }
    }
    __device__ __forceinline__ void operator()(const f32x4 (&acc)[2][2][4][2], const Unit& u, int wr, int wc, int fr, int fq) const {
        const int row0 = u.pm * BM + wr * 64 + fr, col0 = u.pn * BM + wc * 32 + 8 * fq;
#pragma unroll
        for (int ai = 0; ai < 2; ++ai)
#pragma unroll
            for (int m = 0; m < 4; ++m) { const size_t off = (size_t)(row0 + ai * HALF + m * 16) * ldc + col0;
#pragma unroll
                for (int bj = 0; bj < 2; ++bj) { const f32x4 v0 = acc[ai][bj][m][0], v1 = acc[ai][bj][m][1];
                    u32x4 w; w.x = cvt_pk_bf16(v0[0], v0[1]); w.y = cvt_pk_bf16(v0[2], v0[3]); w.z = cvt_pk_bf16(v1[0], v1[1]); w.w = cvt_pk_bf16(v1[2], v1[3]);
                    *(u32x4*)(O + off + bj * HALF) = w; } }
    }
};
struct MoeOrder {
    const PG8_LAS int* tile_e; int T, nN, G, c; size_t expert_stride_bytes;
    const PG8_LAS int* tstart; const PG8_LAS int* cnt; const int* list; int ntok; bool gather;
    __device__ __forceinline__ bool next(int i, Unit& u) const {
        const int L = i * G + c; if (L >= T * nN) return false;
        u.pm = L / nN; u.pn = L % nN; return true;
    }
    __device__ __forceinline__ void a_ready(const Unit&) const {}
    __device__ __forceinline__ void done(const Unit&) const {}
    __device__ __forceinline__ const char* a_base(const Gemm& g, const Unit& u) const { return gather ? (const char*)g.A : (const char*)g.A + (size_t)u.pm * ((size_t)BM * g.K * 2); }
    __device__ __forceinline__ const char* b_base(const Gemm& g, const Unit& u) const { return (const char*)g.Bt + (size_t)tile_e[u.pm] * expert_stride_bytes + (size_t)u.pn * ((size_t)BM * g.K * 2); }
    __device__ __forceinline__ int src_row(const Unit& u, int row) const {
        const int e = tile_e[u.pm]; const int r = (u.pm - tstart[e]) * BM + row;
        const int ce = cnt[e]; const int rc = r < ce ? r : 0; const int v = list[e * ntok + rc]; return r < ce ? v : 0;
    }
};
__device__ __forceinline__ float silu_f(float a) { return a * __builtin_amdgcn_rcpf(1.0f + __builtin_amdgcn_exp2f(-1.4426950408889634f * a)); }
struct EpiSwiGLU {
    static constexpr bool PERM = true, AFTER_DRAIN = false, ACC_INIT = false;
    bf16_t* H;
    __device__ __forceinline__ void operator()(const f32x4 (&acc)[2][2][4][2], const Unit& u, int wr, int wc, int fr, int fq) const {
        const int row0 = u.pm * BM + wr * 64 + fr, col0 = u.pn * 128 + wc * 32 + 8 * fq;
#pragma unroll
        for (int ai = 0; ai < 2; ++ai)
#pragma unroll
            for (int m = 0; m < 4; ++m) { bf16_t* p = H + (size_t)(row0 + ai * HALF + m * 16) * 512 + col0;
                const f32x4 a0 = acc[ai][0][m][0], a1 = acc[ai][0][m][1], b0 = acc[ai][1][m][0], b1 = acc[ai][1][m][1];
                u32x4 w; w.x = cvt_pk_bf16(silu_f(a0[0]) * b0[0], silu_f(a0[1]) * b0[1]); w.y = cvt_pk_bf16(silu_f(a0[2]) * b0[2], silu_f(a0[3]) * b0[3]);
                w.z = cvt_pk_bf16(silu_f(a1[0]) * b1[0], silu_f(a1[1]) * b1[1]); w.w = cvt_pk_bf16(silu_f(a1[2]) * b1[2], silu_f(a1[3]) * b1[3]);
                *(u32x4*)p = w; }
    }
};
struct EpiRowScaleBf16 {
    static constexpr bool PERM = true, AFTER_DRAIN = false, ACC_INIT = false;
    bf16_t* __restrict__ O; int ldc; const float* __restrict__ lgate; const PG8_LAS int* tile_e; const PG8_LAS int* tstart; const PG8_LAS int* cnt; int ntok;
    __device__ __forceinline__ void operator()(const f32x4 (&acc)[2][2][4][2], const Unit& u, int wr, int wc, int fr, int fq) const {
        const int rl0 = wr * 64 + fr, col0 = u.pn * BM + wc * 32 + 8 * fq;
        const int e = tile_e[u.pm]; const int rbase = (u.pm - tstart[e]) * BM; const int ce = cnt[e];
        float sc[2][4];
#pragma unroll
        for (int ai = 0; ai < 2; ++ai)
#pragma unroll
            for (int m = 0; m < 4; ++m) { const int r = rbase + rl0 + ai * HALF + m * 16; const int rc = r < ce ? r : 0; const float gv = lgate[e * ntok + rc]; sc[ai][m] = r < ce ? gv : 0.f; }
#pragma unroll
        for (int ai = 0; ai < 2; ++ai)
#pragma unroll
            for (int m = 0; m < 4; ++m) { const int rl = rl0 + ai * HALF + m * 16; const float s = sc[ai][m];
                bf16_t* rowp = O + (size_t)(u.pm * BM + rl) * ldc + col0;
#pragma unroll
                for (int bj = 0; bj < 2; ++bj) { const f32x4 v0 = acc[ai][bj][m][0] * s, v1 = acc[ai][bj][m][1] * s;
                    u32x4 w; w.x = cvt_pk_bf16(v0[0], v0[1]); w.y = cvt_pk_bf16(v0[2], v0[3]); w.z = cvt_pk_bf16(v1[0], v1[1]); w.w = cvt_pk_bf16(v1[2], v1[3]);
                    *(u32x4*)(rowp + bj * HALF) = w; } }
    }
};
template <class Epi, class Sched, bool ALIGN_EPI = false, bool SP2 = false, bool GATHER = false>
__device__ __forceinline__ void gemm_phase(PG8_LAS unsigned char* lds, const Gemm g, const Sched& S, const Epi& E) {
    const int tid = threadIdx.x, wid = __builtin_amdgcn_readfirstlane(tid >> 6), lane = tid & 63, wr = wid >> 2, wc = wid & 3, fr = lane & 15, fq = lane >> 4;
    const int K = g.K, nt = K / BK;
    unsigned voffA[2], voffB[2];
#pragma unroll
    for (int i = 0; i < 2; ++i) { int R, C; stage_rc(tid * 16 + i * 8192, R, C); const int Rb = Epi::PERM ? ((R & ~31) + perm32(R & 31)) : R;
        voffA[i] = (unsigned)(R * K + C) * 2u; voffB[i] = (unsigned)(Rb * K + C) * 2u; }
    unsigned voA[2][2], voAn[2][2];
    int gR[2], gC[2];
#pragma unroll
    for (int i = 0; i < 2; ++i) { int R, C; stage_rc(tid * 16 + i * 8192, R, C); gR[i] = R; gC[i] = C; }
#pragma unroll
    for (int h = 0; h < 2; ++h)
#pragma unroll
        for (int i = 0; i < 2; ++i) { voA[h][i] = voffA[i] + (unsigned)h * (unsigned)(HALF * K * 2); voAn[h][i] = voA[h][i]; }
    const size_t kstep = (size_t)(BK * 2);
    const size_t hstep = (size_t)HALF * K * 2;
    const size_t tstep = 2 * hstep; (void)tstep;
    const unsigned ldsw = (unsigned)wid * 1024u;
    const int aoff = lds_byte(wr * 64 + fr, fq * 8), boff = lds_byte(wc * 32 + fr, fq * 8);
#define PG8_SA(b, h) (((b) * 2 + (h)) * HTB)
#define PG8_SB(b, h) ((4 + (b) * 2 + (h)) * HTB)
#define PG8_STAGE(bufoff, gbase, voff) do { _Pragma("unroll") for (int _i = 0; _i < 2; ++_i) \
        __builtin_amdgcn_global_load_lds((const unsigned*)((const char*)(gbase) + (voff)[_i]), (PG8_LAS unsigned*)(lds + (bufoff) + ldsw + _i * 8192), 16, 0, 0); } while (0)
#define PG8_STAGE_A(bufoff, gbase, h, vo) do { _Pragma("unroll") for (int _i = 0; _i < 2; ++_i) \
        __builtin_amdgcn_global_load_lds((const unsigned*)((const char*)(gbase) + (vo)[h][_i]), (PG8_LAS unsigned*)(lds + (bufoff) + ldsw + _i * 8192), 16, 0, 0); } while (0)
#define PG8_GATHER_OFFS(dst, unit) do { int _tz = threadIdx.x; asm volatile("" : "+v"(_tz)); int _R[2], _C[2], _sr[2][2]; \
        _Pragma("unroll") for (int _i = 0; _i < 2; ++_i) stage_rc(_tz * 16 + _i * 8192, _R[_i], _C[_i]); \
        _Pragma("unroll") for (int _i = 0; _i < 2; ++_i) _Pragma("unroll") for (int _h = 0; _h < 2; ++_h) _sr[_h][_i] = S.src_row(unit, _h * HALF + _R[_i]); \
        _Pragma("unroll") for (int _i = 0; _i < 2; ++_i) _Pragma("unroll") for (int _h = 0; _h < 2; ++_h) (dst)[_h][_i] = (unsigned)(_sr[_h][_i] * K + _C[_i]) * 2u; } while (0)
#define PG8_LDA(dst, b, h) do { _Pragma("unroll") for (int m = 0; m < 4; ++m) _Pragma("unroll") for (int k = 0; k < 2; ++k) dst[m][k] = *(const PG8_LAS bf16x8*)(lds + PG8_SA(b, h) + aoff + m * 2048 + k * 1024); } while (0)
#define PG8_LDB(dst, b, h) do { _Pragma("unroll") for (int n = 0; n < 2; ++n) _Pragma("unroll") for (int k = 0; k < 2; ++k) dst[n][k] = *(const PG8_LAS bf16x8*)(lds + PG8_SB(b, h) + boff + n * 2048 + k * 1024); } while (0)
#define PG8_MMA(ai, bj, At, Bt) do { __builtin_amdgcn_s_setprio(1); _Pragma("unroll") for (int m = 0; m < 4; ++m) _Pragma("unroll") for (int n = 0; n < 2; ++n) _Pragma("unroll") for (int k = 0; k < 2; ++k) \
        acc[ai][bj][m][n] = __builtin_amdgcn_mfma_f32_16x16x32_bf16(Bt[n][k], At[m][k], acc[ai][bj][m][n], 0, 0, 0); __builtin_amdgcn_s_setprio(0); } while (0)
#define PG8_WAIT_V(n) asm volatile("s_waitcnt vmcnt(" #n ")" ::: "memory")
#define PG8_WAIT_L(n) asm volatile("s_waitcnt lgkmcnt(" #n ")" ::: "memory")
#define PG8_BAR __builtin_amdgcn_s_barrier()
#define PG8_SCHED __builtin_amdgcn_sched_barrier(0)
    Unit cur, nxt; int ui = 0;
    if (!S.next(0, cur)) return;
    f32x4 acc[2][2][4][2];
    if constexpr (Epi::ACC_INIT) { E.init(acc, cur, wr, wc, fr, fq); } else {
#pragma unroll
    for (int a = 0; a < 2; ++a)
#pragma unroll
        for (int b = 0; b < 2; ++b)
#pragma unroll
            for (int m = 0; m < 4; ++m)
#pragma unroll
                for (int n = 0; n < 2; ++n) acc[a][b][m][n] = (f32x4){0.f, 0.f, 0.f, 0.f}; }
    bf16x8 At[4][2], B0[2][2], B1[2][2];
    const char* cA = S.a_base(g, cur); const char* cB = S.b_base(g, cur);
    if constexpr (GATHER) { PG8_GATHER_OFFS(voA, cur); }
    S.a_ready(cur);
    if constexpr (SP2) {
        PG8_STAGE(PG8_SB(0, 0), cB, voffB); PG8_STAGE(PG8_SB(0, 1), cB + hstep, voffB); PG8_STAGE_A(PG8_SA(0, 0), cA, 0, voA); PG8_STAGE_A(PG8_SA(0, 1), cA, 1, voA);
        if (wr == 1) PG8_BAR;
        PG8_WAIT_V(2); PG8_BAR;
        PG8_STAGE(PG8_SB(1, 0), cB + kstep, voffB); PG8_STAGE_A(PG8_SA(1, 0), cA + kstep, 0, voA); PG8_STAGE(PG8_SB(1, 1), cB + hstep + kstep, voffB);
        PG8_WAIT_V(6); PG8_BAR;
    } else {
        PG8_STAGE(PG8_SB(0, 0), cB, voffB); PG8_STAGE_A(PG8_SA(0, 0), cA, 0, voA); PG8_STAGE(PG8_SB(0, 1), cB + hstep, voffB); PG8_STAGE_A(PG8_SA(0, 1), cA, 1, voA);
        if (wr == 1) PG8_BAR;
        PG8_WAIT_V(4); PG8_BAR;
        PG8_STAGE(PG8_SB(1, 0), cB + kstep, voffB); PG8_STAGE_A(PG8_SA(1, 0), cA + kstep, 0, voA); PG8_STAGE(PG8_SB(1, 1), cB + hstep + kstep, voffB);
        PG8_WAIT_V(6); PG8_BAR;
    }
    for (;;) {
        const bool has_next = S.next(ui + 1, nxt);
        const char* nA = has_next ? S.a_base(g, nxt) : cA; const char* nB = has_next ? S.b_base(g, nxt) : cB;
        if constexpr (GATHER) { if (has_next) { PG8_GATHER_OFFS(voAn, nxt); } else {
#pragma unroll
            for (int _h = 0; _h < 2; ++_h) { voAn[_h][0] = voA[_h][0]; voAn[_h][1] = voA[_h][1]; } } }
        for (int t = 0; t < nt; t += 2) {
            const bool last = (t == nt - 2);
            const char* a1 = cA + (size_t)(t + 1) * kstep;
            const char* a2 = last ? nA : cA + (size_t)(t + 2) * kstep; const char* b2 = last ? nB : cB + (size_t)(t + 2) * kstep;
            const char* a3 = a2 + kstep; const char* b3 = b2 + kstep;
            if (last && has_next) S.a_ready(nxt);
            if constexpr (SP2) {
            PG8_LDB(B0, 0, 0); PG8_LDB(B1, 0, 1); PG8_SCHED; PG8_LDA(At, 0, 0); PG8_STAGE_A(PG8_SA(1, 1), a1, 1, voA);
            PG8_WAIT_V(8); PG8_WAIT_L(0); PG8_BAR; PG8_MMA(0, 0, At, B0); PG8_MMA(0, 1, At, B1); PG8_BAR; PG8_SCHED;
            PG8_LDA(At, 0, 1); PG8_STAGE(PG8_SB(0, 0), b2, voffB); PG8_STAGE(PG8_SB(0, 1), b2 + hstep, voffB); if (last) { PG8_STAGE_A(PG8_SA(0, 0), a2, 0, voAn); } else { PG8_STAGE_A(PG8_SA(0, 0), a2, 0, voA); }
            PG8_WAIT_V(8); PG8_WAIT_L(0); PG8_BAR; PG8_MMA(1, 0, At, B0); PG8_MMA(1, 1, At, B1); PG8_BAR; PG8_SCHED;
            PG8_LDB(B0, 1, 0); PG8_LDB(B1, 1, 1); PG8_SCHED; PG8_LDA(At, 1, 0); if (last) { PG8_STAGE_A(PG8_SA(0, 1), a2, 1, voAn); } else { PG8_STAGE_A(PG8_SA(0, 1), a2, 1, voA); }
            PG8_WAIT_V(8); PG8_WAIT_L(0); PG8_BAR; PG8_MMA(0, 0, At, B0); PG8_MMA(0, 1, At, B1); PG8_BAR; PG8_SCHED;
            PG8_LDA(At, 1, 1); PG8_STAGE(PG8_SB(1, 0), b3, voffB); PG8_STAGE(PG8_SB(1, 1), b3 + hstep, voffB); if (last) { PG8_STAGE_A(PG8_SA(1, 0), a3, 0, voAn); } else { PG8_STAGE_A(PG8_SA(1, 0), a3, 0, voA); }
            PG8_WAIT_V(8); PG8_WAIT_L(0); PG8_BAR; PG8_MMA(1, 0, At, B0); PG8_MMA(1, 1, At, B1); PG8_BAR; PG8_SCHED;
            } else {
            PG8_LDB(B0, 0, 0); PG8_SCHED; PG8_LDA(At, 0, 0); PG8_STAGE(PG8_SA(1, 1), a1 + hstep, voffA);
            PG8_WAIT_L(8); PG8_BAR; PG8_WAIT_L(0); PG8_MMA(0, 0, At, B0); PG8_BAR; PG8_SCHED;
            PG8_LDB(B1, 0, 1); PG8_STAGE(PG8_SB(0, 0), b2, voffB);
            PG8_BAR; PG8_WAIT_L(0); PG8_MMA(0, 1, At, B1); PG8_BAR;
            PG8_LDA(At, 0, 1); PG8_STAGE(PG8_SA(0, 0), a2, voffA);
            PG8_BAR; PG8_WAIT_L(0); PG8_MMA(1, 0, At, B0); PG8_BAR; PG8_SCHED;
            PG8_STAGE(PG8_SB(0, 1), b2 + hstep, voffB);
            PG8_WAIT_V(6); PG8_BAR; PG8_MMA(1, 1, At, B1); PG8_BAR;
            PG8_LDB(B0, 1, 0); PG8_SCHED; PG8_LDA(At, 1, 0); PG8_STAGE(PG8_SA(0, 1), a2 + hstep, voffA);
            PG8_WAIT_L(8); PG8_BAR; PG8_WAIT_L(0); PG8_MMA(0, 0, At, B0); PG8_BAR; PG8_SCHED;
            PG8_LDB(B1, 1, 1); PG8_STAGE(PG8_SB(1, 0), b3, voffB);
            PG8_BAR; PG8_WAIT_L(0); PG8_MMA(0, 1, At, B1); PG8_BAR;
            PG8_LDA(At, 1, 1); PG8_STAGE(PG8_SA(1, 0), a3, voffA);
            PG8_BAR; PG8_WAIT_L(0); PG8_MMA(1, 0, At, B0); PG8_BAR; PG8_SCHED;
            PG8_STAGE(PG8_SB(1, 1), b3 + hstep, voffB);
            PG8_WAIT_V(6); PG8_BAR; PG8_MMA(1, 1, At, B1); PG8_BAR;
            }
        }
        if constexpr (ALIGN_EPI) { if (wr == 0) PG8_BAR; }
        if constexpr (!Epi::AFTER_DRAIN) { E(acc, cur, wr, wc, fr, fq); S.done(cur); }
        if (!has_next) break;
        if constexpr (Epi::ACC_INIT) { E.init(acc, nxt, wr, wc, fr, fq); } else {
#pragma unroll
        for (int a = 0; a < 2; ++a)
#pragma unroll
            for (int b = 0; b < 2; ++b)
#pragma unroll
                for (int m = 0; m < 4; ++m)
#pragma unroll
                    for (int n = 0; n < 2; ++n) acc[a][b][m][n] = (f32x4){0.f, 0.f, 0.f, 0.f}; }
        cur = nxt; cA = nA; cB = nB; ++ui;
        if constexpr (GATHER) {
#pragma unroll
            for (int _h = 0; _h < 2; ++_h) { voA[_h][0] = voAn[_h][0]; voA[_h][1] = voAn[_h][1]; } }
        if constexpr (ALIGN_EPI) { if (wr == 1) PG8_BAR; }
    }
    PG8_WAIT_V(0);
    if constexpr (!ALIGN_EPI) { if (wr == 0) PG8_BAR; }
    PG8_BAR;
    if constexpr (Epi::AFTER_DRAIN) { E.fused(acc, cur, wr, wc, fr, fq, lds, wid, lane); S.done(cur); }
#undef PG8_SA
#undef PG8_SB
#undef PG8_STAGE
#undef PG8_STAGE_A
#undef PG8_GATHER_OFFS
#undef PG8_LDA
#undef PG8_LDB
#undef PG8_MMA
#undef PG8_WAIT_V
#undef PG8_WAIT_L
#undef PG8_BAR
#undef PG8_SCHED
}
}
#define LAS __attribute__((address_space(3)))
#define XB_TMO      128
#define XB_XCNT(j)  (256  + 64 * (j))
#define XB_XSUB(j)  (1280 + 64 * (j))
#define XB_XGEN(j)  (2304 + 64 * (j))
#define XB_TOP      3328
#define XB_TOPGEN   3392
#define XCD_BAR_WORDS 3456
#define XB_SPIN_CAP (1u << 18)

__device__ __forceinline__ unsigned xb_ld(unsigned* p)              { return __hip_atomic_load(p, __ATOMIC_RELAXED, __HIP_MEMORY_SCOPE_AGENT); }
__device__ __forceinline__ unsigned xb_add(unsigned* p, unsigned v) { return __hip_atomic_fetch_add(p, v, __ATOMIC_RELAXED, __HIP_MEMORY_SCOPE_AGENT); }
__device__ __forceinline__ unsigned xb_xcc_id() { return (unsigned)__builtin_amdgcn_s_getreg((3 << 11) | 20) & 0xFu; }
#define XB_SPIN(cond, bar) do { unsigned _sp = 0; while (cond) { __builtin_amdgcn_s_sleep(1); \
    if ((++_sp & 255u) == 0u) { if (xb_ld(&(bar)[XB_TMO])) break; if (_sp > XB_SPIN_CAP) { atomicAdd(&(bar)[XB_TMO], 1u); break; } } } } while (0)

struct XcdBarrier {
    unsigned* bar; unsigned x;
    volatile LAS unsigned* st;
};

__device__ __forceinline__ XcdBarrier xcd_barrier_post(unsigned* bar, volatile LAS unsigned* st) {
    XcdBarrier b; b.bar = bar; b.x = xb_xcc_id(); b.st = st;
    if (threadIdx.x == 0) (void)xb_add(&bar[XB_XCNT(b.x)], 1u);
    return b;
}
__device__ __forceinline__ void xcd_barrier_complete(unsigned* bar, unsigned x, unsigned& nloc, unsigned& nx) {
    const unsigned G = gridDim.x * gridDim.y * gridDim.z;
    unsigned sum, cnt, mine, sp = 0u;
    for (;;) {
        sum = 0u; cnt = 0u; mine = 0u;
#pragma unroll
        for (unsigned j = 0; j < 16; ++j) { const unsigned c = xb_ld(&bar[XB_XCNT(j)]); sum += c; cnt += (c > 0u) ? 1u : 0u; mine = (j == x) ? c : mine; }
        if (sum == G) break;
        __builtin_amdgcn_s_sleep(1);
        if ((++sp & 255u) == 0u) { if (xb_ld(&bar[XB_TMO])) break; if (sp > XB_SPIN_CAP) { atomicAdd(&bar[XB_TMO], 1u); break; } }
    }
    nloc = mine > 0u ? mine : 1u; nx = cnt > 0u ? cnt : 1u;
}

__device__ __forceinline__ void xcd_barrier(const XcdBarrier& b) {
    asm volatile("s_waitcnt vmcnt(0)" ::: "memory");
    __syncthreads();
    if (threadIdx.x == 0) {
        unsigned* bar = b.bar;
        __builtin_amdgcn_s_waitcnt(0);
        unsigned nloc = b.st[0], nx = b.st[1];
        if (nloc == 0u) { xcd_barrier_complete(bar, b.x, nloc, nx); b.st[0] = nloc; b.st[1] = nx; }
        const unsigned old = xb_add(&bar[XB_XSUB(b.x)], 1u);
        const unsigned gen = old / nloc;
        if (old + 1u == (gen + 1u) * nloc) {
            __builtin_amdgcn_fence(__ATOMIC_RELEASE, "agent");
            asm volatile("s_waitcnt vmcnt(0)" ::: "memory");
            const unsigned og = xb_add(&bar[XB_TOP], 1u);
            const unsigned tg = og / nx;
            if (og + 1u == (tg + 1u) * nx) xb_add(&bar[XB_TOPGEN], 1u);
            else XB_SPIN(xb_ld(&bar[XB_TOPGEN]) == tg, bar);
            __builtin_amdgcn_fence(__ATOMIC_ACQUIRE, "agent");
            xb_add(&bar[XB_XGEN(b.x)], 1u);
            asm volatile("s_waitcnt vmcnt(0)" ::: "memory");
        } else {
            XB_SPIN(xb_ld(&bar[XB_XGEN(b.x)]) == gen, bar);
            __builtin_amdgcn_fence(__ATOMIC_ACQUIRE, "agent");
            asm volatile("s_waitcnt vmcnt(0)" ::: "memory");
        }
    }
    __syncthreads();
}

#define GAS __attribute__((address_space(1)))
typedef unsigned v4u __attribute__((ext_vector_type(4)));
#define LDS_WAIT() asm volatile("s_waitcnt lgkmcnt(0)" ::: "memory")
constexpr int NWAVES = 8;
constexpr int RING_BYTES = 139264, LDSCTL_OFF = RING_BYTES, MISC_OFF = LDSCTL_OFF + 320, LDS_BYTES = 155648;
constexpr size_t CTL_ZERO_BYTES = 1 * MiB;
constexpr int CW_BAR = 4096;
constexpr int MAX_LAUNCHES = 12;
static_assert((CW_BAR + MAX_LAUNCHES * XCD_BAR_WORDS) * 4 <= (int)CTL_ZERO_BYTES, "ctl");

constexpr size_t WS_WINT = 1 * MiB, WS_WOUTT = 6 * MiB, WS_W13T = 8 * MiB, WS_W2T = 72 * MiB;
constexpr size_t WS_HN1 = 104 * MiB, WS_LRU = 168 * MiB, WS_HYUT = 232 * MiB, WS_HF = 396 * MiB, WS_HB = 428 * MiB;
constexpr size_t WS_YHYT = 104 * MiB, WS_YCAT = 232 * MiB, WS_HN2 = 168 * MiB, WS_EID = 460 * MiB, WS_GATE = 461 * MiB;
constexpr size_t WS_LIST = 460 * MiB, WS_LGATE = 464 * MiB, WS_TOKINFO = 468 * MiB, WS_WRT = 469 * MiB, WS_SGATE = 470 * MiB;
constexpr size_t WS_XS = 232 * MiB, WS_H = 376 * MiB, WS_Y = 168 * MiB, WS_XMID = 104 * MiB;
constexpr size_t WS_XC = 104 * MiB, WS_Z2 = 392 * MiB, WS_KT = 328 * MiB;
constexpr int CW_CNT = 2048;
constexpr int LC_CNT = RING_BYTES + 1024, LC_BASE = RING_BYTES + 1152, LC_TSTART = RING_BYTES + 1280, LC_TILEE = RING_BYTES + 2048;

struct Args { const float* in[37]; float* out; unsigned char* ws; int ph_lo, ph_hi, li, pad; };

__device__ __forceinline__ unsigned pk2(float lo, float hi) { return (unsigned)f2bf(lo) | ((unsigned)f2bf(hi) << 16); }

__device__ __forceinline__ void p0_transpose_item(const float* __restrict__ W, int K, int N, bf16* __restrict__ WT, int drow0, LAS float* scr, int k0, int n0, int lane) {
#pragma unroll 8
    for (int i = 0; i < 32; ++i) { const int kk = 2 * i + (lane >> 5); scr[kk * 33 + (lane & 31)] = W[(size_t)(k0 + kk) * N + n0 + (lane & 31)]; }
    LDS_WAIT(); asm volatile("" ::: "memory");
    const int c = lane & 7;
#pragma unroll
    for (int j = 0; j < 4; ++j) { const int n = (lane >> 3) + 8 * j; const LAS float* s = scr + (8 * c) * 33 + n;
        v4u o; o.x = pk2(s[0 * 33], s[1 * 33]); o.y = pk2(s[2 * 33], s[3 * 33]); o.z = pk2(s[4 * 33], s[5 * 33]); o.w = pk2(s[6 * 33], s[7 * 33]);
        *(v4u*)(WT + (size_t)(drow0 + n) * K + k0 + 8 * c) = o; }
    LDS_WAIT(); asm volatile("" ::: "memory");
}
__device__ __forceinline__ void rms_row_to_bf16(const float* __restrict__ xrow, const float* __restrict__ g, bf16* __restrict__ orow, int lane) {
    const float4* xr = (const float4*)xrow;
    float4 v[4]; float s = 0.f;
#pragma unroll
    for (int j = 0; j < 4; ++j) { v[j] = xr[lane + 64 * j]; s += (v[j].x * v[j].x + v[j].y * v[j].y) + (v[j].z * v[j].z + v[j].w * v[j].w); }
    s = wave_sum(s);
    const float rstd = rsqrtf(s * (1.0f / DM) + EPS);
#pragma unroll
    for (int j = 0; j < 4; ++j) { const int c = (lane + 64 * j) * 4; const float4 gg = *(const float4*)(g + c);
        uint2 o; o.x = pk2(v[j].x * rstd * gg.x, v[j].y * rstd * gg.y); o.y = pk2(v[j].z * rstd * gg.z, v[j].w * rstd * gg.w);
        *(uint2*)(orow + c) = o; }
}


typedef short bf16x8_t __attribute__((ext_vector_type(8)));
typedef float f32x4_t __attribute__((ext_vector_type(4)));
__device__ __forceinline__ int moe_tables(LAS unsigned char* L, unsigned* ctl, int tid) {
    LAS int* cnt = (LAS int*)(L + LC_CNT); LAS int* tstart = (LAS int*)(L + LC_TSTART); LAS int* tile_e = (LAS int*)(L + LC_TILEE);
    __syncthreads();
    if (tid < 32) cnt[tid] = (int)__hip_atomic_load(ctl + CW_CNT + tid, __ATOMIC_RELAXED, __HIP_MEMORY_SCOPE_AGENT);
    __syncthreads();
    if (tid == 0) { int ts = 0; for (int e = 0; e < 32; ++e) { tstart[e] = ts; const int nt = (cnt[e] + 255) >> 8; for (int i = 0; i < nt; ++i) tile_e[ts + i] = e; ts += nt; } tstart[32] = ts; }
    __syncthreads();
    return tstart[32];
}

__device__ __forceinline__ void lru_load_frags(const bf16* xrow0, int sg0, int jl, int dir, v4u (&fr)[4][2]) {
#pragma unroll
    for (int mt = 0; mt < 4; ++mt) { const int sg = 16 * (jl >> 2) + 4 * mt + (jl & 3); const int tau = sg0 + sg; const int t = dir ? (SEQ - 1 - tau) : tau;
#pragma unroll
        for (int s = 0; s < 2; ++s) fr[mt][s] = *(const v4u*)(xrow0 + (size_t)t * 64 + 32 * s); }
}
__device__ __forceinline__ void lru_item(LAS unsigned char* L, const Args& a, int item, const bf16* __restrict__ xcb, bf16* __restrict__ hf, bf16* __restrict__ hb, int tid, int lane, int wave) {
    const int b = item >> 6, h = (item >> 3) & 7, q4 = (item >> 1) & 3, dir = item & 1;
    const float* wr = dir ? a.in[10] : a.in[5]; const float* br = dir ? a.in[11] : a.in[6]; const float* wi = dir ? a.in[12] : a.in[7];
    const float* bi = dir ? a.in[13] : a.in[8]; const float* lam = dir ? a.in[14] : a.in[9];
    bf16* outp = dir ? hb : hf;
    LAS float* carry = (LAS float*)(L + 2048);
    const int jl = lane & 15, kg = lane >> 4;
    const int c = 64 * h + 16 * q4 + jl;
    bf16x8_t Br[2], Bi[2], Bid;
#pragma unroll
    for (int s = 0; s < 2; ++s)
#pragma unroll
        for (int j = 0; j < 8; ++j) { const int i = 32 * s + 8 * kg + j;
            Br[s][j] = (short)f2bf(wr[h * 4096 + i * 64 + 16 * q4 + jl]); Bi[s][j] = (short)f2bf(wi[h * 4096 + i * 64 + 16 * q4 + jl]); }
#pragma unroll
    for (int j = 0; j < 8; ++j) Bid[j] = (8 * kg + j == 16 * (q4 & 1) + jl) ? (short)0x3f80 : (short)0;
    const int sid = q4 >> 1;
    const float brc = br[c], bic = bi[c];
    const float sp8l = 8.0f * log1pf(expf(-lam[c])) * 1.4426950408889634f;
    __syncthreads();
    float Hblk = 0.f;
    const bf16* xrow0 = xcb + ((size_t)(b * 8 + h) * SEQ) * 64 + 8 * kg;
    v4u frn[4][2];
    lru_load_frags(xrow0, 64 * wave, jl, dir, frn);
    for (int it = 0; it < 16; ++it) {
        const int sg0 = 512 * it + 64 * wave;
        bf16x8_t Af[4][2];
#pragma unroll
        for (int mt = 0; mt < 4; ++mt)
#pragma unroll
            for (int s = 0; s < 2; ++s) Af[mt][s] = __builtin_bit_cast(bf16x8_t, frn[mt][s]);
        if (it < 15) lru_load_frags(xrow0, sg0 + 512, jl, dir, frn);
        float hloc[16], Ploc[16];
        float hl = 0.f, P = 1.f;
#pragma unroll
        for (int mt = 0; mt < 4; ++mt) {
            f32x4_t aR = {0.f, 0.f, 0.f, 0.f}, aI = aR, aX = aR;
            aR = __builtin_amdgcn_mfma_f32_16x16x32_bf16(Af[mt][0], Br[0], aR, 0, 0, 0); aR = __builtin_amdgcn_mfma_f32_16x16x32_bf16(Af[mt][1], Br[1], aR, 0, 0, 0);
            aI = __builtin_amdgcn_mfma_f32_16x16x32_bf16(Af[mt][0], Bi[0], aI, 0, 0, 0); aI = __builtin_amdgcn_mfma_f32_16x16x32_bf16(Af[mt][1], Bi[1], aI, 0, 0, 0);
            aX = __builtin_amdgcn_mfma_f32_16x16x32_bf16(sid ? Af[mt][1] : Af[mt][0], Bid, aX, 0, 0, 0);
#pragma unroll
            for (int r = 0; r < 4; ++r) {
                const float rg = __builtin_amdgcn_rcpf(1.0f + __builtin_amdgcn_exp2f(-1.4426950408889634f * (aR[r] + brc)));
                const float ig = __builtin_amdgcn_rcpf(1.0f + __builtin_amdgcn_exp2f(-1.4426950408889634f * (aI[r] + bic)));
                const float av = __builtin_amdgcn_exp2f(-rg * sp8l);
                const float bb = __builtin_amdgcn_sqrtf(fmaxf(1.0f - av * av, 0.f)) * (ig * aX[r]);
                hl = av * hl + bb; P *= av;
                hloc[4 * mt + r] = hl; Ploc[4 * mt + r] = P;
            }
        }
        const float A0 = __shfl(P, jl), B0 = __shfl(hl, jl), A1 = __shfl(P, jl + 16), B1 = __shfl(hl, jl + 16);
        const float A2 = __shfl(P, jl + 32), B2 = __shfl(hl, jl + 32), A3 = __shfl(P, jl + 48), B3 = __shfl(hl, jl + 48);
        LAS float* cbuf = carry + (it & 1) * 256;
        if (kg == 0) { cbuf[(wave * 16 + jl) * 2 + 0] = A0 * A1 * A2 * A3; cbuf[(wave * 16 + jl) * 2 + 1] = ((B0 * A1 + B1) * A2 + B2) * A3 + B3; }
        __syncthreads();
        float Hw = Hblk, Hn = Hblk;
#pragma unroll
        for (int w2 = 0; w2 < 8; ++w2) { const float Aq = cbuf[(w2 * 16 + jl) * 2 + 0], Bq = cbuf[(w2 * 16 + jl) * 2 + 1];
            if (w2 < wave) Hw = Aq * Hw + Bq;
            Hn = Aq * Hn + Bq; }
        Hblk = Hn;
        float Hin = Hw;
        if (kg >= 1) Hin = A0 * Hin + B0;
        if (kg >= 2) Hin = A1 * Hin + B1;
        if (kg >= 3) Hin = A2 * Hin + B2;
#pragma unroll
        for (int k = 0; k < 16; ++k) { const int tau = sg0 + 16 * kg + k; const int t = dir ? (SEQ - 1 - tau) : tau;
            outp[((size_t)b * SEQ + t) * DL + c] = f2bf(hloc[k] + Ploc[k] * Hin); }
    }
}

typedef float f32x2_t __attribute__((ext_vector_type(2)));
typedef _Float16 f16x2_t __attribute__((ext_vector_type(2)));
constexpr int LC_TW = RING_BYTES + 4096, LC_TA = RING_BYTES + 8192, LC_TB = RING_BYTES + 9216, LC_RED = RING_BYTES + 3328;
constexpr size_t WS_SPEC = 328 * MiB, WS_HT = 476 * MiB, WS_XCB = 136 * MiB;
__device__ __forceinline__ f32x2_t cmul(f32x2_t a, f32x2_t b) { f32x2_t r; r.x = a.x * b.x - a.y * b.y; r.y = a.x * b.y + a.y * b.x; return r; }
__device__ __forceinline__ f32x2_t h2_to_f2(unsigned u) { const f16x2_t h = __builtin_bit_cast(f16x2_t, u); f32x2_t k; k.x = (float)h.x; k.y = (float)h.y; return k; }
__device__ __forceinline__ f32x2_t cmulc(f32x2_t a, f32x2_t b) { f32x2_t r; r.x = a.x * b.x + a.y * b.y; r.y = a.y * b.x - a.x * b.y; return r; }
template <bool INV> __device__ __forceinline__ f32x2_t twc(f32x2_t d, int e) {
    constexpr float CT[16] = {1.000000000e+00f, 9.807852804e-01f, 9.238795325e-01f, 8.314696123e-01f, 7.071067812e-01f, 5.555702330e-01f, 3.826834324e-01f, 1.950903220e-01f, 6.123233996e-17f, -1.950903220e-01f, -3.826834324e-01f, -5.555702330e-01f, -7.071067812e-01f, -8.314696123e-01f, -9.238795325e-01f, -9.807852804e-01f};
    constexpr float ST[16] = {0.000000000e+00f, 1.950903220e-01f, 3.826834324e-01f, 5.555702330e-01f, 7.071067812e-01f, 8.314696123e-01f, 9.238795325e-01f, 9.807852804e-01f, 1.000000000e+00f, 9.807852804e-01f, 9.238795325e-01f, 8.314696123e-01f, 7.071067812e-01f, 5.555702330e-01f, 3.826834324e-01f, 1.950903220e-01f};
    f32x2_t r;
    if (e == 0) return d;
    if (e == 8) { if (INV) { r.x = -d.y; r.y = d.x; } else { r.x = d.y; r.y = -d.x; } return r; }
    const float c = CT[e], s = INV ? -ST[e] : ST[e];
    if (e == 4) { r.x = (d.x + (INV ? -d.y : d.y)) * c; r.y = (d.y - (INV ? -d.x : d.x)) * c; return r; }
    r.x = d.x * c + d.y * s; r.y = d.y * c - d.x * s; return r;
}
template <int R, bool INV> struct DFT {
    static __device__ __forceinline__ void run(f32x2_t (&x)[R]) {
        f32x2_t u[R / 2], v[R / 2];
#pragma unroll
        for (int k = 0; k < R / 2; ++k) { const f32x2_t p = x[k], q = x[k + R / 2]; u[k] = p + q; v[k] = twc<INV>(p - q, k * (32 / R)); }
        DFT<R / 2, INV>::run(u); DFT<R / 2, INV>::run(v);
#pragma unroll
        for (int q = 0; q < R / 2; ++q) { x[2 * q] = u[q]; x[2 * q + 1] = v[q]; }
    }
};
template <bool INV> struct DFT<1, INV> { static __device__ __forceinline__ void run(f32x2_t (&)[1]) {} };

typedef f16x2_t c16;
__device__ __forceinline__ c16 c16_from(f32x2_t v) { c16 r; r.x = (_Float16)v.x; r.y = (_Float16)v.y; return r; }
__device__ __forceinline__ c16 cmul16(c16 a, c16 w) { c16 wx; wx.x = w.x; wx.y = w.x; c16 wy; wy.x = w.y; wy.y = w.y; c16 at; at.x = -a.y; at.y = a.x; return a * wx + at * wy; }
__device__ __forceinline__ c16 cmulc16(c16 a, c16 w) { c16 wx; wx.x = w.x; wx.y = w.x; c16 wy; wy.x = w.y; wy.y = w.y; c16 at; at.x = a.y; at.y = -a.x; return a * wx + at * wy; }
template <bool INV> __device__ __forceinline__ c16 twc(c16 d, int e) {
    constexpr float CT[16] = {1.000000000e+00f, 9.807852804e-01f, 9.238795325e-01f, 8.314696123e-01f, 7.071067812e-01f, 5.555702330e-01f, 3.826834324e-01f, 1.950903220e-01f, 6.123233996e-17f, -1.950903220e-01f, -3.826834324e-01f, -5.555702330e-01f, -7.071067812e-01f, -8.314696123e-01f, -9.238795325e-01f, -9.807852804e-01f};
    constexpr float ST[16] = {0.000000000e+00f, 1.950903220e-01f, 3.826834324e-01f, 5.555702330e-01f, 7.071067812e-01f, 8.314696123e-01f, 9.238795325e-01f, 9.807852804e-01f, 1.000000000e+00f, 9.807852804e-01f, 9.238795325e-01f, 8.314696123e-01f, 7.071067812e-01f, 5.555702330e-01f, 3.826834324e-01f, 1.950903220e-01f};
    c16 r;
    if (e == 0) return d;
    if (e == 8) { if (INV) { r.x = -d.y; r.y = d.x; } else { r.x = d.y; r.y = -d.x; } return r; }
    const _Float16 c = (_Float16)CT[e], s = (_Float16)(INV ? -ST[e] : ST[e]);
    c16 cc; cc.x = c; cc.y = c; c16 ss; ss.x = s; ss.y = s; c16 dt; dt.x = d.y; dt.y = -d.x;
    return d * cc + dt * ss;
}
template <int R, bool INV> struct DFTH {
    static __device__ __forceinline__ void run(c16 (&x)[R]) {
        c16 u[R / 2], v[R / 2];
#pragma unroll
        for (int k = 0; k < R / 2; ++k) { const c16 p = x[k], q = x[k + R / 2]; u[k] = p + q; v[k] = twc<INV>(p - q, k * (32 / R)); }
        DFTH<R / 2, INV>::run(u); DFTH<R / 2, INV>::run(v);
#pragma unroll
        for (int q = 0; q < R / 2; ++q) { x[2 * q] = u[q]; x[2 * q + 1] = v[q]; }
    }
};
template <bool INV> struct DFTH<1, INV> { static __device__ __forceinline__ void run(c16 (&)[1]) {} };
template <bool CONJ, int STRIDE> __device__ __forceinline__ void tw_apply16h(c16 (&x)[16], const LAS c16* T) {
#pragma unroll
    for (int q = 1; q < 16; ++q) { const c16 wh = T[q * STRIDE]; x[q] = CONJ ? cmulc16(x[q], wh) : cmul16(x[q], wh); }
}
#define SWZ(p) ((p) + ((p) >> 5))
constexpr int FBUF = 8448;
template <bool CONJ> __device__ __forceinline__ void tw_apply16(f32x2_t (&x)[16], f32x2_t w1) {
    f32x2_t w = w1;
#pragma unroll
    for (int q = 1; q < 16; ++q) { x[q] = CONJ ? cmulc(x[q], w) : cmul(x[q], w); if (q < 15) w = cmul(w, w1); }
}
constexpr int LT_P1 = 67584, LT_P2 = LT_P1 + 32768, LT_WN = LT_P2 + 2048;
static_assert(LT_WN + 8448 * 4 <= RING_BYTES, "fft tables");
__device__ __forceinline__ void fft_tables_init(LAS unsigned char* L, int tid) {
    LAS c16* P1 = (LAS c16*)(L + LT_P1); LAS c16* P2 = (LAS c16*)(L + LT_P2); LAS c16* WN = (LAS c16*)(L + LT_WN);
#pragma unroll 4
    for (int q = 0; q < 16; ++q) { float s, c; sincospif((float)(tid * q) * (1.0f / 4096.0f), &s, &c); c16 w; w.x = (_Float16)c; w.y = (_Float16)(-s); P1[q * 512 + tid] = w; }
    { const int q = tid >> 5, j = tid & 31; float s, c; sincospif((float)(j * q) * (1.0f / 256.0f), &s, &c); c16 w; w.x = (_Float16)c; w.y = (_Float16)(-s); P2[q * 32 + j] = w; }
#pragma unroll 4
    for (int i = 0; i < 16; ++i) { const int n = 16 * tid + i; float s, c; sincospif((float)n * (1.0f / 8192.0f), &s, &c); c16 w; w.x = (_Float16)c; w.y = (_Float16)(-s); WN[n + (n >> 5)] = w; }
    __syncthreads();
}
#define OPAQUE(v) asm volatile("" : "+v"(v))
__device__ __forceinline__ void fwd_pass1(LAS f32x2_t* buf, const LAS f32x2_t* TW, int tid) {
    OPAQUE(tid);
    LAS f32x2_t* b0 = buf + tid + (tid >> 5);
    f32x2_t x[16];
#pragma unroll
    for (int m = 0; m < 16; ++m) x[m] = b0[528 * m];
    DFT<16, false>::run(x); tw_apply16<false>(x, TW[tid]);
#pragma unroll
    for (int q = 0; q < 16; ++q) b0[528 * q] = x[q];
}
__device__ __forceinline__ void fwd_pass2(LAS f32x2_t* buf, const LAS f32x2_t* TW, int tid) {
    OPAQUE(tid);
    LAS f32x2_t* b0 = buf + (tid >> 5) * 528 + (tid & 31);
    f32x2_t x[16];
#pragma unroll
    for (int m = 0; m < 16; ++m) x[m] = b0[33 * m];
    DFT<16, false>::run(x); tw_apply16<false>(x, TW[16 * (tid & 31)]);
#pragma unroll
    for (int q = 0; q < 16; ++q) b0[33 * q] = x[q];
}
__device__ __forceinline__ void inv_pass2(LAS f32x2_t* buf, const LAS f32x2_t* TW, int tid) {
    OPAQUE(tid);
    LAS f32x2_t* b0 = buf + (tid >> 5) * 528 + (tid & 31);
    f32x2_t x[16];
#pragma unroll
    for (int q = 0; q < 16; ++q) x[q] = b0[33 * q];
    tw_apply16<true>(x, TW[16 * (tid & 31)]); DFT<16, true>::run(x);
#pragma unroll
    for (int m = 0; m < 16; ++m) b0[33 * m] = x[m];
}
__device__ __forceinline__ void inv_pass1(LAS f32x2_t* buf, const LAS f32x2_t* TW, int tid) {
    OPAQUE(tid);
    LAS f32x2_t* b0 = buf + tid + (tid >> 5);
    f32x2_t x[16];
#pragma unroll
    for (int q = 0; q < 16; ++q) x[q] = b0[528 * q];
    tw_apply16<true>(x, TW[tid]); DFT<16, true>::run(x);
#pragma unroll
    for (int m = 0; m < 16; ++m) b0[528 * m] = x[m];
}
__device__ __forceinline__ void fft2_forward(LAS unsigned char* L) {
    const int tid = threadIdx.x;
    LAS f32x2_t* bufE = (LAS f32x2_t*)L; LAS f32x2_t* bufO = bufE + FBUF; const LAS f32x2_t* TW = (const LAS f32x2_t*)(L + LC_TW);
    fwd_pass1(bufE, TW, tid); fwd_pass1(bufO, TW, tid);
    __syncthreads();
    fwd_pass2(bufE, TW, tid); fwd_pass2(bufO, TW, tid);
    __syncthreads();
}
template <int MODE>
__device__ __forceinline__ void fft2_middle(LAS unsigned char* L, unsigned* specblk) {
    int tid = threadIdx.x; OPAQUE(tid); const int bsel = tid >> 8, blk = tid & 255;
    LAS f32x2_t* buf = (LAS f32x2_t*)L + (bsel ? FBUF : 0);
    f32x2_t x[32];
    LAS f32x2_t* bm = buf + 33 * blk;
#pragma unroll
    for (int q = 0; q < 32; ++q) x[q] = bm[q];
    DFT<32, false>::run(x);
    unsigned* sp = specblk + (size_t)bsel * 8192 + 32 * blk;
    if (MODE == 0) {
#pragma unroll
        for (int q = 0; q < 32; q += 4) { v4u w;
            { f16x2_t h; h.x = (_Float16)(16.0f * x[q].x); h.y = (_Float16)(16.0f * x[q].y); w.x = __builtin_bit_cast(unsigned, h); }
            { f16x2_t h; h.x = (_Float16)(16.0f * x[q + 1].x); h.y = (_Float16)(16.0f * x[q + 1].y); w.y = __builtin_bit_cast(unsigned, h); }
            { f16x2_t h; h.x = (_Float16)(16.0f * x[q + 2].x); h.y = (_Float16)(16.0f * x[q + 2].y); w.z = __builtin_bit_cast(unsigned, h); }
            { f16x2_t h; h.x = (_Float16)(16.0f * x[q + 3].x); h.y = (_Float16)(16.0f * x[q + 3].y); w.w = __builtin_bit_cast(unsigned, h); }
            *(v4u*)(sp + q) = w; }
    } else {
#pragma unroll
        for (int q = 0; q < 32; q += 4) { const v4u w = *(const v4u*)(sp + q);
            const unsigned w0 = w.x, w1 = w.y, w2 = w.z, w3 = w.w;
            x[q] = cmul(x[q], h2_to_f2(w0)); x[q + 1] = cmul(x[q + 1], h2_to_f2(w1)); x[q + 2] = cmul(x[q + 2], h2_to_f2(w2)); x[q + 3] = cmul(x[q + 3], h2_to_f2(w3)); }
        DFT<32, true>::run(x);
#pragma unroll
        for (int q = 0; q < 32; ++q) bm[q] = x[q];
    }
    __syncthreads();
}
__device__ __forceinline__ void fft2_inverse(LAS unsigned char* L) {
    const int tid = threadIdx.x;
    LAS f32x2_t* bufE = (LAS f32x2_t*)L; LAS f32x2_t* bufO = bufE + FBUF; const LAS f32x2_t* TW = (const LAS f32x2_t*)(L + LC_TW);
    inv_pass2(bufE, TW, tid); inv_pass2(bufO, TW, tid);
    __syncthreads();
    inv_pass1(bufE, TW, tid); inv_pass1(bufO, TW, tid);
}

__device__ __forceinline__ void fwd_pass1h(LAS c16* buf, const LAS c16* TW, int tid) {
    OPAQUE(tid);
    LAS c16* b0 = buf + tid + (tid >> 5);
    c16 x[16];
#pragma unroll
    for (int m = 0; m < 16; ++m) x[m] = b0[528 * m];
    DFTH<16, false>::run(x); tw_apply16h<false, 512>(x, TW + tid);
#pragma unroll
    for (int q = 0; q < 16; ++q) b0[528 * q] = x[q];
}
__device__ __forceinline__ void fwd_pass2h(LAS c16* buf, const LAS c16* TW, int tid) {
    OPAQUE(tid);
    LAS c16* b0 = buf + (tid >> 5) * 528 + (tid & 31);
    c16 x[16];
#pragma unroll
    for (int m = 0; m < 16; ++m) x[m] = b0[33 * m];
    DFTH<16, false>::run(x); tw_apply16h<false, 32>(x, TW + (tid & 31));
#pragma unroll
    for (int q = 0; q < 16; ++q) b0[33 * q] = x[q];
}
__device__ __forceinline__ void inv_pass2h(LAS c16* buf, const LAS c16* TW, int tid) {
    OPAQUE(tid);
    LAS c16* b0 = buf + (tid >> 5) * 528 + (tid & 31);
    c16 x[16];
#pragma unroll
    for (int q = 0; q < 16; ++q) x[q] = b0[33 * q];
    tw_apply16h<true, 32>(x, TW + (tid & 31)); DFTH<16, true>::run(x);
    c16 sc; sc.x = (_Float16)0.0625f; sc.y = (_Float16)0.0625f;
#pragma unroll
    for (int m = 0; m < 16; ++m) b0[33 * m] = x[m] * sc;
}
__device__ __forceinline__ void inv_pass1h(LAS c16* buf, const LAS c16* TW, int tid) {
    OPAQUE(tid);
    LAS c16* b0 = buf + tid + (tid >> 5);
    c16 x[16];
#pragma unroll
    for (int q = 0; q < 16; ++q) x[q] = b0[528 * q];
    tw_apply16h<true, 512>(x, TW + tid); DFTH<16, true>::run(x);
#pragma unroll
    for (int m = 0; m < 16; ++m) b0[528 * m] = x[m];
}
__device__ __forceinline__ void fft2h_forward(LAS unsigned char* L) {
    const int tid = threadIdx.x;
    LAS c16* bufE = (LAS c16*)L; LAS c16* bufO = bufE + FBUF; const LAS c16* P1 = (const LAS c16*)(L + LT_P1); const LAS c16* P2 = (const LAS c16*)(L + LT_P2);
    fwd_pass1h(bufE, P1, tid); fwd_pass1h(bufO, P1, tid);
    __syncthreads();
    fwd_pass2h(bufE, P2, tid); fwd_pass2h(bufO, P2, tid);
    __syncthreads();
}
__device__ __forceinline__ void fft2h_middle(LAS unsigned char* L, const unsigned* specblk) {
    int tid = threadIdx.x; OPAQUE(tid); const int bsel = tid >> 8, blk = tid & 255;
    LAS c16* bm = (LAS c16*)L + (bsel ? FBUF : 0) + 33 * blk;
    c16 x[32];
#pragma unroll
    for (int q = 0; q < 32; ++q) x[q] = bm[q];
    DFTH<32, false>::run(x);
    const unsigned* sp = specblk + (size_t)bsel * 8192 + 32 * blk;
#pragma unroll
    for (int q = 0; q < 32; q += 4) { const v4u w = *(const v4u*)(sp + q);
        const unsigned w0 = w.x, w1 = w.y, w2 = w.z, w3 = w.w;
        x[q] = cmul16(x[q], __builtin_bit_cast(c16, w0)); x[q + 1] = cmul16(x[q + 1], __builtin_bit_cast(c16, w1));
        x[q + 2] = cmul16(x[q + 2], __builtin_bit_cast(c16, w2)); x[q + 3] = cmul16(x[q + 3], __builtin_bit_cast(c16, w3)); }
    DFTH<32, true>::run(x);
    c16 sc; sc.x = (_Float16)0.0625f; sc.y = (_Float16)0.0625f;
#pragma unroll
    for (int q = 0; q < 32; ++q) bm[q] = x[q] * sc;
    __syncthreads();
}

__device__ __forceinline__ void fft2h_middle_store(LAS unsigned char* L, unsigned* specblk) {
    int tid = threadIdx.x; OPAQUE(tid); const int bsel = tid >> 8, blk = tid & 255;
    LAS c16* bm = (LAS c16*)L + (bsel ? FBUF : 0) + 33 * blk;
    c16 x[32];
#pragma unroll
    for (int q = 0; q < 32; ++q) x[q] = bm[q];
    DFTH<32, false>::run(x);
    c16 sc; sc.x = (_Float16)(1.0f / 256.0f); sc.y = (_Float16)(1.0f / 256.0f);
    unsigned* sp = specblk + (size_t)bsel * 8192 + 32 * blk;
#pragma unroll
    for (int q = 0; q < 32; q += 4) { v4u w;
        { const c16 h = x[q] * sc; w.x = __builtin_bit_cast(unsigned, h); } { const c16 h = x[q + 1] * sc; w.y = __builtin_bit_cast(unsigned, h); }
        { const c16 h = x[q + 2] * sc; w.z = __builtin_bit_cast(unsigned, h); } { const c16 h = x[q + 3] * sc; w.w = __builtin_bit_cast(unsigned, h); }
        *(v4u*)(sp + q) = w; }
    __syncthreads();
}
__device__ __forceinline__ void fft2h_inverse(LAS unsigned char* L) {
    const int tid = threadIdx.x;
    LAS c16* bufE = (LAS c16*)L; LAS c16* bufO = bufE + FBUF; const LAS c16* P1 = (const LAS c16*)(L + LT_P1); const LAS c16* P2 = (const LAS c16*)(L + LT_P2);
    inv_pass2h(bufE, P2, tid); inv_pass2h(bufO, P2, tid);
    __syncthreads();
    inv_pass1h(bufE, P1, tid); inv_pass1h(bufO, P1, tid);
}
__device__ __forceinline__ f32x2_t wn16384(const LAS f32x2_t* TA, f32x2_t wb, int tid, int m) { return cmul(TA[(tid >> 6) + 8 * m], wb); }
__device__ __forceinline__ float hy_conv3(const bf16* row, float w0, float w1, float w2, float bias, int n) {
    const int nm = n > 0 ? n - 1 : 0, np = n < SEQ - 1 ? n + 1 : SEQ - 1;
    const float wl = n > 0 ? w0 : 0.f, wr = n < SEQ - 1 ? w2 : 0.f;
    return bias + w1 * bf2f(row[n]) + wl * bf2f(row[nm]) + wr * bf2f(row[np]);
}

__device__ __forceinline__ void load_conv16(const bf16* row, int n0, float w0, float w1, float w2, float bias, float (&out)[16]) {
    const v4u a = *(const v4u*)(row + n0), b = *(const v4u*)(row + n0 + 8);
    const int nl = n0 > 0 ? n0 - 1 : 0, nr = n0 + 16 < SEQ ? n0 + 16 : SEQ - 1;
    const float ul = n0 > 0 ? bf2f(row[nl]) : 0.f, ur = n0 + 16 < SEQ ? bf2f(row[nr]) : 0.f;
    const unsigned a0 = a.x, a1 = a.y, a2 = a.z, a3 = a.w, b0 = b.x, b1 = b.y, b2 = b.z, b3 = b.w;
    float u[18];
    u[0] = ul; u[17] = ur;
    u[1] = __uint_as_float(a0 << 16); u[2] = __uint_as_float(a0 & 0xffff0000u); u[3] = __uint_as_float(a1 << 16); u[4] = __uint_as_float(a1 & 0xffff0000u);
    u[5] = __uint_as_float(a2 << 16); u[6] = __uint_as_float(a2 & 0xffff0000u); u[7] = __uint_as_float(a3 << 16); u[8] = __uint_as_float(a3 & 0xffff0000u);
    u[9] = __uint_as_float(b0 << 16); u[10] = __uint_as_float(b0 & 0xffff0000u); u[11] = __uint_as_float(b1 << 16); u[12] = __uint_as_float(b1 & 0xffff0000u);
    u[13] = __uint_as_float(b2 << 16); u[14] = __uint_as_float(b2 & 0xffff0000u); u[15] = __uint_as_float(b3 << 16); u[16] = __uint_as_float(b3 & 0xffff0000u);
#pragma unroll
    for (int i = 0; i < 16; ++i) out[i] = bias + w0 * u[i] + w1 * u[i + 1] + w2 * u[i + 2];
}
__device__ __forceinline__ void load_f16x16(const _Float16* p, float (&out)[16]) {
    const v4u a = *(const v4u*)p, b = *(const v4u*)(p + 8);
    const unsigned w[8] = {a.x, a.y, a.z, a.w, b.x, b.y, b.z, b.w};
#pragma unroll
    for (int i = 0; i < 8; ++i) { const f32x2_t k = h2_to_f2(w[i]); out[2 * i] = k.x; out[2 * i + 1] = k.y; }
}
__device__ __forceinline__ void load_f32x16(const float* p, float (&out)[16]) {
#pragma unroll
    for (int i = 0; i < 4; ++i) { const float4 v = *(const float4*)(p + 4 * i); out[4 * i] = v.x; out[4 * i + 1] = v.y; out[4 * i + 2] = v.z; out[4 * i + 3] = v.w; }
}
__device__ __forceinline__ void filter_item(LAS unsigned char* L, const Args& a, int c, const _Float16* hT, unsigned* spec, int tid, int lane, int wave) {
    LAS f32x2_t* bufE = (LAS f32x2_t*)L; LAS f32x2_t* bufO = bufE + FBUF;
    LAS float* red = (LAS float*)(L + LC_RED); LAS float* sc = (LAS float*)L;
    const int n0 = 16 * tid;
#pragma unroll 1
    for (int o = 0; o < 2; ++o) {
        float hfv[16], hbv[16];
        load_f16x16(hT + (size_t)(o * 512 + c) * SEQ + n0, hfv);
        load_f16x16(hT + (size_t)(1024 + o * 512 + c) * SEQ + n0, hbv);
        float s = 0.f;
#pragma unroll
        for (int i = 0; i < 16; ++i) { s += fabsf(hfv[i]) + ((n0 + i) > 0 ? fabsf(hbv[i]) : 0.f); sc[n0 + i] = hbv[i]; }
        s = wave_sum(s);
        if (lane == 0) red[wave] = s;
        __syncthreads();
        float tot = 0.f;
#pragma unroll
        for (int i = 0; i < 8; ++i) tot += red[i];
        const float inv = 1.0f / (tot + EPS);
        float ev[16], dv[16];
#pragma unroll
        for (int i = 0; i < 16; ++i) { const int n = n0 + i; const float hbm = n > 0 ? sc[SEQ - n] : 0.f; ev[i] = (hfv[i] + hbm) * inv; dv[i] = (hfv[i] - hbm) * inv; }
        __syncthreads();
        { LAS c16* hE = (LAS c16*)L; LAS c16* hO = hE + FBUF; const LAS c16* WN = (const LAS c16*)(L + LT_WN); const int lb = 16 * tid + (tid >> 1);
#pragma unroll
          for (int i = 0; i < 16; ++i) { c16 xe; xe.x = (_Float16)(ev[i] * 4096.0f); xe.y = (_Float16)0.0f; const _Float16 dh = (_Float16)(dv[i] * 4096.0f); c16 dd; dd.x = dh; dd.y = dh;
              hE[lb + i] = xe; hO[lb + i] = WN[lb + i] * dd; } }
        __syncthreads();
        fft2h_forward(L);
        fft2h_middle_store(L, spec + (size_t)(o * 512 + c) * 16384);
    }
}
__device__ __forceinline__ void hyena_pass(int O, LAS unsigned char* L, const Args& a, int c, int bp, const bf16* hyuT, unsigned* spec, int tid, float (&xa)[16], float (&xb)[16]) {
    LAS c16* bufE = (LAS c16*)L; LAS c16* bufO = bufE + FBUF; const LAS c16* WN = (const LAS c16*)(L + LT_WN);
    const float* cw = a.in[15]; const float* cb = a.in[16];
    const int n0 = 16 * tid;
    const int lb = 16 * tid + (tid >> 1);
#pragma unroll
    for (int i = 0; i < 16; ++i) { c16 x; x.x = (_Float16)(xa[i] * 0.0625f); x.y = (_Float16)(xb[i] * 0.0625f); bufE[lb + i] = x; bufO[lb + i] = cmul16(x, WN[lb + i]); }
    __syncthreads();
    fft2h_forward(L);
    fft2h_middle(L, spec + (size_t)(O * 512 + c) * 16384);
    fft2h_inverse(L);
    __syncthreads();
    const int grow = (O ? 1024 : 512) + c;
    const float w0 = cw[grow], w1 = cw[1536 + grow], w2 = cw[3072 + grow], bs = cb[grow];
    const float skip = a.in[24][O * 512 + c];
    const bf16* g0 = hyuT + (size_t)grow * NTOK + (size_t)(2 * bp) * SEQ; const bf16* g1 = g0 + SEQ;
    float ga[16], gb[16];
    load_conv16(g0, n0, w0, w1, w2, bs, ga); load_conv16(g1, n0, w0, w1, w2, bs, gb);
#pragma unroll
    for (int i = 0; i < 16; ++i) {
        const c16 he = bufE[lb + i], yo = cmulc16(bufO[lb + i], WN[lb + i]); f32x2_t y; y.x = ((float)he.x + (float)yo.x) * (1.0f / 64.0f); y.y = ((float)he.y + (float)yo.y) * (1.0f / 64.0f);
        xa[i] = ga[i] * (y.x + skip * xa[i]); xb[i] = gb[i] * (y.y + skip * xb[i]); }
    __syncthreads();
}
__device__ __forceinline__ void hyena_item(LAS unsigned char* L, const Args& a, int c, int bp, const bf16* hyuT, unsigned* spec, bf16* y_hyT, int tid) {
    const float* cw = a.in[15]; const float* cb = a.in[16];
    const size_t seq0 = (size_t)c * NTOK + (size_t)(2 * bp) * SEQ;
    const int n0 = 16 * tid;
    float xa[16], xb[16];
    load_conv16(hyuT + seq0, n0, cw[c], cw[1536 + c], cw[3072 + c], cb[c], xa); load_conv16(hyuT + seq0 + SEQ, n0, cw[c], cw[1536 + c], cw[3072 + c], cb[c], xb);
#pragma unroll 1
    for (int O = 0; O < 2; ++O) hyena_pass(O, L, a, c, bp, hyuT, spec, tid, xa, xb);
    bf16* o0 = y_hyT + seq0; bf16* o1 = o0 + SEQ;
    v4u p0, p1, q0, q1;
    p0.x = pk2(xa[0], xa[1]); p0.y = pk2(xa[2], xa[3]); p0.z = pk2(xa[4], xa[5]); p0.w = pk2(xa[6], xa[7]); p1.x = pk2(xa[8], xa[9]); p1.y = pk2(xa[10], xa[11]); p1.z = pk2(xa[12], xa[13]); p1.w = pk2(xa[14], xa[15]);
    q0.x = pk2(xb[0], xb[1]); q0.y = pk2(xb[2], xb[3]); q0.z = pk2(xb[4], xb[5]); q0.w = pk2(xb[6], xb[7]); q1.x = pk2(xb[8], xb[9]); q1.y = pk2(xb[10], xb[11]); q1.z = pk2(xb[12], xb[13]); q1.w = pk2(xb[14], xb[15]);
    *(v4u*)(o0 + n0) = p0; *(v4u*)(o0 + n0 + 8) = p1; *(v4u*)(o1 + n0) = q0; *(v4u*)(o1 + n0 + 8) = q1;
}

__global__ void __launch_bounds__(NWAVES * 64, 2) fwd(Args a) {
    extern __shared__ __attribute__((aligned(16))) unsigned char lds_raw[];
    LAS unsigned char* L = (LAS unsigned char*)lds_raw;
    volatile LAS unsigned* MISC = (volatile LAS unsigned*)(L + MISC_OFF);
    const int tid = threadIdx.x, lane = tid & 63, wave = __builtin_amdgcn_readfirstlane(tid >> 6);
    const int G = gridDim.x, bid = blockIdx.x;
    unsigned char* ws = a.ws;
    unsigned* ctl = (unsigned*)ws;
    for (int u = tid; u < (LDS_BYTES - LDSCTL_OFF) / 4; u += NWAVES * 64) ((LAS unsigned*)(L + LDSCTL_OFF))[u] = 0u;
    __syncthreads();
    const int lo = a.ph_lo, hi = a.ph_hi;
    XcdBarrier bar; bar.bar = ctl + CW_BAR + a.li * XCD_BAR_WORDS; bar.x = 0; bar.st = nullptr;
    bar = xcd_barrier_post(ctl + CW_BAR + a.li * XCD_BAR_WORDS, MISC + 8);
#define IN(k) (lo <= (k) && (k) < hi)
#define BOTH(k) (IN(k) && IN((k) + 1))
#ifndef DUP_BAR
#define DUP_BAR 1
#endif
#define GRID_BAR() do { xcd_barrier(bar); if (DUP_BAR > 1) xcd_barrier(bar); } while (0)

    bf16* WinT = (bf16*)(ws + WS_WINT); bf16* WoutT = (bf16*)(ws + WS_WOUTT);
    bf16* hn1 = (bf16*)(ws + WS_HN1); bf16* lru = (bf16*)(ws + WS_LRU); bf16* hyuT = (bf16*)(ws + WS_HYUT);
    bf16* y_cat = (bf16*)(ws + WS_YCAT);
    bf16* W13T = (bf16*)(ws + WS_W13T); bf16* W2T = (bf16*)(ws + WS_W2T); bf16* WrT = (bf16*)(ws + WS_WRT);
    bf16* hn2 = (bf16*)(ws + WS_HN2); bf16* xmidb = (bf16*)(ws + WS_XMID); int* list = (int*)(ws + WS_LIST); float* lgate = (float*)(ws + WS_LGATE); int4* tokinfo = (int4*)(ws + WS_TOKINFO);
    bf16* xs = (bf16*)(ws + WS_XS); (void)xs; bf16* Hb = (bf16*)(ws + WS_H); bf16* Yb = (bf16*)(ws + WS_Y);
    const int gw = bid * NWAVES + wave, NGW = G * NWAVES;

    if (IN(0)) {
#ifndef DUP_P0
#define DUP_P0 1
#endif
        for (int rep0 = 0; rep0 < DUP_P0; ++rep0) {
        LAS float* scr = (LAS float*)(L + wave * 16384);
        constexpr int I_IN = (DM / 64) * (DIN / 32), I_OUT = (DM / 64) * (DM / 32), I_EXP = 768;
        for (int it = gw; it < I_IN + I_OUT + 32 * I_EXP; it += NGW) {
            if (it < I_IN) { const int nblk = DIN / 32, kb = it / nblk, nb = it % nblk; p0_transpose_item(a.in[2], DM, DIN, WinT, 32 * nb, scr, 64 * kb, 32 * nb, lane); }
            else if (it < I_IN + I_OUT) { const int r = it - I_IN; const int nblk = DM / 32, kb = r / nblk, nb = r % nblk; p0_transpose_item(a.in[27], DM, DM, WoutT, 32 * nb, scr, 64 * kb, 32 * nb, lane); }
            else { const int r = it - I_IN - I_OUT, e = r / I_EXP, q = r % I_EXP;
                if (q < 512) { const int w3 = q >> 8, qq = q & 255, kb = qq >> 4, nb = qq & 15, n0 = 32 * nb;
                    p0_transpose_item(a.in[w3 ? 34 : 33] + (size_t)e * 1024 * 512, 1024, 512, W13T, e * 1024 + (n0 >> 7) * 256 + (n0 & 127) + w3 * 128, scr, 64 * kb, n0, lane); }
                else { const int qq = q - 512, kb = qq >> 5, nb = qq & 31;
                    p0_transpose_item(a.in[35] + (size_t)e * 512 * 1024, 512, 1024, W2T, e * 1024 + 32 * nb, scr, 64 * kb, 32 * nb, lane); } }
        }
        for (int idx = bid * (NWAVES * 64) + tid; idx < 48 * 1024; idx += G * NWAVES * 64) { const int j = idx >> 10, k = idx & 1023;
            WrT[idx] = j < 4 ? f2bf(a.in[29][k * 4 + j]) : (j < 36 ? f2bf(a.in[31][k * 32 + (j - 4)]) : (bf16)0); }
        { _Float16* hT = (_Float16*)(ws + WS_HT);
          const float* w1 = a.in[17]; const float* b1 = a.in[18]; const float* f1 = a.in[19]; const float* w2 = a.in[20]; const float* b2 = a.in[21]; const float* f2 = a.in[22]; const float* w3 = a.in[23];
          LAS float* w3s = (LAS float*)L;
          LAS float* z2s = (LAS float*)(L + 65536);
          LAS float* fts = (LAS float*)(L + 73728);
          LAS float* ot  = (LAS float*)(L + 81920);
          for (int tile = bid; tile < SEQ / 32; tile += G) {
              __syncthreads();
              { const int tl = tid & 31, i = tid >> 5; const int t = tile * 32 + tl;
                const float wq = (6.283185307179586f / (float)SEQ) * (float)t; const float band = 1e-4f + (float)i * ((15.0f - 1e-4f) / 15.0f);
                fts[(1 + i) * 32 + tl] = cosf(wq * band); fts[(17 + i) * 32 + tl] = sinf(wq * band);
                if (i == 0) fts[tl] = (float)t / (float)(SEQ - 1); }
              __syncthreads();
              const int tl4 = tid & 31, jq = tid >> 5;
              { float s0 = b1[4 * jq], s1 = b1[4 * jq + 1], s2 = b1[4 * jq + 2], s3 = b1[4 * jq + 3];
#pragma unroll 3
                for (int i = 0; i < 33; ++i) { const float fv = fts[i * 32 + tl4]; const float4 wv = *(const float4*)(w1 + i * 64 + 4 * jq); s0 += fv * wv.x; s1 += fv * wv.y; s2 += fv * wv.z; s3 += fv * wv.w; }
                const float4 fq = *(const float4*)(f1 + 4 * jq);
                s0 = sinf(fq.x * s0); s1 = sinf(fq.y * s1); s2 = sinf(fq.z * s2); s3 = sinf(fq.w * s3);
                __syncthreads();
                fts[(4 * jq) * 32 + tl4] = s0; fts[(4 * jq + 1) * 32 + tl4] = s1; fts[(4 * jq + 2) * 32 + tl4] = s2; fts[(4 * jq + 3) * 32 + tl4] = s3; }
              __syncthreads();
              { float s0 = b2[4 * jq], s1 = b2[4 * jq + 1], s2 = b2[4 * jq + 2], s3 = b2[4 * jq + 3];
#pragma unroll 4
                for (int i = 0; i < 64; ++i) { const float zv = fts[i * 32 + tl4]; const float4 wv = *(const float4*)(w2 + i * 64 + 4 * jq); s0 += zv * wv.x; s1 += zv * wv.y; s2 += zv * wv.z; s3 += zv * wv.w; }
                const float4 fq = *(const float4*)(f2 + 4 * jq);
                z2s[(4 * jq) * 32 + tl4] = sinf(fq.x * s0); z2s[(4 * jq + 1) * 32 + tl4] = sinf(fq.y * s1); z2s[(4 * jq + 2) * 32 + tl4] = sinf(fq.z * s2); z2s[(4 * jq + 3) * 32 + tl4] = sinf(fq.w * s3); }
              __syncthreads();
              const float lo_ = logf(1e-2f) / 1.5f, hi_ = logf(1e-2f) / 0.3f;
              typedef float f32x16_t __attribute__((ext_vector_type(16)));
              bf16x8_t Az[4];
              { const int tr = lane & 31, kg2 = lane >> 5;
#pragma unroll
                for (int s = 0; s < 4; ++s) { v4u pk;
                    pk.x = pk2(z2s[(16 * s + 8 * kg2 + 0) * 32 + tr], z2s[(16 * s + 8 * kg2 + 1) * 32 + tr]); pk.y = pk2(z2s[(16 * s + 8 * kg2 + 2) * 32 + tr], z2s[(16 * s + 8 * kg2 + 3) * 32 + tr]);
                    pk.z = pk2(z2s[(16 * s + 8 * kg2 + 4) * 32 + tr], z2s[(16 * s + 8 * kg2 + 5) * 32 + tr]); pk.w = pk2(z2s[(16 * s + 8 * kg2 + 6) * 32 + tr], z2s[(16 * s + 8 * kg2 + 7) * 32 + tr]);
                    Az[s] = __builtin_bit_cast(bf16x8_t, pk); } }
              LAS unsigned char* wt = L;
              for (int chunk = 0; chunk < 8; ++chunk) {
                  __syncthreads();
#pragma unroll 4
                  for (int r = 0; r < 8; ++r) { const int q = tid + 512 * r; const int j = q >> 6, c4 = q & 63;
                      const f32x4_t wv = *(const f32x4_t*)(w3 + (size_t)j * 2048 + chunk * 256 + 4 * c4);
                      LAS bf16* d = (LAS bf16*)(wt + (4 * c4) * 144 + 2 * j);
                      d[0] = f2bf(wv.x); d[72] = f2bf(wv.y); d[144] = f2bf(wv.z); d[216] = f2bf(wv.w); }
                  __syncthreads();
                  { const int cl = wave * 32 + (lane & 31), kg2 = lane >> 5;
                    f32x16_t acc = {0.f, 0.f, 0.f, 0.f, 0.f, 0.f, 0.f, 0.f, 0.f, 0.f, 0.f, 0.f, 0.f, 0.f, 0.f, 0.f};
#pragma unroll
                    for (int s = 0; s < 4; ++s) { const bf16x8_t Bw = *(const LAS bf16x8_t*)(wt + cl * 144 + (16 * s + 8 * kg2) * 2);
                        acc = __builtin_amdgcn_mfma_f32_32x32x16_bf16(Az[s], Bw, acc, 0, 0, 0); }
                    const int col = chunk * 256 + cl; const int cc = col & 511;
                    const float delta = fabsf(lo_ + (float)cc * ((hi_ - lo_) / 511.0f));
#pragma unroll
                    for (int g4 = 0; g4 < 4; ++g4) { const int tl = 8 * g4 + 4 * kg2;
                        const int t0 = tile * 32 + tl;
                        f16x2_t h01, h23;
                        h01.x = (_Float16)(acc[4 * g4 + 0] * 64.0f * __expf(-((float)(t0 + 0) / (float)(SEQ - 1)) * delta)); h01.y = (_Float16)(acc[4 * g4 + 1] * 64.0f * __expf(-((float)(t0 + 1) / (float)(SEQ - 1)) * delta));
                        h23.x = (_Float16)(acc[4 * g4 + 2] * 64.0f * __expf(-((float)(t0 + 2) / (float)(SEQ - 1)) * delta)); h23.y = (_Float16)(acc[4 * g4 + 3] * 64.0f * __expf(-((float)(t0 + 3) / (float)(SEQ - 1)) * delta));
                        uint2 o; o.x = __builtin_bit_cast(unsigned, h01); o.y = __builtin_bit_cast(unsigned, h23);
                        *(uint2*)(hT + (size_t)col * SEQ + t0) = o; } }
              }
          } }
        __syncthreads();
        for (int m = gw; m < NTOK; m += NGW) rms_row_to_bf16(a.in[0] + (size_t)m * DM, a.in[1], hn1 + (size_t)m * DM, lane);
        }
        if (BOTH(0)) GRID_BAR();
    }
    if (IN(1)) {
#ifndef DUP_G1
#define DUP_G1 1
#endif
        { pg8::Gemm g{hn1, WinT, NTOK, 1024, DM}; pg8::StaticOrder S; S.init(NTOK, 1024, G, bid);
          pg8::EpiBf16<0> E{lru, 1024, nullptr, 0, 0, 1.f};
          pg8::gemm_phase<pg8::EpiBf16<0>, pg8::StaticOrder, true, true>(L, g, S, E); }
        { pg8::Gemm g{WinT + (size_t)1024 * DM, hn1, 1536, NTOK, DM}; pg8::StaticOrder S; S.init(1536, NTOK, G, bid);
          pg8::EpiBf16<0> E{hyuT, NTOK, nullptr, 0, 0, 1.f};
          pg8::gemm_phase<pg8::EpiBf16<0>, pg8::StaticOrder, true, true>(L, g, S, E); }
#if DUP_G1 > 1
        { pg8::Gemm g{hn1, WinT, NTOK, 1024, DM}; pg8::StaticOrder S; S.init(NTOK, 1024, G, bid);
          pg8::EpiBf16<0> E{lru, 1024, nullptr, 0, 0, 1.f};
          pg8::gemm_phase<pg8::EpiBf16<0>, pg8::StaticOrder, true, true>(L, g, S, E); }
        { pg8::Gemm g{WinT + (size_t)1024 * DM, hn1, 1536, NTOK, DM}; pg8::StaticOrder S; S.init(1536, NTOK, G, bid);
          pg8::EpiBf16<0> E{hyuT, NTOK, nullptr, 0, 0, 1.f};
          pg8::gemm_phase<pg8::EpiBf16<0>, pg8::StaticOrder, true, true>(L, g, S, E); }
#endif
        if (BOTH(1)) GRID_BAR();
    }

    if (IN(2)) {
        bf16* hf = (bf16*)(ws + WS_HF); bf16* hb = (bf16*)(ws + WS_HB);
#ifndef DUP_LRU
#define DUP_LRU 1
#endif
#ifndef DUP_HY
#define DUP_HY 1
#endif
        { bf16* xcb = (bf16*)(ws + WS_XCB); const float* cwp = a.in[3]; const float* cbp = a.in[4];
          for (int idx = bid * (NWAVES * 64) + tid; idx < NTOK * 64; idx += G * NWAVES * 64) {
              const int tok = idx >> 6, c8 = (idx & 63) * 8, t = tok & (SEQ - 1), bb = tok >> 13;
              float acc[8];
              { const float4 c0 = *(const float4*)(cbp + c8), c1 = *(const float4*)(cbp + c8 + 4); acc[0] = c0.x; acc[1] = c0.y; acc[2] = c0.z; acc[3] = c0.w; acc[4] = c1.x; acc[5] = c1.y; acc[6] = c1.z; acc[7] = c1.w; }
#pragma unroll
              for (int tap = 0; tap < 4; ++tap) { const int tt = t + tap - 2; const bool ok = tt >= 0 && tt < SEQ; const int tc = ok ? tt : t;
                  const v4u xv = *(const v4u*)(lru + (size_t)(bb * SEQ + tc) * 1024 + c8);
                  const float4 w0 = *(const float4*)(cwp + tap * DL + c8), w1 = *(const float4*)(cwp + tap * DL + c8 + 4);
                  const float m = ok ? 1.f : 0.f; const unsigned x0 = xv.x, x1 = xv.y, x2 = xv.z, x3 = xv.w;
                  acc[0] += m * w0.x * __uint_as_float(x0 << 16); acc[1] += m * w0.y * __uint_as_float(x0 & 0xffff0000u);
                  acc[2] += m * w0.z * __uint_as_float(x1 << 16); acc[3] += m * w0.w * __uint_as_float(x1 & 0xffff0000u);
                  acc[4] += m * w1.x * __uint_as_float(x2 << 16); acc[5] += m * w1.y * __uint_as_float(x2 & 0xffff0000u);
                  acc[6] += m * w1.z * __uint_as_float(x3 << 16); acc[7] += m * w1.w * __uint_as_float(x3 & 0xffff0000u); }
              v4u pk; pk.x = pk2(acc[0], acc[1]); pk.y = pk2(acc[2], acc[3]); pk.z = pk2(acc[4], acc[5]); pk.w = pk2(acc[6], acc[7]);
              const int hh = c8 >> 6, cl = c8 & 63;
              *(v4u*)(xcb + (((size_t)(bb * 8 + hh) * SEQ + t) * 64 + cl)) = pk; } }
        GRID_BAR();
        for (int rep = 0; rep < DUP_LRU; ++rep)
        for (int item = bid; item < 256; item += G) lru_item(L, a, item, (const bf16*)(ws + WS_XCB), hf, hb, tid, lane, wave);
        __syncthreads();
        fft_tables_init(L, tid);
        for (int c = bid; c < DH; c += G) {
            filter_item(L, a, c, (const _Float16*)(ws + WS_HT), (unsigned*)(ws + WS_SPEC), tid, lane, wave);
            asm volatile("s_waitcnt vmcnt(0)" ::: "memory"); __syncthreads();
#pragma unroll 1
            for (int bp = 0; bp < 2; ++bp) hyena_item(L, a, c, bp, hyuT, (unsigned*)(ws + WS_SPEC), (bf16*)(ws + WS_YHYT), tid);
        }
        if (BOTH(2)) GRID_BAR();
    }

    if (IN(3)) {
        const bf16* hf = (const bf16*)(ws + WS_HF); const bf16* hb = (const bf16*)(ws + WS_HB); const bf16* y_hyT = (const bf16*)(ws + WS_YHYT);
        const float* gA = a.in[25]; const float* gB = a.in[26];
#ifndef DUP_P3
#define DUP_P3 1
#endif
        for (int rep3 = 0; rep3 < DUP_P3; ++rep3) {
        for (int tok = gw; tok < NTOK; tok += NGW) {
            const v4u vf = *(const v4u*)(hf + (size_t)tok * DL + 8 * lane), vb = *(const v4u*)(hb + (size_t)tok * DL + 8 * lane), vg = *(const v4u*)(lru + (size_t)tok * 1024 + 512 + 8 * lane);
            const unsigned f0 = vf.x, f1 = vf.y, f2 = vf.z, f3 = vf.w, b0 = vb.x, b1 = vb.y, b2 = vb.z, b3 = vb.w, g0 = vg.x, g1 = vg.y, g2 = vg.z, g3 = vg.w;
            float y[8];
            y[0] = (__uint_as_float(f0 << 16) + __uint_as_float(b0 << 16)) * gelu_tanh(__uint_as_float(g0 << 16));
            y[1] = (__uint_as_float(f0 & 0xffff0000u) + __uint_as_float(b0 & 0xffff0000u)) * gelu_tanh(__uint_as_float(g0 & 0xffff0000u));
            y[2] = (__uint_as_float(f1 << 16) + __uint_as_float(b1 << 16)) * gelu_tanh(__uint_as_float(g1 << 16));
            y[3] = (__uint_as_float(f1 & 0xffff0000u) + __uint_as_float(b1 & 0xffff0000u)) * gelu_tanh(__uint_as_float(g1 & 0xffff0000u));
            y[4] = (__uint_as_float(f2 << 16) + __uint_as_float(b2 << 16)) * gelu_tanh(__uint_as_float(g2 << 16));
            y[5] = (__uint_as_float(f2 & 0xffff0000u) + __uint_as_float(b2 & 0xffff0000u)) * gelu_tanh(__uint_as_float(g2 & 0xffff0000u));
            y[6] = (__uint_as_float(f3 << 16) + __uint_as_float(b3 << 16)) * gelu_tanh(__uint_as_float(g3 << 16));
            y[7] = (__uint_as_float(f3 & 0xffff0000u) + __uint_as_float(b3 & 0xffff0000u)) * gelu_tanh(__uint_as_float(g3 & 0xffff0000u));
            float s = 0.f;
#pragma unroll
            for (int i = 0; i < 8; ++i) s += y[i] * y[i];
            s = wave_sum(s);
            const float rstd = rsqrtf(s * (1.0f / DL) + EPS);
            const float4 ga0 = *(const float4*)(gA + 8 * lane), ga1 = *(const float4*)(gA + 8 * lane + 4);
            v4u o; o.x = pk2(y[0] * rstd * ga0.x, y[1] * rstd * ga0.y); o.y = pk2(y[2] * rstd * ga0.z, y[3] * rstd * ga0.w);
            o.z = pk2(y[4] * rstd * ga1.x, y[5] * rstd * ga1.y); o.w = pk2(y[6] * rstd * ga1.z, y[7] * rstd * ga1.w);
            *(v4u*)(y_cat + (size_t)tok * 1024 + 8 * lane) = o;
        }
        for (int tile = bid; tile < NTOK / 64; tile += G) {
            __syncthreads();
            const int tok0 = tile * 64;
            for (int ch = tid; ch < 512 * 8; ch += NWAVES * 64) { const int c = ch >> 3, piece = ch & 7;
                const v4u v = *(const v4u*)(y_hyT + (size_t)c * NTOK + tok0 + 8 * piece);
                LAS unsigned* d = (LAS unsigned*)(L + c * 132 + piece * 16); d[0] = v.x; d[1] = v.y; d[2] = v.z; d[3] = v.w; }
            __syncthreads();
            for (int tl = wave; tl < 64; tl += NWAVES) {
                float v[8]; float s = 0.f;
#pragma unroll
                for (int i = 0; i < 4; ++i) { const int c = 2 * lane + 128 * i;
                    v[2 * i] = bf2f(*(const LAS bf16*)(L + c * 132 + tl * 2)); v[2 * i + 1] = bf2f(*(const LAS bf16*)(L + (c + 1) * 132 + tl * 2));
                    s += v[2 * i] * v[2 * i] + v[2 * i + 1] * v[2 * i + 1]; }
                s = wave_sum(s);
                const float rstd = rsqrtf(s * (1.0f / DH) + EPS);
#pragma unroll
                for (int i = 0; i < 4; ++i) { const int c = 2 * lane + 128 * i;
                    *(unsigned*)(y_cat + (size_t)(tok0 + tl) * 1024 + 512 + c) = pk2(v[2 * i] * rstd * gB[c], v[2 * i + 1] * rstd * gB[c + 1]); }
            }
        }
        }
        if (BOTH(3)) GRID_BAR();
    }
    if (IN(4)) {
        pg8::Gemm g{y_cat, WoutT, NTOK, DM, DM}; pg8::StaticOrder S; S.init(NTOK, DM, G, bid);
        pg8::EpiResBf16 E{a.in[0], xmidb, DM};
        pg8::gemm_phase<pg8::EpiResBf16, pg8::StaticOrder, true, true>(L, g, S, E);
        if (BOTH(4)) GRID_BAR();
    }

#ifndef DUP_P5
#define DUP_P5 1
#endif
    for (int rep5 = 0; rep5 < DUP_P5; ++rep5)
    if (IN(5)) {
        const bool dummy = (rep5 + 1 < DUP_P5);
        unsigned* cntg = ctl + (dummy ? 3072 : CW_CNT);
        int* list_ = dummy ? (int*)(ws + 376 * MiB) : list; float* lgate_ = dummy ? (float*)(ws + 380 * MiB) : lgate; int4* tokinfo_ = dummy ? (int4*)(ws + 384 * MiB) : tokinfo;
        bf16* hn2_ = dummy ? (bf16*)(ws + 232 * MiB) : hn2;
        LAS float* lg = (LAS float*)(L + 98304);
        LAS int* cnt_l = (LAS int*)(L + LC_CNT); LAS int* base_l = (LAS int*)(L + LC_BASE);
        const float* gff = a.in[28];
        for (int tile = bid; tile < NTOK / 128; tile += G) {
            __syncthreads();
            for (int ch = tid; ch < 48 * 128; ch += NWAVES * 64) { const int row = ch >> 7, c16 = ch & 127;
                *(LAS v4u*)(L + row * 2048 + ((c16 ^ (row & 15)) << 4)) = *(const v4u*)(WrT + (size_t)row * 1024 + c16 * 8); }
            if (tid < 32) cnt_l[tid] = 0;
            __syncthreads();
            const int tk = lane & 15, kg = lane >> 4;
            const int tokw = tile * 128 + wave * 16 + tk;
            const bf16* xr = xmidb + (size_t)tokw * DM + 8 * kg;
            float s = 0.f;
#pragma unroll 8
            for (int st = 0; st < 32; ++st) { const v4u w = *(const v4u*)(xr + 32 * st); const unsigned w0 = w.x, w1 = w.y, w2 = w.z, w3 = w.w;
                const float e0 = __uint_as_float(w0 << 16), e1 = __uint_as_float(w0 & 0xffff0000u), e2 = __uint_as_float(w1 << 16), e3 = __uint_as_float(w1 & 0xffff0000u);
                const float e4 = __uint_as_float(w2 << 16), e5 = __uint_as_float(w2 & 0xffff0000u), e6 = __uint_as_float(w3 << 16), e7 = __uint_as_float(w3 & 0xffff0000u);
                s += (e0 * e0 + e1 * e1) + (e2 * e2 + e3 * e3) + (e4 * e4 + e5 * e5) + (e6 * e6 + e7 * e7); }
            s += __shfl_xor(s, 16); s += __shfl_xor(s, 32);
            const float rstd = rsqrtf(s * (1.0f / DM) + EPS);
            f32x4_t acc0 = {0.f, 0.f, 0.f, 0.f}, acc1 = acc0, acc2 = acc0;
            bf16* hrow = hn2_ + (size_t)tokw * DM + 8 * kg;
#pragma unroll 4
            for (int st = 0; st < 32; ++st) {
                const v4u xw = *(const v4u*)(xr + 32 * st); const unsigned x0 = xw.x, x1 = xw.y, x2 = xw.z, x3 = xw.w;
                const float4 g0 = *(const float4*)(gff + 32 * st + 8 * kg), g1 = *(const float4*)(gff + 32 * st + 8 * kg + 4);
                v4u w; w.x = pk2(__uint_as_float(x0 << 16) * rstd * g0.x, __uint_as_float(x0 & 0xffff0000u) * rstd * g0.y); w.y = pk2(__uint_as_float(x1 << 16) * rstd * g0.z, __uint_as_float(x1 & 0xffff0000u) * rstd * g0.w);
                w.z = pk2(__uint_as_float(x2 << 16) * rstd * g1.x, __uint_as_float(x2 & 0xffff0000u) * rstd * g1.y); w.w = pk2(__uint_as_float(x3 << 16) * rstd * g1.z, __uint_as_float(x3 & 0xffff0000u) * rstd * g1.w);
                *(v4u*)(hrow + 32 * st) = w;
                const bf16x8_t B = __builtin_bit_cast(bf16x8_t, w);
                const int chs = ((4 * st + kg) ^ tk) << 4;
                const bf16x8_t A0 = *(const LAS bf16x8_t*)(L + (0 + tk) * 2048 + chs), A1 = *(const LAS bf16x8_t*)(L + (16 + tk) * 2048 + chs), A2 = *(const LAS bf16x8_t*)(L + (32 + tk) * 2048 + chs);
                acc0 = __builtin_amdgcn_mfma_f32_16x16x32_bf16(A0, B, acc0, 0, 0, 0);
                acc1 = __builtin_amdgcn_mfma_f32_16x16x32_bf16(A1, B, acc1, 0, 0, 0);
                acc2 = __builtin_amdgcn_mfma_f32_16x16x32_bf16(A2, B, acc2, 0, 0, 0);
            }
            { LAS float* lr = lg + (wave * 16 + tk) * 49 + 4 * kg;
#pragma unroll
              for (int r = 0; r < 4; ++r) { lr[r] = acc0[r]; lr[16 + r] = acc1[r]; lr[32 + r] = acc2[r]; } }
            __syncthreads();
            int e0 = 0, e1 = 0, r0l = 0, r1l = 0; float g0 = 0.f, g1 = 0.f;
            if (tid < 128) {
                const LAS float* lr = lg + tid * 49; const float* bgp = a.in[30]; const float* bep = a.in[32];
                int gi = 0; float gm = lr[0] + bgp[0];
                for (int i = 1; i < 4; ++i) { const float v = lr[i] + bgp[i]; if (v > gm) { gm = v; gi = i; } }
                float gs = 0.f; for (int i = 0; i < 4; ++i) gs += __expf(lr[i] + bgp[i] - gm);
                const float gp = 1.0f / gs;
                const LAS float* le = lr + 4 + gi * 8; const float* beg = bep + gi * 8;
                int i1 = 0; float m1 = le[0] + beg[0];
                for (int i = 1; i < 8; ++i) { const float v = le[i] + beg[i]; if (v > m1) { m1 = v; i1 = i; } }
                int i2 = -1; float m2 = -3.0e38f;
                for (int i = 0; i < 8; ++i) { const float v = le[i] + beg[i]; if (i != i1 && v > m2) { m2 = v; i2 = i; } }
                const float ex2 = __expf(m2 - m1);
                e0 = gi * 8 + i1; e1 = gi * 8 + i2; g0 = gp / (1.0f + ex2); g1 = gp * ex2 / (1.0f + ex2);
                r0l = atomicAdd((int*)(cnt_l + e0), 1); r1l = atomicAdd((int*)(cnt_l + e1), 1);
            }
            __syncthreads();
            if (tid < 32) { const int c = cnt_l[tid]; base_l[tid] = c ? (int)atomicAdd(cntg + tid, (unsigned)c) : 0; }
            __syncthreads();
            if (tid < 128) { const int tok = tile * 128 + tid; const int r0 = base_l[e0] + r0l, r1 = base_l[e1] + r1l;
                list_[e0 * NTOK + r0] = tok; lgate_[e0 * NTOK + r0] = g0; list_[e1 * NTOK + r1] = tok; lgate_[e1 * NTOK + r1] = g1;
                tokinfo_[tok] = make_int4(e0, r0, e1, r1); }
        }
        if (BOTH(5) && !dummy) GRID_BAR();
    }
    if (IN(7)) {
        const int T = moe_tables(L, ctl, tid);
        pg8::Gemm g{hn2, W13T, T * 256, 1024, DM};
        pg8::MoeOrder S{(const LAS int*)(L + LC_TILEE), T, 4, G, bid, (size_t)1024 * 1024 * 2, (const LAS int*)(L + LC_TSTART), (const LAS int*)(L + LC_CNT), list, NTOK, true};
        pg8::EpiSwiGLU E{Hb};
        pg8::gemm_phase<pg8::EpiSwiGLU, pg8::MoeOrder, true, true, true>(L, g, S, E);
        if (BOTH(7)) GRID_BAR();
    }
    if (IN(8)) {
        const int T = moe_tables(L, ctl, tid);
        pg8::Gemm g{Hb, W2T, T * 256, 1024, 512};
        pg8::MoeOrder S{(const LAS int*)(L + LC_TILEE), T, 4, G, bid, (size_t)1024 * 512 * 2, (const LAS int*)(L + LC_TSTART), (const LAS int*)(L + LC_CNT), list, NTOK, false};
        pg8::EpiRowScaleBf16 E{Yb, 1024, lgate, (const LAS int*)(L + LC_TILEE), (const LAS int*)(L + LC_TSTART), (const LAS int*)(L + LC_CNT), NTOK};
        pg8::gemm_phase<pg8::EpiRowScaleBf16, pg8::MoeOrder, true, true, false>(L, g, S, E);
        if (BOTH(8)) GRID_BAR();
    }
#ifndef DUP_P9
#define DUP_P9 1
#endif
    for (int rep9 = 0; rep9 < DUP_P9; ++rep9)
    if (IN(9)) {
        float* outw = (rep9 + 1 < DUP_P9) ? (float*)(ws + 256 * MiB) : a.out;
        (void)moe_tables(L, ctl, tid);
        const LAS int* tstart = (const LAS int*)(L + LC_TSTART);
        const float* gfin = a.in[36];
        for (int tok0 = gw * 4; tok0 < NTOK; tok0 += NGW * 4) {
            float4 v[4][4]; uint2 p[4][4], q[4][4];
#pragma unroll
            for (int u = 0; u < 4; ++u) { const int4 ti = tokinfo[tok0 + u];
                const size_t s0 = (size_t)tstart[ti.x] * 256 + ti.y, s1 = (size_t)tstart[ti.z] * 256 + ti.w;
                const uint2* y0 = (const uint2*)(Yb + s0 * DM); const uint2* y1 = (const uint2*)(Yb + s1 * DM);
                const uint2* xr = (const uint2*)(xmidb + (size_t)(tok0 + u) * DM);
#pragma unroll
                for (int j = 0; j < 4; ++j) { const uint2 xx = xr[lane + 64 * j];
                    v[u][j] = make_float4(__uint_as_float(xx.x << 16), __uint_as_float(xx.x & 0xffff0000u), __uint_as_float(xx.y << 16), __uint_as_float(xx.y & 0xffff0000u));
                    p[u][j] = y0[lane + 64 * j]; q[u][j] = y1[lane + 64 * j]; } }
#pragma unroll
            for (int u = 0; u < 4; ++u) { float s = 0.f;
#pragma unroll
                for (int j = 0; j < 4; ++j) { const uint2 pp = p[u][j], qq = q[u][j];
                    v[u][j].x += __uint_as_float(pp.x << 16) + __uint_as_float(qq.x << 16); v[u][j].y += __uint_as_float(pp.x & 0xffff0000u) + __uint_as_float(qq.x & 0xffff0000u);
                    v[u][j].z += __uint_as_float(pp.y << 16) + __uint_as_float(qq.y << 16); v[u][j].w += __uint_as_float(pp.y & 0xffff0000u) + __uint_as_float(qq.y & 0xffff0000u);
                    s += (v[u][j].x * v[u][j].x + v[u][j].y * v[u][j].y) + (v[u][j].z * v[u][j].z + v[u][j].w * v[u][j].w); }
                s = wave_sum(s);
                const float rstd = rsqrtf(s * (1.0f / DM) + EPS);
                float4* xw = (float4*)(outw + (size_t)(tok0 + u) * DM);
#pragma unroll
                for (int j = 0; j < 4; ++j) { const float4 gg = *(const float4*)(gfin + (lane + 64 * j) * 4);
                    xw[lane + 64 * j] = make_float4(v[u][j].x * rstd * gg.x, v[u][j].y * rstd * gg.y, v[u][j].z * rstd * gg.z, v[u][j].w * rstd * gg.w); } }
        }
    }
#undef IN
#undef BOTH
#undef GRID_BAR
}

static void launch_fwd(const Args& base, int lo, int hi, int li, int grid, hipStream_t stream) {
    Args a = base; a.ph_lo = lo; a.ph_hi = hi; a.li = li; a.pad = 0;
    hipLaunchKernelGGL(fwd, dim3(grid), dim3(NWAVES * 64), LDS_BYTES, stream, a);
}

extern "C" void kernel_launch(void* const* d_in, const int* in_sizes, int n_in, void* d_out, int out_size, void* d_ws, size_t ws_size, hipStream_t stream) {
    (void)in_sizes; (void)n_in; (void)out_size; (void)ws_size;
    static int grid = 0;
    if (grid == 0) {
        int dev = 0, cus = 0;
        (void)hipGetDevice(&dev); (void)hipDeviceGetAttribute(&cus, hipDeviceAttributeMultiprocessorCount, dev);
        (void)hipFuncSetAttribute((const void*)fwd, hipFuncAttributeMaxDynamicSharedMemorySize, LDS_BYTES);
        grid = cus > 0 ? cus : 256;
    }
    const float* const* in = (const float* const*)d_in;
    unsigned char* ws = (unsigned char*)d_ws;
    float* out = (float*)d_out;
    (void)hipMemsetAsync(ws, 0, CTL_ZERO_BYTES, stream);
    Args base{};
    for (int i = 0; i < 37; ++i) base.in[i] = in[i];
    base.out = out; base.ws = ws;

#ifndef MK_PER_PHASE
    launch_fwd(base, 0, 10, 0, grid, stream);
#else
    for (int ph = 0; ph < 10; ++ph) launch_fwd(base, ph, ph + 1, ph, grid, stream);
#endif
}
```
